# Optimizing an MI355X kernel written in HIP

```python
import jax, jax.numpy as jnp
from jax import lax
import numpy as np

D_MODEL = 1024
BATCH = 2
SEQ = 16384
DEPTH = 2

N_MIXERS = 2
N_A_LAYERS = (DEPTH + 1) // 2
N_B_LAYERS = DEPTH // 2
RMS_EPS = 1e-6

GLA_HEADS = 4
GLA_DK = D_MODEL // 2 // GLA_HEADS
GLA_DV = D_MODEL // GLA_HEADS
GLA_GATE_RANK = 16
GLA_TAU = 16.0
GLA_CHUNK = 64
GLA_IN = 2 * GLA_HEADS * GLA_DK + 2 * GLA_HEADS * GLA_DV + GLA_GATE_RANK

SWA_HEAD_DIM = 64
SWA_Q_HEADS = D_MODEL // SWA_HEAD_DIM
SWA_KV_HEADS = 2
SWA_GROUP = SWA_Q_HEADS // SWA_KV_HEADS
SWA_WINDOW = 128
SWA_BLOCK = 128
ROPE_THETA = 500000.0
ROPE_DIM = SWA_HEAD_DIM // 4
SWA_IN = (SWA_Q_HEADS + 2 * SWA_KV_HEADS) * SWA_HEAD_DIM

PEER_HEADS = 8
PEER_N_KEYS = 128
PEER_N_EXPERTS = PEER_N_KEYS * PEER_N_KEYS
PEER_QDIM = 128
PEER_HALF = PEER_QDIM // 2
PEER_TOPK = 16
PEER_TOKEN_BLOCK = 128

kernel_name = "hybrid_gla_swa_peer_trunk"


def rms_norm(t, gain):
    t32 = t.astype(jnp.float32)
    y = t32 * lax.rsqrt(jnp.mean(t32 * t32, axis=-1, keepdims=True) + RMS_EPS)
    return (y * gain.astype(jnp.float32)).astype(t.dtype)


def gla_mixer(h, w_in, w_alpha, b_alpha, norm_gain, w_out):
    B, S, _ = h.shape
    H, dk, dv, C = GLA_HEADS, GLA_DK, GLA_DV, GLA_CHUNK
    proj = h @ w_in
    q, k, v, r, lr = jnp.split(proj, [H * dk, 2 * H * dk, 2 * H * dk + H * dv, 2 * H * dk + 2 * H * dv], axis=-1)
    log_a = jax.nn.log_sigmoid((lr @ w_alpha + b_alpha).astype(jnp.float32)) / GLA_TAU
    nc = S // C

    def to_chunks(t, d):
        return t.astype(jnp.float32).reshape(B, nc, C, H, d).transpose(1, 0, 3, 2, 4)

    qc = to_chunks(q, dk) * (dk ** -0.5)
    kc = to_chunks(k, dk)
    vc = to_chunks(v, dv)
    gc = to_chunks(log_a, dk)
    causal = jnp.tril(jnp.ones((C, C), dtype=bool))

    def step(state, xs):
        qb, kb, vb, gb = xs
        b = jnp.cumsum(gb, axis=-2)
        b_last = b[..., -1:, :]
        q_dec = qb * jnp.exp(b)
        k_inv = kb * jnp.exp(-b)
        attn = jnp.where(causal, jnp.einsum('bhid,bhjd->bhij', q_dec, k_inv), 0.0)
        o = jnp.einsum('bhij,bhjv->bhiv', attn, vb) + jnp.einsum('bhid,bhdv->bhiv', q_dec, state)
        k_fwd = kb * jnp.exp(b_last - b)
        state = jnp.exp(b_last[..., 0, :])[..., None] * state + jnp.einsum('bhjd,bhjv->bhdv', k_fwd, vb)
        return state, o

    s0 = jnp.zeros((B, H, dk, dv), jnp.float32)
    _, o = lax.scan(step, s0, (qc, kc, vc, gc))
    o = o.transpose(1, 0, 3, 2, 4).reshape(B, S, H, dv)
    o = rms_norm(o, norm_gain).reshape(B, S, H * dv)
    o = o * jax.nn.silu(r.astype(jnp.float32))
    return o.astype(h.dtype) @ w_out


def apply_partial_rotary(t, cos, sin):
    half = ROPE_DIM // 2
    t32 = t.astype(jnp.float32)
    x1, x2, rest = t32[..., :half], t32[..., half:ROPE_DIM], t32[..., ROPE_DIM:]
    rot = jnp.concatenate([x1 * cos - x2 * sin, x2 * cos + x1 * sin, rest], axis=-1)
    return rot.astype(t.dtype)


def swa_mixer(h, positions, w_in, b_in, q_gain, k_gain, sinks, w_out, b_out):
    B, S, _ = h.shape
    Hq, Hkv, G, hd, BLK = SWA_Q_HEADS, SWA_KV_HEADS, SWA_GROUP, SWA_HEAD_DIM, SWA_BLOCK
    proj = h @ w_in + b_in
    q, k, v = jnp.split(proj, [Hq * hd, (Hq + Hkv) * hd], axis=-1)
    q = rms_norm(q.reshape(B, S, Hq, hd), q_gain)
    k = rms_norm(k.reshape(B, S, Hkv, hd), k_gain)
    v = v.reshape(B, S, Hkv, hd)
    inv_freq = ROPE_THETA ** (-jnp.arange(0, ROPE_DIM, 2, dtype=jnp.float32) / ROPE_DIM)
    ang = positions.astype(jnp.float32)[..., None] * inv_freq
    cos, sin = jnp.cos(ang)[:, :, None, :], jnp.sin(ang)[:, :, None, :]
    q = apply_partial_rotary(q, cos, sin)
    k = apply_partial_rotary(k, cos, sin)

    nb = S // BLK
    qb = q.reshape(B, nb, BLK, Hkv, G, hd)

    def with_prev(t):
        t = t.reshape(B, nb, BLK, Hkv, hd)
        prev = jnp.pad(t[:, :-1], ((0, 0), (1, 0), (0, 0), (0, 0), (0, 0)))
        return jnp.concatenate([prev, t], axis=2)

    kk, vv = with_prev(k), with_prev(v)
    scores = jnp.einsum('bnqhgd,bnkhd->bhgnqk', qb, kk).astype(jnp.float32) * (hd ** -0.5)
    rel = jnp.arange(BLK)[:, None] + BLK - jnp.arange(2 * BLK)[None, :]
    band = (rel >= 0) & (rel < SWA_WINDOW)
    key_pos = jnp.arange(nb)[:, None] * BLK + jnp.arange(2 * BLK)[None, :] - BLK
    mask = band[None] & (key_pos >= 0)[:, None, :]
    scores = jnp.where(mask, scores, -jnp.inf)
    sink = sinks.astype(jnp.float32).reshape(Hkv, G)[None, :, :, None, None]
    m = jnp.maximum(scores.max(axis=-1), sink)
    p = jnp.exp(scores - m[..., None])
    denom = p.sum(axis=-1) + jnp.exp(sink - m)
    p = p / denom[..., None]
    o = jnp.einsum('bhgnqk,bnkhd->bnqhgd', p.astype(vv.dtype), vv).reshape(B, S, Hq * hd)
    return o @ w_out + b_out


def peer_ffn(h, w_q, sub_keys, u, v):
    B, S, D = h.shape
    T = B * S
    K, BLK = PEER_TOPK, PEER_TOKEN_BLOCK
    xt = h.reshape(T // BLK, BLK, D)

    def block(xb):
        q = (xb @ w_q).reshape(BLK, PEER_HEADS, PEER_QDIM)
        s1 = jnp.einsum('thd,hkd->thk', q[..., :PEER_HALF], sub_keys[:, 0]).astype(jnp.float32)
        s2 = jnp.einsum('thd,hkd->thk', q[..., PEER_HALF:], sub_keys[:, 1]).astype(jnp.float32)
        v1, i1 = lax.top_k(s1, K)
        v2, i2 = lax.top_k(s2, K)
        cand = (v1[..., :, None] + v2[..., None, :]).reshape(BLK, PEER_HEADS, K * K)
        sc, ci = lax.top_k(cand, K)
        e = jnp.take_along_axis(i1, ci // K, axis=-1) * PEER_N_KEYS + jnp.take_along_axis(i2, ci % K, axis=-1)
        g = jax.nn.softmax(sc, axis=-1)
        ue = u[e]
        ve = v[e]
        a = jax.nn.gelu(jnp.einsum('thkd,td->thk', ue, xb).astype(jnp.float32), approximate=False) * g
        return jnp.einsum('thk,thkd->td', a.astype(xb.dtype), ve)

    return lax.map(block, xt).reshape(B, S, D)


def setup_inputs(seed: int = 0) -> dict:
    key = jax.random.key(seed)
    ks = jax.random.split(key, 20)
    f32 = jnp.float32
    D = D_MODEL

    def w(k, shape, fan_in):
        return jax.random.normal(k, shape, f32) * (fan_in ** -0.5)

    def gain(k, shape):
        return 1.0 + 0.02 * jax.random.normal(k, shape, f32)

    return {
        "x": jax.random.normal(ks[0], (BATCH, SEQ, D), f32),
        "positions": jnp.broadcast_to(jnp.arange(SEQ, dtype=jnp.int32), (BATCH, SEQ)),
        "ln_mix": gain(ks[1], (DEPTH, D)),
        "ln_ffn": gain(ks[2], (DEPTH, D)),
        "gla_w_in": w(ks[3], (N_A_LAYERS, D, GLA_IN), D),
        "gla_w_alpha": w(ks[4], (N_A_LAYERS, GLA_GATE_RANK, GLA_HEADS * GLA_DK), GLA_GATE_RANK),
        "gla_b_alpha": 0.1 * jax.random.normal(ks[5], (N_A_LAYERS, GLA_HEADS * GLA_DK), f32),
        "gla_norm": gain(ks[6], (N_A_LAYERS, GLA_HEADS, GLA_DV)),
        "gla_w_out": w(ks[7], (N_A_LAYERS, GLA_HEADS * GLA_DV, D), GLA_HEADS * GLA_DV),
        "swa_w_in": w(ks[8], (N_B_LAYERS, D, SWA_IN), D),
        "swa_b_in": 0.02 * jax.random.normal(ks[9], (N_B_LAYERS, SWA_IN), f32),
        "swa_q_norm": gain(ks[10], (N_B_LAYERS, SWA_HEAD_DIM)),
        "swa_k_norm": gain(ks[11], (N_B_LAYERS, SWA_HEAD_DIM)),
        "swa_sinks": 0.5 * jax.random.normal(ks[12], (N_B_LAYERS, SWA_Q_HEADS), f32),
        "swa_w_out": w(ks[13], (N_B_LAYERS, SWA_Q_HEADS * SWA_HEAD_DIM, D), SWA_Q_HEADS * SWA_HEAD_DIM),
        "swa_b_out": 0.02 * jax.random.normal(ks[14], (N_B_LAYERS, D), f32),
        "peer_w_q": w(ks[15], (DEPTH, D, PEER_HEADS * PEER_QDIM), D),
        "peer_keys": w(ks[16], (DEPTH, PEER_HEADS, 2, PEER_N_KEYS, PEER_HALF), PEER_HALF),
        "peer_u": w(ks[17], (DEPTH, PEER_N_EXPERTS, D), D),
        "peer_v": w(ks[18], (DEPTH, PEER_N_EXPERTS, D), D),
    }


def reference(x, positions, ln_mix, ln_ffn, gla_w_in, gla_w_alpha, gla_b_alpha, gla_norm, gla_w_out,
              swa_w_in, swa_b_in, swa_q_norm, swa_k_norm, swa_sinks, swa_w_out, swa_b_out,
              peer_w_q, peer_keys, peer_u, peer_v):
    h = x
    for layer in range(DEPTH):
        j = layer // N_MIXERS
        hn = rms_norm(h, ln_mix[layer])
        if layer % N_MIXERS == 0:
            mix = gla_mixer(hn, gla_w_in[j], gla_w_alpha[j], gla_b_alpha[j], gla_norm[j], gla_w_out[j])
        else:
            mix = swa_mixer(hn, positions, swa_w_in[j], swa_b_in[j], swa_q_norm[j], swa_k_norm[j],
                            swa_sinks[j], swa_w_out[j], swa_b_out[j])
        h = h + mix
        h = h + peer_ffn(rms_norm(h, ln_ffn[layer]), peer_w_q[layer], peer_keys[layer], peer_u[layer], peer_v[layer])
    return h
```

```cpp
#include <hip/hip_runtime.h>
#include <hip/hip_cooperative_groups.h>
#include <stdint.h>
#include <stdio.h>
namespace cg = cooperative_groups;

#ifndef MULTI_LAUNCH
#define MULTI_LAUNCH 1
#endif

#define DI __device__ __forceinline__
typedef unsigned short bf16_t;
typedef __attribute__((ext_vector_type(8))) short bf16x8;
typedef __attribute__((ext_vector_type(16))) float f32x16;
typedef __bf16 bf16x2_t __attribute__((ext_vector_type(2)));
typedef float f32x2_t __attribute__((ext_vector_type(2)));

constexpr int T_TOK = 32768;
constexpr int SEQ = 16384;
constexpr int DM = 1024;
constexpr int NPHASE = 20;

constexpr size_t MiB = 1048576;
constexpr size_t OFF_WT_GLA_IN = 0;
constexpr size_t OFF_WT_GLA_OUT = 7 * MiB;
constexpr size_t OFF_WT_SWA_IN = 9 * MiB;
constexpr size_t OFF_WT_SWA_OUT = 12 * MiB;
constexpr size_t OFF_WT_PQ = 14 * MiB;
constexpr size_t OFF_KEYS = 18 * MiB;
constexpr size_t OFF_TBL_U = 24 * MiB;
constexpr size_t OFF_TBL_V = 56 * MiB;
constexpr size_t OFF_ACT_A = 88 * MiB;
constexpr size_t OFF_BIG = 152 * MiB;
constexpr size_t OFF_E = OFF_BIG + 64 * MiB;
constexpr size_t OFF_G = OFF_BIG + 80 * MiB;
constexpr size_t OFF_KVT = 344 * MiB;
constexpr size_t OFF_ACT_B = OFF_KVT;
constexpr size_t OFF_LR = 472 * MiB;
constexpr size_t OFF_DECAY = 474 * MiB;

constexpr int SMEM_BYTES = 73728;
constexpr int LDK = 72;

struct Params {
  const float* x; const int* pos; const float* ln_mix; const float* ln_ffn;
  const float* gla_w_in; const float* gla_w_alpha; const float* gla_b_alpha; const float* gla_norm; const float* gla_w_out;
  const float* swa_w_in; const float* swa_b_in; const float* swa_qn; const float* swa_kn; const float* swa_sinks;
  const float* swa_w_out; const float* swa_b_out;
  const float* peer_wq; const float* peer_keys; const float* peer_u; const float* peer_v;
  float* out; char* ws;
  int phase_lo, phase_hi;
};

DI unsigned pk(float lo, float hi) { f32x2_t v = {lo, hi}; bf16x2_t b = __builtin_convertvector(v, bf16x2_t); return __builtin_bit_cast(unsigned, b); }
DI bf16_t f2bf(float x) { return (bf16_t)(pk(x, 0.f) & 0xffffu); }
DI float bflo(unsigned w) { return __uint_as_float(w << 16); }
DI float bfhi(unsigned w) { return __uint_as_float(w & 0xffff0000u); }
DI float bf2f(bf16_t b) { return __uint_as_float(((unsigned)b) << 16); }
DI float dot2(unsigned a, unsigned b, float c) { return __builtin_amdgcn_fdot2_f32_bf16(__builtin_bit_cast(bf16x2_t, a), __builtin_bit_cast(bf16x2_t, b), c, false); }
DI int crow(int i, int h) { return (i & 3) + 8 * (i >> 2) + 4 * h; }
DI f32x16 mfma32(bf16x8 a, bf16x8 b, f32x16 c) { return __builtin_amdgcn_mfma_f32_32x32x16_bf16(a, b, c, 0, 0, 0); }
DI f32x16 zero16() { f32x16 z; for (int i = 0; i < 16; ++i) z[i] = 0.f; return z; }
DI void wave_sync() { __builtin_amdgcn_fence(__ATOMIC_RELEASE, "wavefront"); __builtin_amdgcn_wave_barrier(); __builtin_amdgcn_fence(__ATOMIC_ACQUIRE, "wavefront"); }
DI int mbcnt64(unsigned long long m) { return __builtin_amdgcn_mbcnt_hi((unsigned)(m >> 32), __builtin_amdgcn_mbcnt_lo((unsigned)m, 0)); }
DI float logsig(float z) { return fminf(z, 0.f) - log1pf(__expf(-fabsf(z))); }

DI void transpose_tile(const float* __restrict__ src, int N, bf16_t* __restrict__ dst, int kt, int nt, float* sT) {
  const int tid = threadIdx.x;
  const int r = tid >> 4, c4 = (tid & 15) * 4;
#pragma unroll
  for (int i = 0; i < 4; ++i) {
    const int k = kt * 64 + r + 16 * i, n = nt * 64 + c4;
    float4 v = make_float4(0.f, 0.f, 0.f, 0.f);
    if (n + 3 < N) v = *(const float4*)(src + (size_t)k * N + n);
    float* d = sT + (r + 16 * i) * 65 + c4;
    d[0] = v.x; d[1] = v.y; d[2] = v.z; d[3] = v.w;
  }
  __syncthreads();
  const int n = tid >> 2, seg = tid & 3;
  unsigned w[8];
#pragma unroll
  for (int j = 0; j < 8; ++j) w[j] = pk(sT[(seg * 16 + 2 * j) * 65 + n], sT[(seg * 16 + 2 * j + 1) * 65 + n]);
  uint4* d = (uint4*)(dst + (size_t)(nt * 64 + n) * 1024 + kt * 64 + seg * 16);
  d[0] = make_uint4(w[0], w[1], w[2], w[3]);
  d[1] = make_uint4(w[4], w[5], w[6], w[7]);
  __syncthreads();
}

DI void cvt_elems(const float* __restrict__ src, bf16_t* __restrict__ dst, size_t n8) {
  for (size_t i = (size_t)blockIdx.x * 256 + threadIdx.x; i < n8; i += (size_t)gridDim.x * 256) {
    const float4 a = ((const float4*)src)[2 * i], b = ((const float4*)src)[2 * i + 1];
    ((uint4*)dst)[i] = make_uint4(pk(a.x, a.y), pk(a.z, a.w), pk(b.x, b.y), pk(b.z, b.w));
  }
}

DI void phase_convert(const Params& p, char* smem) {
  float* sT = (float*)smem;
  for (int t = blockIdx.x; t < 2144; t += gridDim.x) {
    const float* src; int N, ntn; bf16_t* dst; int local;
    if (t < 800) { src = p.gla_w_in; N = 3088; ntn = 50; dst = (bf16_t*)(p.ws + OFF_WT_GLA_IN); local = t; }
    else if (t < 1056) { src = p.gla_w_out; N = 1024; ntn = 16; dst = (bf16_t*)(p.ws + OFF_WT_GLA_OUT); local = t - 800; }
    else if (t < 1376) { src = p.swa_w_in; N = 1280; ntn = 20; dst = (bf16_t*)(p.ws + OFF_WT_SWA_IN); local = t - 1056; }
    else if (t < 1632) { src = p.swa_w_out; N = 1024; ntn = 16; dst = (bf16_t*)(p.ws + OFF_WT_SWA_OUT); local = t - 1376; }
    else if (t < 1888) { src = p.peer_wq; N = 1024; ntn = 16; dst = (bf16_t*)(p.ws + OFF_WT_PQ); local = t - 1632; }
    else { src = p.peer_wq + (size_t)1024 * 1024; N = 1024; ntn = 16; dst = (bf16_t*)(p.ws + OFF_WT_PQ) + (size_t)1024 * 1024; local = t - 1888; }
    transpose_tile(src, N, dst, local / ntn, local % ntn, sT);
  }
  cvt_elems(p.peer_keys, (bf16_t*)(p.ws + OFF_KEYS), (size_t)2 * 8 * 2 * 128 * 64 / 8);
}

DI void phase_cvt_tables(const Params& p, int layer) {
  cvt_elems(p.peer_u + (size_t)layer * 16384 * 1024, (bf16_t*)(p.ws + OFF_TBL_U), (size_t)16384 * 1024 / 8);
  cvt_elems(p.peer_v + (size_t)layer * 16384 * 1024, (bf16_t*)(p.ws + OFF_TBL_V), (size_t)16384 * 1024 / 8);
}

DI void phase_rmsnorm(const float* __restrict__ src, const float* __restrict__ gain, bf16_t* __restrict__ dst) {
  const int lane = threadIdx.x & 63, w = threadIdx.x >> 6;
  for (int row = blockIdx.x * 4 + w; row < T_TOK; row += gridDim.x * 4) {
    const float4* sp = (const float4*)(src + (size_t)row * DM);
    float4 v[4];
    float ss = 0.f;
#pragma unroll
    for (int i = 0; i < 4; ++i) { v[i] = sp[lane + 64 * i]; ss += v[i].x * v[i].x + v[i].y * v[i].y + v[i].z * v[i].z + v[i].w * v[i].w; }
#pragma unroll
    for (int o = 32; o >= 1; o >>= 1) ss += __shfl_xor(ss, o);
    const float rs = rsqrtf(ss * (1.f / 1024.f) + 1e-6f);
#pragma unroll
    for (int i = 0; i < 4; ++i) {
      const float4 g = ((const float4*)gain)[lane + 64 * i];
      uint2 o2 = make_uint2(pk(v[i].x * rs * g.x, v[i].y * rs * g.y), pk(v[i].z * rs * g.z, v[i].w * rs * g.w));
      *(uint2*)(dst + (size_t)row * DM + (lane + 64 * i) * 4) = o2;
    }
  }
}

DI void mma_64x64(const bf16_t* sA, const bf16_t* sB, int arow0, int brow0, f32x16 (&acc)[2][2], int lane) {
  const int r = lane & 31, h = lane >> 5;
#pragma unroll
  for (int s = 0; s < 4; ++s) {
    bf16x8 a[2], b[2];
#pragma unroll
    for (int mi = 0; mi < 2; ++mi) a[mi] = *(const bf16x8*)(sA + (arow0 + mi * 32 + r) * LDK + s * 16 + h * 8);
#pragma unroll
    for (int ni = 0; ni < 2; ++ni) b[ni] = *(const bf16x8*)(sB + (brow0 + ni * 32 + r) * LDK + s * 16 + h * 8);
#pragma unroll
    for (int mi = 0; mi < 2; ++mi)
#pragma unroll
      for (int ni = 0; ni < 2; ++ni) acc[mi][ni] = mfma32(a[mi], b[ni], acc[mi][ni]);
  }
}

enum { EPI_GLA_IN = 0, EPI_RESID_X = 1, EPI_BF16 = 2, EPI_RESID_INPLACE = 3 };

template <int MODE>
DI void gemm_tile(const Params& p, const bf16_t* __restrict__ A, const bf16_t* __restrict__ Bt, int m0, int n0,
                  bf16_t* dstb, int ldc, const float* __restrict__ bias, char* smem) {
  bf16_t* sA = (bf16_t*)smem;
  bf16_t* sB = sA + 128 * LDK;
  const int tid = threadIdx.x, lane = tid & 63, w = tid >> 6, wm = w >> 1, wn = w & 1;
  f32x16 acc[2][2];
#pragma unroll
  for (int i = 0; i < 2; ++i)
#pragma unroll
    for (int j = 0; j < 2; ++j) acc[i][j] = zero16();
  bf16x8 ra[4], rb[4];
  const int lrow = tid >> 3, kc = tid & 7;
  const bf16_t* ap = A + (size_t)(m0 + lrow) * 1024 + kc * 8;
  const bf16_t* bp = Bt + (size_t)(n0 + lrow) * 1024 + kc * 8;
#pragma unroll
  for (int i = 0; i < 4; ++i) { ra[i] = *(const bf16x8*)(ap + (size_t)i * 32 * 1024); rb[i] = *(const bf16x8*)(bp + (size_t)i * 32 * 1024); }
  __syncthreads();
#pragma unroll
  for (int i = 0; i < 4; ++i) { *(bf16x8*)(sA + (lrow + 32 * i) * LDK + kc * 8) = ra[i]; *(bf16x8*)(sB + (lrow + 32 * i) * LDK + kc * 8) = rb[i]; }
  __syncthreads();
  for (int kt = 0; kt < 16; ++kt) {
    if (kt + 1 < 16) {
#pragma unroll
      for (int i = 0; i < 4; ++i) { ra[i] = *(const bf16x8*)(ap + (size_t)i * 32 * 1024 + (kt + 1) * 64); rb[i] = *(const bf16x8*)(bp + (size_t)i * 32 * 1024 + (kt + 1) * 64); }
    }
    mma_64x64(sA, sB, wm * 64, wn * 64, acc, lane);
    __syncthreads();
    if (kt + 1 < 16) {
#pragma unroll
      for (int i = 0; i < 4; ++i) { *(bf16x8*)(sA + (lrow + 32 * i) * LDK + kc * 8) = ra[i]; *(bf16x8*)(sB + (lrow + 32 * i) * LDK + kc * 8) = rb[i]; }
      __syncthreads();
    }
  }
  const int r = lane & 31, h = lane >> 5;
#pragma unroll
  for (int mi = 0; mi < 2; ++mi)
#pragma unroll
    for (int ni = 0; ni < 2; ++ni) {
      const int col = n0 + wn * 64 + ni * 32 + r;
#pragma unroll
      for (int i = 0; i < 16; ++i) {
        const int row = m0 + wm * 64 + mi * 32 + crow(i, h);
        const float v = acc[mi][ni][i];
        if (MODE == EPI_GLA_IN) {
          if (col < 3072) dstb[(size_t)row * 3072 + col] = f2bf(v);
          else if (col < 3088) ((float*)(p.ws + OFF_LR))[(size_t)row * 16 + (col - 3072)] = v;
        } else if (MODE == EPI_RESID_X) {
          p.out[(size_t)row * 1024 + col] = p.x[(size_t)row * 1024 + col] + v;
        } else if (MODE == EPI_BF16) {
          dstb[(size_t)row * ldc + col] = f2bf(bias ? v + bias[col] : v);
        } else {
          p.out[(size_t)row * 1024 + col] += v + bias[col];
        }
      }
    }
}

template <int MODE>
DI void phase_gemm(const Params& p, const bf16_t* A, const bf16_t* Bt, int NT, bf16_t* dstb, int ldc, const float* bias, char* smem) {
  const int ntiles = (T_TOK / 128) * NT;
  for (int t = blockIdx.x; t < ntiles; t += gridDim.x) gemm_tile<MODE>(p, A, Bt, (t / NT) * 128, (t % NT) * 128, dstb, ldc, bias, smem);
}

DI float gate_la(const float* lr_s, int t, const float (&wa)[16], float ba) {
  float z = ba;
#pragma unroll
  for (int j = 0; j < 16; ++j) z += lr_s[t * 16 + j] * wa[j];
  return logsig(z) * (1.f / 16.f);
}
DI void gla_gates(const Params& p, int t0, int hh, float (&wa)[16], float& ba, float& offset, float& blast, float* lr_s, float* tot_s) {
  const int tid = threadIdx.x, d = tid & 127, half = tid >> 7;
  const float* LR = (const float*)(p.ws + OFF_LR);
  ((float4*)lr_s)[tid] = ((const float4*)(LR + (size_t)t0 * 16))[tid];
#pragma unroll
  for (int j = 0; j < 16; ++j) wa[j] = p.gla_w_alpha[j * 512 + hh * 128 + d];
  ba = p.gla_b_alpha[hh * 128 + d];
  __syncthreads();
  float sum = 0.f;
#pragma unroll 4
  for (int tt = 0; tt < 32; ++tt) sum += gate_la(lr_s, half * 32 + tt, wa, ba);
  tot_s[half * 128 + d] = sum;
  __syncthreads();
  offset = half ? tot_s[d] : 0.f;
  blast = tot_s[d] + tot_s[128 + d];
}

DI void fill_vT(const bf16_t* __restrict__ QKVR, int t0, int hh, int vh, bf16_t* vT) {
  const int tid = threadIdx.x, v = tid & 127, half = tid >> 7;
#pragma unroll 8
  for (int tt = 0; tt < 32; ++tt) {
    const int t = half * 32 + tt;
    vT[v * LDK + t] = QKVR[(size_t)(t0 + t) * 3072 + 1024 + hh * 256 + vh * 128 + v];
  }
}

DI void gla_phase1(const Params& p, int item, char* smem) {
  const int hh = item & 3, c = (item >> 2) & 255, b = item >> 10;
  const int t0 = b * SEQ + c * 64;
  float* lr_s = (float*)smem;
  float* tot_s = (float*)(smem + 4096);
  bf16_t* kfT = (bf16_t*)(smem + 5120);
  bf16_t* vT = kfT + 128 * LDK;
  const bf16_t* QKVR = (const bf16_t*)(p.ws + OFF_BIG);
  bf16_t* KVT = (bf16_t*)(p.ws + OFF_KVT);
  float* DECAY = (float*)(p.ws + OFF_DECAY);
  const int tid = threadIdx.x, lane = tid & 63, w = tid >> 6, wm = w >> 1, wn = w & 1;
  const int d = tid & 127, half = tid >> 7;
  float wa[16], ba, offset, blast;
  gla_gates(p, t0, hh, wa, ba, offset, blast, lr_s, tot_s);
  float run = offset;
#pragma unroll 4
  for (int tt = 0; tt < 32; ++tt) {
    const int t = half * 32 + tt;
    run += gate_la(lr_s, t, wa, ba);
    const float kv = bf2f(QKVR[(size_t)(t0 + t) * 3072 + 512 + hh * 128 + d]);
    kfT[d * LDK + t] = f2bf(kv * __expf(blast - run));
  }
  if (half == 0) DECAY[(size_t)item * 128 + d] = __expf(blast);
  const int r = lane & 31, h = lane >> 5;
  for (int vh = 0; vh < 2; ++vh) {
    __syncthreads();
    fill_vT(QKVR, t0, hh, vh, vT);
    __syncthreads();
    f32x16 acc[2][2];
#pragma unroll
    for (int i = 0; i < 2; ++i)
#pragma unroll
      for (int j = 0; j < 2; ++j) acc[i][j] = zero16();
    mma_64x64(vT, kfT, wm * 64, wn * 64, acc, lane);
    bf16_t* kbase = KVT + (size_t)item * 32768 + (vh * 128 + wm * 64 + 4 * h) * 128 + wn * 64 + r;
#pragma unroll
    for (int mi = 0; mi < 2; ++mi)
#pragma unroll
      for (int ni = 0; ni < 2; ++ni)
#pragma unroll
        for (int i = 0; i < 16; ++i) kbase[(mi * 32 + (i & 3) + 8 * (i >> 2)) * 128 + ni * 32] = f2bf(acc[mi][ni][i]);
  }
  __syncthreads();
}

DI void gla_scan(const Params& p) {
  bf16_t* KVT = (bf16_t*)(p.ws + OFF_KVT);
  const float* DECAY = (const float*)(p.ws + OFF_DECAY);
  for (int idx = blockIdx.x * 256 + threadIdx.x; idx < 8 * 16384; idx += gridDim.x * 256) {
    const int bh = idx >> 14, e2 = idx & 16383, b = bh >> 2, hh = bh & 3, d0 = (2 * e2) & 127;
    float s0 = 0.f, s1 = 0.f;
    for (int c0 = 0; c0 < 256; c0 += 8) {
      unsigned kv[8]; float2 dc[8];
#pragma unroll
      for (int u = 0; u < 8; ++u) {
        const size_t item = (size_t)(b * 256 + c0 + u) * 4 + hh;
        kv[u] = *(const unsigned*)(KVT + item * 32768 + 2 * e2);
        dc[u] = *(const float2*)(DECAY + item * 128 + d0);
      }
#pragma unroll
      for (int u = 0; u < 8; ++u) {
        const size_t item = (size_t)(b * 256 + c0 + u) * 4 + hh;
        *(unsigned*)(KVT + item * 32768 + 2 * e2) = pk(s0, s1);
        s0 = dc[u].x * s0 + bflo(kv[u]);
        s1 = dc[u].y * s1 + bfhi(kv[u]);
      }
    }
  }
}

DI void gla_phase3(const Params& p, int item, char* smem) {
  const int hh = item & 3, c = (item >> 2) & 255, b = item >> 10;
  const int t0 = b * SEQ + c * 64;
  float* lr_s = (float*)smem;
  float* tot_s = (float*)(smem + 4096);
  bf16_t* qd = (bf16_t*)(smem + 5120);
  bf16_t* ki = qd + 64 * 136;
  bf16_t* at = ki + 64 * 136;
  bf16_t* vT = at + 64 * 72;
  bf16_t* ot = qd;
  const bf16_t* QKVR = (const bf16_t*)(p.ws + OFF_BIG);
  const bf16_t* ST = (const bf16_t*)(p.ws + OFF_KVT);
  bf16_t* OG = (bf16_t*)(p.ws + OFF_ACT_A);
  const int tid = threadIdx.x, lane = tid & 63, w = tid >> 6;
  const int d = tid & 127, half = tid >> 7;
  const int r = lane & 31, h = lane >> 5;
  {
    float wa[16], ba, offset, blast;
    gla_gates(p, t0, hh, wa, ba, offset, blast, lr_s, tot_s);
    float run = offset;
#pragma unroll 4
    for (int tt = 0; tt < 32; ++tt) {
      const int t = half * 32 + tt;
      run += gate_la(lr_s, t, wa, ba);
      const float q = bf2f(QKVR[(size_t)(t0 + t) * 3072 + hh * 128 + d]);
      const float k = bf2f(QKVR[(size_t)(t0 + t) * 3072 + 512 + hh * 128 + d]);
      qd[t * 136 + d] = f2bf(q * 0.08838834764831845f * __expf(run));
      ki[t * 136 + d] = f2bf(k * __expf(-run));
    }
  }
  __syncthreads();
  {
    const int mi = w >> 1, nj = w & 1;
    f32x16 a = zero16();
#pragma unroll
    for (int s = 0; s < 8; ++s) {
      const bf16x8 A = *(const bf16x8*)(qd + (mi * 32 + r) * 136 + s * 16 + h * 8);
      const bf16x8 B = *(const bf16x8*)(ki + (nj * 32 + r) * 136 + s * 16 + h * 8);
      a = mfma32(A, B, a);
    }
#pragma unroll
    for (int i = 0; i < 16; ++i) {
      const int it = mi * 32 + crow(i, h), jt = nj * 32 + r;
      at[it * 72 + jt] = f2bf(jt <= it ? a[i] : 0.f);
    }
  }
  f32x16 o[2][2];
#pragma unroll
  for (int i = 0; i < 2; ++i)
#pragma unroll
    for (int j = 0; j < 2; ++j) o[i][j] = zero16();
#pragma unroll
  for (int vh = 0; vh < 2; ++vh) {
    __syncthreads();
    fill_vT(QKVR, t0, hh, vh, vT);
    __syncthreads();
#pragma unroll
    for (int s = 0; s < 4; ++s) {
      const bf16x8 B = *(const bf16x8*)(vT + (w * 32 + r) * LDK + s * 16 + h * 8);
#pragma unroll
      for (int mt = 0; mt < 2; ++mt) {
        const bf16x8 A = *(const bf16x8*)(at + (mt * 32 + r) * 72 + s * 16 + h * 8);
        o[vh][mt] = mfma32(A, B, o[vh][mt]);
      }
    }
    const bf16_t* Sg = ST + (size_t)item * 32768 + (size_t)(vh * 128 + w * 32 + r) * 128 + h * 8;
#pragma unroll
    for (int s = 0; s < 8; ++s) {
      const bf16x8 B = *(const bf16x8*)(Sg + s * 16);
#pragma unroll
      for (int mt = 0; mt < 2; ++mt) {
        const bf16x8 A = *(const bf16x8*)(qd + (mt * 32 + r) * 136 + s * 16 + h * 8);
        o[vh][mt] = mfma32(A, B, o[vh][mt]);
      }
    }
  }
  __syncthreads();
#pragma unroll
  for (int vh = 0; vh < 2; ++vh)
#pragma unroll
    for (int mt = 0; mt < 2; ++mt)
#pragma unroll
      for (int i = 0; i < 16; ++i) ot[(mt * 32 + crow(i, h)) * 264 + vh * 128 + w * 32 + r] = f2bf(o[vh][mt][i]);
  __syncthreads();
  {
    const int row = tid >> 2, seg = tid & 3;
    const bf16_t* orow = ot + row * 264 + seg * 64;
    float ss = 0.f;
#pragma unroll
    for (int c8 = 0; c8 < 8; ++c8) {
      const uint4 ov = *(const uint4*)(orow + c8 * 8);
      const float f0 = bflo(ov.x), f1 = bfhi(ov.x), f2 = bflo(ov.y), f3 = bfhi(ov.y), f4 = bflo(ov.z), f5 = bfhi(ov.z), f6 = bflo(ov.w), f7 = bfhi(ov.w);
      ss += f0 * f0 + f1 * f1 + f2 * f2 + f3 * f3 + f4 * f4 + f5 * f5 + f6 * f6 + f7 * f7;
    }
    ss += __shfl_xor(ss, 1);
    ss += __shfl_xor(ss, 2);
    const float rs = rsqrtf(ss * (1.f / 256.f) + 1e-6f);
    const bf16_t* rrow = QKVR + (size_t)(t0 + row) * 3072 + 2048 + hh * 256 + seg * 64;
    const float* grow = p.gla_norm + hh * 256 + seg * 64;
    bf16_t* dst = OG + (size_t)(t0 + row) * 1024 + hh * 256 + seg * 64;
#pragma unroll
    for (int c8 = 0; c8 < 8; ++c8) {
      const uint4 ov = *(const uint4*)(orow + c8 * 8);
      const uint4 rv = *(const uint4*)(rrow + c8 * 8);
      const float4 g0 = *(const float4*)(grow + c8 * 8), g1 = *(const float4*)(grow + c8 * 8 + 4);
      float of[8] = {bflo(ov.x), bfhi(ov.x), bflo(ov.y), bfhi(ov.y), bflo(ov.z), bfhi(ov.z), bflo(ov.w), bfhi(ov.w)};
      float rf[8] = {bflo(rv.x), bfhi(rv.x), bflo(rv.y), bfhi(rv.y), bflo(rv.z), bfhi(rv.z), bflo(rv.w), bfhi(rv.w)};
      float gf[8] = {g0.x, g0.y, g0.z, g0.w, g1.x, g1.y, g1.z, g1.w};
      float res[8];
#pragma unroll
      for (int e = 0; e < 8; ++e) res[e] = of[e] * rs * gf[e] * (rf[e] / (1.f + __expf(-rf[e])));
      *(uint4*)(dst + c8 * 8) = make_uint4(pk(res[0], res[1]), pk(res[2], res[3]), pk(res[4], res[5]), pk(res[6], res[7]));
    }
  }
  __syncthreads();
}

DI void swa_qknorm(const Params& p) {
  bf16_t* QKV = (bf16_t*)(p.ws + OFF_BIG);
  const int tid = threadIdx.x, sub = tid & 7;
  const int ngroups = T_TOK * 18;
  for (int g = blockIdx.x * 32 + (tid >> 3); g < ngroups; g += gridDim.x * 32) {
    const int tok = g / 18, slot = g - tok * 18;
    bf16_t* ptr = QKV + (size_t)tok * 1280 + slot * 64 + sub * 8;
    const uint4 wv = *(const uint4*)ptr;
    float v[8] = {bflo(wv.x), bfhi(wv.x), bflo(wv.y), bfhi(wv.y), bflo(wv.z), bfhi(wv.z), bflo(wv.w), bfhi(wv.w)};
    float ss = 0.f;
#pragma unroll
    for (int e = 0; e < 8; ++e) ss += v[e] * v[e];
    ss += __shfl_xor(ss, 1);
    ss += __shfl_xor(ss, 2);
    ss += __shfl_xor(ss, 4);
    const float rs = rsqrtf(ss * (1.f / 64.f) + 1e-6f);
    const float* gain = (slot < 16 ? p.swa_qn : p.swa_kn) + sub * 8;
#pragma unroll
    for (int e = 0; e < 8; ++e) v[e] = v[e] * rs * gain[e];
    const float posf = (float)p.pos[tok];
    const float invf[8] = {1.0f, 0.1939227432012558f, 0.03760603070259094f, 0.007292664609849453f,
                           0.0014142135623842478f, 0.00027424818836152554f, 5.318296098266728e-05f, 1.0313386155758053e-05f};
#pragma unroll
    for (int e = 0; e < 8; ++e) {
      const float other = __shfl_xor(v[e], 1);
      if (sub < 2) {
        const float ang = posf * invf[e];
        const double rev = (double)ang * 0.15915494309189535;
        const float fr = (float)(rev - rint(rev));
        const float sn = __builtin_amdgcn_sinf(fr), cs = __builtin_amdgcn_cosf(fr);
        v[e] = (sub == 0) ? (v[e] * cs - other * sn) : (v[e] * cs + other * sn);
      }
    }
    if (slot < 16) {
#pragma unroll
      for (int e = 0; e < 8; ++e) v[e] *= 0.125f;
    }
    *(uint4*)ptr = make_uint4(pk(v[0], v[1]), pk(v[2], v[3]), pk(v[4], v[5]), pk(v[6], v[7]));
  }
}

DI void swa_attn(const Params& p, int item, char* smem) {
  const int hq = item & 15, n = (item >> 4) & 127, b = item >> 11, hkv = hq >> 3;
  const int tok0 = b * SEQ + n * 128;
  bf16_t* Ks = (bf16_t*)smem;
  bf16_t* vT = Ks + 256 * 72;
  const bf16_t* QKV = (const bf16_t*)(p.ws + OFF_BIG);
  bf16_t* OUT = (bf16_t*)(p.ws + OFF_ACT_B);
  const int tid = threadIdx.x, lane = tid & 63, w = tid >> 6, r = lane & 31, h = lane >> 5;
  __syncthreads();
#pragma unroll
  for (int i = 0; i < 8; ++i) {
    const int cidx = tid + 256 * i, kk = cidx >> 3, kc = cidx & 7;
    const int pos = n * 128 - 128 + kk;
    uint4 kw = make_uint4(0, 0, 0, 0), vw = make_uint4(0, 0, 0, 0);
    if (pos >= 0) {
      const bf16_t* base = QKV + (size_t)(b * SEQ + pos) * 1280;
      kw = *(const uint4*)(base + 1024 + hkv * 64 + kc * 8);
      vw = *(const uint4*)(base + 1152 + hkv * 64 + kc * 8);
    }
    *(uint4*)(Ks + kk * 72 + kc * 8) = kw;
    bf16_t* vd = vT + (kc * 8) * 264 + kk;
    vd[0 * 264] = (bf16_t)(vw.x & 0xffff); vd[1 * 264] = (bf16_t)(vw.x >> 16);
    vd[2 * 264] = (bf16_t)(vw.y & 0xffff); vd[3 * 264] = (bf16_t)(vw.y >> 16);
    vd[4 * 264] = (bf16_t)(vw.z & 0xffff); vd[5 * 264] = (bf16_t)(vw.z >> 16);
    vd[6 * 264] = (bf16_t)(vw.w & 0xffff); vd[7 * 264] = (bf16_t)(vw.w >> 16);
  }
  __syncthreads();
  const int iq = 32 * w + r;
  const bf16_t* qrow = QKV + (size_t)(tok0 + iq) * 1280 + hq * 64 + h * 8;
  bf16x8 qf[4];
#pragma unroll
  for (int s = 0; s < 4; ++s) qf[s] = *(const bf16x8*)(qrow + s * 16);
  f32x16 X[5];
#pragma unroll
  for (int kt = 0; kt < 5; ++kt) {
    X[kt] = zero16();
#pragma unroll
    for (int s = 0; s < 4; ++s) {
      const bf16x8 A = *(const bf16x8*)(Ks + ((w + kt) * 32 + r) * 72 + s * 16 + h * 8);
      X[kt] = mfma32(A, qf[s], X[kt]);
    }
  }
  const float sink = p.swa_sinks[hq];
  float m = sink;
#pragma unroll
  for (int kt = 0; kt < 5; ++kt)
#pragma unroll
    for (int i = 0; i < 16; ++i) {
      const int kk = (w + kt) * 32 + crow(i, h);
      const bool valid = (kk > iq) && (kk <= iq + 128) && (n > 0 || kk >= 128);
      const float xv = valid ? X[kt][i] : -INFINITY;
      X[kt][i] = xv;
      m = fmaxf(m, xv);
    }
  m = fmaxf(m, __shfl_xor(m, 32));
  float l = 0.f;
#pragma unroll
  for (int kt = 0; kt < 5; ++kt)
#pragma unroll
    for (int i = 0; i < 16; ++i) {
      const float pv = __expf(X[kt][i] - m);
      X[kt][i] = pv;
      l += pv;
    }
  l += __shfl_xor(l, 32);
  l += __expf(sink - m);
  f32x16 O[2];
  O[0] = zero16(); O[1] = zero16();
#pragma unroll
  for (int kt = 0; kt < 5; ++kt)
#pragma unroll
    for (int s2 = 0; s2 < 2; ++s2) {
      const uint4 pw = make_uint4(pk(X[kt][8 * s2 + 0], X[kt][8 * s2 + 1]), pk(X[kt][8 * s2 + 2], X[kt][8 * s2 + 3]),
                                  pk(X[kt][8 * s2 + 4], X[kt][8 * s2 + 5]), pk(X[kt][8 * s2 + 6], X[kt][8 * s2 + 7]));
      const bf16x8 P = __builtin_bit_cast(bf16x8, pw);
#pragma unroll
      for (int mt = 0; mt < 2; ++mt) {
        const bf16_t* vp = vT + (mt * 32 + r) * 264 + (w + kt) * 32 + 16 * s2 + 4 * h;
        const uint2 lo = *(const uint2*)vp, hi = *(const uint2*)(vp + 8);
        const bf16x8 A = __builtin_bit_cast(bf16x8, make_uint4(lo.x, lo.y, hi.x, hi.y));
        O[mt] = mfma32(A, P, O[mt]);
      }
    }
  const float inv = 1.f / l;
  bf16_t* orow = OUT + (size_t)(tok0 + iq) * 1024 + hq * 64 + 4 * h;
#pragma unroll
  for (int mt = 0; mt < 2; ++mt)
#pragma unroll
    for (int g = 0; g < 4; ++g)
      *(uint2*)(orow + mt * 32 + 8 * g) = make_uint2(pk(O[mt][4 * g] * inv, O[mt][4 * g + 1] * inv), pk(O[mt][4 * g + 2] * inv, O[mt][4 * g + 3] * inv));
}

DI unsigned fkey(float f) { const unsigned u = __float_as_uint(f); return (u & 0x80000000u) ? ~u : (u | 0x80000000u); }

template <int N>
DI unsigned kth_thr(const unsigned (&k)[N]) {
  unsigned res = 0;
  for (int bit = 31; bit >= 0; --bit) {
    const unsigned cand = res | (1u << bit);
    int cnt = 0;
#pragma unroll
    for (int n = 0; n < N; ++n) cnt += __popcll(__ballot(k[n] >= cand));
    if (cnt == 16) return cand - 1u;
    if (cnt > 16) res = cand;
  }
  return res;
}

DI void peer_topk(const Params& p, int layer, int item, char* smem) {
  const int head = item & 7, tok0 = (item >> 3) * 32;
  bf16_t* qs = (bf16_t*)smem;
  bf16_t* ks = qs + 32 * 136;
  float* sc = (float*)(smem + 8704);
  float* scr = (float*)(smem + 8704 + 36864);
  const bf16_t* Q = (const bf16_t*)(p.ws + OFF_BIG);
  const bf16_t* KEYS = (const bf16_t*)(p.ws + OFF_KEYS);
  int* E = (int*)(p.ws + OFF_E);
  float* G = (float*)(p.ws + OFF_G);
  const int tid = threadIdx.x, lane = tid & 63, w = tid >> 6, r = lane & 31, h = lane >> 5;
  __syncthreads();
#pragma unroll
  for (int i = 0; i < 2; ++i) {
    const int cidx = tid + 256 * i, row = cidx >> 4, kc = cidx & 15;
    *(uint4*)(qs + row * 136 + kc * 8) = *(const uint4*)(Q + (size_t)(tok0 + row) * 1024 + head * 128 + kc * 8);
  }
#pragma unroll
  for (int i = 0; i < 8; ++i) {
    const int cidx = tid + 256 * i, row = cidx >> 3, kc = cidx & 7;
    *(uint4*)(ks + row * 72 + kc * 8) = *(const uint4*)(KEYS + ((size_t)(layer * 8 + head) * 256 + row) * 64 + kc * 8);
  }
  __syncthreads();
  f32x16 acc[2];
  acc[0] = zero16(); acc[1] = zero16();
  const int set = w >> 1;
#pragma unroll
  for (int s = 0; s < 4; ++s) {
    const bf16x8 A = *(const bf16x8*)(qs + r * 136 + set * 64 + s * 16 + h * 8);
#pragma unroll
    for (int ni = 0; ni < 2; ++ni) {
      const bf16x8 B = *(const bf16x8*)(ks + (w * 64 + ni * 32 + r) * 72 + s * 16 + h * 8);
      acc[ni] = mfma32(A, B, acc[ni]);
    }
  }
  __syncthreads();
#pragma unroll
  for (int ni = 0; ni < 2; ++ni)
#pragma unroll
    for (int i = 0; i < 16; ++i) sc[crow(i, h) * 260 + w * 64 + ni * 32 + r] = acc[ni][i];
  __syncthreads();
  float* wv1 = scr + w * 96;
  float* wv2 = wv1 + 16;
  float* wsc = wv1 + 32;
  int* wi1 = (int*)(wv1 + 48);
  int* wi2 = (int*)(wv1 + 64);
  int* we = (int*)(wv1 + 80);
  for (int j = 0; j < 8; ++j) {
    const int tl = w * 8 + j;
    const float* srow = sc + tl * 260;
    const float a0 = srow[lane], a1 = srow[64 + lane], b0 = srow[128 + lane], b1 = srow[192 + lane];
    {
      const unsigned k[2] = {fkey(a0), fkey(a1)};
      const unsigned thr = kth_thr<2>(k);
      int base = 0;
#pragma unroll
      for (int n = 0; n < 2; ++n) {
        const bool s = k[n] > thr;
        const unsigned long long mk = __ballot(s);
        const int pos = base + mbcnt64(mk);
        if (s) { wv1[pos] = n ? a1 : a0; wi1[pos] = n * 64 + lane; }
        base += __popcll(mk);
      }
#pragma unroll
      for (int n = 0; n < 2; ++n) {
        const bool s = k[n] == thr;
        const unsigned long long mk = __ballot(s);
        const int pos = base + mbcnt64(mk);
        if (s && pos < 16) { wv1[pos] = n ? a1 : a0; wi1[pos] = n * 64 + lane; }
        base += __popcll(mk);
      }
    }
    {
      const unsigned k[2] = {fkey(b0), fkey(b1)};
      const unsigned thr = kth_thr<2>(k);
      int base = 0;
#pragma unroll
      for (int n = 0; n < 2; ++n) {
        const bool s = k[n] > thr;
        const unsigned long long mk = __ballot(s);
        const int pos = base + mbcnt64(mk);
        if (s) { wv2[pos] = n ? b1 : b0; wi2[pos] = n * 64 + lane; }
        base += __popcll(mk);
      }
#pragma unroll
      for (int n = 0; n < 2; ++n) {
        const bool s = k[n] == thr;
        const unsigned long long mk = __ballot(s);
        const int pos = base + mbcnt64(mk);
        if (s && pos < 16) { wv2[pos] = n ? b1 : b0; wi2[pos] = n * 64 + lane; }
        base += __popcll(mk);
      }
    }
    wave_sync();
    {
      float cv[4]; unsigned k[4];
#pragma unroll
      for (int n = 0; n < 4; ++n) { const int cidx = n * 64 + lane; cv[n] = wv1[cidx >> 4] + wv2[cidx & 15]; k[n] = fkey(cv[n]); }
      const unsigned thr = kth_thr<4>(k);
      int base = 0;
#pragma unroll
      for (int n = 0; n < 4; ++n) {
        const bool s = k[n] > thr;
        const unsigned long long mk = __ballot(s);
        const int pos = base + mbcnt64(mk);
        const int cidx = n * 64 + lane;
        if (s) { wsc[pos] = cv[n]; we[pos] = wi1[cidx >> 4] * 128 + wi2[cidx & 15]; }
        base += __popcll(mk);
      }
#pragma unroll
      for (int n = 0; n < 4; ++n) {
        const bool s = k[n] == thr;
        const unsigned long long mk = __ballot(s);
        const int pos = base + mbcnt64(mk);
        const int cidx = n * 64 + lane;
        if (s && pos < 16) { wsc[pos] = cv[n]; we[pos] = wi1[cidx >> 4] * 128 + wi2[cidx & 15]; }
        base += __popcll(mk);
      }
    }
    wave_sync();
    {
      const float sv = wsc[lane & 15];
      const int ev = we[lane & 15];
      float mx = sv;
      mx = fmaxf(mx, __shfl_xor(mx, 1)); mx = fmaxf(mx, __shfl_xor(mx, 2)); mx = fmaxf(mx, __shfl_xor(mx, 4)); mx = fmaxf(mx, __shfl_xor(mx, 8));
      const float ex = __expf(sv - mx);
      float sm = ex;
      sm += __shfl_xor(sm, 1); sm += __shfl_xor(sm, 2); sm += __shfl_xor(sm, 4); sm += __shfl_xor(sm, 8);
      if (lane < 16) {
        const size_t o = (size_t)(tok0 + tl) * 128 + head * 16 + lane;
        E[o] = ev;
        G[o] = ex / sm;
      }
    }
    wave_sync();
  }
}

DI void peer_gather(const Params& p, char* smem) {
  const int tid = threadIdx.x, lane = tid & 63, w = tid >> 6, grp = lane >> 4, i16 = lane & 15;
  float* a_s = (float*)smem + w * 128;
  const bf16_t* HN = (const bf16_t*)(p.ws + OFF_ACT_A);
  const bf16_t* U = (const bf16_t*)(p.ws + OFF_TBL_U);
  const bf16_t* V = (const bf16_t*)(p.ws + OFF_TBL_V);
  const int* E = (const int*)(p.ws + OFF_E);
  const float* G = (const float*)(p.ws + OFF_G);
  for (int tok = blockIdx.x * 4 + w; tok < T_TOK; tok += gridDim.x * 4) {
    const uint4* xp = (const uint4*)(HN + (size_t)tok * 1024);
    uint4 xr[8];
#pragma unroll
    for (int c = 0; c < 8; ++c) xr[c] = xp[i16 + 16 * c];
    const int e0 = E[(size_t)tok * 128 + lane], e1 = E[(size_t)tok * 128 + 64 + lane];
    const float g0 = G[(size_t)tok * 128 + lane], g1 = G[(size_t)tok * 128 + 64 + lane];
#pragma unroll 2
    for (int mm = 0; mm < 32; ++mm) {
      const int pidx = 4 * mm + grp;
      const int row = __shfl(mm < 16 ? e0 : e1, pidx & 63);
      const float gg = __shfl(mm < 16 ? g0 : g1, pidx & 63);
      const uint4* up = (const uint4*)(U + (size_t)row * 1024);
      float acc0 = 0.f, acc1 = 0.f;
#pragma unroll
      for (int c = 0; c < 8; ++c) {
        const uint4 wv = up[i16 + 16 * c];
        acc0 = dot2(wv.x, xr[c].x, acc0); acc1 = dot2(wv.y, xr[c].y, acc1);
        acc0 = dot2(wv.z, xr[c].z, acc0); acc1 = dot2(wv.w, xr[c].w, acc1);
      }
      float acc = acc0 + acc1;
      acc += __shfl_xor(acc, 1); acc += __shfl_xor(acc, 2); acc += __shfl_xor(acc, 4); acc += __shfl_xor(acc, 8);
      const float a = 0.5f * acc * (1.f + erff(acc * 0.7071067811865476f)) * gg;
      if (i16 == 0) a_s[pidx] = a;
    }
    wave_sync();
    float o[16];
#pragma unroll
    for (int i = 0; i < 16; ++i) o[i] = 0.f;
#pragma unroll 8
    for (int pp = 0; pp < 128; ++pp) {
      const int row = __builtin_amdgcn_readlane(pp < 64 ? e0 : e1, pp & 63);
      const float a = a_s[pp];
      const uint4* vp = (const uint4*)(V + (size_t)row * 1024);
      const uint4 w0 = vp[lane], w1 = vp[64 + lane];
      o[0] += a * bflo(w0.x); o[1] += a * bfhi(w0.x); o[2] += a * bflo(w0.y); o[3] += a * bfhi(w0.y);
      o[4] += a * bflo(w0.z); o[5] += a * bfhi(w0.z); o[6] += a * bflo(w0.w); o[7] += a * bfhi(w0.w);
      o[8] += a * bflo(w1.x); o[9] += a * bfhi(w1.x); o[10] += a * bflo(w1.y); o[11] += a * bfhi(w1.y);
      o[12] += a * bflo(w1.z); o[13] += a * bfhi(w1.z); o[14] += a * bflo(w1.w); o[15] += a * bfhi(w1.w);
    }
    float4* hp = (float4*)(p.out + (size_t)tok * 1024 + lane * 8);
    float4 t0 = hp[0], t1 = hp[1];
    t0.x += o[0]; t0.y += o[1]; t0.z += o[2]; t0.w += o[3]; t1.x += o[4]; t1.y += o[5]; t1.z += o[6]; t1.w += o[7];
    hp[0] = t0; hp[1] = t1;
    float4* hq = (float4*)(p.out + (size_t)tok * 1024 + 512 + lane * 8);
    float4 t2 = hq[0], t3 = hq[1];
    t2.x += o[8]; t2.y += o[9]; t2.z += o[10]; t2.w += o[11]; t3.x += o[12]; t3.y += o[13]; t3.z += o[14]; t3.w += o[15];
    hq[0] = t2; hq[1] = t3;
    wave_sync();
  }
}

DI void run_phase(const Params& p, int ph, char* smem) {
  bf16_t* actA = (bf16_t*)(p.ws + OFF_ACT_A);
  bf16_t* big = (bf16_t*)(p.ws + OFF_BIG);
  switch (ph) {
    case 0: phase_convert(p, smem); phase_cvt_tables(p, 0); break;
    case 1: phase_rmsnorm(p.x, p.ln_mix, actA); break;
    case 2: phase_gemm<EPI_GLA_IN>(p, actA, (const bf16_t*)(p.ws + OFF_WT_GLA_IN), 25, big, 3072, nullptr, smem); break;
    case 3: for (int it = blockIdx.x; it < 2048; it += gridDim.x) gla_phase1(p, it, smem); break;
    case 4: gla_scan(p); break;
    case 5: for (int it = blockIdx.x; it < 2048; it += gridDim.x) gla_phase3(p, it, smem); break;
    case 6: phase_gemm<EPI_RESID_X>(p, actA, (const bf16_t*)(p.ws + OFF_WT_GLA_OUT), 8, nullptr, 0, nullptr, smem); break;
    case 7: phase_rmsnorm(p.out, p.ln_ffn, actA); break;
    case 8: phase_gemm<EPI_BF16>(p, actA, (const bf16_t*)(p.ws + OFF_WT_PQ), 8, big, 1024, nullptr, smem); break;
    case 9: for (int it = blockIdx.x; it < 8192; it += gridDim.x) peer_topk(p, 0, it, smem); break;
    case 10: peer_gather(p, smem); break;
    case 11: phase_rmsnorm(p.out, p.ln_mix + 1024, actA); phase_cvt_tables(p, 1); break;
    case 12: phase_gemm<EPI_BF16>(p, actA, (const bf16_t*)(p.ws + OFF_WT_SWA_IN), 10, big, 1280, p.swa_b_in, smem); break;
    case 13: swa_qknorm(p); break;
    case 14: for (int it = blockIdx.x; it < 4096; it += gridDim.x) swa_attn(p, it, smem); break;
    case 15: phase_gemm<EPI_RESID_INPLACE>(p, (const bf16_t*)(p.ws + OFF_ACT_B), (const bf16_t*)(p.ws + OFF_WT_SWA_OUT), 8, nullptr, 0, p.swa_b_out, smem); break;
    case 16: phase_rmsnorm(p.out, p.ln_ffn + 1024, actA); break;
    case 17: phase_gemm<EPI_BF16>(p, actA, (const bf16_t*)(p.ws + OFF_WT_PQ) + (size_t)1024 * 1024, 8, big, 1024, nullptr, smem); break;
    case 18: for (int it = blockIdx.x; it < 8192; it += gridDim.x) peer_topk(p, 1, it, smem); break;
    case 19: peer_gather(p, smem); break;
    default: break;
  }
}

template <int PH>
__global__ void __launch_bounds__(256, 2) phase_kernel(Params p) {
  __shared__ __attribute__((aligned(16))) char smem[SMEM_BYTES];
  run_phase(p, PH, smem);
}

template <int PH>
static void launch_phases(const Params& p, int grid, hipStream_t stream) {
  hipLaunchKernelGGL(phase_kernel<PH>, dim3(grid), dim3(256), 0, stream, p);
  if constexpr (PH + 1 < NPHASE) launch_phases<PH + 1>(p, grid, stream);
}

#if !MULTI_LAUNCH
__global__ void __launch_bounds__(256, 2) trunk_kernel(Params p) {
  __shared__ __attribute__((aligned(16))) char smem[SMEM_BYTES];
  for (int ph = p.phase_lo; ph <= p.phase_hi; ++ph) {
    run_phase(p, ph, smem);
    if (ph < p.phase_hi) cg::this_grid().sync();
  }
}
#endif

extern "C" void kernel_launch(void* const* d_in, const int* in_sizes, int n_in, void* d_out, int out_size, void* d_ws, size_t ws_size,
                              hipStream_t stream) {
  Params p{};
  p.x = (const float*)d_in[0]; p.pos = (const int*)d_in[1]; p.ln_mix = (const float*)d_in[2]; p.ln_ffn = (const float*)d_in[3];
  p.gla_w_in = (const float*)d_in[4]; p.gla_w_alpha = (const float*)d_in[5]; p.gla_b_alpha = (const float*)d_in[6];
  p.gla_norm = (const float*)d_in[7]; p.gla_w_out = (const float*)d_in[8];
  p.swa_w_in = (const float*)d_in[9]; p.swa_b_in = (const float*)d_in[10]; p.swa_qn = (const float*)d_in[11]; p.swa_kn = (const float*)d_in[12];
  p.swa_sinks = (const float*)d_in[13]; p.swa_w_out = (const float*)d_in[14]; p.swa_b_out = (const float*)d_in[15];
  p.peer_wq = (const float*)d_in[16]; p.peer_keys = (const float*)d_in[17]; p.peer_u = (const float*)d_in[18]; p.peer_v = (const float*)d_in[19];
  p.out = (float*)d_out; p.ws = (char*)d_ws;
  static int grid_blocks = 0;
  if (!grid_blocks) {
    int dev = 0, cus = 0, per_cu = 0;
    (void)hipGetDevice(&dev);
    (void)hipDeviceGetAttribute(&cus, hipDeviceAttributeMultiprocessorCount, dev);
    #if MULTI_LAUNCH
    per_cu = 2;
#else
    (void)hipOccupancyMaxActiveBlocksPerMultiprocessor(&per_cu, trunk_kernel, 256, 0);
#endif
    if (per_cu < 1) per_cu = 1;
    if (per_cu > 2) per_cu = 2;
    grid_blocks = cus * per_cu;
  }
#if MULTI_LAUNCH
  p.phase_lo = 0; p.phase_hi = 0;
  launch_phases<0>(p, grid_blocks, stream);
#else
  p.phase_lo = 0; p.phase_hi = NPHASE - 1;
  void* args[] = {&p};
  hipError_t e = hipLaunchCooperativeKernel((void*)trunk_kernel, dim3(grid_blocks), dim3(256), args, 0, stream);
  if (e != hipSuccess) fprintf(stderr, "cooperative launch failed: %s (grid %d)\n", hipGetErrorString(e), grid_blocks);
#endif
}
```

```cpp
#include <hip/hip_runtime.h>
#include <hip/hip_cooperative_groups.h>
#include <stdint.h>
#include <stdio.h>
namespace cg = cooperative_groups;

#ifndef MULTI_LAUNCH
#define MULTI_LAUNCH 0
#endif

#define DI __device__ __forceinline__
typedef unsigned short bf16_t;
typedef __attribute__((ext_vector_type(8))) short bf16x8;
typedef __attribute__((ext_vector_type(16))) float f32x16;
typedef __bf16 bf16x2_t __attribute__((ext_vector_type(2)));
typedef float f32x2_t __attribute__((ext_vector_type(2)));

constexpr int T_TOK = 32768;
constexpr int SEQ = 16384;
constexpr int DM = 1024;
constexpr int NPHASE = 20;

constexpr size_t MiB = 1048576;
constexpr size_t OFF_WT_GLA_IN = 0;
constexpr size_t OFF_WT_GLA_OUT = 7 * MiB;
constexpr size_t OFF_WT_SWA_IN = 9 * MiB;
constexpr size_t OFF_WT_SWA_OUT = 12 * MiB;
constexpr size_t OFF_WT_PQ = 14 * MiB;
constexpr size_t OFF_KEYS = 18 * MiB;
constexpr size_t OFF_TBL_U = 24 * MiB;
constexpr size_t OFF_TBL_V = 56 * MiB;
constexpr size_t OFF_ACT_A = 88 * MiB;
constexpr size_t OFF_BIG = 152 * MiB;
constexpr size_t OFF_E = OFF_BIG + 64 * MiB;
constexpr size_t OFF_G = OFF_BIG + 80 * MiB;
constexpr size_t OFF_KVT = 344 * MiB;
constexpr size_t OFF_ACT_B = OFF_KVT;
constexpr size_t OFF_LR = 472 * MiB;
constexpr size_t OFF_DECAY = 474 * MiB;

constexpr int SMEM_BYTES = 73728;
constexpr int LDK = 72;

struct Params {
  const float* x; const int* pos; const float* ln_mix; const float* ln_ffn;
  const float* gla_w_in; const float* gla_w_alpha; const float* gla_b_alpha; const float* gla_norm; const float* gla_w_out;
  const float* swa_w_in; const float* swa_b_in; const float* swa_qn; const float* swa_kn; const float* swa_sinks;
  const float* swa_w_out; const float* swa_b_out;
  const float* peer_wq; const float* peer_keys; const float* peer_u; const float* peer_v;
  float* out; char* ws;
  int phase_lo, phase_hi;
};

DI unsigned pk(float lo, float hi) { f32x2_t v = {lo, hi}; bf16x2_t b = __builtin_convertvector(v, bf16x2_t); return __builtin_bit_cast(unsigned, b); }
DI bf16_t f2bf(float x) { return (bf16_t)(pk(x, 0.f) & 0xffffu); }
DI float bflo(unsigned w) { return __uint_as_float(w << 16); }
DI float bfhi(unsigned w) { return __uint_as_float(w & 0xffff0000u); }
DI float bf2f(bf16_t b) { return __uint_as_float(((unsigned)b) << 16); }
DI float dot2(unsigned a, unsigned b, float c) { return __builtin_amdgcn_fdot2_f32_bf16(__builtin_bit_cast(bf16x2_t, a), __builtin_bit_cast(bf16x2_t, b), c, false); }
DI int crow(int i, int h) { return (i & 3) + 8 * (i >> 2) + 4 * h; }
DI f32x16 mfma32(bf16x8 a, bf16x8 b, f32x16 c) { return __builtin_amdgcn_mfma_f32_32x32x16_bf16(a, b, c, 0, 0, 0); }
DI f32x16 zero16() { f32x16 z; for (int i = 0; i < 16; ++i) z[i] = 0.f; return z; }
DI void wave_sync() { __builtin_amdgcn_fence(__ATOMIC_RELEASE, "wavefront"); __builtin_amdgcn_wave_barrier(); __builtin_amdgcn_fence(__ATOMIC_ACQUIRE, "wavefront"); }
DI int mbcnt64(unsigned long long m) { return __builtin_amdgcn_mbcnt_hi((unsigned)(m >> 32), __builtin_amdgcn_mbcnt_lo((unsigned)m, 0)); }
DI float logsig(float z) { return fminf(z, 0.f) - log1pf(__expf(-fabsf(z))); }

DI void transpose_tile(const float* __restrict__ src, int N, bf16_t* __restrict__ dst, int kt, int nt, float* sT) {
  const int tid = threadIdx.x;
  const int r = tid >> 4, c4 = (tid & 15) * 4;
#pragma unroll
  for (int i = 0; i < 4; ++i) {
    const int k = kt * 64 + r + 16 * i, n = nt * 64 + c4;
    float4 v = make_float4(0.f, 0.f, 0.f, 0.f);
    if (n + 3 < N) v = *(const float4*)(src + (size_t)k * N + n);
    float* d = sT + (r + 16 * i) * 65 + c4;
    d[0] = v.x; d[1] = v.y; d[2] = v.z; d[3] = v.w;
  }
  __syncthreads();
  const int n = tid >> 2, seg = tid & 3;
  unsigned w[8];
#pragma unroll
  for (int j = 0; j < 8; ++j) w[j] = pk(sT[(seg * 16 + 2 * j) * 65 + n], sT[(seg * 16 + 2 * j + 1) * 65 + n]);
  uint4* d = (uint4*)(dst + (size_t)(nt * 64 + n) * 1024 + kt * 64 + seg * 16);
  d[0] = make_uint4(w[0], w[1], w[2], w[3]);
  d[1] = make_uint4(w[4], w[5], w[6], w[7]);
  __syncthreads();
}

DI void cvt_elems(const float* __restrict__ src, bf16_t* __restrict__ dst, size_t n8) {
  for (size_t i = (size_t)blockIdx.x * 256 + threadIdx.x; i < n8; i += (size_t)gridDim.x * 256) {
    const float4 a = ((const float4*)src)[2 * i], b = ((const float4*)src)[2 * i + 1];
    ((uint4*)dst)[i] = make_uint4(pk(a.x, a.y), pk(a.z, a.w), pk(b.x, b.y), pk(b.z, b.w));
  }
}

DI void phase_convert(const Params& p, char* smem) {
  float* sT = (float*)smem;
  for (int t = blockIdx.x; t < 2144; t += gridDim.x) {
    const float* src; int N, ntn; bf16_t* dst; int local;
    if (t < 800) { src = p.gla_w_in; N = 3088; ntn = 50; dst = (bf16_t*)(p.ws + OFF_WT_GLA_IN); local = t; }
    else if (t < 1056) { src = p.gla_w_out; N = 1024; ntn = 16; dst = (bf16_t*)(p.ws + OFF_WT_GLA_OUT); local = t - 800; }
    else if (t < 1376) { src = p.swa_w_in; N = 1280; ntn = 20; dst = (bf16_t*)(p.ws + OFF_WT_SWA_IN); local = t - 1056; }
    else if (t < 1632) { src = p.swa_w_out; N = 1024; ntn = 16; dst = (bf16_t*)(p.ws + OFF_WT_SWA_OUT); local = t - 1376; }
    else if (t < 1888) { src = p.peer_wq; N = 1024; ntn = 16; dst = (bf16_t*)(p.ws + OFF_WT_PQ); local = t - 1632; }
    else { src = p.peer_wq + (size_t)1024 * 1024; N = 1024; ntn = 16; dst = (bf16_t*)(p.ws + OFF_WT_PQ) + (size_t)1024 * 1024; local = t - 1888; }
    transpose_tile(src, N, dst, local / ntn, local % ntn, sT);
  }
  cvt_elems(p.peer_keys, (bf16_t*)(p.ws + OFF_KEYS), (size_t)2 * 8 * 2 * 128 * 64 / 8);
}

DI void phase_cvt_tables(const Params& p, int layer) {
  cvt_elems(p.peer_u + (size_t)layer * 16384 * 1024, (bf16_t*)(p.ws + OFF_TBL_U), (size_t)16384 * 1024 / 8);
  cvt_elems(p.peer_v + (size_t)layer * 16384 * 1024, (bf16_t*)(p.ws + OFF_TBL_V), (size_t)16384 * 1024 / 8);
}

DI void phase_rmsnorm(const float* __restrict__ src, const float* __restrict__ gain, bf16_t* __restrict__ dst) {
  const int lane = threadIdx.x & 63, w = threadIdx.x >> 6;
  for (int row = blockIdx.x * 4 + w; row < T_TOK; row += gridDim.x * 4) {
    const float4* sp = (const float4*)(src + (size_t)row * DM);
    float4 v[4];
    float ss = 0.f;
#pragma unroll
    for (int i = 0; i < 4; ++i) { v[i] = sp[lane + 64 * i]; ss += v[i].x * v[i].x + v[i].y * v[i].y + v[i].z * v[i].z + v[i].w * v[i].w; }
#pragma unroll
    for (int o = 32; o >= 1; o >>= 1) ss += __shfl_xor(ss, o);
    const float rs = rsqrtf(ss * (1.f / 1024.f) + 1e-6f);
#pragma unroll
    for (int i = 0; i < 4; ++i) {
      const float4 g = ((const float4*)gain)[lane + 64 * i];
      uint2 o2 = make_uint2(pk(v[i].x * rs * g.x, v[i].y * rs * g.y), pk(v[i].z * rs * g.z, v[i].w * rs * g.w));
      *(uint2*)(dst + (size_t)row * DM + (lane + 64 * i) * 4) = o2;
    }
  }
}

DI void mma_64x64(const bf16_t* sA, const bf16_t* sB, int arow0, int brow0, f32x16 (&acc)[2][2], int lane) {
  const int r = lane & 31, h = lane >> 5;
#pragma unroll
  for (int s = 0; s < 4; ++s) {
    bf16x8 a[2], b[2];
#pragma unroll
    for (int mi = 0; mi < 2; ++mi) a[mi] = *(const bf16x8*)(sA + (arow0 + mi * 32 + r) * LDK + s * 16 + h * 8);
#pragma unroll
    for (int ni = 0; ni < 2; ++ni) b[ni] = *(const bf16x8*)(sB + (brow0 + ni * 32 + r) * LDK + s * 16 + h * 8);
#pragma unroll
    for (int mi = 0; mi < 2; ++mi)
#pragma unroll
      for (int ni = 0; ni < 2; ++ni) acc[mi][ni] = mfma32(a[mi], b[ni], acc[mi][ni]);
  }
}

enum { EPI_GLA_IN = 0, EPI_RESID_X = 1, EPI_BF16 = 2, EPI_RESID_INPLACE = 3 };

template <int MODE>
DI void gemm_tile(const Params& p, const bf16_t* __restrict__ A, const bf16_t* __restrict__ Bt, int m0, int n0,
                  bf16_t* dstb, int ldc, const float* __restrict__ bias, char* smem) {
  bf16_t* sA = (bf16_t*)smem;
  bf16_t* sB = sA + 128 * LDK;
  const int tid = threadIdx.x, lane = tid & 63, w = tid >> 6, wm = w >> 1, wn = w & 1;
  f32x16 acc[2][2];
#pragma unroll
  for (int i = 0; i < 2; ++i)
#pragma unroll
    for (int j = 0; j < 2; ++j) acc[i][j] = zero16();
  bf16x8 ra[4], rb[4];
  const int lrow = tid >> 3, kc = tid & 7;
  const bf16_t* ap = A + (size_t)(m0 + lrow) * 1024 + kc * 8;
  const bf16_t* bp = Bt + (size_t)(n0 + lrow) * 1024 + kc * 8;
#pragma unroll
  for (int i = 0; i < 4; ++i) { ra[i] = *(const bf16x8*)(ap + (size_t)i * 32 * 1024); rb[i] = *(const bf16x8*)(bp + (size_t)i * 32 * 1024); }
  __syncthreads();
#pragma unroll
  for (int i = 0; i < 4; ++i) { *(bf16x8*)(sA + (lrow + 32 * i) * LDK + kc * 8) = ra[i]; *(bf16x8*)(sB + (lrow + 32 * i) * LDK + kc * 8) = rb[i]; }
  __syncthreads();
  for (int kt = 0; kt < 16; ++kt) {
    if (kt + 1 < 16) {
#pragma unroll
      for (int i = 0; i < 4; ++i) { ra[i] = *(const bf16x8*)(ap + (size_t)i * 32 * 1024 + (kt + 1) * 64); rb[i] = *(const bf16x8*)(bp + (size_t)i * 32 * 1024 + (kt + 1) * 64); }
    }
    mma_64x64(sA, sB, wm * 64, wn * 64, acc, lane);
    __syncthreads();
    if (kt + 1 < 16) {
#pragma unroll
      for (int i = 0; i < 4; ++i) { *(bf16x8*)(sA + (lrow + 32 * i) * LDK + kc * 8) = ra[i]; *(bf16x8*)(sB + (lrow + 32 * i) * LDK + kc * 8) = rb[i]; }
      __syncthreads();
    }
  }
  const int r = lane & 31, h = lane >> 5;
#pragma unroll
  for (int mi = 0; mi < 2; ++mi)
#pragma unroll
    for (int ni = 0; ni < 2; ++ni) {
      const int col = n0 + wn * 64 + ni * 32 + r;
#pragma unroll
      for (int i = 0; i < 16; ++i) {
        const int row = m0 + wm * 64 + mi * 32 + crow(i, h);
        const float v = acc[mi][ni][i];
        if (MODE == EPI_GLA_IN) {
          if (col < 3072) dstb[(size_t)row * 3072 + col] = f2bf(v);
          else if (col < 3088) ((float*)(p.ws + OFF_LR))[(size_t)row * 16 + (col - 3072)] = v;
        } else if (MODE == EPI_RESID_X) {
          p.out[(size_t)row * 1024 + col] = p.x[(size_t)row * 1024 + col] + v;
        } else if (MODE == EPI_BF16) {
          dstb[(size_t)row * ldc + col] = f2bf(bias ? v + bias[col] : v);
        } else {
          p.out[(size_t)row * 1024 + col] += v + bias[col];
        }
      }
    }
}

template <int MODE>
DI void phase_gemm(const Params& p, const bf16_t* A, const bf16_t* Bt, int NT, bf16_t* dstb, int ldc, const float* bias, char* smem) {
  const int ntiles = (T_TOK / 128) * NT;
  for (int t = blockIdx.x; t < ntiles; t += gridDim.x) gemm_tile<MODE>(p, A, Bt, (t / NT) * 128, (t % NT) * 128, dstb, ldc, bias, smem);
}

DI float gate_la(const float* lr_s, int t, const float (&wa)[16], float ba) {
  float z = ba;
#pragma unroll
  for (int j = 0; j < 16; ++j) z += lr_s[t * 16 + j] * wa[j];
  return logsig(z) * (1.f / 16.f);
}
DI void gla_gates(const Params& p, int t0, int hh, float (&wa)[16], float& ba, float& offset, float& blast, float* lr_s, float* tot_s) {
  const int tid = threadIdx.x, d = tid & 127, half = tid >> 7;
  const float* LR = (const float*)(p.ws + OFF_LR);
  ((float4*)lr_s)[tid] = ((const float4*)(LR + (size_t)t0 * 16))[tid];
#pragma unroll
  for (int j = 0; j < 16; ++j) wa[j] = p.gla_w_alpha[j * 512 + hh * 128 + d];
  ba = p.gla_b_alpha[hh * 128 + d];
  __syncthreads();
  float sum = 0.f;
#pragma unroll 4
  for (int tt = 0; tt < 32; ++tt) sum += gate_la(lr_s, half * 32 + tt, wa, ba);
  tot_s[half * 128 + d] = sum;
  __syncthreads();
  offset = half ? tot_s[d] : 0.f;
  blast = tot_s[d] + tot_s[128 + d];
}

DI void fill_vT(const bf16_t* __restrict__ QKVR, int t0, int hh, int vh, bf16_t* vT) {
  const int tid = threadIdx.x, v = tid & 127, half = tid >> 7;
#pragma unroll 8
  for (int tt = 0; tt < 32; ++tt) {
    const int t = half * 32 + tt;
    vT[v * LDK + t] = QKVR[(size_t)(t0 + t) * 3072 + 1024 + hh * 256 + vh * 128 + v];
  }
}

DI void gla_phase1(const Params& p, int item, char* smem) {
  const int hh = item & 3, c = (item >> 2) & 255, b = item >> 10;
  const int t0 = b * SEQ + c * 64;
  float* lr_s = (float*)smem;
  float* tot_s = (float*)(smem + 4096);
  bf16_t* kfT = (bf16_t*)(smem + 5120);
  bf16_t* vT = kfT + 128 * LDK;
  const bf16_t* QKVR = (const bf16_t*)(p.ws + OFF_BIG);
  bf16_t* KVT = (bf16_t*)(p.ws + OFF_KVT);
  float* DECAY = (float*)(p.ws + OFF_DECAY);
  const int tid = threadIdx.x, lane = tid & 63, w = tid >> 6, wm = w >> 1, wn = w & 1;
  const int d = tid & 127, half = tid >> 7;
  float wa[16], ba, offset, blast;
  gla_gates(p, t0, hh, wa, ba, offset, blast, lr_s, tot_s);
  float run = offset;
#pragma unroll 4
  for (int tt = 0; tt < 32; ++tt) {
    const int t = half * 32 + tt;
    run += gate_la(lr_s, t, wa, ba);
    const float kv = bf2f(QKVR[(size_t)(t0 + t) * 3072 + 512 + hh * 128 + d]);
    kfT[d * LDK + t] = f2bf(kv * __expf(blast - run));
  }
  if (half == 0) DECAY[(size_t)item * 128 + d] = __expf(blast);
  const int r = lane & 31, h = lane >> 5;
  for (int vh = 0; vh < 2; ++vh) {
    __syncthreads();
    fill_vT(QKVR, t0, hh, vh, vT);
    __syncthreads();
    f32x16 acc[2][2];
#pragma unroll
    for (int i = 0; i < 2; ++i)
#pragma unroll
      for (int j = 0; j < 2; ++j) acc[i][j] = zero16();
    mma_64x64(vT, kfT, wm * 64, wn * 64, acc, lane);
    bf16_t* kbase = KVT + (size_t)item * 32768 + (vh * 128 + wm * 64 + 4 * h) * 128 + wn * 64 + r;
#pragma unroll
    for (int mi = 0; mi < 2; ++mi)
#pragma unroll
      for (int ni = 0; ni < 2; ++ni)
#pragma unroll
        for (int i = 0; i < 16; ++i) kbase[(mi * 32 + (i & 3) + 8 * (i >> 2)) * 128 + ni * 32] = f2bf(acc[mi][ni][i]);
  }
  __syncthreads();
}

DI void gla_scan(const Params& p) {
  bf16_t* KVT = (bf16_t*)(p.ws + OFF_KVT);
  const float* DECAY = (const float*)(p.ws + OFF_DECAY);
  for (int idx = blockIdx.x * 256 + threadIdx.x; idx < 8 * 16384; idx += gridDim.x * 256) {
    const int bh = idx >> 14, e2 = idx & 16383, b = bh >> 2, hh = bh & 3, d0 = (2 * e2) & 127;
    float s0 = 0.f, s1 = 0.f;
    for (int c0 = 0; c0 < 256; c0 += 8) {
      unsigned kv[8]; float2 dc[8];
#pragma unroll
      for (int u = 0; u < 8; ++u) {
        const size_t item = (size_t)(b * 256 + c0 + u) * 4 + hh;
        kv[u] = *(const unsigned*)(KVT + item * 32768 + 2 * e2);
        dc[u] = *(const float2*)(DECAY + item * 128 + d0);
      }
#pragma unroll
      for (int u = 0; u < 8; ++u) {
        const size_t item = (size_t)(b * 256 + c0 + u) * 4 + hh;
        *(unsigned*)(KVT + item * 32768 + 2 * e2) = pk(s0, s1);
        s0 = dc[u].x * s0 + bflo(kv[u]);
        s1 = dc[u].y * s1 + bfhi(kv[u]);
      }
    }
  }
}

DI void gla_phase3(const Params& p, int item, char* smem) {
  const int hh = item & 3, c = (item >> 2) & 255, b = item >> 10;
  const int t0 = b * SEQ + c * 64;
  float* lr_s = (float*)smem;
  float* tot_s = (float*)(smem + 4096);
  bf16_t* qd = (bf16_t*)(smem + 5120);
  bf16_t* ki = qd + 64 * 136;
  bf16_t* at = ki + 64 * 136;
  bf16_t* vT = at + 64 * 72;
  bf16_t* ot = qd;
  const bf16_t* QKVR = (const bf16_t*)(p.ws + OFF_BIG);
  const bf16_t* ST = (const bf16_t*)(p.ws + OFF_KVT);
  bf16_t* OG = (bf16_t*)(p.ws + OFF_ACT_A);
  const int tid = threadIdx.x, lane = tid & 63, w = tid >> 6;
  const int d = tid & 127, half = tid >> 7;
  const int r = lane & 31, h = lane >> 5;
  {
    float wa[16], ba, offset, blast;
    gla_gates(p, t0, hh, wa, ba, offset, blast, lr_s, tot_s);
    float run = offset;
#pragma unroll 4
    for (int tt = 0; tt < 32; ++tt) {
      const int t = half * 32 + tt;
      run += gate_la(lr_s, t, wa, ba);
      const float q = bf2f(QKVR[(size_t)(t0 + t) * 3072 + hh * 128 + d]);
      const float k = bf2f(QKVR[(size_t)(t0 + t) * 3072 + 512 + hh * 128 + d]);
      qd[t * 136 + d] = f2bf(q * 0.08838834764831845f * __expf(run));
      ki[t * 136 + d] = f2bf(k * __expf(-run));
    }
  }
  __syncthreads();
  {
    const int mi = w >> 1, nj = w & 1;
    f32x16 a = zero16();
#pragma unroll
    for (int s = 0; s < 8; ++s) {
      const bf16x8 A = *(const bf16x8*)(qd + (mi * 32 + r) * 136 + s * 16 + h * 8);
      const bf16x8 B = *(const bf16x8*)(ki + (nj * 32 + r) * 136 + s * 16 + h * 8);
      a = mfma32(A, B, a);
    }
#pragma unroll
    for (int i = 0; i < 16; ++i) {
      const int it = mi * 32 + crow(i, h), jt = nj * 32 + r;
      at[it * 72 + jt] = f2bf(jt <= it ? a[i] : 0.f);
    }
  }
  f32x16 o[2][2];
#pragma unroll
  for (int i = 0; i < 2; ++i)
#pragma unroll
    for (int j = 0; j < 2; ++j) o[i][j] = zero16();
#pragma unroll
  for (int vh = 0; vh < 2; ++vh) {
    __syncthreads();
    fill_vT(QKVR, t0, hh, vh, vT);
    __syncthreads();
#pragma unroll
    for (int s = 0; s < 4; ++s) {
      const bf16x8 B = *(const bf16x8*)(vT + (w * 32 + r) * LDK + s * 16 + h * 8);
#pragma unroll
      for (int mt = 0; mt < 2; ++mt) {
        const bf16x8 A = *(const bf16x8*)(at + (mt * 32 + r) * 72 + s * 16 + h * 8);
        o[vh][mt] = mfma32(A, B, o[vh][mt]);
      }
    }
    const bf16_t* Sg = ST + (size_t)item * 32768 + (size_t)(vh * 128 + w * 32 + r) * 128 + h * 8;
#pragma unroll
    for (int s = 0; s < 8; ++s) {
      const bf16x8 B = *(const bf16x8*)(Sg + s * 16);
#pragma unroll
      for (int mt = 0; mt < 2; ++mt) {
        const bf16x8 A = *(const bf16x8*)(qd + (mt * 32 + r) * 136 + s * 16 + h * 8);
        o[vh][mt] = mfma32(A, B, o[vh][mt]);
      }
    }
  }
  __syncthreads();
#pragma unroll
  for (int vh = 0; vh < 2; ++vh)
#pragma unroll
    for (int mt = 0; mt < 2; ++mt)
#pragma unroll
      for (int i = 0; i < 16; ++i) ot[(mt * 32 + crow(i, h)) * 264 + vh * 128 + w * 32 + r] = f2bf(o[vh][mt][i]);
  __syncthreads();
  {
    const int row = tid >> 2, seg = tid & 3;
    const bf16_t* orow = ot + row * 264 + seg * 64;
    float ss = 0.f;
#pragma unroll
    for (int c8 = 0; c8 < 8; ++c8) {
      const uint4 ov = *(const uint4*)(orow + c8 * 8);
      const float f0 = bflo(ov.x), f1 = bfhi(ov.x), f2 = bflo(ov.y), f3 = bfhi(ov.y), f4 = bflo(ov.z), f5 = bfhi(ov.z), f6 = bflo(ov.w), f7 = bfhi(ov.w);
      ss += f0 * f0 + f1 * f1 + f2 * f2 + f3 * f3 + f4 * f4 + f5 * f5 + f6 * f6 + f7 * f7;
    }
    ss += __shfl_xor(ss, 1);
    ss += __shfl_xor(ss, 2);
    const float rs = rsqrtf(ss * (1.f / 256.f) + 1e-6f);
    const bf16_t* rrow = QKVR + (size_t)(t0 + row) * 3072 + 2048 + hh * 256 + seg * 64;
    const float* grow = p.gla_norm + hh * 256 + seg * 64;
    bf16_t* dst = OG + (size_t)(t0 + row) * 1024 + hh * 256 + seg * 64;
#pragma unroll
    for (int c8 = 0; c8 < 8; ++c8) {
      const uint4 ov = *(const uint4*)(orow + c8 * 8);
      const uint4 rv = *(const uint4*)(rrow + c8 * 8);
      const float4 g0 = *(const float4*)(grow + c8 * 8), g1 = *(const float4*)(grow + c8 * 8 + 4);
      float of[8] = {bflo(ov.x), bfhi(ov.x), bflo(ov.y), bfhi(ov.y), bflo(ov.z), bfhi(ov.z), bflo(ov.w), bfhi(ov.w)};
      float rf[8] = {bflo(rv.x), bfhi(rv.x), bflo(rv.y), bfhi(rv.y), bflo(rv.z), bfhi(rv.z), bflo(rv.w), bfhi(rv.w)};
      float gf[8] = {g0.x, g0.y, g0.z, g0.w, g1.x, g1.y, g1.z, g1.w};
      float res[8];
#pragma unroll
      for (int e = 0; e < 8; ++e) res[e] = of[e] * rs * gf[e] * (rf[e] / (1.f + __expf(-rf[e])));
      *(uint4*)(dst + c8 * 8) = make_uint4(pk(res[0], res[1]), pk(res[2], res[3]), pk(res[4], res[5]), pk(res[6], res[7]));
    }
  }
  __syncthreads();
}

DI void swa_qknorm(const Params& p) {
  bf16_t* QKV = (bf16_t*)(p.ws + OFF_BIG);
  const int tid = threadIdx.x, sub = tid & 7;
  const int ngroups = T_TOK * 18;
  for (int g = blockIdx.x * 32 + (tid >> 3); g < ngroups; g += gridDim.x * 32) {
    const int tok = g / 18, slot = g - tok * 18;
    bf16_t* ptr = QKV + (size_t)tok * 1280 + slot * 64 + sub * 8;
    const uint4 wv = *(const uint4*)ptr;
    float v[8] = {bflo(wv.x), bfhi(wv.x), bflo(wv.y), bfhi(wv.y), bflo(wv.z), bfhi(wv.z), bflo(wv.w), bfhi(wv.w)};
    float ss = 0.f;
#pragma unroll
    for (int e = 0; e < 8; ++e) ss += v[e] * v[e];
    ss += __shfl_xor(ss, 1);
    ss += __shfl_xor(ss, 2);
    ss += __shfl_xor(ss, 4);
    const float rs = rsqrtf(ss * (1.f / 64.f) + 1e-6f);
    const float* gain = (slot < 16 ? p.swa_qn : p.swa_kn) + sub * 8;
#pragma unroll
    for (int e = 0; e < 8; ++e) v[e] = v[e] * rs * gain[e];
    const float posf = (float)p.pos[tok];
    const float invf[8] = {1.0f, 0.1939227432012558f, 0.03760603070259094f, 0.007292664609849453f,
                           0.0014142135623842478f, 0.00027424818836152554f, 5.318296098266728e-05f, 1.0313386155758053e-05f};
#pragma unroll
    for (int e = 0; e < 8; ++e) {
      const float other = __shfl_xor(v[e], 1);
      if (sub < 2) {
        const float ang = posf * invf[e];
        const double rev = (double)ang * 0.15915494309189535;
        const float fr = (float)(rev - rint(rev));
        const float sn = __builtin_amdgcn_sinf(fr), cs = __builtin_amdgcn_cosf(fr);
        v[e] = (sub == 0) ? (v[e] * cs - other * sn) : (v[e] * cs + other * sn);
      }
    }
    if (slot < 16) {
#pragma unroll
      for (int e = 0; e < 8; ++e) v[e] *= 0.125f;
    }
    *(uint4*)ptr = make_uint4(pk(v[0], v[1]), pk(v[2], v[3]), pk(v[4], v[5]), pk(v[6], v[7]));
  }
}

DI void swa_attn(const Params& p, int item, char* smem) {
  const int hq = item & 15, n = (item >> 4) & 127, b = item >> 11, hkv = hq >> 3;
  const int tok0 = b * SEQ + n * 128;
  bf16_t* Ks = (bf16_t*)smem;
  bf16_t* vT = Ks + 256 * 72;
  const bf16_t* QKV = (const bf16_t*)(p.ws + OFF_BIG);
  bf16_t* OUT = (bf16_t*)(p.ws + OFF_ACT_B);
  const int tid = threadIdx.x, lane = tid & 63, w = tid >> 6, r = lane & 31, h = lane >> 5;
  __syncthreads();
#pragma unroll
  for (int i = 0; i < 8; ++i) {
    const int cidx = tid + 256 * i, kk = cidx >> 3, kc = cidx & 7;
    const int pos = n * 128 - 128 + kk;
    uint4 kw = make_uint4(0, 0, 0, 0), vw = make_uint4(0, 0, 0, 0);
    if (pos >= 0) {
      const bf16_t* base = QKV + (size_t)(b * SEQ + pos) * 1280;
      kw = *(const uint4*)(base + 1024 + hkv * 64 + kc * 8);
      vw = *(const uint4*)(base + 1152 + hkv * 64 + kc * 8);
    }
    *(uint4*)(Ks + kk * 72 + kc * 8) = kw;
    bf16_t* vd = vT + (kc * 8) * 264 + kk;
    vd[0 * 264] = (bf16_t)(vw.x & 0xffff); vd[1 * 264] = (bf16_t)(vw.x >> 16);
    vd[2 * 264] = (bf16_t)(vw.y & 0xffff); vd[3 * 264] = (bf16_t)(vw.y >> 16);
    vd[4 * 264] = (bf16_t)(vw.z & 0xffff); vd[5 * 264] = (bf16_t)(vw.z >> 16);
    vd[6 * 264] = (bf16_t)(vw.w & 0xffff); vd[7 * 264] = (bf16_t)(vw.w >> 16);
  }
  __syncthreads();
  const int iq = 32 * w + r;
  const bf16_t* qrow = QKV + (size_t)(tok0 + iq) * 1280 + hq * 64 + h * 8;
  bf16x8 qf[4];
#pragma unroll
  for (int s = 0; s < 4; ++s) qf[s] = *(const bf16x8*)(qrow + s * 16);
  f32x16 X[5];
#pragma unroll
  for (int kt = 0; kt < 5; ++kt) {
    X[kt] = zero16();
#pragma unroll
    for (int s = 0; s < 4; ++s) {
      const bf16x8 A = *(const bf16x8*)(Ks + ((w + kt) * 32 + r) * 72 + s * 16 + h * 8);
      X[kt] = mfma32(A, qf[s], X[kt]);
    }
  }
  const float sink = p.swa_sinks[hq];
  float m = sink;
#pragma unroll
  for (int kt = 0; kt < 5; ++kt)
#pragma unroll
    for (int i = 0; i < 16; ++i) {
      const int kk = (w + kt) * 32 + crow(i, h);
      const bool valid = (kk > iq) && (kk <= iq + 128) && (n > 0 || kk >= 128);
      const float xv = valid ? X[kt][i] : -INFINITY;
      X[kt][i] = xv;
      m = fmaxf(m, xv);
    }
  m = fmaxf(m, __shfl_xor(m, 32));
  float l = 0.f;
#pragma unroll
  for (int kt = 0; kt < 5; ++kt)
#pragma unroll
    for (int i = 0; i < 16; ++i) {
      const float pv = __expf(X[kt][i] - m);
      X[kt][i] = pv;
      l += pv;
    }
  l += __shfl_xor(l, 32);
  l += __expf(sink - m);
  f32x16 O[2];
  O[0] = zero16(); O[1] = zero16();
#pragma unroll
  for (int kt = 0; kt < 5; ++kt)
#pragma unroll
    for (int s2 = 0; s2 < 2; ++s2) {
      const uint4 pw = make_uint4(pk(X[kt][8 * s2 + 0], X[kt][8 * s2 + 1]), pk(X[kt][8 * s2 + 2], X[kt][8 * s2 + 3]),
                                  pk(X[kt][8 * s2 + 4], X[kt][8 * s2 + 5]), pk(X[kt][8 * s2 + 6], X[kt][8 * s2 + 7]));
      const bf16x8 P = __builtin_bit_cast(bf16x8, pw);
#pragma unroll
      for (int mt = 0; mt < 2; ++mt) {
        const bf16_t* vp = vT + (mt * 32 + r) * 264 + (w + kt) * 32 + 16 * s2 + 4 * h;
        const uint2 lo = *(const uint2*)vp, hi = *(const uint2*)(vp + 8);
        const bf16x8 A = __builtin_bit_cast(bf16x8, make_uint4(lo.x, lo.y, hi.x, hi.y));
        O[mt] = mfma32(A, P, O[mt]);
      }
    }
  const float inv = 1.f / l;
  bf16_t* orow = OUT + (size_t)(tok0 + iq) * 1024 + hq * 64 + 4 * h;
#pragma unroll
  for (int mt = 0; mt < 2; ++mt)
#pragma unroll
    for (int g = 0; g < 4; ++g)
      *(uint2*)(orow + mt * 32 + 8 * g) = make_uint2(pk(O[mt][4 * g] * inv, O[mt][4 * g + 1] * inv), pk(O[mt][4 * g + 2] * inv, O[mt][4 * g + 3] * inv));
}

DI unsigned fkey(float f) { const unsigned u = __float_as_uint(f); return (u & 0x80000000u) ? ~u : (u | 0x80000000u); }

template <int N>
DI unsigned kth_thr(const unsigned (&k)[N]) {
  unsigned res = 0;
  for (int bit = 31; bit >= 0; --bit) {
    const unsigned cand = res | (1u << bit);
    int cnt = 0;
#pragma unroll
    for (int n = 0; n < N; ++n) cnt += __popcll(__ballot(k[n] >= cand));
    if (cnt == 16) return cand - 1u;
    if (cnt > 16) res = cand;
  }
  return res;
}

DI void peer_topk(const Params& p, int layer, int item, char* smem) {
  const int head = item & 7, tok0 = (item >> 3) * 32;
  bf16_t* qs = (bf16_t*)smem;
  bf16_t* ks = qs + 32 * 136;
  float* sc = (float*)(smem + 8704);
  float* scr = (float*)(smem + 8704 + 36864);
  const bf16_t* Q = (const bf16_t*)(p.ws + OFF_BIG);
  const bf16_t* KEYS = (const bf16_t*)(p.ws + OFF_KEYS);
  int* E = (int*)(p.ws + OFF_E);
  float* G = (float*)(p.ws + OFF_G);
  const int tid = threadIdx.x, lane = tid & 63, w = tid >> 6, r = lane & 31, h = lane >> 5;
  __syncthreads();
#pragma unroll
  for (int i = 0; i < 2; ++i) {
    const int cidx = tid + 256 * i, row = cidx >> 4, kc = cidx & 15;
    *(uint4*)(qs + row * 136 + kc * 8) = *(const uint4*)(Q + (size_t)(tok0 + row) * 1024 + head * 128 + kc * 8);
  }
#pragma unroll
  for (int i = 0; i < 8; ++i) {
    const int cidx = tid + 256 * i, row = cidx >> 3, kc = cidx & 7;
    *(uint4*)(ks + row * 72 + kc * 8) = *(const uint4*)(KEYS + ((size_t)(layer * 8 + head) * 256 + row) * 64 + kc * 8);
  }
  __syncthreads();
  f32x16 acc[2];
  acc[0] = zero16(); acc[1] = zero16();
  const int set = w >> 1;
#pragma unroll
  for (int s = 0; s < 4; ++s) {
    const bf16x8 A = *(const bf16x8*)(qs + r * 136 + set * 64 + s * 16 + h * 8);
#pragma unroll
    for (int ni = 0; ni < 2; ++ni) {
      const bf16x8 B = *(const bf16x8*)(ks + (w * 64 + ni * 32 + r) * 72 + s * 16 + h * 8);
      acc[ni] = mfma32(A, B, acc[ni]);
    }
  }
  __syncthreads();
#pragma unroll
  for (int ni = 0; ni < 2; ++ni)
#pragma unroll
    for (int i = 0; i < 16; ++i) sc[crow(i, h) * 260 + w * 64 + ni * 32 + r] = acc[ni][i];
  __syncthreads();
  float* wv1 = scr + w * 96;
  float* wv2 = wv1 + 16;
  float* wsc = wv1 + 32;
  int* wi1 = (int*)(wv1 + 48);
  int* wi2 = (int*)(wv1 + 64);
  int* we = (int*)(wv1 + 80);
  for (int j = 0; j < 8; ++j) {
    const int tl = w * 8 + j;
    const float* srow = sc + tl * 260;
    const float a0 = srow[lane], a1 = srow[64 + lane], b0 = srow[128 + lane], b1 = srow[192 + lane];
    {
      const unsigned k[2] = {fkey(a0), fkey(a1)};
      const unsigned thr = kth_thr<2>(k);
      int base = 0;
#pragma unroll
      for (int n = 0; n < 2; ++n) {
        const bool s = k[n] > thr;
        const unsigned long long mk = __ballot(s);
        const int pos = base + mbcnt64(mk);
        if (s) { wv1[pos] = n ? a1 : a0; wi1[pos] = n * 64 + lane; }
        base += __popcll(mk);
      }
#pragma unroll
      for (int n = 0; n < 2; ++n) {
        const bool s = k[n] == thr;
        const unsigned long long mk = __ballot(s);
        const int pos = base + mbcnt64(mk);
        if (s && pos < 16) { wv1[pos] = n ? a1 : a0; wi1[pos] = n * 64 + lane; }
        base += __popcll(mk);
      }
    }
    {
      const unsigned k[2] = {fkey(b0), fkey(b1)};
      const unsigned thr = kth_thr<2>(k);
      int base = 0;
#pragma unroll
      for (int n = 0; n < 2; ++n) {
        const bool s = k[n] > thr;
        const unsigned long long mk = __ballot(s);
        const int pos = base + mbcnt64(mk);
        if (s) { wv2[pos] = n ? b1 : b0; wi2[pos] = n * 64 + lane; }
        base += __popcll(mk);
      }
#pragma unroll
      for (int n = 0; n < 2; ++n) {
        const bool s = k[n] == thr;
        const unsigned long long mk = __ballot(s);
        const int pos = base + mbcnt64(mk);
        if (s && pos < 16) { wv2[pos] = n ? b1 : b0; wi2[pos] = n * 64 + lane; }
        base += __popcll(mk);
      }
    }
    wave_sync();
    {
      float cv[4]; unsigned k[4];
#pragma unroll
      for (int n = 0; n < 4; ++n) { const int cidx = n * 64 + lane; cv[n] = wv1[cidx >> 4] + wv2[cidx & 15]; k[n] = fkey(cv[n]); }
      const unsigned thr = kth_thr<4>(k);
      int base = 0;
#pragma unroll
      for (int n = 0; n < 4; ++n) {
        const bool s = k[n] > thr;
        const unsigned long long mk = __ballot(s);
        const int pos = base + mbcnt64(mk);
        const int cidx = n * 64 + lane;
        if (s) { wsc[pos] = cv[n]; we[pos] = wi1[cidx >> 4] * 128 + wi2[cidx & 15]; }
        base += __popcll(mk);
      }
#pragma unroll
      for (int n = 0; n < 4; ++n) {
        const bool s = k[n] == thr;
        const unsigned long long mk = __ballot(s);
        const int pos = base + mbcnt64(mk);
        const int cidx = n * 64 + lane;
        if (s && pos < 16) { wsc[pos] = cv[n]; we[pos] = wi1[cidx >> 4] * 128 + wi2[cidx & 15]; }
        base += __popcll(mk);
      }
    }
    wave_sync();
    {
      const float sv = wsc[lane & 15];
      const int ev = we[lane & 15];
      float mx = sv;
      mx = fmaxf(mx, __shfl_xor(mx, 1)); mx = fmaxf(mx, __shfl_xor(mx, 2)); mx = fmaxf(mx, __shfl_xor(mx, 4)); mx = fmaxf(mx, __shfl_xor(mx, 8));
      const float ex = __expf(sv - mx);
      float sm = ex;
      sm += __shfl_xor(sm, 1); sm += __shfl_xor(sm, 2); sm += __shfl_xor(sm, 4); sm += __shfl_xor(sm, 8);
      if (lane < 16) {
        const size_t o = (size_t)(tok0 + tl) * 128 + head * 16 + lane;
        E[o] = ev;
        G[o] = ex / sm;
      }
    }
    wave_sync();
  }
}

DI void peer_gather(const Params& p, char* smem) {
  const int tid = threadIdx.x, lane = tid & 63, w = tid >> 6, grp = lane >> 4, i16 = lane & 15;
  float* a_s = (float*)smem + w * 128;
  const bf16_t* HN = (const bf16_t*)(p.ws + OFF_ACT_A);
  const bf16_t* U = (const bf16_t*)(p.ws + OFF_TBL_U);
  const bf16_t* V = (const bf16_t*)(p.ws + OFF_TBL_V);
  const int* E = (const int*)(p.ws + OFF_E);
  const float* G = (const float*)(p.ws + OFF_G);
  for (int tok = blockIdx.x * 4 + w; tok < T_TOK; tok += gridDim.x * 4) {
    const uint4* xp = (const uint4*)(HN + (size_t)tok * 1024);
    uint4 xr[8];
#pragma unroll
    for (int c = 0; c < 8; ++c) xr[c] = xp[i16 + 16 * c];
    const int e0 = E[(size_t)tok * 128 + lane], e1 = E[(size_t)tok * 128 + 64 + lane];
    const float g0 = G[(size_t)tok * 128 + lane], g1 = G[(size_t)tok * 128 + 64 + lane];
#pragma unroll 2
    for (int mm = 0; mm < 32; ++mm) {
      const int pidx = 4 * mm + grp;
      const int row = __shfl(mm < 16 ? e0 : e1, pidx & 63);
      const float gg = __shfl(mm < 16 ? g0 : g1, pidx & 63);
      const uint4* up = (const uint4*)(U + (size_t)row * 1024);
      float acc0 = 0.f, acc1 = 0.f;
#pragma unroll
      for (int c = 0; c < 8; ++c) {
        const uint4 wv = up[i16 + 16 * c];
        acc0 = dot2(wv.x, xr[c].x, acc0); acc1 = dot2(wv.y, xr[c].y, acc1);
        acc0 = dot2(wv.z, xr[c].z, acc0); acc1 = dot2(wv.w, xr[c].w, acc1);
      }
      float acc = acc0 + acc1;
      acc += __shfl_xor(acc, 1); acc += __shfl_xor(acc, 2); acc += __shfl_xor(acc, 4); acc += __shfl_xor(acc, 8);
      const float a = 0.5f * acc * (1.f + erff(acc * 0.7071067811865476f)) * gg;
      if (i16 == 0) a_s[pidx] = a;
    }
    wave_sync();
    float o[16];
#pragma unroll
    for (int i = 0; i < 16; ++i) o[i] = 0.f;
#pragma unroll 8
    for (int pp = 0; pp < 128; ++pp) {
      const int row = __builtin_amdgcn_readlane(pp < 64 ? e0 : e1, pp & 63);
      const float a = a_s[pp];
      const uint4* vp = (const uint4*)(V + (size_t)row * 1024);
      const uint4 w0 = vp[lane], w1 = vp[64 + lane];
      o[0] += a * bflo(w0.x); o[1] += a * bfhi(w0.x); o[2] += a * bflo(w0.y); o[3] += a * bfhi(w0.y);
      o[4] += a * bflo(w0.z); o[5] += a * bfhi(w0.z); o[6] += a * bflo(w0.w); o[7] += a * bfhi(w0.w);
      o[8] += a * bflo(w1.x); o[9] += a * bfhi(w1.x); o[10] += a * bflo(w1.y); o[11] += a * bfhi(w1.y);
      o[12] += a * bflo(w1.z); o[13] += a * bfhi(w1.z); o[14] += a * bflo(w1.w); o[15] += a * bfhi(w1.w);
    }
    float4* hp = (float4*)(p.out + (size_t)tok * 1024 + lane * 8);
    float4 t0 = hp[0], t1 = hp[1];
    t0.x += o[0]; t0.y += o[1]; t0.z += o[2]; t0.w += o[3]; t1.x += o[4]; t1.y += o[5]; t1.z += o[6]; t1.w += o[7];
    hp[0] = t0; hp[1] = t1;
    float4* hq = (float4*)(p.out + (size_t)tok * 1024 + 512 + lane * 8);
    float4 t2 = hq[0], t3 = hq[1];
    t2.x += o[8]; t2.y += o[9]; t2.z += o[10]; t2.w += o[11]; t3.x += o[12]; t3.y += o[13]; t3.z += o[14]; t3.w += o[15];
    hq[0] = t2; hq[1] = t3;
    wave_sync();
  }
}

DI void run_phase(const Params& p, int ph, char* smem) {
  bf16_t* actA = (bf16_t*)(p.ws + OFF_ACT_A);
  bf16_t* big = (bf16_t*)(p.ws + OFF_BIG);
  switch (ph) {
    case 0: phase_convert(p, smem); phase_cvt_tables(p, 0); break;
    case 1: phase_rmsnorm(p.x, p.ln_mix, actA); break;
    case 2: phase_gemm<EPI_GLA_IN>(p, actA, (const bf16_t*)(p.ws + OFF_WT_GLA_IN), 25, big, 3072, nullptr, smem); break;
    case 3: for (int it = blockIdx.x; it < 2048; it += gridDim.x) gla_phase1(p, it, smem); break;
    case 4: gla_scan(p); break;
    case 5: for (int it = blockIdx.x; it < 2048; it += gridDim.x) gla_phase3(p, it, smem); break;
    case 6: phase_gemm<EPI_RESID_X>(p, actA, (const bf16_t*)(p.ws + OFF_WT_GLA_OUT), 8, nullptr, 0, nullptr, smem); break;
    case 7: phase_rmsnorm(p.out, p.ln_ffn, actA); break;
    case 8: phase_gemm<EPI_BF16>(p, actA, (const bf16_t*)(p.ws + OFF_WT_PQ), 8, big, 1024, nullptr, smem); break;
    case 9: for (int it = blockIdx.x; it < 8192; it += gridDim.x) peer_topk(p, 0, it, smem); break;
    case 10: peer_gather(p, smem); break;
    case 11: phase_rmsnorm(p.out, p.ln_mix + 1024, actA); phase_cvt_tables(p, 1); break;
    case 12: phase_gemm<EPI_BF16>(p, actA, (const bf16_t*)(p.ws + OFF_WT_SWA_IN), 10, big, 1280, p.swa_b_in, smem); break;
    case 13: swa_qknorm(p); break;
    case 14: for (int it = blockIdx.x; it < 4096; it += gridDim.x) swa_attn(p, it, smem); break;
    case 15: phase_gemm<EPI_RESID_INPLACE>(p, (const bf16_t*)(p.ws + OFF_ACT_B), (const bf16_t*)(p.ws + OFF_WT_SWA_OUT), 8, nullptr, 0, p.swa_b_out, smem); break;
    case 16: phase_rmsnorm(p.out, p.ln_ffn + 1024, actA); break;
    case 17: phase_gemm<EPI_BF16>(p, actA, (const bf16_t*)(p.ws + OFF_WT_PQ) + (size_t)1024 * 1024, 8, big, 1024, nullptr, smem); break;
    case 18: for (int it = blockIdx.x; it < 8192; it += gridDim.x) peer_topk(p, 1, it, smem); break;
    case 19: peer_gather(p, smem); break;
    default: break;
  }
}

template <int PH>
__global__ void __launch_bounds__(256, 2) phase_kernel(Params p) {
  __shared__ __attribute__((aligned(16))) char smem[SMEM_BYTES];
  run_phase(p, PH, smem);
}

template <int PH>
static void launch_phases(const Params& p, int grid, hipStream_t stream) {
  hipLaunchKernelGGL(phase_kernel<PH>, dim3(grid), dim3(256), 0, stream, p);
  if constexpr (PH + 1 < NPHASE) launch_phases<PH + 1>(p, grid, stream);
}

#if !MULTI_LAUNCH
template <int PH>
DI void run_all(const Params& p, char* smem) {
  run_phase(p, PH, smem);
  if constexpr (PH + 1 < NPHASE) {
    cg::this_grid().sync();
    run_all<PH + 1>(p, smem);
  }
}
__global__ void __launch_bounds__(256, 2) trunk_kernel(Params p) {
  __shared__ __attribute__((aligned(16))) char smem[SMEM_BYTES];
  run_all<0>(p, smem);
}
#endif

extern "C" void kernel_launch(void* const* d_in, const int* in_sizes, int n_in, void* d_out, int out_size, void* d_ws, size_t ws_size,
                              hipStream_t stream) {
  Params p{};
  p.x = (const float*)d_in[0]; p.pos = (const int*)d_in[1]; p.ln_mix = (const float*)d_in[2]; p.ln_ffn = (const float*)d_in[3];
  p.gla_w_in = (const float*)d_in[4]; p.gla_w_alpha = (const float*)d_in[5]; p.gla_b_alpha = (const float*)d_in[6];
  p.gla_norm = (const float*)d_in[7]; p.gla_w_out = (const float*)d_in[8];
  p.swa_w_in = (const float*)d_in[9]; p.swa_b_in = (const float*)d_in[10]; p.swa_qn = (const float*)d_in[11]; p.swa_kn = (const float*)d_in[12];
  p.swa_sinks = (const float*)d_in[13]; p.swa_w_out = (const float*)d_in[14]; p.swa_b_out = (const float*)d_in[15];
  p.peer_wq = (const float*)d_in[16]; p.peer_keys = (const float*)d_in[17]; p.peer_u = (const float*)d_in[18]; p.peer_v = (const float*)d_in[19];
  p.out = (float*)d_out; p.ws = (char*)d_ws;
  static int grid_blocks = 0;
  if (!grid_blocks) {
    int dev = 0, cus = 0, per_cu = 0;
    (void)hipGetDevice(&dev);
    (void)hipDeviceGetAttribute(&cus, hipDeviceAttributeMultiprocessorCount, dev);
    #if MULTI_LAUNCH
    per_cu = 2;
#else
    (void)hipOccupancyMaxActiveBlocksPerMultiprocessor(&per_cu, trunk_kernel, 256, 0);
#endif
    if (per_cu < 1) per_cu = 1;
    if (per_cu > 2) per_cu = 2;
    grid_blocks = cus * per_cu;
  }
#if MULTI_LAUNCH
  p.phase_lo = 0; p.phase_hi = 0;
  launch_phases<0>(p, grid_blocks, stream);
#else
  p.phase_lo = 0; p.phase_hi = NPHASE - 1;
  void* args[] = {&p};
  hipError_t e = hipLaunchCooperativeKernel((void*)trunk_kernel, dim3(grid_blocks), dim3(256), args, 0, stream);
  if (e != hipSuccess) fprintf(stderr, "cooperative launch failed: %s (grid %d)\n", hipGetErrorString(e), grid_blocks);
#endif
}
```

```cpp
#include <hip/hip_runtime.h>
#include <hip/hip_cooperative_groups.h>
#include <stdint.h>
#include <stdio.h>
namespace cg = cooperative_groups;

#ifndef MULTI_LAUNCH
#define MULTI_LAUNCH 0
#endif

#define DI __device__ __forceinline__
typedef unsigned short bf16_t;
typedef __attribute__((ext_vector_type(8))) short bf16x8;
typedef __attribute__((ext_vector_type(16))) float f32x16;
typedef __bf16 bf16x2_t __attribute__((ext_vector_type(2)));
typedef float f32x2_t __attribute__((ext_vector_type(2)));

constexpr int T_TOK = 32768;
constexpr int SEQ = 16384;
constexpr int DM = 1024;
constexpr int NPHASE = 20;

constexpr size_t MiB = 1048576;
constexpr size_t OFF_WT_GLA_IN = 0;
constexpr size_t OFF_WT_GLA_OUT = 7 * MiB;
constexpr size_t OFF_WT_SWA_IN = 9 * MiB;
constexpr size_t OFF_WT_SWA_OUT = 12 * MiB;
constexpr size_t OFF_WT_PQ = 14 * MiB;
constexpr size_t OFF_KEYS = 18 * MiB;
constexpr size_t OFF_TBL_U = 24 * MiB;
constexpr size_t OFF_TBL_V = 56 * MiB;
constexpr size_t OFF_ACT_A = 88 * MiB;
constexpr size_t OFF_BIG = 152 * MiB;
constexpr size_t OFF_E = OFF_BIG + 64 * MiB;
constexpr size_t OFF_G = OFF_BIG + 80 * MiB;
constexpr size_t OFF_KVT = 344 * MiB;
constexpr size_t OFF_ACT_B = OFF_KVT;
constexpr size_t OFF_LR = 472 * MiB;
constexpr size_t OFF_DECAY = 474 * MiB;
constexpr size_t OFF_BAR = 476 * MiB;

constexpr int SMEM_BYTES = 73728;
constexpr int LDK = 72;

struct Params {
  const float* x; const int* pos; const float* ln_mix; const float* ln_ffn;
  const float* gla_w_in; const float* gla_w_alpha; const float* gla_b_alpha; const float* gla_norm; const float* gla_w_out;
  const float* swa_w_in; const float* swa_b_in; const float* swa_qn; const float* swa_kn; const float* swa_sinks;
  const float* swa_w_out; const float* swa_b_out;
  const float* peer_wq; const float* peer_keys; const float* peer_u; const float* peer_v;
  float* out; char* ws;
  int phase_lo, phase_hi;
};

DI unsigned pk(float lo, float hi) { f32x2_t v = {lo, hi}; bf16x2_t b = __builtin_convertvector(v, bf16x2_t); return __builtin_bit_cast(unsigned, b); }
DI bf16_t f2bf(float x) { return (bf16_t)(pk(x, 0.f) & 0xffffu); }
DI float bflo(unsigned w) { return __uint_as_float(w << 16); }
DI float bfhi(unsigned w) { return __uint_as_float(w & 0xffff0000u); }
DI float bf2f(bf16_t b) { return __uint_as_float(((unsigned)b) << 16); }
DI float dot2(unsigned a, unsigned b, float c) { return __builtin_amdgcn_fdot2_f32_bf16(__builtin_bit_cast(bf16x2_t, a), __builtin_bit_cast(bf16x2_t, b), c, false); }
DI int crow(int i, int h) { return (i & 3) + 8 * (i >> 2) + 4 * h; }
DI f32x16 mfma32(bf16x8 a, bf16x8 b, f32x16 c) { return __builtin_amdgcn_mfma_f32_32x32x16_bf16(a, b, c, 0, 0, 0); }
DI f32x16 zero16() { f32x16 z; for (int i = 0; i < 16; ++i) z[i] = 0.f; return z; }
DI void wave_sync() { __builtin_amdgcn_fence(__ATOMIC_RELEASE, "wavefront"); __builtin_amdgcn_wave_barrier(); __builtin_amdgcn_fence(__ATOMIC_ACQUIRE, "wavefront"); }
DI int mbcnt64(unsigned long long m) { return __builtin_amdgcn_mbcnt_hi((unsigned)(m >> 32), __builtin_amdgcn_mbcnt_lo((unsigned)m, 0)); }
DI float logsig(float z) { return fminf(z, 0.f) - log1pf(__expf(-fabsf(z))); }

DI void transpose_tile(const float* __restrict__ src, int N, bf16_t* __restrict__ dst, int kt, int nt, float* sT) {
  const int tid = threadIdx.x;
  const int r = tid >> 4, c4 = (tid & 15) * 4;
#pragma unroll
  for (int i = 0; i < 4; ++i) {
    const int k = kt * 64 + r + 16 * i, n = nt * 64 + c4;
    float4 v = make_float4(0.f, 0.f, 0.f, 0.f);
    if (n + 3 < N) v = *(const float4*)(src + (size_t)k * N + n);
    float* d = sT + (r + 16 * i) * 65 + c4;
    d[0] = v.x; d[1] = v.y; d[2] = v.z; d[3] = v.w;
  }
  __syncthreads();
  const int n = tid >> 2, seg = tid & 3;
  unsigned w[8];
#pragma unroll
  for (int j = 0; j < 8; ++j) w[j] = pk(sT[(seg * 16 + 2 * j) * 65 + n], sT[(seg * 16 + 2 * j + 1) * 65 + n]);
  uint4* d = (uint4*)(dst + (size_t)(nt * 64 + n) * 1024 + kt * 64 + seg * 16);
  d[0] = make_uint4(w[0], w[1], w[2], w[3]);
  d[1] = make_uint4(w[4], w[5], w[6], w[7]);
  __syncthreads();
}

DI void cvt_elems(const float* __restrict__ src, bf16_t* __restrict__ dst, size_t n8) {
  for (size_t i = (size_t)blockIdx.x * 256 + threadIdx.x; i < n8; i += (size_t)gridDim.x * 256) {
    const float4 a = ((const float4*)src)[2 * i], b = ((const float4*)src)[2 * i + 1];
    ((uint4*)dst)[i] = make_uint4(pk(a.x, a.y), pk(a.z, a.w), pk(b.x, b.y), pk(b.z, b.w));
  }
}

DI void phase_convert(const Params& p, char* smem) {
  float* sT = (float*)smem;
  for (int t = blockIdx.x; t < 2144; t += gridDim.x) {
    const float* src; int N, ntn; bf16_t* dst; int local;
    if (t < 800) { src = p.gla_w_in; N = 3088; ntn = 50; dst = (bf16_t*)(p.ws + OFF_WT_GLA_IN); local = t; }
    else if (t < 1056) { src = p.gla_w_out; N = 1024; ntn = 16; dst = (bf16_t*)(p.ws + OFF_WT_GLA_OUT); local = t - 800; }
    else if (t < 1376) { src = p.swa_w_in; N = 1280; ntn = 20; dst = (bf16_t*)(p.ws + OFF_WT_SWA_IN); local = t - 1056; }
    else if (t < 1632) { src = p.swa_w_out; N = 1024; ntn = 16; dst = (bf16_t*)(p.ws + OFF_WT_SWA_OUT); local = t - 1376; }
    else if (t < 1888) { src = p.peer_wq; N = 1024; ntn = 16; dst = (bf16_t*)(p.ws + OFF_WT_PQ); local = t - 1632; }
    else { src = p.peer_wq + (size_t)1024 * 1024; N = 1024; ntn = 16; dst = (bf16_t*)(p.ws + OFF_WT_PQ) + (size_t)1024 * 1024; local = t - 1888; }
    transpose_tile(src, N, dst, local / ntn, local % ntn, sT);
  }
  cvt_elems(p.peer_keys, (bf16_t*)(p.ws + OFF_KEYS), (size_t)2 * 8 * 2 * 128 * 64 / 8);
}

DI void phase_cvt_tables(const Params& p, int layer) {
  cvt_elems(p.peer_u + (size_t)layer * 16384 * 1024, (bf16_t*)(p.ws + OFF_TBL_U), (size_t)16384 * 1024 / 8);
  cvt_elems(p.peer_v + (size_t)layer * 16384 * 1024, (bf16_t*)(p.ws + OFF_TBL_V), (size_t)16384 * 1024 / 8);
}

DI void phase_rmsnorm(const float* __restrict__ src, const float* __restrict__ gain, bf16_t* __restrict__ dst) {
  const int lane = threadIdx.x & 63, w = threadIdx.x >> 6;
  for (int row = blockIdx.x * 4 + w; row < T_TOK; row += gridDim.x * 4) {
    const float4* sp = (const float4*)(src + (size_t)row * DM);
    float4 v[4];
    float ss = 0.f;
#pragma unroll
    for (int i = 0; i < 4; ++i) { v[i] = sp[lane + 64 * i]; ss += v[i].x * v[i].x + v[i].y * v[i].y + v[i].z * v[i].z + v[i].w * v[i].w; }
#pragma unroll
    for (int o = 32; o >= 1; o >>= 1) ss += __shfl_xor(ss, o);
    const float rs = rsqrtf(ss * (1.f / 1024.f) + 1e-6f);
#pragma unroll
    for (int i = 0; i < 4; ++i) {
      const float4 g = ((const float4*)gain)[lane + 64 * i];
      uint2 o2 = make_uint2(pk(v[i].x * rs * g.x, v[i].y * rs * g.y), pk(v[i].z * rs * g.z, v[i].w * rs * g.w));
      *(uint2*)(dst + (size_t)row * DM + (lane + 64 * i) * 4) = o2;
    }
  }
}

DI void mma_64x64(const bf16_t* sA, const bf16_t* sB, int arow0, int brow0, f32x16 (&acc)[2][2], int lane) {
  const int r = lane & 31, h = lane >> 5;
#pragma unroll
  for (int s = 0; s < 4; ++s) {
    bf16x8 a[2], b[2];
#pragma unroll
    for (int mi = 0; mi < 2; ++mi) a[mi] = *(const bf16x8*)(sA + (arow0 + mi * 32 + r) * LDK + s * 16 + h * 8);
#pragma unroll
    for (int ni = 0; ni < 2; ++ni) b[ni] = *(const bf16x8*)(sB + (brow0 + ni * 32 + r) * LDK + s * 16 + h * 8);
#pragma unroll
    for (int mi = 0; mi < 2; ++mi)
#pragma unroll
      for (int ni = 0; ni < 2; ++ni) acc[mi][ni] = mfma32(a[mi], b[ni], acc[mi][ni]);
  }
}

enum { EPI_GLA_IN = 0, EPI_RESID_X = 1, EPI_BF16 = 2, EPI_RESID_INPLACE = 3 };

template <int MODE>
DI void gemm_tile(const Params& p, const bf16_t* __restrict__ A, const bf16_t* __restrict__ Bt, int m0, int n0,
                  bf16_t* dstb, int ldc, const float* __restrict__ bias, char* smem) {
  bf16_t* sA = (bf16_t*)smem;
  bf16_t* sB = sA + 128 * LDK;
  const int tid = threadIdx.x, lane = tid & 63, w = tid >> 6, wm = w >> 1, wn = w & 1;
  f32x16 acc[2][2];
#pragma unroll
  for (int i = 0; i < 2; ++i)
#pragma unroll
    for (int j = 0; j < 2; ++j) acc[i][j] = zero16();
  bf16x8 ra[4], rb[4];
  const int lrow = tid >> 3, kc = tid & 7;
  const bf16_t* ap = A + (size_t)(m0 + lrow) * 1024 + kc * 8;
  const bf16_t* bp = Bt + (size_t)(n0 + lrow) * 1024 + kc * 8;
#pragma unroll
  for (int i = 0; i < 4; ++i) { ra[i] = *(const bf16x8*)(ap + (size_t)i * 32 * 1024); rb[i] = *(const bf16x8*)(bp + (size_t)i * 32 * 1024); }
  __syncthreads();
#pragma unroll
  for (int i = 0; i < 4; ++i) { *(bf16x8*)(sA + (lrow + 32 * i) * LDK + kc * 8) = ra[i]; *(bf16x8*)(sB + (lrow + 32 * i) * LDK + kc * 8) = rb[i]; }
  __syncthreads();
  for (int kt = 0; kt < 16; ++kt) {
    if (kt + 1 < 16) {
#pragma unroll
      for (int i = 0; i < 4; ++i) { ra[i] = *(const bf16x8*)(ap + (size_t)i * 32 * 1024 + (kt + 1) * 64); rb[i] = *(const bf16x8*)(bp + (size_t)i * 32 * 1024 + (kt + 1) * 64); }
    }
    mma_64x64(sA, sB, wm * 64, wn * 64, acc, lane);
    __syncthreads();
    if (kt + 1 < 16) {
#pragma unroll
      for (int i = 0; i < 4; ++i) { *(bf16x8*)(sA + (lrow + 32 * i) * LDK + kc * 8) = ra[i]; *(bf16x8*)(sB + (lrow + 32 * i) * LDK + kc * 8) = rb[i]; }
      __syncthreads();
    }
  }
  const int r = lane & 31, h = lane >> 5;
#pragma unroll
  for (int mi = 0; mi < 2; ++mi)
#pragma unroll
    for (int ni = 0; ni < 2; ++ni) {
      const int col = n0 + wn * 64 + ni * 32 + r;
#pragma unroll
      for (int i = 0; i < 16; ++i) {
        const int row = m0 + wm * 64 + mi * 32 + crow(i, h);
        const float v = acc[mi][ni][i];
        if (MODE == EPI_GLA_IN) {
          if (col < 3072) dstb[(size_t)row * 3072 + col] = f2bf(v);
          else if (col < 3088) ((float*)(p.ws + OFF_LR))[(size_t)row * 16 + (col - 3072)] = v;
        } else if (MODE == EPI_RESID_X) {
          p.out[(size_t)row * 1024 + col] = p.x[(size_t)row * 1024 + col] + v;
        } else if (MODE == EPI_BF16) {
          dstb[(size_t)row * ldc + col] = f2bf(bias ? v + bias[col] : v);
        } else {
          p.out[(size_t)row * 1024 + col] += v + bias[col];
        }
      }
    }
}

template <int MODE>
DI void phase_gemm(const Params& p, const bf16_t* A, const bf16_t* Bt, int NT, bf16_t* dstb, int ldc, const float* bias, char* smem) {
  const int ntiles = (T_TOK / 128) * NT;
  for (int t = blockIdx.x; t < ntiles; t += gridDim.x) gemm_tile<MODE>(p, A, Bt, (t / NT) * 128, (t % NT) * 128, dstb, ldc, bias, smem);
}

DI float gate_la(const float* lr_s, int t, const float (&wa)[16], float ba) {
  float z = ba;
#pragma unroll
  for (int j = 0; j < 16; ++j) z += lr_s[t * 16 + j] * wa[j];
  return logsig(z) * (1.f / 16.f);
}
DI void gla_gates(const Params& p, int t0, int hh, float (&wa)[16], float& ba, float& offset, float& blast, float* lr_s, float* tot_s) {
  const int tid = threadIdx.x, d = tid & 127, half = tid >> 7;
  const float* LR = (const float*)(p.ws + OFF_LR);
  ((float4*)lr_s)[tid] = ((const float4*)(LR + (size_t)t0 * 16))[tid];
#pragma unroll
  for (int j = 0; j < 16; ++j) wa[j] = p.gla_w_alpha[j * 512 + hh * 128 + d];
  ba = p.gla_b_alpha[hh * 128 + d];
  __syncthreads();
  float sum = 0.f;
#pragma unroll 4
  for (int tt = 0; tt < 32; ++tt) sum += gate_la(lr_s, half * 32 + tt, wa, ba);
  tot_s[half * 128 + d] = sum;
  __syncthreads();
  offset = half ? tot_s[d] : 0.f;
  blast = tot_s[d] + tot_s[128 + d];
}

DI void fill_vT(const bf16_t* __restrict__ QKVR, int t0, int hh, int vh, bf16_t* vT) {
  const int tid = threadIdx.x, v = tid & 127, half = tid >> 7;
#pragma unroll 8
  for (int tt = 0; tt < 32; ++tt) {
    const int t = half * 32 + tt;
    vT[v * LDK + t] = QKVR[(size_t)(t0 + t) * 3072 + 1024 + hh * 256 + vh * 128 + v];
  }
}

DI void gla_phase1(const Params& p, int item, char* smem) {
  const int hh = item & 3, c = (item >> 2) & 255, b = item >> 10;
  const int t0 = b * SEQ + c * 64;
  float* lr_s = (float*)smem;
  float* tot_s = (float*)(smem + 4096);
  bf16_t* kfT = (bf16_t*)(smem + 5120);
  bf16_t* vT = kfT + 128 * LDK;
  const bf16_t* QKVR = (const bf16_t*)(p.ws + OFF_BIG);
  bf16_t* KVT = (bf16_t*)(p.ws + OFF_KVT);
  float* DECAY = (float*)(p.ws + OFF_DECAY);
  const int tid = threadIdx.x, lane = tid & 63, w = tid >> 6, wm = w >> 1, wn = w & 1;
  const int d = tid & 127, half = tid >> 7;
  float wa[16], ba, offset, blast;
  gla_gates(p, t0, hh, wa, ba, offset, blast, lr_s, tot_s);
  float run = offset;
#pragma unroll 4
  for (int tt = 0; tt < 32; ++tt) {
    const int t = half * 32 + tt;
    run += gate_la(lr_s, t, wa, ba);
    const float kv = bf2f(QKVR[(size_t)(t0 + t) * 3072 + 512 + hh * 128 + d]);
    kfT[d * LDK + t] = f2bf(kv * __expf(blast - run));
  }
  if (half == 0) DECAY[(size_t)item * 128 + d] = __expf(blast);
  const int r = lane & 31, h = lane >> 5;
  for (int vh = 0; vh < 2; ++vh) {
    __syncthreads();
    fill_vT(QKVR, t0, hh, vh, vT);
    __syncthreads();
    f32x16 acc[2][2];
#pragma unroll
    for (int i = 0; i < 2; ++i)
#pragma unroll
      for (int j = 0; j < 2; ++j) acc[i][j] = zero16();
    mma_64x64(vT, kfT, wm * 64, wn * 64, acc, lane);
    bf16_t* kbase = KVT + (size_t)item * 32768 + (vh * 128 + wm * 64 + 4 * h) * 128 + wn * 64 + r;
#pragma unroll
    for (int mi = 0; mi < 2; ++mi)
#pragma unroll
      for (int ni = 0; ni < 2; ++ni)
#pragma unroll
        for (int i = 0; i < 16; ++i) kbase[(mi * 32 + (i & 3) + 8 * (i >> 2)) * 128 + ni * 32] = f2bf(acc[mi][ni][i]);
  }
  __syncthreads();
}

DI void gla_scan(const Params& p) {
  bf16_t* KVT = (bf16_t*)(p.ws + OFF_KVT);
  const float* DECAY = (const float*)(p.ws + OFF_DECAY);
  for (int idx = blockIdx.x * 256 + threadIdx.x; idx < 8 * 16384; idx += gridDim.x * 256) {
    const int bh = idx >> 14, e2 = idx & 16383, b = bh >> 2, hh = bh & 3, d0 = (2 * e2) & 127;
    float s0 = 0.f, s1 = 0.f;
    for (int c0 = 0; c0 < 256; c0 += 8) {
      unsigned kv[8]; float2 dc[8];
#pragma unroll
      for (int u = 0; u < 8; ++u) {
        const size_t item = (size_t)(b * 256 + c0 + u) * 4 + hh;
        kv[u] = *(const unsigned*)(KVT + item * 32768 + 2 * e2);
        dc[u] = *(const float2*)(DECAY + item * 128 + d0);
      }
#pragma unroll
      for (int u = 0; u < 8; ++u) {
        const size_t item = (size_t)(b * 256 + c0 + u) * 4 + hh;
        *(unsigned*)(KVT + item * 32768 + 2 * e2) = pk(s0, s1);
        s0 = dc[u].x * s0 + bflo(kv[u]);
        s1 = dc[u].y * s1 + bfhi(kv[u]);
      }
    }
  }
}

DI void gla_phase3(const Params& p, int item, char* smem) {
  const int hh = item & 3, c = (item >> 2) & 255, b = item >> 10;
  const int t0 = b * SEQ + c * 64;
  float* lr_s = (float*)smem;
  float* tot_s = (float*)(smem + 4096);
  bf16_t* qd = (bf16_t*)(smem + 5120);
  bf16_t* ki = qd + 64 * 136;
  bf16_t* at = ki + 64 * 136;
  bf16_t* vT = at + 64 * 72;
  bf16_t* ot = qd;
  const bf16_t* QKVR = (const bf16_t*)(p.ws + OFF_BIG);
  const bf16_t* ST = (const bf16_t*)(p.ws + OFF_KVT);
  bf16_t* OG = (bf16_t*)(p.ws + OFF_ACT_A);
  const int tid = threadIdx.x, lane = tid & 63, w = tid >> 6;
  const int d = tid & 127, half = tid >> 7;
  const int r = lane & 31, h = lane >> 5;
  {
    float wa[16], ba, offset, blast;
    gla_gates(p, t0, hh, wa, ba, offset, blast, lr_s, tot_s);
    float run = offset;
#pragma unroll 4
    for (int tt = 0; tt < 32; ++tt) {
      const int t = half * 32 + tt;
      run += gate_la(lr_s, t, wa, ba);
      const float q = bf2f(QKVR[(size_t)(t0 + t) * 3072 + hh * 128 + d]);
      const float k = bf2f(QKVR[(size_t)(t0 + t) * 3072 + 512 + hh * 128 + d]);
      qd[t * 136 + d] = f2bf(q * 0.08838834764831845f * __expf(run));
      ki[t * 136 + d] = f2bf(k * __expf(-run));
    }
  }
  __syncthreads();
  {
    const int mi = w >> 1, nj = w & 1;
    f32x16 a = zero16();
#pragma unroll
    for (int s = 0; s < 8; ++s) {
      const bf16x8 A = *(const bf16x8*)(qd + (mi * 32 + r) * 136 + s * 16 + h * 8);
      const bf16x8 B = *(const bf16x8*)(ki + (nj * 32 + r) * 136 + s * 16 + h * 8);
      a = mfma32(A, B, a);
    }
#pragma unroll
    for (int i = 0; i < 16; ++i) {
      const int it = mi * 32 + crow(i, h), jt = nj * 32 + r;
      at[it * 72 + jt] = f2bf(jt <= it ? a[i] : 0.f);
    }
  }
  f32x16 o[2][2];
#pragma unroll
  for (int i = 0; i < 2; ++i)
#pragma unroll
    for (int j = 0; j < 2; ++j) o[i][j] = zero16();
#pragma unroll
  for (int vh = 0; vh < 2; ++vh) {
    __syncthreads();
    fill_vT(QKVR, t0, hh, vh, vT);
    __syncthreads();
#pragma unroll
    for (int s = 0; s < 4; ++s) {
      const bf16x8 B = *(const bf16x8*)(vT + (w * 32 + r) * LDK + s * 16 + h * 8);
#pragma unroll
      for (int mt = 0; mt < 2; ++mt) {
        const bf16x8 A = *(const bf16x8*)(at + (mt * 32 + r) * 72 + s * 16 + h * 8);
        o[vh][mt] = mfma32(A, B, o[vh][mt]);
      }
    }
    const bf16_t* Sg = ST + (size_t)item * 32768 + (size_t)(vh * 128 + w * 32 + r) * 128 + h * 8;
#pragma unroll
    for (int s = 0; s < 8; ++s) {
      const bf16x8 B = *(const bf16x8*)(Sg + s * 16);
#pragma unroll
      for (int mt = 0; mt < 2; ++mt) {
        const bf16x8 A = *(const bf16x8*)(qd + (mt * 32 + r) * 136 + s * 16 + h * 8);
        o[vh][mt] = mfma32(A, B, o[vh][mt]);
      }
    }
  }
  __syncthreads();
#pragma unroll
  for (int vh = 0; vh < 2; ++vh)
#pragma unroll
    for (int mt = 0; mt < 2; ++mt)
#pragma unroll
      for (int i = 0; i < 16; ++i) ot[(mt * 32 + crow(i, h)) * 264 + vh * 128 + w * 32 + r] = f2bf(o[vh][mt][i]);
  __syncthreads();
  {
    const int row = tid >> 2, seg = tid & 3;
    const bf16_t* orow = ot + row * 264 + seg * 64;
    float ss = 0.f;
#pragma unroll
    for (int c8 = 0; c8 < 8; ++c8) {
      const uint4 ov = *(const uint4*)(orow + c8 * 8);
      const float f0 = bflo(ov.x), f1 = bfhi(ov.x), f2 = bflo(ov.y), f3 = bfhi(ov.y), f4 = bflo(ov.z), f5 = bfhi(ov.z), f6 = bflo(ov.w), f7 = bfhi(ov.w);
      ss += f0 * f0 + f1 * f1 + f2 * f2 + f3 * f3 + f4 * f4 + f5 * f5 + f6 * f6 + f7 * f7;
    }
    ss += __shfl_xor(ss, 1);
    ss += __shfl_xor(ss, 2);
    const float rs = rsqrtf(ss * (1.f / 256.f) + 1e-6f);
    const bf16_t* rrow = QKVR + (size_t)(t0 + row) * 3072 + 2048 + hh * 256 + seg * 64;
    const float* grow = p.gla_norm + hh * 256 + seg * 64;
    bf16_t* dst = OG + (size_t)(t0 + row) * 1024 + hh * 256 + seg * 64;
#pragma unroll
    for (int c8 = 0; c8 < 8; ++c8) {
      const uint4 ov = *(const uint4*)(orow + c8 * 8);
      const uint4 rv = *(const uint4*)(rrow + c8 * 8);
      const float4 g0 = *(const float4*)(grow + c8 * 8), g1 = *(const float4*)(grow + c8 * 8 + 4);
      float of[8] = {bflo(ov.x), bfhi(ov.x), bflo(ov.y), bfhi(ov.y), bflo(ov.z), bfhi(ov.z), bflo(ov.w), bfhi(ov.w)};
      float rf[8] = {bflo(rv.x), bfhi(rv.x), bflo(rv.y), bfhi(rv.y), bflo(rv.z), bfhi(rv.z), bflo(rv.w), bfhi(rv.w)};
      float gf[8] = {g0.x, g0.y, g0.z, g0.w, g1.x, g1.y, g1.z, g1.w};
      float res[8];
#pragma unroll
      for (int e = 0; e < 8; ++e) res[e] = of[e] * rs * gf[e] * (rf[e] / (1.f + __expf(-rf[e])));
      *(uint4*)(dst + c8 * 8) = make_uint4(pk(res[0], res[1]), pk(res[2], res[3]), pk(res[4], res[5]), pk(res[6], res[7]));
    }
  }
  __syncthreads();
}

DI void swa_qknorm(const Params& p) {
  bf16_t* QKV = (bf16_t*)(p.ws + OFF_BIG);
  const int tid = threadIdx.x, sub = tid & 7;
  const int ngroups = T_TOK * 18;
  for (int g = blockIdx.x * 32 + (tid >> 3); g < ngroups; g += gridDim.x * 32) {
    const int tok = g / 18, slot = g - tok * 18;
    bf16_t* ptr = QKV + (size_t)tok * 1280 + slot * 64 + sub * 8;
    const uint4 wv = *(const uint4*)ptr;
    float v[8] = {bflo(wv.x), bfhi(wv.x), bflo(wv.y), bfhi(wv.y), bflo(wv.z), bfhi(wv.z), bflo(wv.w), bfhi(wv.w)};
    float ss = 0.f;
#pragma unroll
    for (int e = 0; e < 8; ++e) ss += v[e] * v[e];
    ss += __shfl_xor(ss, 1);
    ss += __shfl_xor(ss, 2);
    ss += __shfl_xor(ss, 4);
    const float rs = rsqrtf(ss * (1.f / 64.f) + 1e-6f);
    const float* gain = (slot < 16 ? p.swa_qn : p.swa_kn) + sub * 8;
#pragma unroll
    for (int e = 0; e < 8; ++e) v[e] = v[e] * rs * gain[e];
    const float posf = (float)p.pos[tok];
    const float invf[8] = {1.0f, 0.1939227432012558f, 0.03760603070259094f, 0.007292664609849453f,
                           0.0014142135623842478f, 0.00027424818836152554f, 5.318296098266728e-05f, 1.0313386155758053e-05f};
#pragma unroll
    for (int e = 0; e < 8; ++e) {
      const float other = __shfl_xor(v[e], 1);
      if (sub < 2) {
        const float ang = posf * invf[e];
        const double rev = (double)ang * 0.15915494309189535;
        const float fr = (float)(rev - rint(rev));
        const float sn = __builtin_amdgcn_sinf(fr), cs = __builtin_amdgcn_cosf(fr);
        v[e] = (sub == 0) ? (v[e] * cs - other * sn) : (v[e] * cs + other * sn);
      }
    }
    if (slot < 16) {
#pragma unroll
      for (int e = 0; e < 8; ++e) v[e] *= 0.125f;
    }
    *(uint4*)ptr = make_uint4(pk(v[0], v[1]), pk(v[2], v[3]), pk(v[4], v[5]), pk(v[6], v[7]));
  }
}

DI void swa_attn(const Params& p, int item, char* smem) {
  const int hq = item & 15, n = (item >> 4) & 127, b = item >> 11, hkv = hq >> 3;
  const int tok0 = b * SEQ + n * 128;
  bf16_t* Ks = (bf16_t*)smem;
  bf16_t* vT = Ks + 256 * 72;
  const bf16_t* QKV = (const bf16_t*)(p.ws + OFF_BIG);
  bf16_t* OUT = (bf16_t*)(p.ws + OFF_ACT_B);
  const int tid = threadIdx.x, lane = tid & 63, w = tid >> 6, r = lane & 31, h = lane >> 5;
  __syncthreads();
#pragma unroll
  for (int i = 0; i < 8; ++i) {
    const int cidx = tid + 256 * i, kk = cidx >> 3, kc = cidx & 7;
    const int pos = n * 128 - 128 + kk;
    uint4 kw = make_uint4(0, 0, 0, 0), vw = make_uint4(0, 0, 0, 0);
    if (pos >= 0) {
      const bf16_t* base = QKV + (size_t)(b * SEQ + pos) * 1280;
      kw = *(const uint4*)(base + 1024 + hkv * 64 + kc * 8);
      vw = *(const uint4*)(base + 1152 + hkv * 64 + kc * 8);
    }
    *(uint4*)(Ks + kk * 72 + kc * 8) = kw;
    bf16_t* vd = vT + (kc * 8) * 264 + kk;
    vd[0 * 264] = (bf16_t)(vw.x & 0xffff); vd[1 * 264] = (bf16_t)(vw.x >> 16);
    vd[2 * 264] = (bf16_t)(vw.y & 0xffff); vd[3 * 264] = (bf16_t)(vw.y >> 16);
    vd[4 * 264] = (bf16_t)(vw.z & 0xffff); vd[5 * 264] = (bf16_t)(vw.z >> 16);
    vd[6 * 264] = (bf16_t)(vw.w & 0xffff); vd[7 * 264] = (bf16_t)(vw.w >> 16);
  }
  __syncthreads();
  const int iq = 32 * w + r;
  const bf16_t* qrow = QKV + (size_t)(tok0 + iq) * 1280 + hq * 64 + h * 8;
  bf16x8 qf[4];
#pragma unroll
  for (int s = 0; s < 4; ++s) qf[s] = *(const bf16x8*)(qrow + s * 16);
  f32x16 X[5];
#pragma unroll
  for (int kt = 0; kt < 5; ++kt) {
    X[kt] = zero16();
#pragma unroll
    for (int s = 0; s < 4; ++s) {
      const bf16x8 A = *(const bf16x8*)(Ks + ((w + kt) * 32 + r) * 72 + s * 16 + h * 8);
      X[kt] = mfma32(A, qf[s], X[kt]);
    }
  }
  const float sink = p.swa_sinks[hq];
  float m = sink;
#pragma unroll
  for (int kt = 0; kt < 5; ++kt)
#pragma unroll
    for (int i = 0; i < 16; ++i) {
      const int kk = (w + kt) * 32 + crow(i, h);
      const bool valid = (kk > iq) && (kk <= iq + 128) && (n > 0 || kk >= 128);
      const float xv = valid ? X[kt][i] : -INFINITY;
      X[kt][i] = xv;
      m = fmaxf(m, xv);
    }
  m = fmaxf(m, __shfl_xor(m, 32));
  float l = 0.f;
#pragma unroll
  for (int kt = 0; kt < 5; ++kt)
#pragma unroll
    for (int i = 0; i < 16; ++i) {
      const float pv = __expf(X[kt][i] - m);
      X[kt][i] = pv;
      l += pv;
    }
  l += __shfl_xor(l, 32);
  l += __expf(sink - m);
  f32x16 O[2];
  O[0] = zero16(); O[1] = zero16();
#pragma unroll
  for (int kt = 0; kt < 5; ++kt)
#pragma unroll
    for (int s2 = 0; s2 < 2; ++s2) {
      const uint4 pw = make_uint4(pk(X[kt][8 * s2 + 0], X[kt][8 * s2 + 1]), pk(X[kt][8 * s2 + 2], X[kt][8 * s2 + 3]),
                                  pk(X[kt][8 * s2 + 4], X[kt][8 * s2 + 5]), pk(X[kt][8 * s2 + 6], X[kt][8 * s2 + 7]));
      const bf16x8 P = __builtin_bit_cast(bf16x8, pw);
#pragma unroll
      for (int mt = 0; mt < 2; ++mt) {
        const bf16_t* vp = vT + (mt * 32 + r) * 264 + (w + kt) * 32 + 16 * s2 + 4 * h;
        const uint2 lo = *(const uint2*)vp, hi = *(const uint2*)(vp + 8);
        const bf16x8 A = __builtin_bit_cast(bf16x8, make_uint4(lo.x, lo.y, hi.x, hi.y));
        O[mt] = mfma32(A, P, O[mt]);
      }
    }
  const float inv = 1.f / l;
  bf16_t* orow = OUT + (size_t)(tok0 + iq) * 1024 + hq * 64 + 4 * h;
#pragma unroll
  for (int mt = 0; mt < 2; ++mt)
#pragma unroll
    for (int g = 0; g < 4; ++g)
      *(uint2*)(orow + mt * 32 + 8 * g) = make_uint2(pk(O[mt][4 * g] * inv, O[mt][4 * g + 1] * inv), pk(O[mt][4 * g + 2] * inv, O[mt][4 * g + 3] * inv));
}

DI unsigned fkey(float f) { const unsigned u = __float_as_uint(f); return (u & 0x80000000u) ? ~u : (u | 0x80000000u); }

template <int N>
DI unsigned kth_thr(const unsigned (&k)[N]) {
  unsigned res = 0;
  for (int bit = 31; bit >= 0; --bit) {
    const unsigned cand = res | (1u << bit);
    int cnt = 0;
#pragma unroll
    for (int n = 0; n < N; ++n) cnt += __popcll(__ballot(k[n] >= cand));
    if (cnt == 16) return cand - 1u;
    if (cnt > 16) res = cand;
  }
  return res;
}

DI void peer_topk(const Params& p, int layer, int item, char* smem) {
  const int head = item & 7, tok0 = (item >> 3) * 32;
  bf16_t* qs = (bf16_t*)smem;
  bf16_t* ks = qs + 32 * 136;
  float* sc = (float*)(smem + 8704);
  float* scr = (float*)(smem + 8704 + 36864);
  const bf16_t* Q = (const bf16_t*)(p.ws + OFF_BIG);
  const bf16_t* KEYS = (const bf16_t*)(p.ws + OFF_KEYS);
  int* E = (int*)(p.ws + OFF_E);
  float* G = (float*)(p.ws + OFF_G);
  const int tid = threadIdx.x, lane = tid & 63, w = tid >> 6, r = lane & 31, h = lane >> 5;
  __syncthreads();
#pragma unroll
  for (int i = 0; i < 2; ++i) {
    const int cidx = tid + 256 * i, row = cidx >> 4, kc = cidx & 15;
    *(uint4*)(qs + row * 136 + kc * 8) = *(const uint4*)(Q + (size_t)(tok0 + row) * 1024 + head * 128 + kc * 8);
  }
#pragma unroll
  for (int i = 0; i < 8; ++i) {
    const int cidx = tid + 256 * i, row = cidx >> 3, kc = cidx & 7;
    *(uint4*)(ks + row * 72 + kc * 8) = *(const uint4*)(KEYS + ((size_t)(layer * 8 + head) * 256 + row) * 64 + kc * 8);
  }
  __syncthreads();
  f32x16 acc[2];
  acc[0] = zero16(); acc[1] = zero16();
  const int set = w >> 1;
#pragma unroll
  for (int s = 0; s < 4; ++s) {
    const bf16x8 A = *(const bf16x8*)(qs + r * 136 + set * 64 + s * 16 + h * 8);
#pragma unroll
    for (int ni = 0; ni < 2; ++ni) {
      const bf16x8 B = *(const bf16x8*)(ks + (w * 64 + ni * 32 + r) * 72 + s * 16 + h * 8);
      acc[ni] = mfma32(A, B, acc[ni]);
    }
  }
  __syncthreads();
#pragma unroll
  for (int ni = 0; ni < 2; ++ni)
#pragma unroll
    for (int i = 0; i < 16; ++i) sc[crow(i, h) * 260 + w * 64 + ni * 32 + r] = acc[ni][i];
  __syncthreads();
  float* wv1 = scr + w * 96;
  float* wv2 = wv1 + 16;
  float* wsc = wv1 + 32;
  int* wi1 = (int*)(wv1 + 48);
  int* wi2 = (int*)(wv1 + 64);
  int* we = (int*)(wv1 + 80);
  for (int j = 0; j < 8; ++j) {
    const int tl = w * 8 + j;
    const float* srow = sc + tl * 260;
    const float a0 = srow[lane], a1 = srow[64 + lane], b0 = srow[128 + lane], b1 = srow[192 + lane];
    {
      const unsigned k[2] = {fkey(a0), fkey(a1)};
      const unsigned thr = kth_thr<2>(k);
      int base = 0;
#pragma unroll
      for (int n = 0; n < 2; ++n) {
        const bool s = k[n] > thr;
        const unsigned long long mk = __ballot(s);
        const int pos = base + mbcnt64(mk);
        if (s) { wv1[pos] = n ? a1 : a0; wi1[pos] = n * 64 + lane; }
        base += __popcll(mk);
      }
#pragma unroll
      for (int n = 0; n < 2; ++n) {
        const bool s = k[n] == thr;
        const unsigned long long mk = __ballot(s);
        const int pos = base + mbcnt64(mk);
        if (s && pos < 16) { wv1[pos] = n ? a1 : a0; wi1[pos] = n * 64 + lane; }
        base += __popcll(mk);
      }
    }
    {
      const unsigned k[2] = {fkey(b0), fkey(b1)};
      const unsigned thr = kth_thr<2>(k);
      int base = 0;
#pragma unroll
      for (int n = 0; n < 2; ++n) {
        const bool s = k[n] > thr;
        const unsigned long long mk = __ballot(s);
        const int pos = base + mbcnt64(mk);
        if (s) { wv2[pos] = n ? b1 : b0; wi2[pos] = n * 64 + lane; }
        base += __popcll(mk);
      }
#pragma unroll
      for (int n = 0; n < 2; ++n) {
        const bool s = k[n] == thr;
        const unsigned long long mk = __ballot(s);
        const int pos = base + mbcnt64(mk);
        if (s && pos < 16) { wv2[pos] = n ? b1 : b0; wi2[pos] = n * 64 + lane; }
        base += __popcll(mk);
      }
    }
    wave_sync();
    {
      float cv[4]; unsigned k[4];
#pragma unroll
      for (int n = 0; n < 4; ++n) { const int cidx = n * 64 + lane; cv[n] = wv1[cidx >> 4] + wv2[cidx & 15]; k[n] = fkey(cv[n]); }
      const unsigned thr = kth_thr<4>(k);
      int base = 0;
#pragma unroll
      for (int n = 0; n < 4; ++n) {
        const bool s = k[n] > thr;
        const unsigned long long mk = __ballot(s);
        const int pos = base + mbcnt64(mk);
        const int cidx = n * 64 + lane;
        if (s) { wsc[pos] = cv[n]; we[pos] = wi1[cidx >> 4] * 128 + wi2[cidx & 15]; }
        base += __popcll(mk);
      }
#pragma unroll
      for (int n = 0; n < 4; ++n) {
        const bool s = k[n] == thr;
        const unsigned long long mk = __ballot(s);
        const int pos = base + mbcnt64(mk);
        const int cidx = n * 64 + lane;
        if (s && pos < 16) { wsc[pos] = cv[n]; we[pos] = wi1[cidx >> 4] * 128 + wi2[cidx & 15]; }
        base += __popcll(mk);
      }
    }
    wave_sync();
    {
      const float sv = wsc[lane & 15];
      const int ev = we[lane & 15];
      float mx = sv;
      mx = fmaxf(mx, __shfl_xor(mx, 1)); mx = fmaxf(mx, __shfl_xor(mx, 2)); mx = fmaxf(mx, __shfl_xor(mx, 4)); mx = fmaxf(mx, __shfl_xor(mx, 8));
      const float ex = __expf(sv - mx);
      float sm = ex;
      sm += __shfl_xor(sm, 1); sm += __shfl_xor(sm, 2); sm += __shfl_xor(sm, 4); sm += __shfl_xor(sm, 8);
      if (lane < 16) {
        const size_t o = (size_t)(tok0 + tl) * 128 + head * 16 + lane;
        E[o] = ev;
        G[o] = ex / sm;
      }
    }
    wave_sync();
  }
}

DI void peer_gather(const Params& p, char* smem) {
  const int tid = threadIdx.x, lane = tid & 63, w = tid >> 6, grp = lane >> 4, i16 = lane & 15;
  float* a_s = (float*)smem + w * 128;
  const bf16_t* HN = (const bf16_t*)(p.ws + OFF_ACT_A);
  const bf16_t* U = (const bf16_t*)(p.ws + OFF_TBL_U);
  const bf16_t* V = (const bf16_t*)(p.ws + OFF_TBL_V);
  const int* E = (const int*)(p.ws + OFF_E);
  const float* G = (const float*)(p.ws + OFF_G);
  for (int tok = blockIdx.x * 4 + w; tok < T_TOK; tok += gridDim.x * 4) {
    const uint4* xp = (const uint4*)(HN + (size_t)tok * 1024);
    uint4 xr[8];
#pragma unroll
    for (int c = 0; c < 8; ++c) xr[c] = xp[i16 + 16 * c];
    const int e0 = E[(size_t)tok * 128 + lane], e1 = E[(size_t)tok * 128 + 64 + lane];
    const float g0 = G[(size_t)tok * 128 + lane], g1 = G[(size_t)tok * 128 + 64 + lane];
#pragma unroll 2
    for (int mm = 0; mm < 32; ++mm) {
      const int pidx = 4 * mm + grp;
      const int row = __shfl(mm < 16 ? e0 : e1, pidx & 63);
      const float gg = __shfl(mm < 16 ? g0 : g1, pidx & 63);
      const uint4* up = (const uint4*)(U + (size_t)row * 1024);
      float acc0 = 0.f, acc1 = 0.f;
#pragma unroll
      for (int c = 0; c < 8; ++c) {
        const uint4 wv = up[i16 + 16 * c];
        acc0 = dot2(wv.x, xr[c].x, acc0); acc1 = dot2(wv.y, xr[c].y, acc1);
        acc0 = dot2(wv.z, xr[c].z, acc0); acc1 = dot2(wv.w, xr[c].w, acc1);
      }
      float acc = acc0 + acc1;
      acc += __shfl_xor(acc, 1); acc += __shfl_xor(acc, 2); acc += __shfl_xor(acc, 4); acc += __shfl_xor(acc, 8);
      const float a = 0.5f * acc * (1.f + erff(acc * 0.7071067811865476f)) * gg;
      if (i16 == 0) a_s[pidx] = a;
    }
    wave_sync();
    float o[16];
#pragma unroll
    for (int i = 0; i < 16; ++i) o[i] = 0.f;
#pragma unroll 8
    for (int pp = 0; pp < 128; ++pp) {
      const int row = __builtin_amdgcn_readlane(pp < 64 ? e0 : e1, pp & 63);
      const float a = a_s[pp];
      const uint4* vp = (const uint4*)(V + (size_t)row * 1024);
      const uint4 w0 = vp[lane], w1 = vp[64 + lane];
      o[0] += a * bflo(w0.x); o[1] += a * bfhi(w0.x); o[2] += a * bflo(w0.y); o[3] += a * bfhi(w0.y);
      o[4] += a * bflo(w0.z); o[5] += a * bfhi(w0.z); o[6] += a * bflo(w0.w); o[7] += a * bfhi(w0.w);
      o[8] += a * bflo(w1.x); o[9] += a * bfhi(w1.x); o[10] += a * bflo(w1.y); o[11] += a * bfhi(w1.y);
      o[12] += a * bflo(w1.z); o[13] += a * bfhi(w1.z); o[14] += a * bflo(w1.w); o[15] += a * bfhi(w1.w);
    }
    float4* hp = (float4*)(p.out + (size_t)tok * 1024 + lane * 8);
    float4 t0 = hp[0], t1 = hp[1];
    t0.x += o[0]; t0.y += o[1]; t0.z += o[2]; t0.w += o[3]; t1.x += o[4]; t1.y += o[5]; t1.z += o[6]; t1.w += o[7];
    hp[0] = t0; hp[1] = t1;
    float4* hq = (float4*)(p.out + (size_t)tok * 1024 + 512 + lane * 8);
    float4 t2 = hq[0], t3 = hq[1];
    t2.x += o[8]; t2.y += o[9]; t2.z += o[10]; t2.w += o[11]; t3.x += o[12]; t3.y += o[13]; t3.z += o[14]; t3.w += o[15];
    hq[0] = t2; hq[1] = t3;
    wave_sync();
  }
}

DI void run_phase(const Params& p, int ph, char* smem) {
  bf16_t* actA = (bf16_t*)(p.ws + OFF_ACT_A);
  bf16_t* big = (bf16_t*)(p.ws + OFF_BIG);
  switch (ph) {
    case 0: phase_convert(p, smem); phase_cvt_tables(p, 0); break;
    case 1: phase_rmsnorm(p.x, p.ln_mix, actA); break;
    case 2: phase_gemm<EPI_GLA_IN>(p, actA, (const bf16_t*)(p.ws + OFF_WT_GLA_IN), 25, big, 3072, nullptr, smem); break;
    case 3: for (int it = blockIdx.x; it < 2048; it += gridDim.x) gla_phase1(p, it, smem); break;
    case 4: gla_scan(p); break;
    case 5: for (int it = blockIdx.x; it < 2048; it += gridDim.x) gla_phase3(p, it, smem); break;
    case 6: phase_gemm<EPI_RESID_X>(p, actA, (const bf16_t*)(p.ws + OFF_WT_GLA_OUT), 8, nullptr, 0, nullptr, smem); break;
    case 7: phase_rmsnorm(p.out, p.ln_ffn, actA); break;
    case 8: phase_gemm<EPI_BF16>(p, actA, (const bf16_t*)(p.ws + OFF_WT_PQ), 8, big, 1024, nullptr, smem); break;
    case 9: for (int it = blockIdx.x; it < 8192; it += gridDim.x) peer_topk(p, 0, it, smem); break;
    case 10: peer_gather(p, smem); break;
    case 11: phase_rmsnorm(p.out, p.ln_mix + 1024, actA); phase_cvt_tables(p, 1); break;
    case 12: phase_gemm<EPI_BF16>(p, actA, (const bf16_t*)(p.ws + OFF_WT_SWA_IN), 10, big, 1280, p.swa_b_in, smem); break;
    case 13: swa_qknorm(p); break;
    case 14: for (int it = blockIdx.x; it < 4096; it += gridDim.x) swa_attn(p, it, smem); break;
    case 15: phase_gemm<EPI_RESID_INPLACE>(p, (const bf16_t*)(p.ws + OFF_ACT_B), (const bf16_t*)(p.ws + OFF_WT_SWA_OUT), 8, nullptr, 0, p.swa_b_out, smem); break;
    case 16: phase_rmsnorm(p.out, p.ln_ffn + 1024, actA); break;
    case 17: phase_gemm<EPI_BF16>(p, actA, (const bf16_t*)(p.ws + OFF_WT_PQ) + (size_t)1024 * 1024, 8, big, 1024, nullptr, smem); break;
    case 18: for (int it = blockIdx.x; it < 8192; it += gridDim.x) peer_topk(p, 1, it, smem); break;
    case 19: peer_gather(p, smem); break;
    default: break;
  }
}

template <int PH>
__global__ void __launch_bounds__(256, 2) phase_kernel(Params p) {
  __shared__ __attribute__((aligned(16))) char smem[SMEM_BYTES];
  run_phase(p, PH, smem);
}

template <int PH>
static void launch_phases(const Params& p, int grid, hipStream_t stream) {
  hipLaunchKernelGGL(phase_kernel<PH>, dim3(grid), dim3(256), 0, stream, p);
  if constexpr (PH + 1 < NPHASE) launch_phases<PH + 1>(p, grid, stream);
}


#define XB_TMO      128
#define XB_XCNT(j)  (256  + 64 * (j))
#define XB_XSUB(j)  (1280 + 64 * (j))
#define XB_XGEN(j)  (2304 + 64 * (j))
#define XB_TOP      3328
#define XB_TOPGEN   3392
#define XCD_BAR_WORDS 3456
#define XB_SPIN_CAP (1u << 23)
#define LAS __attribute__((address_space(3)))
DI unsigned xb_ld(unsigned* p) { return __hip_atomic_load(p, __ATOMIC_RELAXED, __HIP_MEMORY_SCOPE_AGENT); }
DI unsigned xb_add(unsigned* p, unsigned v) { return __hip_atomic_fetch_add(p, v, __ATOMIC_RELAXED, __HIP_MEMORY_SCOPE_AGENT); }
DI unsigned xb_xcc_id() { return (unsigned)__builtin_amdgcn_s_getreg((3 << 11) | 20) & 0xFu; }
#define XB_SPIN(cond, bar) do { unsigned _sp = 0; while (cond) { __builtin_amdgcn_s_sleep(1); \
    if ((++_sp & 255u) == 0u) { if (xb_ld(&(bar)[XB_TMO])) break; if (_sp > XB_SPIN_CAP) { atomicAdd(&(bar)[XB_TMO], 1u); break; } } } } while (0)
struct XcdBarrier { unsigned* bar; unsigned x; volatile LAS unsigned* st; };
DI XcdBarrier xcd_barrier_post(unsigned* bar, volatile LAS unsigned* st) {
  XcdBarrier b; b.bar = bar; b.x = xb_xcc_id(); b.st = st;
  if (threadIdx.x == 0) (void)xb_add(&bar[XB_XCNT(b.x)], 1u);
  return b;
}
DI void xcd_barrier_complete(unsigned* bar, unsigned x, unsigned& nloc, unsigned& nx) {
  const unsigned G = gridDim.x * gridDim.y * gridDim.z;
  unsigned sum, cnt, mine, sp = 0u;
  for (;;) {
    sum = 0u; cnt = 0u; mine = 0u;
#pragma unroll
    for (unsigned j = 0; j < 16; ++j) { const unsigned c = xb_ld(&bar[XB_XCNT(j)]); sum += c; cnt += (c > 0u) ? 1u : 0u; mine = (j == x) ? c : mine; }
    if (sum == G) break;
    __builtin_amdgcn_s_sleep(1);
    if ((++sp & 255u) == 0u) { if (xb_ld(&bar[XB_TMO])) break; if (sp > XB_SPIN_CAP) { atomicAdd(&bar[XB_TMO], 1u); break; } }
  }
  nloc = mine > 0u ? mine : 1u; nx = cnt > 0u ? cnt : 1u;
}
DI void xcd_barrier(const XcdBarrier& b) {
  asm volatile("s_waitcnt vmcnt(0)" ::: "memory");
  __syncthreads();
  if (threadIdx.x == 0) {
    unsigned* bar = b.bar;
    __builtin_amdgcn_s_waitcnt(0);
    unsigned nloc = b.st[0], nx = b.st[1];
    if (nloc == 0u) { xcd_barrier_complete(bar, b.x, nloc, nx); b.st[0] = nloc; b.st[1] = nx; }
    const unsigned old = xb_add(&bar[XB_XSUB(b.x)], 1u);
    const unsigned gen = old / nloc;
    if (old + 1u == (gen + 1u) * nloc) {
      __builtin_amdgcn_fence(__ATOMIC_RELEASE, "agent");
      asm volatile("s_waitcnt vmcnt(0)" ::: "memory");
      const unsigned og = xb_add(&bar[XB_TOP], 1u);
      const unsigned tg = og / nx;
      if (og + 1u == (tg + 1u) * nx) xb_add(&bar[XB_TOPGEN], 1u);
      else XB_SPIN(xb_ld(&bar[XB_TOPGEN]) == tg, bar);
      __builtin_amdgcn_fence(__ATOMIC_ACQUIRE, "agent");
      xb_add(&bar[XB_XGEN(b.x)], 1u);
      asm volatile("s_waitcnt vmcnt(0)" ::: "memory");
    } else {
      XB_SPIN(xb_ld(&bar[XB_XGEN(b.x)]) == gen, bar);
      __builtin_amdgcn_fence(__ATOMIC_ACQUIRE, "agent");
      asm volatile("s_waitcnt vmcnt(0)" ::: "memory");
    }
  }
  __syncthreads();
}

#if !MULTI_LAUNCH
template <int PH>
DI void run_all(const Params& p, char* smem, const XcdBarrier& xb) {
  run_phase(p, PH, smem);
  if constexpr (PH + 1 < NPHASE) {
    if constexpr (PH == 0) cg::this_grid().sync();
    else xcd_barrier(xb);
    run_all<PH + 1>(p, smem, xb);
  }
}
__global__ void __launch_bounds__(256, 2) trunk_kernel(Params p) {
  __shared__ __attribute__((aligned(16))) char smem[SMEM_BYTES];
  __shared__ uint4 xb_words;
  if (threadIdx.x == 0) xb_words = make_uint4(0u, 0u, 0u, 0u);
  __syncthreads();
  const XcdBarrier xb = xcd_barrier_post((unsigned*)(p.ws + OFF_BAR), (volatile LAS unsigned*)&xb_words);
  run_all<0>(p, smem, xb);
}
#endif

extern "C" void kernel_launch(void* const* d_in, const int* in_sizes, int n_in, void* d_out, int out_size, void* d_ws, size_t ws_size,
                              hipStream_t stream) {
  Params p{};
  p.x = (const float*)d_in[0]; p.pos = (const int*)d_in[1]; p.ln_mix = (const float*)d_in[2]; p.ln_ffn = (const float*)d_in[3];
  p.gla_w_in = (const float*)d_in[4]; p.gla_w_alpha = (const float*)d_in[5]; p.gla_b_alpha = (const float*)d_in[6];
  p.gla_norm = (const float*)d_in[7]; p.gla_w_out = (const float*)d_in[8];
  p.swa_w_in = (const float*)d_in[9]; p.swa_b_in = (const float*)d_in[10]; p.swa_qn = (const float*)d_in[11]; p.swa_kn = (const float*)d_in[12];
  p.swa_sinks = (const float*)d_in[13]; p.swa_w_out = (const float*)d_in[14]; p.swa_b_out = (const float*)d_in[15];
  p.peer_wq = (const float*)d_in[16]; p.peer_keys = (const float*)d_in[17]; p.peer_u = (const float*)d_in[18]; p.peer_v = (const float*)d_in[19];
  p.out = (float*)d_out; p.ws = (char*)d_ws;
  static int grid_blocks = 0;
  if (!grid_blocks) {
    int dev = 0, cus = 0, per_cu = 0;
    (void)hipGetDevice(&dev);
    (void)hipDeviceGetAttribute(&cus, hipDeviceAttributeMultiprocessorCount, dev);
    #if MULTI_LAUNCH
    per_cu = 2;
#else
    (void)hipOccupancyMaxActiveBlocksPerMultiprocessor(&per_cu, trunk_kernel, 256, 0);
#endif
    if (per_cu < 1) per_cu = 1;
    if (per_cu > 2) per_cu = 2;
    grid_blocks = cus * per_cu;
  }
#if MULTI_LAUNCH
  p.phase_lo = 0; p.phase_hi = 0;
  launch_phases<0>(p, grid_blocks, stream);
#else
  p.phase_lo = 0; p.phase_hi = NPHASE - 1;
  void* args[] = {&p};
  (void)hipMemsetAsync((char*)d_ws + OFF_BAR, 0, XCD_BAR_WORDS * 4, stream);
  hipError_t e = hipLaunchCooperativeKernel((void*)trunk_kernel, dim3(grid_blocks), dim3(256), args, 0, stream);
  if (e != hipSuccess) fprintf(stderr, "cooperative launch failed: %s (grid %d)\n", hipGetErrorString(e), grid_blocks);
#endif
}
```

```cpp
#include <hip/hip_runtime.h>
#include <hip/hip_cooperative_groups.h>
#include <stdint.h>
#include <stdio.h>
namespace cg = cooperative_groups;

#ifndef MULTI_LAUNCH
#define MULTI_LAUNCH 0
#endif

#define DI __device__ __forceinline__
typedef unsigned short bf16_t;
typedef __attribute__((ext_vector_type(8))) short bf16x8;
typedef __attribute__((ext_vector_type(16))) float f32x16;
typedef __bf16 bf16x2_t __attribute__((ext_vector_type(2)));
typedef float f32x2_t __attribute__((ext_vector_type(2)));
typedef float f2 __attribute__((ext_vector_type(2)));

constexpr int T_TOK = 32768;
constexpr int SEQ = 16384;
constexpr int DM = 1024;
constexpr int NPHASE = 20;

constexpr size_t MiB = 1048576;
constexpr size_t OFF_WT_GLA_IN = 0;
constexpr size_t OFF_WT_GLA_OUT = 7 * MiB;
constexpr size_t OFF_WT_SWA_IN = 9 * MiB;
constexpr size_t OFF_WT_SWA_OUT = 12 * MiB;
constexpr size_t OFF_WT_PQ = 14 * MiB;
constexpr size_t OFF_KEYS = 18 * MiB;
constexpr size_t OFF_INV = 20 * MiB;
constexpr size_t OFF_TBL_U = 24 * MiB;
constexpr size_t OFF_TBL_V = 56 * MiB;
constexpr size_t OFF_ACT_A = 88 * MiB;
constexpr size_t OFF_BIG = 152 * MiB;
constexpr size_t OFF_E = OFF_BIG + 64 * MiB;
constexpr size_t OFF_G = OFF_BIG + 80 * MiB;
constexpr size_t OFF_KVT = 344 * MiB;
constexpr size_t OFF_ACT_B = OFF_KVT;
constexpr size_t OFF_LR = 472 * MiB;
constexpr size_t OFF_DECAY = 474 * MiB;
constexpr size_t OFF_BAR = 476 * MiB;

constexpr int SMEM_BYTES = 73728;
constexpr int LDK = 72;

struct Params {
  const float* x; const int* pos; const float* ln_mix; const float* ln_ffn;
  const float* gla_w_in; const float* gla_w_alpha; const float* gla_b_alpha; const float* gla_norm; const float* gla_w_out;
  const float* swa_w_in; const float* swa_b_in; const float* swa_qn; const float* swa_kn; const float* swa_sinks;
  const float* swa_w_out; const float* swa_b_out;
  const float* peer_wq; const float* peer_keys; const float* peer_u; const float* peer_v;
  float* out; char* ws;
  int phase_lo, phase_hi;
};

DI unsigned pk(float lo, float hi) { f32x2_t v = {lo, hi}; bf16x2_t b = __builtin_convertvector(v, bf16x2_t); return __builtin_bit_cast(unsigned, b); }
DI bf16_t f2bf(float x) { return (bf16_t)(pk(x, 0.f) & 0xffffu); }
DI float bflo(unsigned w) { return __uint_as_float(w << 16); }
DI float bfhi(unsigned w) { return __uint_as_float(w & 0xffff0000u); }
DI float bf2f(bf16_t b) { return __uint_as_float(((unsigned)b) << 16); }
DI float dot2(unsigned a, unsigned b, float c) { return __builtin_amdgcn_fdot2_f32_bf16(__builtin_bit_cast(bf16x2_t, a), __builtin_bit_cast(bf16x2_t, b), c, false); }
DI int crow(int i, int h) { return (i & 3) + 8 * (i >> 2) + 4 * h; }
DI f32x16 mfma32(bf16x8 a, bf16x8 b, f32x16 c) { return __builtin_amdgcn_mfma_f32_32x32x16_bf16(a, b, c, 0, 0, 0); }
DI f32x16 zero16() { f32x16 z; for (int i = 0; i < 16; ++i) z[i] = 0.f; return z; }
DI void wave_sync() { __builtin_amdgcn_fence(__ATOMIC_RELEASE, "wavefront"); __builtin_amdgcn_wave_barrier(); __builtin_amdgcn_fence(__ATOMIC_ACQUIRE, "wavefront"); }
DI int mbcnt64(unsigned long long m) { return __builtin_amdgcn_mbcnt_hi((unsigned)(m >> 32), __builtin_amdgcn_mbcnt_lo((unsigned)m, 0)); }
DI float logsig(float z) { return fminf(z, 0.f) - log1pf(__expf(-fabsf(z))); }

DI void transpose_tile(const float* __restrict__ src, int N, bf16_t* __restrict__ dst, int kt, int nt, float* sT) {
  const int tid = threadIdx.x;
  const int r = tid >> 4, c4 = (tid & 15) * 4;
#pragma unroll
  for (int i = 0; i < 4; ++i) {
    const int k = kt * 64 + r + 16 * i, n = nt * 64 + c4;
    float4 v = make_float4(0.f, 0.f, 0.f, 0.f);
    if (n + 3 < N) v = *(const float4*)(src + (size_t)k * N + n);
    float* d = sT + (r + 16 * i) * 65 + c4;
    d[0] = v.x; d[1] = v.y; d[2] = v.z; d[3] = v.w;
  }
  __syncthreads();
  const int n = tid >> 2, seg = tid & 3;
  unsigned w[8];
#pragma unroll
  for (int j = 0; j < 8; ++j) w[j] = pk(sT[(seg * 16 + 2 * j) * 65 + n], sT[(seg * 16 + 2 * j + 1) * 65 + n]);
  uint4* d = (uint4*)(dst + (size_t)(nt * 64 + n) * 1024 + kt * 64 + seg * 16);
  d[0] = make_uint4(w[0], w[1], w[2], w[3]);
  d[1] = make_uint4(w[4], w[5], w[6], w[7]);
  __syncthreads();
}

DI void cvt_elems(const float* __restrict__ src, bf16_t* __restrict__ dst, size_t n8) {
  for (size_t i = (size_t)blockIdx.x * 256 + threadIdx.x; i < n8; i += (size_t)gridDim.x * 256) {
    const float4 a = ((const float4*)src)[2 * i], b = ((const float4*)src)[2 * i + 1];
    ((uint4*)dst)[i] = make_uint4(pk(a.x, a.y), pk(a.z, a.w), pk(b.x, b.y), pk(b.z, b.w));
  }
}

DI void phase_convert(const Params& p, char* smem) {
  float* sT = (float*)smem;
  for (int t = blockIdx.x; t < 2144; t += gridDim.x) {
    const float* src; int N, ntn; bf16_t* dst; int local;
    if (t < 800) { src = p.gla_w_in; N = 3088; ntn = 50; dst = (bf16_t*)(p.ws + OFF_WT_GLA_IN); local = t; }
    else if (t < 1056) { src = p.gla_w_out; N = 1024; ntn = 16; dst = (bf16_t*)(p.ws + OFF_WT_GLA_OUT); local = t - 800; }
    else if (t < 1376) { src = p.swa_w_in; N = 1280; ntn = 20; dst = (bf16_t*)(p.ws + OFF_WT_SWA_IN); local = t - 1056; }
    else if (t < 1632) { src = p.swa_w_out; N = 1024; ntn = 16; dst = (bf16_t*)(p.ws + OFF_WT_SWA_OUT); local = t - 1376; }
    else if (t < 1888) { src = p.peer_wq; N = 1024; ntn = 16; dst = (bf16_t*)(p.ws + OFF_WT_PQ); local = t - 1632; }
    else { src = p.peer_wq + (size_t)1024 * 1024; N = 1024; ntn = 16; dst = (bf16_t*)(p.ws + OFF_WT_PQ) + (size_t)1024 * 1024; local = t - 1888; }
    transpose_tile(src, N, dst, local / ntn, local % ntn, sT);
  }
  cvt_elems(p.peer_keys, (bf16_t*)(p.ws + OFF_KEYS), (size_t)2 * 8 * 2 * 128 * 64 / 8);
}

DI void cvt_table_fp8(const float* __restrict__ src, unsigned char* __restrict__ dst, float* __restrict__ inv) {
  const int lane = threadIdx.x & 63, w = threadIdx.x >> 6;
  for (int row = blockIdx.x * 4 + w; row < 16384; row += gridDim.x * 4) {
    const float4* sp = (const float4*)(src + (size_t)row * 1024);
    float4 v[4];
    float mx = 0.f;
#pragma unroll
    for (int i = 0; i < 4; ++i) { v[i] = sp[lane + 64 * i]; mx = fmaxf(fmaxf(mx, fmaxf(fabsf(v[i].x), fabsf(v[i].y))), fmaxf(fabsf(v[i].z), fabsf(v[i].w))); }
#pragma unroll
    for (int o = 32; o >= 1; o >>= 1) mx = fmaxf(mx, __shfl_xor(mx, o));
    const float sc = mx > 0.f ? 400.f / mx : 1.f;
#pragma unroll
    for (int i = 0; i < 4; ++i) {
      int wd = __builtin_amdgcn_cvt_pk_fp8_f32(v[i].x * sc, v[i].y * sc, 0, false);
      wd = __builtin_amdgcn_cvt_pk_fp8_f32(v[i].z * sc, v[i].w * sc, wd, true);
      ((int*)(dst + (size_t)row * 1024))[lane + 64 * i] = wd;
    }
    if (lane == 0) inv[row] = mx > 0.f ? mx * (1.f / 400.f) : 1.f;
  }
}
DI void phase_cvt_tables(const Params& p, int layer) {
  cvt_table_fp8(p.peer_u + (size_t)layer * 16384 * 1024, (unsigned char*)(p.ws + OFF_TBL_U) + (size_t)layer * 16 * MiB, (float*)(p.ws + OFF_INV) + (layer * 2 + 0) * 16384);
  cvt_table_fp8(p.peer_v + (size_t)layer * 16384 * 1024, (unsigned char*)(p.ws + OFF_TBL_V) + (size_t)layer * 16 * MiB, (float*)(p.ws + OFF_INV) + (layer * 2 + 1) * 16384);
}

DI void phase_rmsnorm(const float* __restrict__ src, const float* __restrict__ gain, bf16_t* __restrict__ dst) {
  const int lane = threadIdx.x & 63, w = threadIdx.x >> 6;
  for (int row = blockIdx.x * 4 + w; row < T_TOK; row += gridDim.x * 4) {
    const float4* sp = (const float4*)(src + (size_t)row * DM);
    float4 v[4];
    float ss = 0.f;
#pragma unroll
    for (int i = 0; i < 4; ++i) { v[i] = sp[lane + 64 * i]; ss += v[i].x * v[i].x + v[i].y * v[i].y + v[i].z * v[i].z + v[i].w * v[i].w; }
#pragma unroll
    for (int o = 32; o >= 1; o >>= 1) ss += __shfl_xor(ss, o);
    const float rs = rsqrtf(ss * (1.f / 1024.f) + 1e-6f);
#pragma unroll
    for (int i = 0; i < 4; ++i) {
      const float4 g = ((const float4*)gain)[lane + 64 * i];
      uint2 o2 = make_uint2(pk(v[i].x * rs * g.x, v[i].y * rs * g.y), pk(v[i].z * rs * g.z, v[i].w * rs * g.w));
      *(uint2*)(dst + (size_t)row * DM + (lane + 64 * i) * 4) = o2;
    }
  }
}

DI void mma_64x64(const bf16_t* sA, const bf16_t* sB, int arow0, int brow0, f32x16 (&acc)[2][2], int lane) {
  const int r = lane & 31, h = lane >> 5;
#pragma unroll
  for (int s = 0; s < 4; ++s) {
    bf16x8 a[2], b[2];
#pragma unroll
    for (int mi = 0; mi < 2; ++mi) a[mi] = *(const bf16x8*)(sA + (arow0 + mi * 32 + r) * LDK + s * 16 + h * 8);
#pragma unroll
    for (int ni = 0; ni < 2; ++ni) b[ni] = *(const bf16x8*)(sB + (brow0 + ni * 32 + r) * LDK + s * 16 + h * 8);
#pragma unroll
    for (int mi = 0; mi < 2; ++mi)
#pragma unroll
      for (int ni = 0; ni < 2; ++ni) acc[mi][ni] = mfma32(a[mi], b[ni], acc[mi][ni]);
  }
}

enum { EPI_GLA_IN = 0, EPI_RESID_X = 1, EPI_BF16 = 2, EPI_RESID_INPLACE = 3 };

template <int MODE>
DI void gemm_tile(const Params& p, const bf16_t* __restrict__ A, const bf16_t* __restrict__ Bt, int m0, int n0,
                  bf16_t* dstb, int ldc, const float* __restrict__ bias, char* smem) {
  bf16_t* sA = (bf16_t*)smem;
  bf16_t* sB = sA + 128 * LDK;
  const int tid = threadIdx.x, lane = tid & 63, w = tid >> 6, wm = w >> 1, wn = w & 1;
  f32x16 acc[2][2];
#pragma unroll
  for (int i = 0; i < 2; ++i)
#pragma unroll
    for (int j = 0; j < 2; ++j) acc[i][j] = zero16();
  bf16x8 ra[4], rb[4];
  const int lrow = tid >> 3, kc = tid & 7;
  const bf16_t* ap = A + (size_t)(m0 + lrow) * 1024 + kc * 8;
  const bf16_t* bp = Bt + (size_t)(n0 + lrow) * 1024 + kc * 8;
#pragma unroll
  for (int i = 0; i < 4; ++i) { ra[i] = *(const bf16x8*)(ap + (size_t)i * 32 * 1024); rb[i] = *(const bf16x8*)(bp + (size_t)i * 32 * 1024); }
  __syncthreads();
#pragma unroll
  for (int i = 0; i < 4; ++i) { *(bf16x8*)(sA + (lrow + 32 * i) * LDK + kc * 8) = ra[i]; *(bf16x8*)(sB + (lrow + 32 * i) * LDK + kc * 8) = rb[i]; }
  __syncthreads();
  for (int kt = 0; kt < 16; ++kt) {
    if (kt + 1 < 16) {
#pragma unroll
      for (int i = 0; i < 4; ++i) { ra[i] = *(const bf16x8*)(ap + (size_t)i * 32 * 1024 + (kt + 1) * 64); rb[i] = *(const bf16x8*)(bp + (size_t)i * 32 * 1024 + (kt + 1) * 64); }
    }
    mma_64x64(sA, sB, wm * 64, wn * 64, acc, lane);
    __syncthreads();
    if (kt + 1 < 16) {
#pragma unroll
      for (int i = 0; i < 4; ++i) { *(bf16x8*)(sA + (lrow + 32 * i) * LDK + kc * 8) = ra[i]; *(bf16x8*)(sB + (lrow + 32 * i) * LDK + kc * 8) = rb[i]; }
      __syncthreads();
    }
  }
  const int r = lane & 31, h = lane >> 5;
#pragma unroll
  for (int mi = 0; mi < 2; ++mi)
#pragma unroll
    for (int ni = 0; ni < 2; ++ni) {
      const int col = n0 + wn * 64 + ni * 32 + r;
#pragma unroll
      for (int i = 0; i < 16; ++i) {
        const int row = m0 + wm * 64 + mi * 32 + crow(i, h);
        const float v = acc[mi][ni][i];
        if (MODE == EPI_GLA_IN) {
          if (col < 3072) dstb[(size_t)row * 3072 + col] = f2bf(v);
          else if (col < 3088) ((float*)(p.ws + OFF_LR))[(size_t)row * 16 + (col - 3072)] = v;
        } else if (MODE == EPI_RESID_X) {
          p.out[(size_t)row * 1024 + col] = p.x[(size_t)row * 1024 + col] + v;
        } else if (MODE == EPI_BF16) {
          dstb[(size_t)row * ldc + col] = f2bf(bias ? v + bias[col] : v);
        } else {
          p.out[(size_t)row * 1024 + col] += v + bias[col];
        }
      }
    }
}

template <int MODE>
DI void phase_gemm(const Params& p, const bf16_t* A, const bf16_t* Bt, int NT, bf16_t* dstb, int ldc, const float* bias, char* smem) {
  const int ntiles = (T_TOK / 128) * NT;
  for (int t = blockIdx.x; t < ntiles; t += gridDim.x) gemm_tile<MODE>(p, A, Bt, (t / NT) * 128, (t % NT) * 128, dstb, ldc, bias, smem);
}

DI float gate_la(const float* lr_s, int t, const float (&wa)[16], float ba) {
  float z = ba;
#pragma unroll
  for (int j = 0; j < 16; ++j) z += lr_s[t * 16 + j] * wa[j];
  return logsig(z) * (1.f / 16.f);
}
DI void gla_gates(const Params& p, int t0, int hh, float (&wa)[16], float& ba, float& offset, float& blast, float* lr_s, float* tot_s) {
  const int tid = threadIdx.x, d = tid & 127, half = tid >> 7;
  const float* LR = (const float*)(p.ws + OFF_LR);
  ((float4*)lr_s)[tid] = ((const float4*)(LR + (size_t)t0 * 16))[tid];
#pragma unroll
  for (int j = 0; j < 16; ++j) wa[j] = p.gla_w_alpha[j * 512 + hh * 128 + d];
  ba = p.gla_b_alpha[hh * 128 + d];
  __syncthreads();
  float sum = 0.f;
#pragma unroll 4
  for (int tt = 0; tt < 32; ++tt) sum += gate_la(lr_s, half * 32 + tt, wa, ba);
  tot_s[half * 128 + d] = sum;
  __syncthreads();
  offset = half ? tot_s[d] : 0.f;
  blast = tot_s[d] + tot_s[128 + d];
}

DI void fill_vT(const bf16_t* __restrict__ QKVR, int t0, int hh, int vh, bf16_t* vT) {
  const int tid = threadIdx.x, v = tid & 127, half = tid >> 7;
#pragma unroll 8
  for (int tt = 0; tt < 32; ++tt) {
    const int t = half * 32 + tt;
    vT[v * LDK + t] = QKVR[(size_t)(t0 + t) * 3072 + 1024 + hh * 256 + vh * 128 + v];
  }
}

DI void gla_phase1(const Params& p, int item, char* smem) {
  const int hh = item & 3, c = (item >> 2) & 255, b = item >> 10;
  const int t0 = b * SEQ + c * 64;
  float* lr_s = (float*)smem;
  float* tot_s = (float*)(smem + 4096);
  bf16_t* kfT = (bf16_t*)(smem + 5120);
  bf16_t* vT = kfT + 128 * LDK;
  const bf16_t* QKVR = (const bf16_t*)(p.ws + OFF_BIG);
  bf16_t* KVT = (bf16_t*)(p.ws + OFF_KVT);
  float* DECAY = (float*)(p.ws + OFF_DECAY);
  const int tid = threadIdx.x, lane = tid & 63, w = tid >> 6, wm = w >> 1, wn = w & 1;
  const int d = tid & 127, half = tid >> 7;
  float wa[16], ba, offset, blast;
  gla_gates(p, t0, hh, wa, ba, offset, blast, lr_s, tot_s);
  float run = offset;
#pragma unroll 4
  for (int tt = 0; tt < 32; ++tt) {
    const int t = half * 32 + tt;
    run += gate_la(lr_s, t, wa, ba);
    const float kv = bf2f(QKVR[(size_t)(t0 + t) * 3072 + 512 + hh * 128 + d]);
    kfT[d * LDK + t] = f2bf(kv * __expf(blast - run));
  }
  if (half == 0) DECAY[(size_t)item * 128 + d] = __expf(blast);
  const int r = lane & 31, h = lane >> 5;
  for (int vh = 0; vh < 2; ++vh) {
    __syncthreads();
    fill_vT(QKVR, t0, hh, vh, vT);
    __syncthreads();
    f32x16 acc[2][2];
#pragma unroll
    for (int i = 0; i < 2; ++i)
#pragma unroll
      for (int j = 0; j < 2; ++j) acc[i][j] = zero16();
    mma_64x64(vT, kfT, wm * 64, wn * 64, acc, lane);
    bf16_t* kbase = KVT + (size_t)item * 32768 + (vh * 128 + wm * 64 + 4 * h) * 128 + wn * 64 + r;
#pragma unroll
    for (int mi = 0; mi < 2; ++mi)
#pragma unroll
      for (int ni = 0; ni < 2; ++ni)
#pragma unroll
        for (int i = 0; i < 16; ++i) kbase[(mi * 32 + (i & 3) + 8 * (i >> 2)) * 128 + ni * 32] = f2bf(acc[mi][ni][i]);
  }
  __syncthreads();
}

DI void gla_scan(const Params& p) {
  bf16_t* KVT = (bf16_t*)(p.ws + OFF_KVT);
  const float* DECAY = (const float*)(p.ws + OFF_DECAY);
  for (int idx = blockIdx.x * 256 + threadIdx.x; idx < 8 * 16384; idx += gridDim.x * 256) {
    const int bh = idx >> 14, e2 = idx & 16383, b = bh >> 2, hh = bh & 3, d0 = (2 * e2) & 127;
    float s0 = 0.f, s1 = 0.f;
    for (int c0 = 0; c0 < 256; c0 += 8) {
      unsigned kv[8]; float2 dc[8];
#pragma unroll
      for (int u = 0; u < 8; ++u) {
        const size_t item = (size_t)(b * 256 + c0 + u) * 4 + hh;
        kv[u] = *(const unsigned*)(KVT + item * 32768 + 2 * e2);
        dc[u] = *(const float2*)(DECAY + item * 128 + d0);
      }
#pragma unroll
      for (int u = 0; u < 8; ++u) {
        const size_t item = (size_t)(b * 256 + c0 + u) * 4 + hh;
        *(unsigned*)(KVT + item * 32768 + 2 * e2) = pk(s0, s1);
        s0 = dc[u].x * s0 + bflo(kv[u]);
        s1 = dc[u].y * s1 + bfhi(kv[u]);
      }
    }
  }
}

DI void gla_phase3(const Params& p, int item, char* smem) {
  const int hh = item & 3, c = (item >> 2) & 255, b = item >> 10;
  const int t0 = b * SEQ + c * 64;
  float* lr_s = (float*)smem;
  float* tot_s = (float*)(smem + 4096);
  bf16_t* qd = (bf16_t*)(smem + 5120);
  bf16_t* ki = qd + 64 * 136;
  bf16_t* at = ki + 64 * 136;
  bf16_t* vT = at + 64 * 72;
  bf16_t* ot = qd;
  const bf16_t* QKVR = (const bf16_t*)(p.ws + OFF_BIG);
  const bf16_t* ST = (const bf16_t*)(p.ws + OFF_KVT);
  bf16_t* OG = (bf16_t*)(p.ws + OFF_ACT_A);
  const int tid = threadIdx.x, lane = tid & 63, w = tid >> 6;
  const int d = tid & 127, half = tid >> 7;
  const int r = lane & 31, h = lane >> 5;
  {
    float wa[16], ba, offset, blast;
    gla_gates(p, t0, hh, wa, ba, offset, blast, lr_s, tot_s);
    float run = offset;
#pragma unroll 4
    for (int tt = 0; tt < 32; ++tt) {
      const int t = half * 32 + tt;
      run += gate_la(lr_s, t, wa, ba);
      const float q = bf2f(QKVR[(size_t)(t0 + t) * 3072 + hh * 128 + d]);
      const float k = bf2f(QKVR[(size_t)(t0 + t) * 3072 + 512 + hh * 128 + d]);
      qd[t * 136 + d] = f2bf(q * 0.08838834764831845f * __expf(run));
      ki[t * 136 + d] = f2bf(k * __expf(-run));
    }
  }
  __syncthreads();
  {
    const int mi = w >> 1, nj = w & 1;
    f32x16 a = zero16();
#pragma unroll
    for (int s = 0; s < 8; ++s) {
      const bf16x8 A = *(const bf16x8*)(qd + (mi * 32 + r) * 136 + s * 16 + h * 8);
      const bf16x8 B = *(const bf16x8*)(ki + (nj * 32 + r) * 136 + s * 16 + h * 8);
      a = mfma32(A, B, a);
    }
#pragma unroll
    for (int i = 0; i < 16; ++i) {
      const int it = mi * 32 + crow(i, h), jt = nj * 32 + r;
      at[it * 72 + jt] = f2bf(jt <= it ? a[i] : 0.f);
    }
  }
  f32x16 o[2][2];
#pragma unroll
  for (int i = 0; i < 2; ++i)
#pragma unroll
    for (int j = 0; j < 2; ++j) o[i][j] = zero16();
#pragma unroll
  for (int vh = 0; vh < 2; ++vh) {
    __syncthreads();
    fill_vT(QKVR, t0, hh, vh, vT);
    __syncthreads();
#pragma unroll
    for (int s = 0; s < 4; ++s) {
      const bf16x8 B = *(const bf16x8*)(vT + (w * 32 + r) * LDK + s * 16 + h * 8);
#pragma unroll
      for (int mt = 0; mt < 2; ++mt) {
        const bf16x8 A = *(const bf16x8*)(at + (mt * 32 + r) * 72 + s * 16 + h * 8);
        o[vh][mt] = mfma32(A, B, o[vh][mt]);
      }
    }
    const bf16_t* Sg = ST + (size_t)item * 32768 + (size_t)(vh * 128 + w * 32 + r) * 128 + h * 8;
#pragma unroll
    for (int s = 0; s < 8; ++s) {
      const bf16x8 B = *(const bf16x8*)(Sg + s * 16);
#pragma unroll
      for (int mt = 0; mt < 2; ++mt) {
        const bf16x8 A = *(const bf16x8*)(qd + (mt * 32 + r) * 136 + s * 16 + h * 8);
        o[vh][mt] = mfma32(A, B, o[vh][mt]);
      }
    }
  }
  __syncthreads();
#pragma unroll
  for (int vh = 0; vh < 2; ++vh)
#pragma unroll
    for (int mt = 0; mt < 2; ++mt)
#pragma unroll
      for (int i = 0; i < 16; ++i) ot[(mt * 32 + crow(i, h)) * 264 + vh * 128 + w * 32 + r] = f2bf(o[vh][mt][i]);
  __syncthreads();
  {
    const int row = tid >> 2, seg = tid & 3;
    const bf16_t* orow = ot + row * 264 + seg * 64;
    float ss = 0.f;
#pragma unroll
    for (int c8 = 0; c8 < 8; ++c8) {
      const uint4 ov = *(const uint4*)(orow + c8 * 8);
      const float f0 = bflo(ov.x), f1 = bfhi(ov.x), f2 = bflo(ov.y), f3 = bfhi(ov.y), f4 = bflo(ov.z), f5 = bfhi(ov.z), f6 = bflo(ov.w), f7 = bfhi(ov.w);
      ss += f0 * f0 + f1 * f1 + f2 * f2 + f3 * f3 + f4 * f4 + f5 * f5 + f6 * f6 + f7 * f7;
    }
    ss += __shfl_xor(ss, 1);
    ss += __shfl_xor(ss, 2);
    const float rs = rsqrtf(ss * (1.f / 256.f) + 1e-6f);
    const bf16_t* rrow = QKVR + (size_t)(t0 + row) * 3072 + 2048 + hh * 256 + seg * 64;
    const float* grow = p.gla_norm + hh * 256 + seg * 64;
    bf16_t* dst = OG + (size_t)(t0 + row) * 1024 + hh * 256 + seg * 64;
#pragma unroll
    for (int c8 = 0; c8 < 8; ++c8) {
      const uint4 ov = *(const uint4*)(orow + c8 * 8);
      const uint4 rv = *(const uint4*)(rrow + c8 * 8);
      const float4 g0 = *(const float4*)(grow + c8 * 8), g1 = *(const float4*)(grow + c8 * 8 + 4);
      float of[8] = {bflo(ov.x), bfhi(ov.x), bflo(ov.y), bfhi(ov.y), bflo(ov.z), bfhi(ov.z), bflo(ov.w), bfhi(ov.w)};
      float rf[8] = {bflo(rv.x), bfhi(rv.x), bflo(rv.y), bfhi(rv.y), bflo(rv.z), bfhi(rv.z), bflo(rv.w), bfhi(rv.w)};
      float gf[8] = {g0.x, g0.y, g0.z, g0.w, g1.x, g1.y, g1.z, g1.w};
      float res[8];
#pragma unroll
      for (int e = 0; e < 8; ++e) res[e] = of[e] * rs * gf[e] * (rf[e] / (1.f + __expf(-rf[e])));
      *(uint4*)(dst + c8 * 8) = make_uint4(pk(res[0], res[1]), pk(res[2], res[3]), pk(res[4], res[5]), pk(res[6], res[7]));
    }
  }
  __syncthreads();
}

DI void swa_qknorm(const Params& p) {
  bf16_t* QKV = (bf16_t*)(p.ws + OFF_BIG);
  const int tid = threadIdx.x, sub = tid & 7;
  const int ngroups = T_TOK * 18;
  for (int g = blockIdx.x * 32 + (tid >> 3); g < ngroups; g += gridDim.x * 32) {
    const int tok = g / 18, slot = g - tok * 18;
    bf16_t* ptr = QKV + (size_t)tok * 1280 + slot * 64 + sub * 8;
    const uint4 wv = *(const uint4*)ptr;
    float v[8] = {bflo(wv.x), bfhi(wv.x), bflo(wv.y), bfhi(wv.y), bflo(wv.z), bfhi(wv.z), bflo(wv.w), bfhi(wv.w)};
    float ss = 0.f;
#pragma unroll
    for (int e = 0; e < 8; ++e) ss += v[e] * v[e];
    ss += __shfl_xor(ss, 1);
    ss += __shfl_xor(ss, 2);
    ss += __shfl_xor(ss, 4);
    const float rs = rsqrtf(ss * (1.f / 64.f) + 1e-6f);
    const float* gain = (slot < 16 ? p.swa_qn : p.swa_kn) + sub * 8;
#pragma unroll
    for (int e = 0; e < 8; ++e) v[e] = v[e] * rs * gain[e];
    const float posf = (float)p.pos[tok];
    const float invf[8] = {1.0f, 0.1939227432012558f, 0.03760603070259094f, 0.007292664609849453f,
                           0.0014142135623842478f, 0.00027424818836152554f, 5.318296098266728e-05f, 1.0313386155758053e-05f};
#pragma unroll
    for (int e = 0; e < 8; ++e) {
      const float other = __shfl_xor(v[e], 1);
      if (sub < 2) {
        const float ang = posf * invf[e];
        const double rev = (double)ang * 0.15915494309189535;
        const float fr = (float)(rev - rint(rev));
        const float sn = __builtin_amdgcn_sinf(fr), cs = __builtin_amdgcn_cosf(fr);
        v[e] = (sub == 0) ? (v[e] * cs - other * sn) : (v[e] * cs + other * sn);
      }
    }
    if (slot < 16) {
#pragma unroll
      for (int e = 0; e < 8; ++e) v[e] *= 0.125f;
    }
    *(uint4*)ptr = make_uint4(pk(v[0], v[1]), pk(v[2], v[3]), pk(v[4], v[5]), pk(v[6], v[7]));
  }
}

DI void swa_attn(const Params& p, int item, char* smem) {
  const int hq = item & 15, n = (item >> 4) & 127, b = item >> 11, hkv = hq >> 3;
  const int tok0 = b * SEQ + n * 128;
  bf16_t* Ks = (bf16_t*)smem;
  bf16_t* vT = Ks + 256 * 72;
  const bf16_t* QKV = (const bf16_t*)(p.ws + OFF_BIG);
  bf16_t* OUT = (bf16_t*)(p.ws + OFF_ACT_B);
  const int tid = threadIdx.x, lane = tid & 63, w = tid >> 6, r = lane & 31, h = lane >> 5;
  __syncthreads();
#pragma unroll
  for (int i = 0; i < 8; ++i) {
    const int cidx = tid + 256 * i, kk = cidx >> 3, kc = cidx & 7;
    const int pos = n * 128 - 128 + kk;
    uint4 kw = make_uint4(0, 0, 0, 0), vw = make_uint4(0, 0, 0, 0);
    if (pos >= 0) {
      const bf16_t* base = QKV + (size_t)(b * SEQ + pos) * 1280;
      kw = *(const uint4*)(base + 1024 + hkv * 64 + kc * 8);
      vw = *(const uint4*)(base + 1152 + hkv * 64 + kc * 8);
    }
    *(uint4*)(Ks + kk * 72 + kc * 8) = kw;
    bf16_t* vd = vT + (kc * 8) * 264 + kk;
    vd[0 * 264] = (bf16_t)(vw.x & 0xffff); vd[1 * 264] = (bf16_t)(vw.x >> 16);
    vd[2 * 264] = (bf16_t)(vw.y & 0xffff); vd[3 * 264] = (bf16_t)(vw.y >> 16);
    vd[4 * 264] = (bf16_t)(vw.z & 0xffff); vd[5 * 264] = (bf16_t)(vw.z >> 16);
    vd[6 * 264] = (bf16_t)(vw.w & 0xffff); vd[7 * 264] = (bf16_t)(vw.w >> 16);
  }
  __syncthreads();
  const int iq = 32 * w + r;
  const bf16_t* qrow = QKV + (size_t)(tok0 + iq) * 1280 + hq * 64 + h * 8;
  bf16x8 qf[4];
#pragma unroll
  for (int s = 0; s < 4; ++s) qf[s] = *(const bf16x8*)(qrow + s * 16);
  f32x16 X[5];
#pragma unroll
  for (int kt = 0; kt < 5; ++kt) {
    X[kt] = zero16();
#pragma unroll
    for (int s = 0; s < 4; ++s) {
      const bf16x8 A = *(const bf16x8*)(Ks + ((w + kt) * 32 + r) * 72 + s * 16 + h * 8);
      X[kt] = mfma32(A, qf[s], X[kt]);
    }
  }
  const float sink = p.swa_sinks[hq];
  float m = sink;
#pragma unroll
  for (int kt = 0; kt < 5; ++kt)
#pragma unroll
    for (int i = 0; i < 16; ++i) {
      const int kk = (w + kt) * 32 + crow(i, h);
      const bool valid = (kk > iq) && (kk <= iq + 128) && (n > 0 || kk >= 128);
      const float xv = valid ? X[kt][i] : -INFINITY;
      X[kt][i] = xv;
      m = fmaxf(m, xv);
    }
  m = fmaxf(m, __shfl_xor(m, 32));
  float l = 0.f;
#pragma unroll
  for (int kt = 0; kt < 5; ++kt)
#pragma unroll
    for (int i = 0; i < 16; ++i) {
      const float pv = __expf(X[kt][i] - m);
      X[kt][i] = pv;
      l += pv;
    }
  l += __shfl_xor(l, 32);
  l += __expf(sink - m);
  f32x16 O[2];
  O[0] = zero16(); O[1] = zero16();
#pragma unroll
  for (int kt = 0; kt < 5; ++kt)
#pragma unroll
    for (int s2 = 0; s2 < 2; ++s2) {
      const uint4 pw = make_uint4(pk(X[kt][8 * s2 + 0], X[kt][8 * s2 + 1]), pk(X[kt][8 * s2 + 2], X[kt][8 * s2 + 3]),
                                  pk(X[kt][8 * s2 + 4], X[kt][8 * s2 + 5]), pk(X[kt][8 * s2 + 6], X[kt][8 * s2 + 7]));
      const bf16x8 P = __builtin_bit_cast(bf16x8, pw);
#pragma unroll
      for (int mt = 0; mt < 2; ++mt) {
        const bf16_t* vp = vT + (mt * 32 + r) * 264 + (w + kt) * 32 + 16 * s2 + 4 * h;
        const uint2 lo = *(const uint2*)vp, hi = *(const uint2*)(vp + 8);
        const bf16x8 A = __builtin_bit_cast(bf16x8, make_uint4(lo.x, lo.y, hi.x, hi.y));
        O[mt] = mfma32(A, P, O[mt]);
      }
    }
  const float inv = 1.f / l;
  bf16_t* orow = OUT + (size_t)(tok0 + iq) * 1024 + hq * 64 + 4 * h;
#pragma unroll
  for (int mt = 0; mt < 2; ++mt)
#pragma unroll
    for (int g = 0; g < 4; ++g)
      *(uint2*)(orow + mt * 32 + 8 * g) = make_uint2(pk(O[mt][4 * g] * inv, O[mt][4 * g + 1] * inv), pk(O[mt][4 * g + 2] * inv, O[mt][4 * g + 3] * inv));
}

DI unsigned fkey(float f) { const unsigned u = __float_as_uint(f); return (u & 0x80000000u) ? ~u : (u | 0x80000000u); }

template <int N>
DI unsigned kth_thr(const unsigned (&k)[N]) {
  unsigned res = 0;
  for (int bit = 31; bit >= 0; --bit) {
    const unsigned cand = res | (1u << bit);
    int cnt = 0;
#pragma unroll
    for (int n = 0; n < N; ++n) cnt += __popcll(__ballot(k[n] >= cand));
    if (cnt == 16) return cand - 1u;
    if (cnt > 16) res = cand;
  }
  return res;
}

DI void peer_topk(const Params& p, int layer, int item, char* smem) {
  const int head = item & 7, tok0 = (item >> 3) * 32;
  bf16_t* qs = (bf16_t*)smem;
  bf16_t* ks = qs + 32 * 136;
  float* sc = (float*)(smem + 8704);
  float* scr = (float*)(smem + 8704 + 36864);
  const bf16_t* Q = (const bf16_t*)(p.ws + OFF_BIG);
  const bf16_t* KEYS = (const bf16_t*)(p.ws + OFF_KEYS);
  int* E = (int*)(p.ws + OFF_E);
  float* G = (float*)(p.ws + OFF_G);
  const int tid = threadIdx.x, lane = tid & 63, w = tid >> 6, r = lane & 31, h = lane >> 5;
  __syncthreads();
#pragma unroll
  for (int i = 0; i < 2; ++i) {
    const int cidx = tid + 256 * i, row = cidx >> 4, kc = cidx & 15;
    *(uint4*)(qs + row * 136 + kc * 8) = *(const uint4*)(Q + (size_t)(tok0 + row) * 1024 + head * 128 + kc * 8);
  }
#pragma unroll
  for (int i = 0; i < 8; ++i) {
    const int cidx = tid + 256 * i, row = cidx >> 3, kc = cidx & 7;
    *(uint4*)(ks + row * 72 + kc * 8) = *(const uint4*)(KEYS + ((size_t)(layer * 8 + head) * 256 + row) * 64 + kc * 8);
  }
  __syncthreads();
  f32x16 acc[2];
  acc[0] = zero16(); acc[1] = zero16();
  const int set = w >> 1;
#pragma unroll
  for (int s = 0; s < 4; ++s) {
    const bf16x8 A = *(const bf16x8*)(qs + r * 136 + set * 64 + s * 16 + h * 8);
#pragma unroll
    for (int ni = 0; ni < 2; ++ni) {
      const bf16x8 B = *(const bf16x8*)(ks + (w * 64 + ni * 32 + r) * 72 + s * 16 + h * 8);
      acc[ni] = mfma32(A, B, acc[ni]);
    }
  }
  __syncthreads();
#pragma unroll
  for (int ni = 0; ni < 2; ++ni)
#pragma unroll
    for (int i = 0; i < 16; ++i) sc[crow(i, h) * 260 + w * 64 + ni * 32 + r] = acc[ni][i];
  __syncthreads();
  float* wv1 = scr + w * 96;
  float* wv2 = wv1 + 16;
  float* wsc = wv1 + 32;
  int* wi1 = (int*)(wv1 + 48);
  int* wi2 = (int*)(wv1 + 64);
  int* we = (int*)(wv1 + 80);
  for (int j = 0; j < 8; ++j) {
    const int tl = w * 8 + j;
    const float* srow = sc + tl * 260;
    const float a0 = srow[lane], a1 = srow[64 + lane], b0 = srow[128 + lane], b1 = srow[192 + lane];
    {
      const unsigned k[2] = {fkey(a0), fkey(a1)};
      const unsigned thr = kth_thr<2>(k);
      int base = 0;
#pragma unroll
      for (int n = 0; n < 2; ++n) {
        const bool s = k[n] > thr;
        const unsigned long long mk = __ballot(s);
        const int pos = base + mbcnt64(mk);
        if (s) { wv1[pos] = n ? a1 : a0; wi1[pos] = n * 64 + lane; }
        base += __popcll(mk);
      }
#pragma unroll
      for (int n = 0; n < 2; ++n) {
        const bool s = k[n] == thr;
        const unsigned long long mk = __ballot(s);
        const int pos = base + mbcnt64(mk);
        if (s && pos < 16) { wv1[pos] = n ? a1 : a0; wi1[pos] = n * 64 + lane; }
        base += __popcll(mk);
      }
    }
    {
      const unsigned k[2] = {fkey(b0), fkey(b1)};
      const unsigned thr = kth_thr<2>(k);
      int base = 0;
#pragma unroll
      for (int n = 0; n < 2; ++n) {
        const bool s = k[n] > thr;
        const unsigned long long mk = __ballot(s);
        const int pos = base + mbcnt64(mk);
        if (s) { wv2[pos] = n ? b1 : b0; wi2[pos] = n * 64 + lane; }
        base += __popcll(mk);
      }
#pragma unroll
      for (int n = 0; n < 2; ++n) {
        const bool s = k[n] == thr;
        const unsigned long long mk = __ballot(s);
        const int pos = base + mbcnt64(mk);
        if (s && pos < 16) { wv2[pos] = n ? b1 : b0; wi2[pos] = n * 64 + lane; }
        base += __popcll(mk);
      }
    }
    wave_sync();
    {
      float cv[4]; unsigned k[4];
#pragma unroll
      for (int n = 0; n < 4; ++n) { const int cidx = n * 64 + lane; cv[n] = wv1[cidx >> 4] + wv2[cidx & 15]; k[n] = fkey(cv[n]); }
      const unsigned thr = kth_thr<4>(k);
      int base = 0;
#pragma unroll
      for (int n = 0; n < 4; ++n) {
        const bool s = k[n] > thr;
        const unsigned long long mk = __ballot(s);
        const int pos = base + mbcnt64(mk);
        const int cidx = n * 64 + lane;
        if (s) { wsc[pos] = cv[n]; we[pos] = wi1[cidx >> 4] * 128 + wi2[cidx & 15]; }
        base += __popcll(mk);
      }
#pragma unroll
      for (int n = 0; n < 4; ++n) {
        const bool s = k[n] == thr;
        const unsigned long long mk = __ballot(s);
        const int pos = base + mbcnt64(mk);
        const int cidx = n * 64 + lane;
        if (s && pos < 16) { wsc[pos] = cv[n]; we[pos] = wi1[cidx >> 4] * 128 + wi2[cidx & 15]; }
        base += __popcll(mk);
      }
    }
    wave_sync();
    {
      const float sv = wsc[lane & 15];
      const int ev = we[lane & 15];
      float mx = sv;
      mx = fmaxf(mx, __shfl_xor(mx, 1)); mx = fmaxf(mx, __shfl_xor(mx, 2)); mx = fmaxf(mx, __shfl_xor(mx, 4)); mx = fmaxf(mx, __shfl_xor(mx, 8));
      const float ex = __expf(sv - mx);
      float sm = ex;
      sm += __shfl_xor(sm, 1); sm += __shfl_xor(sm, 2); sm += __shfl_xor(sm, 4); sm += __shfl_xor(sm, 8);
      if (lane < 16) {
        const size_t o = (size_t)(tok0 + tl) * 128 + head * 16 + lane;
        E[o] = ev;
        G[o] = ex / sm;
      }
    }
    wave_sync();
  }
}

DI f2 fp8lo(unsigned w) { return __builtin_amdgcn_cvt_pk_f32_fp8((int)w, false); }
DI f2 fp8hi(unsigned w) { return __builtin_amdgcn_cvt_pk_f32_fp8((int)w, true); }

DI void peer_gather(const Params& p, int layer, char* smem) {
  const int tid = threadIdx.x, lane = tid & 63, w = tid >> 6, grp = lane >> 4, i16 = lane & 15;
  float* a_s = (float*)smem + w * 128;
  const bf16_t* HN = (const bf16_t*)(p.ws + OFF_ACT_A);
  const unsigned char* U = (const unsigned char*)(p.ws + OFF_TBL_U) + (size_t)layer * 16 * MiB;
  const unsigned char* V = (const unsigned char*)(p.ws + OFF_TBL_V) + (size_t)layer * 16 * MiB;
  const float* IU = (const float*)(p.ws + OFF_INV) + (layer * 2 + 0) * 16384;
  const float* IV = (const float*)(p.ws + OFF_INV) + (layer * 2 + 1) * 16384;
  const int* E = (const int*)(p.ws + OFF_E);
  const float* G = (const float*)(p.ws + OFF_G);
  for (int tok = blockIdx.x * 4 + w; tok < T_TOK; tok += gridDim.x * 4) {
    f2 xf[4][8];
#pragma unroll
    for (int c = 0; c < 4; ++c) {
      const uint4* xp = (const uint4*)(HN + (size_t)tok * 1024 + (i16 + 16 * c) * 16);
      const uint4 x0 = xp[0], x1 = xp[1];
      xf[c][0] = f2{bflo(x0.x), bfhi(x0.x)}; xf[c][1] = f2{bflo(x0.y), bfhi(x0.y)}; xf[c][2] = f2{bflo(x0.z), bfhi(x0.z)}; xf[c][3] = f2{bflo(x0.w), bfhi(x0.w)};
      xf[c][4] = f2{bflo(x1.x), bfhi(x1.x)}; xf[c][5] = f2{bflo(x1.y), bfhi(x1.y)}; xf[c][6] = f2{bflo(x1.z), bfhi(x1.z)}; xf[c][7] = f2{bflo(x1.w), bfhi(x1.w)};
    }
    const int e0 = E[(size_t)tok * 128 + lane], e1 = E[(size_t)tok * 128 + 64 + lane];
    const float su0 = IU[e0], su1 = IU[e1];
    const float gv0 = G[(size_t)tok * 128 + lane] * IV[e0], gv1 = G[(size_t)tok * 128 + 64 + lane] * IV[e1];
#pragma unroll 4
    for (int mm = 0; mm < 32; ++mm) {
      const int pidx = 4 * mm + grp;
      const int row = __shfl(mm < 16 ? e0 : e1, pidx & 63);
      const float su = __shfl(mm < 16 ? su0 : su1, pidx & 63);
      const float gv = __shfl(mm < 16 ? gv0 : gv1, pidx & 63);
      const uint4* up = (const uint4*)(U + (size_t)row * 1024);
      f2 acc0 = f2{0.f, 0.f}, acc1 = f2{0.f, 0.f};
#pragma unroll
      for (int c = 0; c < 4; ++c) {
        const uint4 wv = up[i16 + 16 * c];
        acc0 = fp8lo(wv.x) * xf[c][0] + acc0; acc1 = fp8hi(wv.x) * xf[c][1] + acc1;
        acc0 = fp8lo(wv.y) * xf[c][2] + acc0; acc1 = fp8hi(wv.y) * xf[c][3] + acc1;
        acc0 = fp8lo(wv.z) * xf[c][4] + acc0; acc1 = fp8hi(wv.z) * xf[c][5] + acc1;
        acc0 = fp8lo(wv.w) * xf[c][6] + acc0; acc1 = fp8hi(wv.w) * xf[c][7] + acc1;
      }
      float acc = (acc0.x + acc0.y) + (acc1.x + acc1.y);
      acc += __shfl_xor(acc, 1); acc += __shfl_xor(acc, 2); acc += __shfl_xor(acc, 4); acc += __shfl_xor(acc, 8);
      acc *= su;
      const float a = 0.5f * acc * (1.f + erff(acc * 0.7071067811865476f)) * gv;
      if (i16 == 0) a_s[pidx] = a;
    }
    wave_sync();
    f2 o[8];
#pragma unroll
    for (int i = 0; i < 8; ++i) o[i] = f2{0.f, 0.f};
#pragma unroll 16
    for (int pp = 0; pp < 128; ++pp) {
      const int row = __builtin_amdgcn_readlane(pp < 64 ? e0 : e1, pp & 63);
      const float a = a_s[pp];
      const f2 av = f2{a, a};
      const uint4 wv = ((const uint4*)(V + (size_t)row * 1024))[lane];
      o[0] = av * fp8lo(wv.x) + o[0]; o[1] = av * fp8hi(wv.x) + o[1];
      o[2] = av * fp8lo(wv.y) + o[2]; o[3] = av * fp8hi(wv.y) + o[3];
      o[4] = av * fp8lo(wv.z) + o[4]; o[5] = av * fp8hi(wv.z) + o[5];
      o[6] = av * fp8lo(wv.w) + o[6]; o[7] = av * fp8hi(wv.w) + o[7];
    }
    float4* hp = (float4*)(p.out + (size_t)tok * 1024 + lane * 16);
#pragma unroll
    for (int q = 0; q < 4; ++q) {
      float4 t = hp[q];
      t.x += o[2 * q].x; t.y += o[2 * q].y; t.z += o[2 * q + 1].x; t.w += o[2 * q + 1].y;
      hp[q] = t;
    }
    wave_sync();
  }
}

DI void run_phase(const Params& p, int ph, char* smem) {
  bf16_t* actA = (bf16_t*)(p.ws + OFF_ACT_A);
  bf16_t* big = (bf16_t*)(p.ws + OFF_BIG);
  switch (ph) {
    case 0: phase_convert(p, smem); phase_cvt_tables(p, 0); phase_cvt_tables(p, 1); break;
    case 1: phase_rmsnorm(p.x, p.ln_mix, actA); break;
    case 2: phase_gemm<EPI_GLA_IN>(p, actA, (const bf16_t*)(p.ws + OFF_WT_GLA_IN), 25, big, 3072, nullptr, smem); break;
    case 3: for (int it = blockIdx.x; it < 2048; it += gridDim.x) gla_phase1(p, it, smem); break;
    case 4: gla_scan(p); break;
    case 5: for (int it = blockIdx.x; it < 2048; it += gridDim.x) gla_phase3(p, it, smem); break;
    case 6: phase_gemm<EPI_RESID_X>(p, actA, (const bf16_t*)(p.ws + OFF_WT_GLA_OUT), 8, nullptr, 0, nullptr, smem); break;
    case 7: phase_rmsnorm(p.out, p.ln_ffn, actA); break;
    case 8: phase_gemm<EPI_BF16>(p, actA, (const bf16_t*)(p.ws + OFF_WT_PQ), 8, big, 1024, nullptr, smem); break;
    case 9: for (int it = blockIdx.x; it < 8192; it += gridDim.x) peer_topk(p, 0, it, smem); break;
    case 10: peer_gather(p, 0, smem); break;
    case 11: phase_rmsnorm(p.out, p.ln_mix + 1024, actA); break;
    case 12: phase_gemm<EPI_BF16>(p, actA, (const bf16_t*)(p.ws + OFF_WT_SWA_IN), 10, big, 1280, p.swa_b_in, smem); break;
    case 13: swa_qknorm(p); break;
    case 14: for (int it = blockIdx.x; it < 4096; it += gridDim.x) swa_attn(p, it, smem); break;
    case 15: phase_gemm<EPI_RESID_INPLACE>(p, (const bf16_t*)(p.ws + OFF_ACT_B), (const bf16_t*)(p.ws + OFF_WT_SWA_OUT), 8, nullptr, 0, p.swa_b_out, smem); break;
    case 16: phase_rmsnorm(p.out, p.ln_ffn + 1024, actA); break;
    case 17: phase_gemm<EPI_BF16>(p, actA, (const bf16_t*)(p.ws + OFF_WT_PQ) + (size_t)1024 * 1024, 8, big, 1024, nullptr, smem); break;
    case 18: for (int it = blockIdx.x; it < 8192; it += gridDim.x) peer_topk(p, 1, it, smem); break;
    case 19: peer_gather(p, 1, smem); break;
    default: break;
  }
}

template <int PH>
__global__ void __launch_bounds__(256, 2) phase_kernel(Params p) {
  __shared__ __attribute__((aligned(16))) char smem[SMEM_BYTES];
  run_phase(p, PH, smem);
}

template <int PH>
static void launch_phases(const Params& p, int grid, hipStream_t stream) {
  hipLaunchKernelGGL(phase_kernel<PH>, dim3(grid), dim3(256), 0, stream, p);
  if constexpr (PH + 1 < NPHASE) launch_phases<PH + 1>(p, grid, stream);
}


#define XB_TMO      128
#define XB_XCNT(j)  (256  + 64 * (j))
#define XB_XSUB(j)  (1280 + 64 * (j))
#define XB_XGEN(j)  (2304 + 64 * (j))
#define XB_TOP      3328
#define XB_TOPGEN   3392
#define XCD_BAR_WORDS 3456
#define XB_SPIN_CAP (1u << 23)
#define LAS __attribute__((address_space(3)))
DI unsigned xb_ld(unsigned* p) { return __hip_atomic_load(p, __ATOMIC_RELAXED, __HIP_MEMORY_SCOPE_AGENT); }
DI unsigned xb_add(unsigned* p, unsigned v) { return __hip_atomic_fetch_add(p, v, __ATOMIC_RELAXED, __HIP_MEMORY_SCOPE_AGENT); }
DI unsigned xb_xcc_id() { return (unsigned)__builtin_amdgcn_s_getreg((3 << 11) | 20) & 0xFu; }
#define XB_SPIN(cond, bar) do { unsigned _sp = 0; while (cond) { __builtin_amdgcn_s_sleep(1); \
    if ((++_sp & 255u) == 0u) { if (xb_ld(&(bar)[XB_TMO])) break; if (_sp > XB_SPIN_CAP) { atomicAdd(&(bar)[XB_TMO], 1u); break; } } } } while (0)
struct XcdBarrier { unsigned* bar; unsigned x; volatile LAS unsigned* st; };
DI XcdBarrier xcd_barrier_post(unsigned* bar, volatile LAS unsigned* st) {
  XcdBarrier b; b.bar = bar; b.x = xb_xcc_id(); b.st = st;
  if (threadIdx.x == 0) (void)xb_add(&bar[XB_XCNT(b.x)], 1u);
  return b;
}
DI void xcd_barrier_complete(unsigned* bar, unsigned x, unsigned& nloc, unsigned& nx) {
  const unsigned G = gridDim.x * gridDim.y * gridDim.z;
  unsigned sum, cnt, mine, sp = 0u;
  for (;;) {
    sum = 0u; cnt = 0u; mine = 0u;
#pragma unroll
    for (unsigned j = 0; j < 16; ++j) { const unsigned c = xb_ld(&bar[XB_XCNT(j)]); sum += c; cnt += (c > 0u) ? 1u : 0u; mine = (j == x) ? c : mine; }
    if (sum == G) break;
    __builtin_amdgcn_s_sleep(1);
    if ((++sp & 255u) == 0u) { if (xb_ld(&bar[XB_TMO])) break; if (sp > XB_SPIN_CAP) { atomicAdd(&bar[XB_TMO], 1u); break; } }
  }
  nloc = mine > 0u ? mine : 1u; nx = cnt > 0u ? cnt : 1u;
}
DI void xcd_barrier(const XcdBarrier& b) {
  asm volatile("s_waitcnt vmcnt(0)" ::: "memory");
  __syncthreads();
  if (threadIdx.x == 0) {
    unsigned* bar = b.bar;
    __builtin_amdgcn_s_waitcnt(0);
    unsigned nloc = b.st[0], nx = b.st[1];
    if (nloc == 0u) { xcd_barrier_complete(bar, b.x, nloc, nx); b.st[0] = nloc; b.st[1] = nx; }
    const unsigned old = xb_add(&bar[XB_XSUB(b.x)], 1u);
    const unsigned gen = old / nloc;
    if (old + 1u == (gen + 1u) * nloc) {
      __builtin_amdgcn_fence(__ATOMIC_RELEASE, "agent");
      asm volatile("s_waitcnt vmcnt(0)" ::: "memory");
      const unsigned og = xb_add(&bar[XB_TOP], 1u);
      const unsigned tg = og / nx;
      if (og + 1u == (tg + 1u) * nx) xb_add(&bar[XB_TOPGEN], 1u);
      else XB_SPIN(xb_ld(&bar[XB_TOPGEN]) == tg, bar);
      __builtin_amdgcn_fence(__ATOMIC_ACQUIRE, "agent");
      xb_add(&bar[XB_XGEN(b.x)], 1u);
      asm volatile("s_waitcnt vmcnt(0)" ::: "memory");
    } else {
      XB_SPIN(xb_ld(&bar[XB_XGEN(b.x)]) == gen, bar);
      __builtin_amdgcn_fence(__ATOMIC_ACQUIRE, "agent");
      asm volatile("s_waitcnt vmcnt(0)" ::: "memory");
    }
  }
  __syncthreads();
}

#if !MULTI_LAUNCH
template <int PH>
DI void run_all(const Params& p, char* smem, const XcdBarrier& xb) {
  run_phase(p, PH, smem);
  if constexpr (PH + 1 < NPHASE) {
    if constexpr (PH == 0) cg::this_grid().sync();
    else xcd_barrier(xb);
    run_all<PH + 1>(p, smem, xb);
  }
}
__global__ void __launch_bounds__(256, 2) trunk_kernel(Params p) {
  __shared__ __attribute__((aligned(16))) char smem[SMEM_BYTES];
  __shared__ uint4 xb_words;
  if (threadIdx.x == 0) xb_words = make_uint4(0u, 0u, 0u, 0u);
  __syncthreads();
  const XcdBarrier xb = xcd_barrier_post((unsigned*)(p.ws + OFF_BAR), (volatile LAS unsigned*)&xb_words);
  run_all<0>(p, smem, xb);
}
#endif

extern "C" void kernel_launch(void* const* d_in, const int* in_sizes, int n_in, void* d_out, int out_size, void* d_ws, size_t ws_size,
                              hipStream_t stream) {
  Params p{};
  p.x = (const float*)d_in[0]; p.pos = (const int*)d_in[1]; p.ln_mix = (const float*)d_in[2]; p.ln_ffn = (const float*)d_in[3];
  p.gla_w_in = (const float*)d_in[4]; p.gla_w_alpha = (const float*)d_in[5]; p.gla_b_alpha = (const float*)d_in[6];
  p.gla_norm = (const float*)d_in[7]; p.gla_w_out = (const float*)d_in[8];
  p.swa_w_in = (const float*)d_in[9]; p.swa_b_in = (const float*)d_in[10]; p.swa_qn = (const float*)d_in[11]; p.swa_kn = (const float*)d_in[12];
  p.swa_sinks = (const float*)d_in[13]; p.swa_w_out = (const float*)d_in[14]; p.swa_b_out = (const float*)d_in[15];
  p.peer_wq = (const float*)d_in[16]; p.peer_keys = (const float*)d_in[17]; p.peer_u = (const float*)d_in[18]; p.peer_v = (const float*)d_in[19];
  p.out = (float*)d_out; p.ws = (char*)d_ws;
  static int grid_blocks = 0;
  if (!grid_blocks) {
    int dev = 0, cus = 0, per_cu = 0;
    (void)hipGetDevice(&dev);
    (void)hipDeviceGetAttribute(&cus, hipDeviceAttributeMultiprocessorCount, dev);
    #if MULTI_LAUNCH
    per_cu = 2;
#else
    (void)hipOccupancyMaxActiveBlocksPerMultiprocessor(&per_cu, trunk_kernel, 256, 0);
#endif
    if (per_cu < 1) per_cu = 1;
    if (per_cu > 2) per_cu = 2;
    grid_blocks = cus * per_cu;
  }
#if MULTI_LAUNCH
  p.phase_lo = 0; p.phase_hi = 0;
  launch_phases<0>(p, grid_blocks, stream);
#else
  p.phase_lo = 0; p.phase_hi = NPHASE - 1;
  void* args[] = {&p};
  (void)hipMemsetAsync((char*)d_ws + OFF_BAR, 0, XCD_BAR_WORDS * 4, stream);
  hipError_t e = hipLaunchCooperativeKernel((void*)trunk_kernel, dim3(grid_blocks), dim3(256), args, 0, stream);
  if (e != hipSuccess) fprintf(stderr, "cooperative launch failed: %s (grid %d)\n", hipGetErrorString(e), grid_blocks);
#endif
}
```

```cpp
#include <hip/hip_runtime.h>
#include <hip/hip_cooperative_groups.h>
#include <stdint.h>
#include <stdio.h>
namespace cg = cooperative_groups;

#ifndef MULTI_LAUNCH
#define MULTI_LAUNCH 0
#endif

#define DI __device__ __forceinline__
typedef unsigned short bf16_t;
typedef __attribute__((ext_vector_type(8))) short bf16x8;
typedef __attribute__((ext_vector_type(16))) float f32x16;
typedef __bf16 bf16x2_t __attribute__((ext_vector_type(2)));
typedef float f32x2_t __attribute__((ext_vector_type(2)));
typedef float f2 __attribute__((ext_vector_type(2)));

constexpr int T_TOK = 32768;
constexpr int SEQ = 16384;
constexpr int DM = 1024;
constexpr int NPHASE = 20;

constexpr size_t MiB = 1048576;
constexpr size_t OFF_WT_GLA_IN = 0;
constexpr size_t OFF_WT_GLA_OUT = 7 * MiB;
constexpr size_t OFF_WT_SWA_IN = 9 * MiB;
constexpr size_t OFF_WT_SWA_OUT = 12 * MiB;
constexpr size_t OFF_WT_PQ = 14 * MiB;
constexpr size_t OFF_KEYS = 18 * MiB;
constexpr size_t OFF_INV = 20 * MiB;
constexpr size_t OFF_TBL_U = 24 * MiB;
constexpr size_t OFF_TBL_V = 56 * MiB;
constexpr size_t OFF_ACT_A = 88 * MiB;
constexpr size_t OFF_BIG = 152 * MiB;
constexpr size_t OFF_E = OFF_BIG + 64 * MiB;
constexpr size_t OFF_G = OFF_BIG + 80 * MiB;
constexpr size_t OFF_KVT = 344 * MiB;
constexpr size_t OFF_ACT_B = OFF_KVT;
constexpr size_t OFF_LR = 472 * MiB;
constexpr size_t OFF_DECAY = 474 * MiB;
constexpr size_t OFF_BAR = 476 * MiB;

constexpr int SMEM_BYTES = 73728;
constexpr int LDK = 72;

struct Params {
  const float* x; const int* pos; const float* ln_mix; const float* ln_ffn;
  const float* gla_w_in; const float* gla_w_alpha; const float* gla_b_alpha; const float* gla_norm; const float* gla_w_out;
  const float* swa_w_in; const float* swa_b_in; const float* swa_qn; const float* swa_kn; const float* swa_sinks;
  const float* swa_w_out; const float* swa_b_out;
  const float* peer_wq; const float* peer_keys; const float* peer_u; const float* peer_v;
  float* out; char* ws;
  int phase_lo, phase_hi;
};

DI unsigned pk(float lo, float hi) { f32x2_t v = {lo, hi}; bf16x2_t b = __builtin_convertvector(v, bf16x2_t); return __builtin_bit_cast(unsigned, b); }
DI bf16_t f2bf(float x) { return (bf16_t)(pk(x, 0.f) & 0xffffu); }
DI float bflo(unsigned w) { return __uint_as_float(w << 16); }
DI float bfhi(unsigned w) { return __uint_as_float(w & 0xffff0000u); }
DI float bf2f(bf16_t b) { return __uint_as_float(((unsigned)b) << 16); }
DI float dot2(unsigned a, unsigned b, float c) { return __builtin_amdgcn_fdot2_f32_bf16(__builtin_bit_cast(bf16x2_t, a), __builtin_bit_cast(bf16x2_t, b), c, false); }
DI int crow(int i, int h) { return (i & 3) + 8 * (i >> 2) + 4 * h; }
DI f32x16 mfma32(bf16x8 a, bf16x8 b, f32x16 c) { return __builtin_amdgcn_mfma_f32_32x32x16_bf16(a, b, c, 0, 0, 0); }
DI f32x16 zero16() { f32x16 z; for (int i = 0; i < 16; ++i) z[i] = 0.f; return z; }
DI void wave_sync() { __builtin_amdgcn_fence(__ATOMIC_RELEASE, "wavefront"); __builtin_amdgcn_wave_barrier(); __builtin_amdgcn_fence(__ATOMIC_ACQUIRE, "wavefront"); }
DI int mbcnt64(unsigned long long m) { return __builtin_amdgcn_mbcnt_hi((unsigned)(m >> 32), __builtin_amdgcn_mbcnt_lo((unsigned)m, 0)); }
DI float logsig(float z) { return fminf(z, 0.f) - log1pf(__expf(-fabsf(z))); }

DI void transpose_tile(const float* __restrict__ src, int N, bf16_t* __restrict__ dst, int kt, int nt, float* sT) {
  const int tid = threadIdx.x;
  const int r = tid >> 4, c4 = (tid & 15) * 4;
#pragma unroll
  for (int i = 0; i < 4; ++i) {
    const int k = kt * 64 + r + 16 * i, n = nt * 64 + c4;
    float4 v = make_float4(0.f, 0.f, 0.f, 0.f);
    if (n + 3 < N) v = *(const float4*)(src + (size_t)k * N + n);
    float* d = sT + (r + 16 * i) * 65 + c4;
    d[0] = v.x; d[1] = v.y; d[2] = v.z; d[3] = v.w;
  }
  __syncthreads();
  const int n = tid >> 2, seg = tid & 3;
  unsigned w[8];
#pragma unroll
  for (int j = 0; j < 8; ++j) w[j] = pk(sT[(seg * 16 + 2 * j) * 65 + n], sT[(seg * 16 + 2 * j + 1) * 65 + n]);
  uint4* d = (uint4*)(dst + (size_t)(nt * 64 + n) * 1024 + kt * 64 + seg * 16);
  d[0] = make_uint4(w[0], w[1], w[2], w[3]);
  d[1] = make_uint4(w[4], w[5], w[6], w[7]);
  __syncthreads();
}

DI void cvt_elems(const float* __restrict__ src, bf16_t* __restrict__ dst, size_t n8) {
  for (size_t i = (size_t)blockIdx.x * 256 + threadIdx.x; i < n8; i += (size_t)gridDim.x * 256) {
    const float4 a = ((const float4*)src)[2 * i], b = ((const float4*)src)[2 * i + 1];
    ((uint4*)dst)[i] = make_uint4(pk(a.x, a.y), pk(a.z, a.w), pk(b.x, b.y), pk(b.z, b.w));
  }
}

DI void phase_convert(const Params& p, char* smem) {
  float* sT = (float*)smem;
  for (int t = blockIdx.x; t < 2144; t += gridDim.x) {
    const float* src; int N, ntn; bf16_t* dst; int local;
    if (t < 800) { src = p.gla_w_in; N = 3088; ntn = 50; dst = (bf16_t*)(p.ws + OFF_WT_GLA_IN); local = t; }
    else if (t < 1056) { src = p.gla_w_out; N = 1024; ntn = 16; dst = (bf16_t*)(p.ws + OFF_WT_GLA_OUT); local = t - 800; }
    else if (t < 1376) { src = p.swa_w_in; N = 1280; ntn = 20; dst = (bf16_t*)(p.ws + OFF_WT_SWA_IN); local = t - 1056; }
    else if (t < 1632) { src = p.swa_w_out; N = 1024; ntn = 16; dst = (bf16_t*)(p.ws + OFF_WT_SWA_OUT); local = t - 1376; }
    else if (t < 1888) { src = p.peer_wq; N = 1024; ntn = 16; dst = (bf16_t*)(p.ws + OFF_WT_PQ); local = t - 1632; }
    else { src = p.peer_wq + (size_t)1024 * 1024; N = 1024; ntn = 16; dst = (bf16_t*)(p.ws + OFF_WT_PQ) + (size_t)1024 * 1024; local = t - 1888; }
    transpose_tile(src, N, dst, local / ntn, local % ntn, sT);
  }
  cvt_elems(p.peer_keys, (bf16_t*)(p.ws + OFF_KEYS), (size_t)2 * 8 * 2 * 128 * 64 / 8);
}

DI void cvt_table_fp8(const float* __restrict__ src, unsigned char* __restrict__ dst, float* __restrict__ inv) {
  const int lane = threadIdx.x & 63, w = threadIdx.x >> 6;
  for (int row = blockIdx.x * 4 + w; row < 16384; row += gridDim.x * 4) {
    const float4* sp = (const float4*)(src + (size_t)row * 1024);
    float4 v[4];
    float mx = 0.f;
#pragma unroll
    for (int i = 0; i < 4; ++i) { v[i] = sp[lane + 64 * i]; mx = fmaxf(fmaxf(mx, fmaxf(fabsf(v[i].x), fabsf(v[i].y))), fmaxf(fabsf(v[i].z), fabsf(v[i].w))); }
#pragma unroll
    for (int o = 32; o >= 1; o >>= 1) mx = fmaxf(mx, __shfl_xor(mx, o));
    const float sc = mx > 0.f ? 400.f / mx : 1.f;
#pragma unroll
    for (int i = 0; i < 4; ++i) {
      int wd = __builtin_amdgcn_cvt_pk_fp8_f32(v[i].x * sc, v[i].y * sc, 0, false);
      wd = __builtin_amdgcn_cvt_pk_fp8_f32(v[i].z * sc, v[i].w * sc, wd, true);
      ((int*)(dst + (size_t)row * 1024))[lane + 64 * i] = wd;
    }
    if (lane == 0) inv[row] = mx > 0.f ? mx * (1.f / 400.f) : 1.f;
  }
}
DI void phase_cvt_tables(const Params& p, int layer) {
  cvt_table_fp8(p.peer_u + (size_t)layer * 16384 * 1024, (unsigned char*)(p.ws + OFF_TBL_U) + (size_t)layer * 16 * MiB, (float*)(p.ws + OFF_INV) + (layer * 2 + 0) * 16384);
  cvt_table_fp8(p.peer_v + (size_t)layer * 16384 * 1024, (unsigned char*)(p.ws + OFF_TBL_V) + (size_t)layer * 16 * MiB, (float*)(p.ws + OFF_INV) + (layer * 2 + 1) * 16384);
}

DI void phase_rmsnorm(const float* __restrict__ src, const float* __restrict__ gain, bf16_t* __restrict__ dst) {
  const int lane = threadIdx.x & 63, w = threadIdx.x >> 6;
  for (int row = blockIdx.x * 4 + w; row < T_TOK; row += gridDim.x * 4) {
    const float4* sp = (const float4*)(src + (size_t)row * DM);
    float4 v[4];
    float ss = 0.f;
#pragma unroll
    for (int i = 0; i < 4; ++i) { v[i] = sp[lane + 64 * i]; ss += v[i].x * v[i].x + v[i].y * v[i].y + v[i].z * v[i].z + v[i].w * v[i].w; }
#pragma unroll
    for (int o = 32; o >= 1; o >>= 1) ss += __shfl_xor(ss, o);
    const float rs = rsqrtf(ss * (1.f / 1024.f) + 1e-6f);
#pragma unroll
    for (int i = 0; i < 4; ++i) {
      const float4 g = ((const float4*)gain)[lane + 64 * i];
      uint2 o2 = make_uint2(pk(v[i].x * rs * g.x, v[i].y * rs * g.y), pk(v[i].z * rs * g.z, v[i].w * rs * g.w));
      *(uint2*)(dst + (size_t)row * DM + (lane + 64 * i) * 4) = o2;
    }
  }
}

DI void mma_64x64(const bf16_t* sA, const bf16_t* sB, int arow0, int brow0, f32x16 (&acc)[2][2], int lane) {
  const int r = lane & 31, h = lane >> 5;
#pragma unroll
  for (int s = 0; s < 4; ++s) {
    bf16x8 a[2], b[2];
#pragma unroll
    for (int mi = 0; mi < 2; ++mi) a[mi] = *(const bf16x8*)(sA + (arow0 + mi * 32 + r) * LDK + s * 16 + h * 8);
#pragma unroll
    for (int ni = 0; ni < 2; ++ni) b[ni] = *(const bf16x8*)(sB + (brow0 + ni * 32 + r) * LDK + s * 16 + h * 8);
#pragma unroll
    for (int mi = 0; mi < 2; ++mi)
#pragma unroll
      for (int ni = 0; ni < 2; ++ni) acc[mi][ni] = mfma32(a[mi], b[ni], acc[mi][ni]);
  }
}

enum { EPI_GLA_IN = 0, EPI_RESID_X = 1, EPI_BF16 = 2, EPI_RESID_INPLACE = 3 };

template <int MODE>
DI void gemm_tile(const Params& p, const bf16_t* __restrict__ A, const bf16_t* __restrict__ Bt, int m0, int n0,
                  bf16_t* dstb, int ldc, const float* __restrict__ bias, char* smem) {
  bf16_t* sA = (bf16_t*)smem;
  bf16_t* sB = sA + 128 * LDK;
  const int tid = threadIdx.x, lane = tid & 63, w = tid >> 6, wm = w >> 1, wn = w & 1;
  f32x16 acc[2][2];
#pragma unroll
  for (int i = 0; i < 2; ++i)
#pragma unroll
    for (int j = 0; j < 2; ++j) acc[i][j] = zero16();
  bf16x8 ra[4], rb[4];
  const int lrow = tid >> 3, kc = tid & 7;
  const bf16_t* ap = A + (size_t)(m0 + lrow) * 1024 + kc * 8;
  const bf16_t* bp = Bt + (size_t)(n0 + lrow) * 1024 + kc * 8;
#pragma unroll
  for (int i = 0; i < 4; ++i) { ra[i] = *(const bf16x8*)(ap + (size_t)i * 32 * 1024); rb[i] = *(const bf16x8*)(bp + (size_t)i * 32 * 1024); }
  __syncthreads();
#pragma unroll
  for (int i = 0; i < 4; ++i) { *(bf16x8*)(sA + (lrow + 32 * i) * LDK + kc * 8) = ra[i]; *(bf16x8*)(sB + (lrow + 32 * i) * LDK + kc * 8) = rb[i]; }
  __syncthreads();
  for (int kt = 0; kt < 16; ++kt) {
    if (kt + 1 < 16) {
#pragma unroll
      for (int i = 0; i < 4; ++i) { ra[i] = *(const bf16x8*)(ap + (size_t)i * 32 * 1024 + (kt + 1) * 64); rb[i] = *(const bf16x8*)(bp + (size_t)i * 32 * 1024 + (kt + 1) * 64); }
    }
    mma_64x64(sA, sB, wm * 64, wn * 64, acc, lane);
    __syncthreads();
    if (kt + 1 < 16) {
#pragma unroll
      for (int i = 0; i < 4; ++i) { *(bf16x8*)(sA + (lrow + 32 * i) * LDK + kc * 8) = ra[i]; *(bf16x8*)(sB + (lrow + 32 * i) * LDK + kc * 8) = rb[i]; }
      __syncthreads();
    }
  }
  const int r = lane & 31, h = lane >> 5;
#pragma unroll
  for (int mi = 0; mi < 2; ++mi)
#pragma unroll
    for (int ni = 0; ni < 2; ++ni) {
      const int col = n0 + wn * 64 + ni * 32 + r;
#pragma unroll
      for (int i = 0; i < 16; ++i) {
        const int row = m0 + wm * 64 + mi * 32 + crow(i, h);
        const float v = acc[mi][ni][i];
        if (MODE == EPI_GLA_IN) {
          if (col < 3072) dstb[(size_t)row * 3072 + col] = f2bf(v);
          else if (col < 3088) ((float*)(p.ws + OFF_LR))[(size_t)row * 16 + (col - 3072)] = v;
        } else if (MODE == EPI_RESID_X) {
          p.out[(size_t)row * 1024 + col] = p.x[(size_t)row * 1024 + col] + v;
        } else if (MODE == EPI_BF16) {
          dstb[(size_t)row * ldc + col] = f2bf(bias ? v + bias[col] : v);
        } else {
          p.out[(size_t)row * 1024 + col] += v + bias[col];
        }
      }
    }
}

template <int MODE>
DI void phase_gemm(const Params& p, const bf16_t* A, const bf16_t* Bt, int NT, bf16_t* dstb, int ldc, const float* bias, char* smem) {
  const int ntiles = (T_TOK / 128) * NT;
  for (int t = blockIdx.x; t < ntiles; t += gridDim.x) gemm_tile<MODE>(p, A, Bt, (t / NT) * 128, (t % NT) * 128, dstb, ldc, bias, smem);
}

DI float gate_la(const float* lr_s, int t, const float (&wa)[16], float ba) {
  float z = ba;
#pragma unroll
  for (int j = 0; j < 16; ++j) z += lr_s[t * 16 + j] * wa[j];
  return logsig(z) * (1.f / 16.f);
}
DI void gla_gates(const Params& p, int t0, int hh, float (&wa)[16], float& ba, float& offset, float& blast, float* lr_s, float* tot_s) {
  const int tid = threadIdx.x, d = tid & 127, half = tid >> 7;
  const float* LR = (const float*)(p.ws + OFF_LR);
  ((float4*)lr_s)[tid] = ((const float4*)(LR + (size_t)t0 * 16))[tid];
#pragma unroll
  for (int j = 0; j < 16; ++j) wa[j] = p.gla_w_alpha[j * 512 + hh * 128 + d];
  ba = p.gla_b_alpha[hh * 128 + d];
  __syncthreads();
  float sum = 0.f;
#pragma unroll 4
  for (int tt = 0; tt < 32; ++tt) sum += gate_la(lr_s, half * 32 + tt, wa, ba);
  tot_s[half * 128 + d] = sum;
  __syncthreads();
  offset = half ? tot_s[d] : 0.f;
  blast = tot_s[d] + tot_s[128 + d];
}

DI void fill_vT(const bf16_t* __restrict__ QKVR, int t0, int hh, int vh, bf16_t* vT) {
  const int tid = threadIdx.x, v = tid & 127, half = tid >> 7;
#pragma unroll 8
  for (int tt = 0; tt < 32; ++tt) {
    const int t = half * 32 + tt;
    vT[v * LDK + t] = QKVR[(size_t)(t0 + t) * 3072 + 1024 + hh * 256 + vh * 128 + v];
  }
}

DI void gla_phase1(const Params& p, int item, char* smem) {
  const int hh = item & 3, c = (item >> 2) & 255, b = item >> 10;
  const int t0 = b * SEQ + c * 64;
  float* lr_s = (float*)smem;
  float* tot_s = (float*)(smem + 4096);
  bf16_t* kfT = (bf16_t*)(smem + 5120);
  bf16_t* vT = kfT + 128 * LDK;
  const bf16_t* QKVR = (const bf16_t*)(p.ws + OFF_BIG);
  bf16_t* KVT = (bf16_t*)(p.ws + OFF_KVT);
  float* DECAY = (float*)(p.ws + OFF_DECAY);
  const int tid = threadIdx.x, lane = tid & 63, w = tid >> 6, wm = w >> 1, wn = w & 1;
  const int d = tid & 127, half = tid >> 7;
  float wa[16], ba, offset, blast;
  gla_gates(p, t0, hh, wa, ba, offset, blast, lr_s, tot_s);
  float run = offset;
#pragma unroll 4
  for (int tt = 0; tt < 32; ++tt) {
    const int t = half * 32 + tt;
    run += gate_la(lr_s, t, wa, ba);
    const float kv = bf2f(QKVR[(size_t)(t0 + t) * 3072 + 512 + hh * 128 + d]);
    kfT[d * LDK + t] = f2bf(kv * __expf(blast - run));
  }
  if (half == 0) DECAY[(size_t)item * 128 + d] = __expf(blast);
  const int r = lane & 31, h = lane >> 5;
  for (int vh = 0; vh < 2; ++vh) {
    __syncthreads();
    fill_vT(QKVR, t0, hh, vh, vT);
    __syncthreads();
    f32x16 acc[2][2];
#pragma unroll
    for (int i = 0; i < 2; ++i)
#pragma unroll
      for (int j = 0; j < 2; ++j) acc[i][j] = zero16();
    mma_64x64(vT, kfT, wm * 64, wn * 64, acc, lane);
    bf16_t* kbase = KVT + (size_t)item * 32768 + (vh * 128 + wm * 64 + 4 * h) * 128 + wn * 64 + r;
#pragma unroll
    for (int mi = 0; mi < 2; ++mi)
#pragma unroll
      for (int ni = 0; ni < 2; ++ni)
#pragma unroll
        for (int i = 0; i < 16; ++i) kbase[(mi * 32 + (i & 3) + 8 * (i >> 2)) * 128 + ni * 32] = f2bf(acc[mi][ni][i]);
  }
  __syncthreads();
}

DI void gla_scan(const Params& p) {
  bf16_t* KVT = (bf16_t*)(p.ws + OFF_KVT);
  const float* DECAY = (const float*)(p.ws + OFF_DECAY);
  for (int idx = blockIdx.x * 256 + threadIdx.x; idx < 8 * 16384; idx += gridDim.x * 256) {
    const int bh = idx >> 14, e2 = idx & 16383, b = bh >> 2, hh = bh & 3, d0 = (2 * e2) & 127;
    float s0 = 0.f, s1 = 0.f;
    for (int c0 = 0; c0 < 256; c0 += 8) {
      unsigned kv[8]; float2 dc[8];
#pragma unroll
      for (int u = 0; u < 8; ++u) {
        const size_t item = (size_t)(b * 256 + c0 + u) * 4 + hh;
        kv[u] = *(const unsigned*)(KVT + item * 32768 + 2 * e2);
        dc[u] = *(const float2*)(DECAY + item * 128 + d0);
      }
#pragma unroll
      for (int u = 0; u < 8; ++u) {
        const size_t item = (size_t)(b * 256 + c0 + u) * 4 + hh;
        *(unsigned*)(KVT + item * 32768 + 2 * e2) = pk(s0, s1);
        s0 = dc[u].x * s0 + bflo(kv[u]);
        s1 = dc[u].y * s1 + bfhi(kv[u]);
      }
    }
  }
}

DI void gla_phase3(const Params& p, int item, char* smem) {
  const int hh = item & 3, c = (item >> 2) & 255, b = item >> 10;
  const int t0 = b * SEQ + c * 64;
  float* lr_s = (float*)smem;
  float* tot_s = (float*)(smem + 4096);
  bf16_t* qd = (bf16_t*)(smem + 5120);
  bf16_t* ki = qd + 64 * 136;
  bf16_t* at = ki + 64 * 136;
  bf16_t* vT = at + 64 * 72;
  bf16_t* ot = qd;
  const bf16_t* QKVR = (const bf16_t*)(p.ws + OFF_BIG);
  const bf16_t* ST = (const bf16_t*)(p.ws + OFF_KVT);
  bf16_t* OG = (bf16_t*)(p.ws + OFF_ACT_A);
  const int tid = threadIdx.x, lane = tid & 63, w = tid >> 6;
  const int d = tid & 127, half = tid >> 7;
  const int r = lane & 31, h = lane >> 5;
  {
    float wa[16], ba, offset, blast;
    gla_gates(p, t0, hh, wa, ba, offset, blast, lr_s, tot_s);
    float run = offset;
#pragma unroll 4
    for (int tt = 0; tt < 32; ++tt) {
      const int t = half * 32 + tt;
      run += gate_la(lr_s, t, wa, ba);
      const float q = bf2f(QKVR[(size_t)(t0 + t) * 3072 + hh * 128 + d]);
      const float k = bf2f(QKVR[(size_t)(t0 + t) * 3072 + 512 + hh * 128 + d]);
      qd[t * 136 + d] = f2bf(q * 0.08838834764831845f * __expf(run));
      ki[t * 136 + d] = f2bf(k * __expf(-run));
    }
  }
  __syncthreads();
  {
    const int mi = w >> 1, nj = w & 1;
    f32x16 a = zero16();
#pragma unroll
    for (int s = 0; s < 8; ++s) {
      const bf16x8 A = *(const bf16x8*)(qd + (mi * 32 + r) * 136 + s * 16 + h * 8);
      const bf16x8 B = *(const bf16x8*)(ki + (nj * 32 + r) * 136 + s * 16 + h * 8);
      a = mfma32(A, B, a);
    }
#pragma unroll
    for (int i = 0; i < 16; ++i) {
      const int it = mi * 32 + crow(i, h), jt = nj * 32 + r;
      at[it * 72 + jt] = f2bf(jt <= it ? a[i] : 0.f);
    }
  }
  f32x16 o[2][2];
#pragma unroll
  for (int i = 0; i < 2; ++i)
#pragma unroll
    for (int j = 0; j < 2; ++j) o[i][j] = zero16();
#pragma unroll
  for (int vh = 0; vh < 2; ++vh) {
    __syncthreads();
    fill_vT(QKVR, t0, hh, vh, vT);
    __syncthreads();
#pragma unroll
    for (int s = 0; s < 4; ++s) {
      const bf16x8 B = *(const bf16x8*)(vT + (w * 32 + r) * LDK + s * 16 + h * 8);
#pragma unroll
      for (int mt = 0; mt < 2; ++mt) {
        const bf16x8 A = *(const bf16x8*)(at + (mt * 32 + r) * 72 + s * 16 + h * 8);
        o[vh][mt] = mfma32(A, B, o[vh][mt]);
      }
    }
    const bf16_t* Sg = ST + (size_t)item * 32768 + (size_t)(vh * 128 + w * 32 + r) * 128 + h * 8;
#pragma unroll
    for (int s = 0; s < 8; ++s) {
      const bf16x8 B = *(const bf16x8*)(Sg + s * 16);
#pragma unroll
      for (int mt = 0; mt < 2; ++mt) {
        const bf16x8 A = *(const bf16x8*)(qd + (mt * 32 + r) * 136 + s * 16 + h * 8);
        o[vh][mt] = mfma32(A, B, o[vh][mt]);
      }
    }
  }
  __syncthreads();
#pragma unroll
  for (int vh = 0; vh < 2; ++vh)
#pragma unroll
    for (int mt = 0; mt < 2; ++mt)
#pragma unroll
      for (int i = 0; i < 16; ++i) ot[(mt * 32 + crow(i, h)) * 264 + vh * 128 + w * 32 + r] = f2bf(o[vh][mt][i]);
  __syncthreads();
  {
    const int row = tid >> 2, seg = tid & 3;
    const bf16_t* orow = ot + row * 264 + seg * 64;
    float ss = 0.f;
#pragma unroll
    for (int c8 = 0; c8 < 8; ++c8) {
      const uint4 ov = *(const uint4*)(orow + c8 * 8);
      const float f0 = bflo(ov.x), f1 = bfhi(ov.x), f2 = bflo(ov.y), f3 = bfhi(ov.y), f4 = bflo(ov.z), f5 = bfhi(ov.z), f6 = bflo(ov.w), f7 = bfhi(ov.w);
      ss += f0 * f0 + f1 * f1 + f2 * f2 + f3 * f3 + f4 * f4 + f5 * f5 + f6 * f6 + f7 * f7;
    }
    ss += __shfl_xor(ss, 1);
    ss += __shfl_xor(ss, 2);
    const float rs = rsqrtf(ss * (1.f / 256.f) + 1e-6f);
    const bf16_t* rrow = QKVR + (size_t)(t0 + row) * 3072 + 2048 + hh * 256 + seg * 64;
    const float* grow = p.gla_norm + hh * 256 + seg * 64;
    bf16_t* dst = OG + (size_t)(t0 + row) * 1024 + hh * 256 + seg * 64;
#pragma unroll
    for (int c8 = 0; c8 < 8; ++c8) {
      const uint4 ov = *(const uint4*)(orow + c8 * 8);
      const uint4 rv = *(const uint4*)(rrow + c8 * 8);
      const float4 g0 = *(const float4*)(grow + c8 * 8), g1 = *(const float4*)(grow + c8 * 8 + 4);
      float of[8] = {bflo(ov.x), bfhi(ov.x), bflo(ov.y), bfhi(ov.y), bflo(ov.z), bfhi(ov.z), bflo(ov.w), bfhi(ov.w)};
      float rf[8] = {bflo(rv.x), bfhi(rv.x), bflo(rv.y), bfhi(rv.y), bflo(rv.z), bfhi(rv.z), bflo(rv.w), bfhi(rv.w)};
      float gf[8] = {g0.x, g0.y, g0.z, g0.w, g1.x, g1.y, g1.z, g1.w};
      float res[8];
#pragma unroll
      for (int e = 0; e < 8; ++e) res[e] = of[e] * rs * gf[e] * (rf[e] / (1.f + __expf(-rf[e])));
      *(uint4*)(dst + c8 * 8) = make_uint4(pk(res[0], res[1]), pk(res[2], res[3]), pk(res[4], res[5]), pk(res[6], res[7]));
    }
  }
  __syncthreads();
}

DI void swa_qknorm(const Params& p) {
  bf16_t* QKV = (bf16_t*)(p.ws + OFF_BIG);
  const int tid = threadIdx.x, sub = tid & 7;
  const int ngroups = T_TOK * 18;
  for (int g = blockIdx.x * 32 + (tid >> 3); g < ngroups; g += gridDim.x * 32) {
    const int tok = g / 18, slot = g - tok * 18;
    bf16_t* ptr = QKV + (size_t)tok * 1280 + slot * 64 + sub * 8;
    const uint4 wv = *(const uint4*)ptr;
    float v[8] = {bflo(wv.x), bfhi(wv.x), bflo(wv.y), bfhi(wv.y), bflo(wv.z), bfhi(wv.z), bflo(wv.w), bfhi(wv.w)};
    float ss = 0.f;
#pragma unroll
    for (int e = 0; e < 8; ++e) ss += v[e] * v[e];
    ss += __shfl_xor(ss, 1);
    ss += __shfl_xor(ss, 2);
    ss += __shfl_xor(ss, 4);
    const float rs = rsqrtf(ss * (1.f / 64.f) + 1e-6f);
    const float* gain = (slot < 16 ? p.swa_qn : p.swa_kn) + sub * 8;
#pragma unroll
    for (int e = 0; e < 8; ++e) v[e] = v[e] * rs * gain[e];
    const float posf = (float)p.pos[tok];
    const float invf[8] = {1.0f, 0.1939227432012558f, 0.03760603070259094f, 0.007292664609849453f,
                           0.0014142135623842478f, 0.00027424818836152554f, 5.318296098266728e-05f, 1.0313386155758053e-05f};
#pragma unroll
    for (int e = 0; e < 8; ++e) {
      const float other = __shfl_xor(v[e], 1);
      if (sub < 2) {
        const float ang = posf * invf[e];
        const double rev = (double)ang * 0.15915494309189535;
        const float fr = (float)(rev - rint(rev));
        const float sn = __builtin_amdgcn_sinf(fr), cs = __builtin_amdgcn_cosf(fr);
        v[e] = (sub == 0) ? (v[e] * cs - other * sn) : (v[e] * cs + other * sn);
      }
    }
    if (slot < 16) {
#pragma unroll
      for (int e = 0; e < 8; ++e) v[e] *= 0.125f;
    }
    *(uint4*)ptr = make_uint4(pk(v[0], v[1]), pk(v[2], v[3]), pk(v[4], v[5]), pk(v[6], v[7]));
  }
}

DI void swa_attn(const Params& p, int item, char* smem) {
  const int hq = item & 15, n = (item >> 4) & 127, b = item >> 11, hkv = hq >> 3;
  const int tok0 = b * SEQ + n * 128;
  bf16_t* Ks = (bf16_t*)smem;
  bf16_t* vT = Ks + 256 * 72;
  const bf16_t* QKV = (const bf16_t*)(p.ws + OFF_BIG);
  bf16_t* OUT = (bf16_t*)(p.ws + OFF_ACT_B);
  const int tid = threadIdx.x, lane = tid & 63, w = tid >> 6, r = lane & 31, h = lane >> 5;
  __syncthreads();
#pragma unroll
  for (int i = 0; i < 8; ++i) {
    const int cidx = tid + 256 * i, kk = cidx >> 3, kc = cidx & 7;
    const int pos = n * 128 - 128 + kk;
    uint4 kw = make_uint4(0, 0, 0, 0), vw = make_uint4(0, 0, 0, 0);
    if (pos >= 0) {
      const bf16_t* base = QKV + (size_t)(b * SEQ + pos) * 1280;
      kw = *(const uint4*)(base + 1024 + hkv * 64 + kc * 8);
      vw = *(const uint4*)(base + 1152 + hkv * 64 + kc * 8);
    }
    *(uint4*)(Ks + kk * 72 + kc * 8) = kw;
    bf16_t* vd = vT + (kc * 8) * 264 + kk;
    vd[0 * 264] = (bf16_t)(vw.x & 0xffff); vd[1 * 264] = (bf16_t)(vw.x >> 16);
    vd[2 * 264] = (bf16_t)(vw.y & 0xffff); vd[3 * 264] = (bf16_t)(vw.y >> 16);
    vd[4 * 264] = (bf16_t)(vw.z & 0xffff); vd[5 * 264] = (bf16_t)(vw.z >> 16);
    vd[6 * 264] = (bf16_t)(vw.w & 0xffff); vd[7 * 264] = (bf16_t)(vw.w >> 16);
  }
  __syncthreads();
  const int iq = 32 * w + r;
  const bf16_t* qrow = QKV + (size_t)(tok0 + iq) * 1280 + hq * 64 + h * 8;
  bf16x8 qf[4];
#pragma unroll
  for (int s = 0; s < 4; ++s) qf[s] = *(const bf16x8*)(qrow + s * 16);
  f32x16 X[5];
#pragma unroll
  for (int kt = 0; kt < 5; ++kt) {
    X[kt] = zero16();
#pragma unroll
    for (int s = 0; s < 4; ++s) {
      const bf16x8 A = *(const bf16x8*)(Ks + ((w + kt) * 32 + r) * 72 + s * 16 + h * 8);
      X[kt] = mfma32(A, qf[s], X[kt]);
    }
  }
  const float sink = p.swa_sinks[hq];
  float m = sink;
#pragma unroll
  for (int kt = 0; kt < 5; ++kt)
#pragma unroll
    for (int i = 0; i < 16; ++i) {
      const int kk = (w + kt) * 32 + crow(i, h);
      const bool valid = (kk > iq) && (kk <= iq + 128) && (n > 0 || kk >= 128);
      const float xv = valid ? X[kt][i] : -INFINITY;
      X[kt][i] = xv;
      m = fmaxf(m, xv);
    }
  m = fmaxf(m, __shfl_xor(m, 32));
  float l = 0.f;
#pragma unroll
  for (int kt = 0; kt < 5; ++kt)
#pragma unroll
    for (int i = 0; i < 16; ++i) {
      const float pv = __expf(X[kt][i] - m);
      X[kt][i] = pv;
      l += pv;
    }
  l += __shfl_xor(l, 32);
  l += __expf(sink - m);
  f32x16 O[2];
  O[0] = zero16(); O[1] = zero16();
#pragma unroll
  for (int kt = 0; kt < 5; ++kt)
#pragma unroll
    for (int s2 = 0; s2 < 2; ++s2) {
      const uint4 pw = make_uint4(pk(X[kt][8 * s2 + 0], X[kt][8 * s2 + 1]), pk(X[kt][8 * s2 + 2], X[kt][8 * s2 + 3]),
                                  pk(X[kt][8 * s2 + 4], X[kt][8 * s2 + 5]), pk(X[kt][8 * s2 + 6], X[kt][8 * s2 + 7]));
      const bf16x8 P = __builtin_bit_cast(bf16x8, pw);
#pragma unroll
      for (int mt = 0; mt < 2; ++mt) {
        const bf16_t* vp = vT + (mt * 32 + r) * 264 + (w + kt) * 32 + 16 * s2 + 4 * h;
        const uint2 lo = *(const uint2*)vp, hi = *(const uint2*)(vp + 8);
        const bf16x8 A = __builtin_bit_cast(bf16x8, make_uint4(lo.x, lo.y, hi.x, hi.y));
        O[mt] = mfma32(A, P, O[mt]);
      }
    }
  const float inv = 1.f / l;
  bf16_t* orow = OUT + (size_t)(tok0 + iq) * 1024 + hq * 64 + 4 * h;
#pragma unroll
  for (int mt = 0; mt < 2; ++mt)
#pragma unroll
    for (int g = 0; g < 4; ++g)
      *(uint2*)(orow + mt * 32 + 8 * g) = make_uint2(pk(O[mt][4 * g] * inv, O[mt][4 * g + 1] * inv), pk(O[mt][4 * g + 2] * inv, O[mt][4 * g + 3] * inv));
}

DI unsigned fkey_u(unsigned u) { return u ^ ((unsigned)((int)u >> 31) | 0x80000000u); }
DI float unfkey(unsigned k) { return __uint_as_float(k ^ ((~(unsigned)((int)k >> 31)) | 0x80000000u)); }
DI void cswap(unsigned& a, unsigned& b) { const unsigned hi = a > b ? a : b, lo = a > b ? b : a; a = hi; b = lo; }
DI void sort16(unsigned (&t)[16]) {
#pragma unroll
  for (int k = 2; k <= 16; k <<= 1)
#pragma unroll
    for (int j = k >> 1; j > 0; j >>= 1)
#pragma unroll
      for (int i = 0; i < 16; ++i) {
        const int l = i ^ j;
        if (l > i) { if ((i & k) == 0) cswap(t[i], t[l]); else cswap(t[l], t[i]); }
      }
}
DI void merge16(unsigned (&a)[16], const unsigned (&b)[16]) {
#pragma unroll
  for (int j = 0; j < 16; ++j) a[j] = a[j] > b[15 - j] ? a[j] : b[15 - j];
#pragma unroll
  for (int j = 8; j > 0; j >>= 1)
#pragma unroll
    for (int i = 0; i < 16; ++i) { const int l = i ^ j; if (l > i) cswap(a[i], a[l]); }
}
DI void cswap2(unsigned& ak, int& ap, unsigned& bk, int& bp) {
  const bool sw = bk > ak;
  const unsigned hk = sw ? bk : ak, lk = sw ? ak : bk;
  const int hp = sw ? bp : ap, lp = sw ? ap : bp;
  ak = hk; ap = hp; bk = lk; bp = lp;
}
DI void sort16p(unsigned (&t)[16], int (&q)[16]) {
#pragma unroll
  for (int k = 2; k <= 16; k <<= 1)
#pragma unroll
    for (int j = k >> 1; j > 0; j >>= 1)
#pragma unroll
      for (int i = 0; i < 16; ++i) {
        const int l = i ^ j;
        if (l > i) { if ((i & k) == 0) cswap2(t[i], q[i], t[l], q[l]); else cswap2(t[l], q[l], t[i], q[i]); }
      }
}
__device__ constexpr int CIA[25] = {0,0,0,0,0,0,0,0,0,0,0,0,0,0,0,0, 2,2,2,2,2, 3,3,3,3};
__device__ constexpr int CJA[25] = {0,1,2,3,4,5,6,7,8,9,10,11,12,13,14,15, 0,1,2,3,4, 0,1,2,3};
__device__ constexpr int CIB[25] = {1,1,1,1,1,1,1,1, 4,4,4, 5,5,6,6,7,7, 8,9,10,11,12,13,14,15};
__device__ constexpr int CJB[25] = {0,1,2,3,4,5,6,7, 0,1,2, 0,1,0,1,0,1, 0,0,0,0,0,0,0,0};

DI void peer_topk_wave(const Params& p, int layer, int item) {
  const int head = item >> 10, tok0 = (item & 1023) * 32;
  const bf16_t* Q = (const bf16_t*)(p.ws + OFF_BIG);
  const bf16_t* KEYS = (const bf16_t*)(p.ws + OFF_KEYS) + (size_t)(layer * 8 + head) * 256 * 64;
  int* E = (int*)(p.ws + OFF_E);
  float* G = (float*)(p.ws + OFF_G);
  const int lane = threadIdx.x & 63, r = lane & 31, h = lane >> 5;
  const unsigned h4 = 4u * (1u - (unsigned)h);
  unsigned tl[2][16];
#pragma unroll
  for (int set = 0; set < 2; ++set) {
    bf16x8 qf[4];
    const bf16_t* qrow = Q + (size_t)(tok0 + r) * 1024 + head * 128 + set * 64 + h * 8;
#pragma unroll
    for (int s = 0; s < 4; ++s) qf[s] = *(const bf16x8*)(qrow + s * 16);
#pragma unroll
    for (int kt = 0; kt < 4; ++kt) {
      const bf16_t* krow = KEYS + (size_t)(set * 128 + kt * 32 + r) * 64 + h * 8;
      f32x16 X = zero16();
#pragma unroll
      for (int s = 0; s < 4; ++s) X = mfma32(*(const bf16x8*)(krow + s * 16), qf[s], X);
      unsigned kk[16];
#pragma unroll
      for (int i = 0; i < 16; ++i)
        kk[i] = (fkey_u(__float_as_uint(X[i])) & ~127u) + ((unsigned)(127 - kt * 32 - (i & 3) - 8 * (i >> 2) - 4) + h4);
      sort16(kk);
      if (kt == 0) {
#pragma unroll
        for (int i = 0; i < 16; ++i) tl[set][i] = kk[i];
      } else merge16(tl[set], kk);
    }
  }
  unsigned mine[16], oth[16];
#pragma unroll
  for (int j = 0; j < 16; ++j) {
    const unsigned send = h ? tl[0][j] : tl[1][j];
    oth[j] = (unsigned)__shfl_xor((int)send, 32);
    mine[j] = h ? tl[1][j] : tl[0][j];
  }
  merge16(mine, oth);
  float v1[16], v2[16]; int i1[16], i2[16];
#pragma unroll
  for (int j = 0; j < 16; ++j) {
    const unsigned o = (unsigned)__shfl_xor((int)mine[j], 32);
    const unsigned A = h ? o : mine[j], B = h ? mine[j] : o;
    v1[j] = unfkey(A & ~127u); i1[j] = 127 - (int)(A & 127u);
    v2[j] = unfkey(B & ~127u); i2[j] = 127 - (int)(B & 127u);
  }
  unsigned ck[16], dk[16]; int cp[16], dp[16];
#pragma unroll
  for (int n = 0; n < 32; ++n) {
    unsigned key = 0u; int e = 0;
    if (n < 25) {
      const float sA = v1[CIA[n]] + v2[CJA[n]], sB = v1[CIB[n]] + v2[CJB[n]];
      const int eA = i1[CIA[n]] * 128 + i2[CJA[n]], eB = i1[CIB[n]] * 128 + i2[CJB[n]];
      key = fkey_u(__float_as_uint(h ? sB : sA)); e = h ? eB : eA;
    }
    if (n < 16) { ck[n] = key; cp[n] = e; } else { dk[n - 16] = key; dp[n - 16] = e; }
  }
  sort16p(ck, cp);
  sort16p(dk, dp);
#pragma unroll
  for (int j = 0; j < 16; ++j) { const bool sw = dk[15 - j] > ck[j]; ck[j] = sw ? dk[15 - j] : ck[j]; cp[j] = sw ? dp[15 - j] : cp[j]; }
#pragma unroll
  for (int j = 8; j > 0; j >>= 1)
#pragma unroll
    for (int i = 0; i < 16; ++i) { const int l = i ^ j; if (l > i) cswap2(ck[i], cp[i], ck[l], cp[l]); }
  unsigned fk[16]; int fe[16];
#pragma unroll
  for (int j = 0; j < 16; ++j) { dk[j] = (unsigned)__shfl_xor((int)ck[j], 32); dp[j] = __shfl_xor(cp[j], 32); }
#pragma unroll
  for (int j = 0; j < 16; ++j) {
    const bool sw = (dk[15 - j] > ck[j]) || (dk[15 - j] == ck[j] && dp[15 - j] > cp[j]);
    fk[j] = sw ? dk[15 - j] : ck[j]; fe[j] = sw ? dp[15 - j] : cp[j];
  }
  float sv[16], mx = -INFINITY;
#pragma unroll
  for (int j = 0; j < 16; ++j) { sv[j] = unfkey(fk[j]); mx = fmaxf(mx, sv[j]); }
  float sm = 0.f;
#pragma unroll
  for (int j = 0; j < 16; ++j) { sv[j] = __expf(sv[j] - mx); sm += sv[j]; }
  const float inv = 1.f / sm;
  const size_t o = ((size_t)(tok0 + r) * 8 + head) * 16 + h * 8;
  *(int4*)(E + o) = make_int4(fe[0], fe[1], fe[2], fe[3]);
  *(int4*)(E + o + 4) = make_int4(fe[4], fe[5], fe[6], fe[7]);
  *(float4*)(G + o) = make_float4(sv[0] * inv, sv[1] * inv, sv[2] * inv, sv[3] * inv);
  *(float4*)(G + o + 4) = make_float4(sv[4] * inv, sv[5] * inv, sv[6] * inv, sv[7] * inv);
}

DI f2 fp8lo(unsigned w) { return __builtin_amdgcn_cvt_pk_f32_fp8((int)w, false); }
DI f2 fp8hi(unsigned w) { return __builtin_amdgcn_cvt_pk_f32_fp8((int)w, true); }

DI void peer_gather(const Params& p, int layer, char* smem) {
  const int tid = threadIdx.x, lane = tid & 63, w = tid >> 6, grp = lane >> 4, i16 = lane & 15;
  float* a_s = (float*)smem + w * 128;
  const bf16_t* HN = (const bf16_t*)(p.ws + OFF_ACT_A);
  const unsigned char* U = (const unsigned char*)(p.ws + OFF_TBL_U) + (size_t)layer * 16 * MiB;
  const unsigned char* V = (const unsigned char*)(p.ws + OFF_TBL_V) + (size_t)layer * 16 * MiB;
  const float* IU = (const float*)(p.ws + OFF_INV) + (layer * 2 + 0) * 16384;
  const float* IV = (const float*)(p.ws + OFF_INV) + (layer * 2 + 1) * 16384;
  const int* E = (const int*)(p.ws + OFF_E);
  const float* G = (const float*)(p.ws + OFF_G);
  for (int tok = blockIdx.x * 4 + w; tok < T_TOK; tok += gridDim.x * 4) {
    f2 xf[4][8];
#pragma unroll
    for (int c = 0; c < 4; ++c) {
      const uint4* xp = (const uint4*)(HN + (size_t)tok * 1024 + (i16 + 16 * c) * 16);
      const uint4 x0 = xp[0], x1 = xp[1];
      xf[c][0] = f2{bflo(x0.x), bfhi(x0.x)}; xf[c][1] = f2{bflo(x0.y), bfhi(x0.y)}; xf[c][2] = f2{bflo(x0.z), bfhi(x0.z)}; xf[c][3] = f2{bflo(x0.w), bfhi(x0.w)};
      xf[c][4] = f2{bflo(x1.x), bfhi(x1.x)}; xf[c][5] = f2{bflo(x1.y), bfhi(x1.y)}; xf[c][6] = f2{bflo(x1.z), bfhi(x1.z)}; xf[c][7] = f2{bflo(x1.w), bfhi(x1.w)};
    }
    const int e0 = E[(size_t)tok * 128 + lane], e1 = E[(size_t)tok * 128 + 64 + lane];
    const float su0 = IU[e0], su1 = IU[e1];
    const float gv0 = G[(size_t)tok * 128 + lane] * IV[e0], gv1 = G[(size_t)tok * 128 + 64 + lane] * IV[e1];
#pragma unroll 4
    for (int mm = 0; mm < 32; ++mm) {
      const int pidx = 4 * mm + grp;
      const int row = __shfl(mm < 16 ? e0 : e1, pidx & 63);
      const float su = __shfl(mm < 16 ? su0 : su1, pidx & 63);
      const float gv = __shfl(mm < 16 ? gv0 : gv1, pidx & 63);
      const uint4* up = (const uint4*)(U + (size_t)row * 1024);
      f2 acc0 = f2{0.f, 0.f}, acc1 = f2{0.f, 0.f};
#pragma unroll
      for (int c = 0; c < 4; ++c) {
        const uint4 wv = up[i16 + 16 * c];
        acc0 = fp8lo(wv.x) * xf[c][0] + acc0; acc1 = fp8hi(wv.x) * xf[c][1] + acc1;
        acc0 = fp8lo(wv.y) * xf[c][2] + acc0; acc1 = fp8hi(wv.y) * xf[c][3] + acc1;
        acc0 = fp8lo(wv.z) * xf[c][4] + acc0; acc1 = fp8hi(wv.z) * xf[c][5] + acc1;
        acc0 = fp8lo(wv.w) * xf[c][6] + acc0; acc1 = fp8hi(wv.w) * xf[c][7] + acc1;
      }
      float acc = (acc0.x + acc0.y) + (acc1.x + acc1.y);
      acc += __shfl_xor(acc, 1); acc += __shfl_xor(acc, 2); acc += __shfl_xor(acc, 4); acc += __shfl_xor(acc, 8);
      acc *= su;
      const float a = 0.5f * acc * (1.f + erff(acc * 0.7071067811865476f)) * gv;
      if (i16 == 0) a_s[pidx] = a;
    }
    wave_sync();
    f2 o[8];
#pragma unroll
    for (int i = 0; i < 8; ++i) o[i] = f2{0.f, 0.f};
#pragma unroll 16
    for (int pp = 0; pp < 128; ++pp) {
      const int row = __builtin_amdgcn_readlane(pp < 64 ? e0 : e1, pp & 63);
      const float a = a_s[pp];
      const f2 av = f2{a, a};
      const uint4 wv = ((const uint4*)(V + (size_t)row * 1024))[lane];
      o[0] = av * fp8lo(wv.x) + o[0]; o[1] = av * fp8hi(wv.x) + o[1];
      o[2] = av * fp8lo(wv.y) + o[2]; o[3] = av * fp8hi(wv.y) + o[3];
      o[4] = av * fp8lo(wv.z) + o[4]; o[5] = av * fp8hi(wv.z) + o[5];
      o[6] = av * fp8lo(wv.w) + o[6]; o[7] = av * fp8hi(wv.w) + o[7];
    }
    float4* hp = (float4*)(p.out + (size_t)tok * 1024 + lane * 16);
#pragma unroll
    for (int q = 0; q < 4; ++q) {
      float4 t = hp[q];
      t.x += o[2 * q].x; t.y += o[2 * q].y; t.z += o[2 * q + 1].x; t.w += o[2 * q + 1].y;
      hp[q] = t;
    }
    wave_sync();
  }
}

DI void run_phase(const Params& p, int ph, char* smem) {
  bf16_t* actA = (bf16_t*)(p.ws + OFF_ACT_A);
  bf16_t* big = (bf16_t*)(p.ws + OFF_BIG);
  switch (ph) {
    case 0: phase_convert(p, smem); phase_cvt_tables(p, 0); phase_cvt_tables(p, 1); break;
    case 1: phase_rmsnorm(p.x, p.ln_mix, actA); break;
    case 2: phase_gemm<EPI_GLA_IN>(p, actA, (const bf16_t*)(p.ws + OFF_WT_GLA_IN), 25, big, 3072, nullptr, smem); break;
    case 3: for (int it = blockIdx.x; it < 2048; it += gridDim.x) gla_phase1(p, it, smem); break;
    case 4: gla_scan(p); break;
    case 5: for (int it = blockIdx.x; it < 2048; it += gridDim.x) gla_phase3(p, it, smem); break;
    case 6: phase_gemm<EPI_RESID_X>(p, actA, (const bf16_t*)(p.ws + OFF_WT_GLA_OUT), 8, nullptr, 0, nullptr, smem); break;
    case 7: phase_rmsnorm(p.out, p.ln_ffn, actA); break;
    case 8: phase_gemm<EPI_BF16>(p, actA, (const bf16_t*)(p.ws + OFF_WT_PQ), 8, big, 1024, nullptr, smem); break;
    case 9: for (int it = blockIdx.x * 4 + (threadIdx.x >> 6); it < 8192; it += gridDim.x * 4) peer_topk_wave(p, 0, it); break;
    case 10: peer_gather(p, 0, smem); break;
    case 11: phase_rmsnorm(p.out, p.ln_mix + 1024, actA); break;
    case 12: phase_gemm<EPI_BF16>(p, actA, (const bf16_t*)(p.ws + OFF_WT_SWA_IN), 10, big, 1280, p.swa_b_in, smem); break;
    case 13: swa_qknorm(p); break;
    case 14: for (int it = blockIdx.x; it < 4096; it += gridDim.x) swa_attn(p, it, smem); break;
    case 15: phase_gemm<EPI_RESID_INPLACE>(p, (const bf16_t*)(p.ws + OFF_ACT_B), (const bf16_t*)(p.ws + OFF_WT_SWA_OUT), 8, nullptr, 0, p.swa_b_out, smem); break;
    case 16: phase_rmsnorm(p.out, p.ln_ffn + 1024, actA); break;
    case 17: phase_gemm<EPI_BF16>(p, actA, (const bf16_t*)(p.ws + OFF_WT_PQ) + (size_t)1024 * 1024, 8, big, 1024, nullptr, smem); break;
    case 18: for (int it = blockIdx.x * 4 + (threadIdx.x >> 6); it < 8192; it += gridDim.x * 4) peer_topk_wave(p, 1, it); break;
    case 19: peer_gather(p, 1, smem); break;
    default: break;
  }
}

template <int PH>
__global__ void __launch_bounds__(256, 2) phase_kernel(Params p) {
  __shared__ __attribute__((aligned(16))) char smem[SMEM_BYTES];
  run_phase(p, PH, smem);
}

template <int PH>
static void launch_phases(const Params& p, int grid, hipStream_t stream) {
  hipLaunchKernelGGL(phase_kernel<PH>, dim3(grid), dim3(256), 0, stream, p);
  if constexpr (PH + 1 < NPHASE) launch_phases<PH + 1>(p, grid, stream);
}


#define XB_TMO      128
#define XB_XCNT(j)  (256  + 64 * (j))
#define XB_XSUB(j)  (1280 + 64 * (j))
#define XB_XGEN(j)  (2304 + 64 * (j))
#define XB_TOP      3328
#define XB_TOPGEN   3392
#define XCD_BAR_WORDS 3456
#define XB_SPIN_CAP (1u << 23)
#define LAS __attribute__((address_space(3)))
DI unsigned xb_ld(unsigned* p) { return __hip_atomic_load(p, __ATOMIC_RELAXED, __HIP_MEMORY_SCOPE_AGENT); }
DI unsigned xb_add(unsigned* p, unsigned v) { return __hip_atomic_fetch_add(p, v, __ATOMIC_RELAXED, __HIP_MEMORY_SCOPE_AGENT); }
DI unsigned xb_xcc_id() { return (unsigned)__builtin_amdgcn_s_getreg((3 << 11) | 20) & 0xFu; }
#define XB_SPIN(cond, bar) do { unsigned _sp = 0; while (cond) { __builtin_amdgcn_s_sleep(1); \
    if ((++_sp & 255u) == 0u) { if (xb_ld(&(bar)[XB_TMO])) break; if (_sp > XB_SPIN_CAP) { atomicAdd(&(bar)[XB_TMO], 1u); break; } } } } while (0)
struct XcdBarrier { unsigned* bar; unsigned x; volatile LAS unsigned* st; };
DI XcdBarrier xcd_barrier_post(unsigned* bar, volatile LAS unsigned* st) {
  XcdBarrier b; b.bar = bar; b.x = xb_xcc_id(); b.st = st;
  if (threadIdx.x == 0) (void)xb_add(&bar[XB_XCNT(b.x)], 1u);
  return b;
}
DI void xcd_barrier_complete(unsigned* bar, unsigned x, unsigned& nloc, unsigned& nx) {
  const unsigned G = gridDim.x * gridDim.y * gridDim.z;
  unsigned sum, cnt, mine, sp = 0u;
  for (;;) {
    sum = 0u; cnt = 0u; mine = 0u;
#pragma unroll
    for (unsigned j = 0; j < 16; ++j) { const unsigned c = xb_ld(&bar[XB_XCNT(j)]); sum += c; cnt += (c > 0u) ? 1u : 0u; mine = (j == x) ? c : mine; }
    if (sum == G) break;
    __builtin_amdgcn_s_sleep(1);
    if ((++sp & 255u) == 0u) { if (xb_ld(&bar[XB_TMO])) break; if (sp > XB_SPIN_CAP) { atomicAdd(&bar[XB_TMO], 1u); break; } }
  }
  nloc = mine > 0u ? mine : 1u; nx = cnt > 0u ? cnt : 1u;
}
DI void xcd_barrier(const XcdBarrier& b) {
  asm volatile("s_waitcnt vmcnt(0)" ::: "memory");
  __syncthreads();
  if (threadIdx.x == 0) {
    unsigned* bar = b.bar;
    __builtin_amdgcn_s_waitcnt(0);
    unsigned nloc = b.st[0], nx = b.st[1];
    if (nloc == 0u) { xcd_barrier_complete(bar, b.x, nloc, nx); b.st[0] = nloc; b.st[1] = nx; }
    const unsigned old = xb_add(&bar[XB_XSUB(b.x)], 1u);
    const unsigned gen = old / nloc;
    if (old + 1u == (gen + 1u) * nloc) {
      __builtin_amdgcn_fence(__ATOMIC_RELEASE, "agent");
      asm volatile("s_waitcnt vmcnt(0)" ::: "memory");
      const unsigned og = xb_add(&bar[XB_TOP], 1u);
      const unsigned tg = og / nx;
      if (og + 1u == (tg + 1u) * nx) xb_add(&bar[XB_TOPGEN], 1u);
      else XB_SPIN(xb_ld(&bar[XB_TOPGEN]) == tg, bar);
      __builtin_amdgcn_fence(__ATOMIC_ACQUIRE, "agent");
      xb_add(&bar[XB_XGEN(b.x)], 1u);
      asm volatile("s_waitcnt vmcnt(0)" ::: "memory");
    } else {
      XB_SPIN(xb_ld(&bar[XB_XGEN(b.x)]) == gen, bar);
      __builtin_amdgcn_fence(__ATOMIC_ACQUIRE, "agent");
      asm volatile("s_waitcnt vmcnt(0)" ::: "memory");
    }
  }
  __syncthreads();
}

#if !MULTI_LAUNCH
template <int PH>
DI void run_all(const Params& p, char* smem, const XcdBarrier& xb) {
  run_phase(p, PH, smem);
  if constexpr (PH + 1 < NPHASE) {
    if constexpr (PH == 0) cg::this_grid().sync();
    else xcd_barrier(xb);
    run_all<PH + 1>(p, smem, xb);
  }
}
__global__ void __launch_bounds__(256, 2) trunk_kernel(Params p) {
  __shared__ __attribute__((aligned(16))) char smem[SMEM_BYTES];
  __shared__ uint4 xb_words;
  if (threadIdx.x == 0) xb_words = make_uint4(0u, 0u, 0u, 0u);
  __syncthreads();
  const XcdBarrier xb = xcd_barrier_post((unsigned*)(p.ws + OFF_BAR), (volatile LAS unsigned*)&xb_words);
  run_all<0>(p, smem, xb);
}
#endif

extern "C" void kernel_launch(void* const* d_in, const int* in_sizes, int n_in, void* d_out, int out_size, void* d_ws, size_t ws_size,
                              hipStream_t stream) {
  Params p{};
  p.x = (const float*)d_in[0]; p.pos = (const int*)d_in[1]; p.ln_mix = (const float*)d_in[2]; p.ln_ffn = (const float*)d_in[3];
  p.gla_w_in = (const float*)d_in[4]; p.gla_w_alpha = (const float*)d_in[5]; p.gla_b_alpha = (const float*)d_in[6];
  p.gla_norm = (const float*)d_in[7]; p.gla_w_out = (const float*)d_in[8];
  p.swa_w_in = (const float*)d_in[9]; p.swa_b_in = (const float*)d_in[10]; p.swa_qn = (const float*)d_in[11]; p.swa_kn = (const float*)d_in[12];
  p.swa_sinks = (const float*)d_in[13]; p.swa_w_out = (const float*)d_in[14]; p.swa_b_out = (const float*)d_in[15];
  p.peer_wq = (const float*)d_in[16]; p.peer_keys = (const float*)d_in[17]; p.peer_u = (const float*)d_in[18]; p.peer_v = (const float*)d_in[19];
  p.out = (float*)d_out; p.ws = (char*)d_ws;
  static int grid_blocks = 0;
  if (!grid_blocks) {
    int dev = 0, cus = 0, per_cu = 0;
    (void)hipGetDevice(&dev);
    (void)hipDeviceGetAttribute(&cus, hipDeviceAttributeMultiprocessorCount, dev);
    #if MULTI_LAUNCH
    per_cu = 2;
#else
    (void)hipOccupancyMaxActiveBlocksPerMultiprocessor(&per_cu, trunk_kernel, 256, 0);
#endif
    if (per_cu < 1) per_cu = 1;
    if (per_cu > 2) per_cu = 2;
    grid_blocks = cus * per_cu;
  }
#if MULTI_LAUNCH
  p.phase_lo = 0; p.phase_hi = 0;
  launch_phases<0>(p, grid_blocks, stream);
#else
  p.phase_lo = 0; p.phase_hi = NPHASE - 1;
  void* args[] = {&p};
  (void)hipMemsetAsync((char*)d_ws + OFF_BAR, 0, XCD_BAR_WORDS * 4, stream);
  hipError_t e = hipLaunchCooperativeKernel((void*)trunk_kernel, dim3(grid_blocks), dim3(256), args, 0, stream);
  if (e != hipSuccess) fprintf(stderr, "cooperative launch failed: %s (grid %d)\n", hipGetErrorString(e), grid_blocks);
#endif
}
```

```cpp
#include <hip/hip_runtime.h>
#include <hip/hip_cooperative_groups.h>
#include <stdint.h>
#include <stdio.h>
namespace cg = cooperative_groups;

#ifndef MULTI_LAUNCH
#define MULTI_LAUNCH 0
#endif

#define DI __device__ __forceinline__
typedef unsigned short bf16_t;
typedef __attribute__((ext_vector_type(8))) short bf16x8;
typedef __attribute__((ext_vector_type(16))) float f32x16;
typedef __bf16 bf16x2_t __attribute__((ext_vector_type(2)));
typedef float f32x2_t __attribute__((ext_vector_type(2)));
typedef float f2 __attribute__((ext_vector_type(2)));

constexpr int T_TOK = 32768;
constexpr int SEQ = 16384;
constexpr int DM = 1024;
constexpr int NPHASE = 20;

constexpr size_t MiB = 1048576;
constexpr size_t OFF_WT_GLA_IN = 0;
constexpr size_t OFF_WT_GLA_OUT = 7 * MiB;
constexpr size_t OFF_WT_SWA_IN = 9 * MiB;
constexpr size_t OFF_WT_SWA_OUT = 12 * MiB;
constexpr size_t OFF_WT_PQ = 14 * MiB;
constexpr size_t OFF_KEYS = 18 * MiB;
constexpr size_t OFF_INV = 20 * MiB;
constexpr size_t OFF_TBL_U = 24 * MiB;
constexpr size_t OFF_TBL_V = 56 * MiB;
constexpr size_t OFF_ACT_A = 88 * MiB;
constexpr size_t OFF_BIG = 152 * MiB;
constexpr size_t OFF_E = OFF_BIG + 64 * MiB;
constexpr size_t OFF_G = OFF_BIG + 80 * MiB;
constexpr size_t OFF_KVT = 344 * MiB;
constexpr size_t OFF_ACT_B = OFF_KVT;
constexpr size_t OFF_LR = 472 * MiB;
constexpr size_t OFF_DECAY = 474 * MiB;
constexpr size_t OFF_BAR = 476 * MiB;

constexpr int SMEM_BYTES = 73728;
constexpr int LDK = 72;

struct Params {
  const float* x; const int* pos; const float* ln_mix; const float* ln_ffn;
  const float* gla_w_in; const float* gla_w_alpha; const float* gla_b_alpha; const float* gla_norm; const float* gla_w_out;
  const float* swa_w_in; const float* swa_b_in; const float* swa_qn; const float* swa_kn; const float* swa_sinks;
  const float* swa_w_out; const float* swa_b_out;
  const float* peer_wq; const float* peer_keys; const float* peer_u; const float* peer_v;
  float* out; char* ws;
  int phase_lo, phase_hi;
};

DI unsigned pk(float lo, float hi) { f32x2_t v = {lo, hi}; bf16x2_t b = __builtin_convertvector(v, bf16x2_t); return __builtin_bit_cast(unsigned, b); }
DI bf16_t f2bf(float x) { return (bf16_t)(pk(x, 0.f) & 0xffffu); }
DI float bflo(unsigned w) { return __uint_as_float(w << 16); }
DI float bfhi(unsigned w) { return __uint_as_float(w & 0xffff0000u); }
DI float bf2f(bf16_t b) { return __uint_as_float(((unsigned)b) << 16); }
DI float dot2(unsigned a, unsigned b, float c) { return __builtin_amdgcn_fdot2_f32_bf16(__builtin_bit_cast(bf16x2_t, a), __builtin_bit_cast(bf16x2_t, b), c, false); }
DI int crow(int i, int h) { return (i & 3) + 8 * (i >> 2) + 4 * h; }
DI f32x16 mfma32(bf16x8 a, bf16x8 b, f32x16 c) { return __builtin_amdgcn_mfma_f32_32x32x16_bf16(a, b, c, 0, 0, 0); }
DI f32x16 zero16() { f32x16 z; for (int i = 0; i < 16; ++i) z[i] = 0.f; return z; }
DI void wave_sync() { __builtin_amdgcn_fence(__ATOMIC_RELEASE, "wavefront"); __builtin_amdgcn_wave_barrier(); __builtin_amdgcn_fence(__ATOMIC_ACQUIRE, "wavefront"); }
DI int mbcnt64(unsigned long long m) { return __builtin_amdgcn_mbcnt_hi((unsigned)(m >> 32), __builtin_amdgcn_mbcnt_lo((unsigned)m, 0)); }
DI float logsig(float z) { return fminf(z, 0.f) - log1pf(__expf(-fabsf(z))); }

DI void transpose_tile(const float* __restrict__ src, int N, bf16_t* __restrict__ dst, int kt, int nt, float* sT) {
  const int tid = threadIdx.x;
  const int r = tid >> 4, c4 = (tid & 15) * 4;
#pragma unroll
  for (int i = 0; i < 4; ++i) {
    const int k = kt * 64 + r + 16 * i, n = nt * 64 + c4;
    float4 v = make_float4(0.f, 0.f, 0.f, 0.f);
    if (n + 3 < N) v = *(const float4*)(src + (size_t)k * N + n);
    float* d = sT + (r + 16 * i) * 65 + c4;
    d[0] = v.x; d[1] = v.y; d[2] = v.z; d[3] = v.w;
  }
  __syncthreads();
  const int n = tid >> 2, seg = tid & 3;
  unsigned w[8];
#pragma unroll
  for (int j = 0; j < 8; ++j) w[j] = pk(sT[(seg * 16 + 2 * j) * 65 + n], sT[(seg * 16 + 2 * j + 1) * 65 + n]);
  uint4* d = (uint4*)(dst + (size_t)(nt * 64 + n) * 1024 + kt * 64 + seg * 16);
  d[0] = make_uint4(w[0], w[1], w[2], w[3]);
  d[1] = make_uint4(w[4], w[5], w[6], w[7]);
  __syncthreads();
}

DI void cvt_elems(const float* __restrict__ src, bf16_t* __restrict__ dst, size_t n8) {
  for (size_t i = (size_t)blockIdx.x * 256 + threadIdx.x; i < n8; i += (size_t)gridDim.x * 256) {
    const float4 a = ((const float4*)src)[2 * i], b = ((const float4*)src)[2 * i + 1];
    ((uint4*)dst)[i] = make_uint4(pk(a.x, a.y), pk(a.z, a.w), pk(b.x, b.y), pk(b.z, b.w));
  }
}

DI void phase_convert(const Params& p, char* smem) {
  float* sT = (float*)smem;
  for (int t = blockIdx.x; t < 2144; t += gridDim.x) {
    const float* src; int N, ntn; bf16_t* dst; int local;
    if (t < 800) { src = p.gla_w_in; N = 3088; ntn = 50; dst = (bf16_t*)(p.ws + OFF_WT_GLA_IN); local = t; }
    else if (t < 1056) { src = p.gla_w_out; N = 1024; ntn = 16; dst = (bf16_t*)(p.ws + OFF_WT_GLA_OUT); local = t - 800; }
    else if (t < 1376) { src = p.swa_w_in; N = 1280; ntn = 20; dst = (bf16_t*)(p.ws + OFF_WT_SWA_IN); local = t - 1056; }
    else if (t < 1632) { src = p.swa_w_out; N = 1024; ntn = 16; dst = (bf16_t*)(p.ws + OFF_WT_SWA_OUT); local = t - 1376; }
    else if (t < 1888) { src = p.peer_wq; N = 1024; ntn = 16; dst = (bf16_t*)(p.ws + OFF_WT_PQ); local = t - 1632; }
    else { src = p.peer_wq + (size_t)1024 * 1024; N = 1024; ntn = 16; dst = (bf16_t*)(p.ws + OFF_WT_PQ) + (size_t)1024 * 1024; local = t - 1888; }
    transpose_tile(src, N, dst, local / ntn, local % ntn, sT);
  }
  cvt_elems(p.peer_keys, (bf16_t*)(p.ws + OFF_KEYS), (size_t)2 * 8 * 2 * 128 * 64 / 8);
}

typedef unsigned v6u __attribute__((ext_vector_type(6)));
typedef float v32f __attribute__((ext_vector_type(32)));
DI unsigned fp6_code(float y) {
  const float a = fminf(fabsf(y), 7.5f);
  float c = rintf(a * 8.f);
  c = a >= 2.f ? rintf(a * 4.f) + 8.f : c;
  c = a >= 4.f ? rintf(a * 2.f) + 16.f : c;
  unsigned u = (unsigned)c;
  u = u > 31u ? 31u : u;
  return u | ((__float_as_uint(y) >> 26) & 32u);
}
DI void cvt_table_fp6(const float* __restrict__ src, unsigned char* __restrict__ dst, float* __restrict__ inv) {
  const int lane = threadIdx.x & 63, w = threadIdx.x >> 6, r = lane & 31, h = lane >> 5;
  for (int rp = blockIdx.x * 4 + w; rp < 8192; rp += gridDim.x * 4) {
    const int row = rp * 2 + h;
    const float4* sp = (const float4*)(src + (size_t)row * 1024 + r * 32);
    float v[32];
    float mx = 0.f;
#pragma unroll
    for (int i = 0; i < 8; ++i) {
      const float4 t = sp[i];
      v[4 * i] = t.x; v[4 * i + 1] = t.y; v[4 * i + 2] = t.z; v[4 * i + 3] = t.w;
      mx = fmaxf(fmaxf(mx, fmaxf(fabsf(t.x), fabsf(t.y))), fmaxf(fabsf(t.z), fabsf(t.w)));
    }
#pragma unroll
    for (int o = 16; o >= 1; o >>= 1) mx = fmaxf(mx, __shfl_xor(mx, o));
    const float sc = mx > 0.f ? 7.5f / mx : 1.f;
    unsigned c[32];
#pragma unroll
    for (int i = 0; i < 32; ++i) c[i] = fp6_code(v[i] * sc);
    unsigned d[6];
#pragma unroll
    for (int g = 0; g < 2; ++g) {
      const unsigned* q = c + 16 * g;
      d[3 * g + 0] = q[0] | (q[1] << 6) | (q[2] << 12) | (q[3] << 18) | (q[4] << 24) | (q[5] << 30);
      d[3 * g + 1] = (q[5] >> 2) | (q[6] << 4) | (q[7] << 10) | (q[8] << 16) | (q[9] << 22) | (q[10] << 28);
      d[3 * g + 2] = (q[10] >> 4) | (q[11] << 2) | (q[12] << 8) | (q[13] << 14) | (q[14] << 20) | (q[15] << 26);
    }
    uint2* dp = (uint2*)(dst + (size_t)row * 768 + r * 24);
    dp[0] = make_uint2(d[0], d[1]); dp[1] = make_uint2(d[2], d[3]); dp[2] = make_uint2(d[4], d[5]);
    if (r == 0) inv[row] = mx > 0.f ? mx * (1.f / 7.5f) : 1.f;
  }
}
DI void phase_cvt_tables(const Params& p, int layer) {
  cvt_table_fp6(p.peer_u + (size_t)layer * 16384 * 1024, (unsigned char*)(p.ws + OFF_TBL_U) + (size_t)layer * 16 * MiB, (float*)(p.ws + OFF_INV) + (layer * 2 + 0) * 16384);
  cvt_table_fp6(p.peer_v + (size_t)layer * 16384 * 1024, (unsigned char*)(p.ws + OFF_TBL_V) + (size_t)layer * 16 * MiB, (float*)(p.ws + OFF_INV) + (layer * 2 + 1) * 16384);
}

DI void phase_rmsnorm(const float* __restrict__ src, const float* __restrict__ gain, bf16_t* __restrict__ dst) {
  const int lane = threadIdx.x & 63, w = threadIdx.x >> 6;
  for (int row = blockIdx.x * 4 + w; row < T_TOK; row += gridDim.x * 4) {
    const float4* sp = (const float4*)(src + (size_t)row * DM);
    float4 v[4];
    float ss = 0.f;
#pragma unroll
    for (int i = 0; i < 4; ++i) { v[i] = sp[lane + 64 * i]; ss += v[i].x * v[i].x + v[i].y * v[i].y + v[i].z * v[i].z + v[i].w * v[i].w; }
#pragma unroll
    for (int o = 32; o >= 1; o >>= 1) ss += __shfl_xor(ss, o);
    const float rs = rsqrtf(ss * (1.f / 1024.f) + 1e-6f);
#pragma unroll
    for (int i = 0; i < 4; ++i) {
      const float4 g = ((const float4*)gain)[lane + 64 * i];
      uint2 o2 = make_uint2(pk(v[i].x * rs * g.x, v[i].y * rs * g.y), pk(v[i].z * rs * g.z, v[i].w * rs * g.w));
      *(uint2*)(dst + (size_t)row * DM + (lane + 64 * i) * 4) = o2;
    }
  }
}

DI void mma_64x64(const bf16_t* sA, const bf16_t* sB, int arow0, int brow0, f32x16 (&acc)[2][2], int lane) {
  const int r = lane & 31, h = lane >> 5;
#pragma unroll
  for (int s = 0; s < 4; ++s) {
    bf16x8 a[2], b[2];
#pragma unroll
    for (int mi = 0; mi < 2; ++mi) a[mi] = *(const bf16x8*)(sA + (arow0 + mi * 32 + r) * LDK + s * 16 + h * 8);
#pragma unroll
    for (int ni = 0; ni < 2; ++ni) b[ni] = *(const bf16x8*)(sB + (brow0 + ni * 32 + r) * LDK + s * 16 + h * 8);
#pragma unroll
    for (int mi = 0; mi < 2; ++mi)
#pragma unroll
      for (int ni = 0; ni < 2; ++ni) acc[mi][ni] = mfma32(a[mi], b[ni], acc[mi][ni]);
  }
}

enum { EPI_GLA_IN = 0, EPI_RESID_X = 1, EPI_BF16 = 2, EPI_RESID_INPLACE = 3 };

template <int MODE>
DI void gemm_tile(const Params& p, const bf16_t* __restrict__ A, const bf16_t* __restrict__ Bt, int m0, int n0,
                  bf16_t* dstb, int ldc, const float* __restrict__ bias, char* smem) {
  bf16_t* sA = (bf16_t*)smem;
  bf16_t* sB = sA + 128 * LDK;
  const int tid = threadIdx.x, lane = tid & 63, w = tid >> 6, wm = w >> 1, wn = w & 1;
  f32x16 acc[2][2];
#pragma unroll
  for (int i = 0; i < 2; ++i)
#pragma unroll
    for (int j = 0; j < 2; ++j) acc[i][j] = zero16();
  bf16x8 ra[4], rb[4];
  const int lrow = tid >> 3, kc = tid & 7;
  const bf16_t* ap = A + (size_t)(m0 + lrow) * 1024 + kc * 8;
  const bf16_t* bp = Bt + (size_t)(n0 + lrow) * 1024 + kc * 8;
#pragma unroll
  for (int i = 0; i < 4; ++i) { ra[i] = *(const bf16x8*)(ap + (size_t)i * 32 * 1024); rb[i] = *(const bf16x8*)(bp + (size_t)i * 32 * 1024); }
  __syncthreads();
#pragma unroll
  for (int i = 0; i < 4; ++i) { *(bf16x8*)(sA + (lrow + 32 * i) * LDK + kc * 8) = ra[i]; *(bf16x8*)(sB + (lrow + 32 * i) * LDK + kc * 8) = rb[i]; }
  __syncthreads();
  for (int kt = 0; kt < 16; ++kt) {
    if (kt + 1 < 16) {
#pragma unroll
      for (int i = 0; i < 4; ++i) { ra[i] = *(const bf16x8*)(ap + (size_t)i * 32 * 1024 + (kt + 1) * 64); rb[i] = *(const bf16x8*)(bp + (size_t)i * 32 * 1024 + (kt + 1) * 64); }
    }
    mma_64x64(sA, sB, wm * 64, wn * 64, acc, lane);
    __syncthreads();
    if (kt + 1 < 16) {
#pragma unroll
      for (int i = 0; i < 4; ++i) { *(bf16x8*)(sA + (lrow + 32 * i) * LDK + kc * 8) = ra[i]; *(bf16x8*)(sB + (lrow + 32 * i) * LDK + kc * 8) = rb[i]; }
      __syncthreads();
    }
  }
  const int r = lane & 31, h = lane >> 5;
#pragma unroll
  for (int mi = 0; mi < 2; ++mi)
#pragma unroll
    for (int ni = 0; ni < 2; ++ni) {
      const int col = n0 + wn * 64 + ni * 32 + r;
#pragma unroll
      for (int i = 0; i < 16; ++i) {
        const int row = m0 + wm * 64 + mi * 32 + crow(i, h);
        const float v = acc[mi][ni][i];
        if (MODE == EPI_GLA_IN) {
          if (col < 3072) dstb[(size_t)row * 3072 + col] = f2bf(v);
          else if (col < 3088) ((float*)(p.ws + OFF_LR))[(size_t)row * 16 + (col - 3072)] = v;
        } else if (MODE == EPI_RESID_X) {
          p.out[(size_t)row * 1024 + col] = p.x[(size_t)row * 1024 + col] + v;
        } else if (MODE == EPI_BF16) {
          dstb[(size_t)row * ldc + col] = f2bf(bias ? v + bias[col] : v);
        } else {
          p.out[(size_t)row * 1024 + col] += v + bias[col];
        }
      }
    }
}

template <int MODE>
DI void phase_gemm(const Params& p, const bf16_t* A, const bf16_t* Bt, int NT, bf16_t* dstb, int ldc, const float* bias, char* smem) {
  const int ntiles = (T_TOK / 128) * NT;
  for (int t = blockIdx.x; t < ntiles; t += gridDim.x) gemm_tile<MODE>(p, A, Bt, (t / NT) * 128, (t % NT) * 128, dstb, ldc, bias, smem);
}

DI float gate_la(const float* lr_s, int t, const float (&wa)[16], float ba) {
  float z = ba;
#pragma unroll
  for (int j = 0; j < 16; ++j) z += lr_s[t * 16 + j] * wa[j];
  return logsig(z) * (1.f / 16.f);
}
DI void gla_gates(const Params& p, int t0, int hh, float (&wa)[16], float& ba, float& offset, float& blast, float* lr_s, float* tot_s) {
  const int tid = threadIdx.x, d = tid & 127, half = tid >> 7;
  const float* LR = (const float*)(p.ws + OFF_LR);
  ((float4*)lr_s)[tid] = ((const float4*)(LR + (size_t)t0 * 16))[tid];
#pragma unroll
  for (int j = 0; j < 16; ++j) wa[j] = p.gla_w_alpha[j * 512 + hh * 128 + d];
  ba = p.gla_b_alpha[hh * 128 + d];
  __syncthreads();
  float sum = 0.f;
#pragma unroll 4
  for (int tt = 0; tt < 32; ++tt) sum += gate_la(lr_s, half * 32 + tt, wa, ba);
  tot_s[half * 128 + d] = sum;
  __syncthreads();
  offset = half ? tot_s[d] : 0.f;
  blast = tot_s[d] + tot_s[128 + d];
}

DI void fill_vT(const bf16_t* __restrict__ QKVR, int t0, int hh, int vh, bf16_t* vT) {
  const int tid = threadIdx.x, v = tid & 127, half = tid >> 7;
#pragma unroll 8
  for (int tt = 0; tt < 32; ++tt) {
    const int t = half * 32 + tt;
    vT[v * LDK + t] = QKVR[(size_t)(t0 + t) * 3072 + 1024 + hh * 256 + vh * 128 + v];
  }
}

DI void gla_phase1(const Params& p, int item, char* smem) {
  const int hh = item & 3, c = (item >> 2) & 255, b = item >> 10;
  const int t0 = b * SEQ + c * 64;
  float* lr_s = (float*)smem;
  float* tot_s = (float*)(smem + 4096);
  bf16_t* kfT = (bf16_t*)(smem + 5120);
  bf16_t* vT = kfT + 128 * LDK;
  const bf16_t* QKVR = (const bf16_t*)(p.ws + OFF_BIG);
  bf16_t* KVT = (bf16_t*)(p.ws + OFF_KVT);
  float* DECAY = (float*)(p.ws + OFF_DECAY);
  const int tid = threadIdx.x, lane = tid & 63, w = tid >> 6, wm = w >> 1, wn = w & 1;
  const int d = tid & 127, half = tid >> 7;
  float wa[16], ba, offset, blast;
  gla_gates(p, t0, hh, wa, ba, offset, blast, lr_s, tot_s);
  float run = offset;
#pragma unroll 4
  for (int tt = 0; tt < 32; ++tt) {
    const int t = half * 32 + tt;
    run += gate_la(lr_s, t, wa, ba);
    const float kv = bf2f(QKVR[(size_t)(t0 + t) * 3072 + 512 + hh * 128 + d]);
    kfT[d * LDK + t] = f2bf(kv * __expf(blast - run));
  }
  if (half == 0) DECAY[(size_t)item * 128 + d] = __expf(blast);
  const int r = lane & 31, h = lane >> 5;
  for (int vh = 0; vh < 2; ++vh) {
    __syncthreads();
    fill_vT(QKVR, t0, hh, vh, vT);
    __syncthreads();
    f32x16 acc[2][2];
#pragma unroll
    for (int i = 0; i < 2; ++i)
#pragma unroll
      for (int j = 0; j < 2; ++j) acc[i][j] = zero16();
    mma_64x64(vT, kfT, wm * 64, wn * 64, acc, lane);
    bf16_t* kbase = KVT + (size_t)item * 32768 + (vh * 128 + wm * 64 + 4 * h) * 128 + wn * 64 + r;
#pragma unroll
    for (int mi = 0; mi < 2; ++mi)
#pragma unroll
      for (int ni = 0; ni < 2; ++ni)
#pragma unroll
        for (int i = 0; i < 16; ++i) kbase[(mi * 32 + (i & 3) + 8 * (i >> 2)) * 128 + ni * 32] = f2bf(acc[mi][ni][i]);
  }
  __syncthreads();
}

DI void gla_scan(const Params& p) {
  bf16_t* KVT = (bf16_t*)(p.ws + OFF_KVT);
  const float* DECAY = (const float*)(p.ws + OFF_DECAY);
  for (int idx = blockIdx.x * 256 + threadIdx.x; idx < 8 * 16384; idx += gridDim.x * 256) {
    const int bh = idx >> 14, e2 = idx & 16383, b = bh >> 2, hh = bh & 3, d0 = (2 * e2) & 127;
    float s0 = 0.f, s1 = 0.f;
    for (int c0 = 0; c0 < 256; c0 += 8) {
      unsigned kv[8]; float2 dc[8];
#pragma unroll
      for (int u = 0; u < 8; ++u) {
        const size_t item = (size_t)(b * 256 + c0 + u) * 4 + hh;
        kv[u] = *(const unsigned*)(KVT + item * 32768 + 2 * e2);
        dc[u] = *(const float2*)(DECAY + item * 128 + d0);
      }
#pragma unroll
      for (int u = 0; u < 8; ++u) {
        const size_t item = (size_t)(b * 256 + c0 + u) * 4 + hh;
        *(unsigned*)(KVT + item * 32768 + 2 * e2) = pk(s0, s1);
        s0 = dc[u].x * s0 + bflo(kv[u]);
        s1 = dc[u].y * s1 + bfhi(kv[u]);
      }
    }
  }
}

DI void gla_phase3(const Params& p, int item, char* smem) {
  const int hh = item & 3, c = (item >> 2) & 255, b = item >> 10;
  const int t0 = b * SEQ + c * 64;
  float* lr_s = (float*)smem;
  float* tot_s = (float*)(smem + 4096);
  bf16_t* qd = (bf16_t*)(smem + 5120);
  bf16_t* ki = qd + 64 * 136;
  bf16_t* at = ki + 64 * 136;
  bf16_t* vT = at + 64 * 72;
  bf16_t* ot = qd;
  const bf16_t* QKVR = (const bf16_t*)(p.ws + OFF_BIG);
  const bf16_t* ST = (const bf16_t*)(p.ws + OFF_KVT);
  bf16_t* OG = (bf16_t*)(p.ws + OFF_ACT_A);
  const int tid = threadIdx.x, lane = tid & 63, w = tid >> 6;
  const int d = tid & 127, half = tid >> 7;
  const int r = lane & 31, h = lane >> 5;
  {
    float wa[16], ba, offset, blast;
    gla_gates(p, t0, hh, wa, ba, offset, blast, lr_s, tot_s);
    float run = offset;
#pragma unroll 4
    for (int tt = 0; tt < 32; ++tt) {
      const int t = half * 32 + tt;
      run += gate_la(lr_s, t, wa, ba);
      const float q = bf2f(QKVR[(size_t)(t0 + t) * 3072 + hh * 128 + d]);
      const float k = bf2f(QKVR[(size_t)(t0 + t) * 3072 + 512 + hh * 128 + d]);
      qd[t * 136 + d] = f2bf(q * 0.08838834764831845f * __expf(run));
      ki[t * 136 + d] = f2bf(k * __expf(-run));
    }
  }
  __syncthreads();
  {
    const int mi = w >> 1, nj = w & 1;
    f32x16 a = zero16();
#pragma unroll
    for (int s = 0; s < 8; ++s) {
      const bf16x8 A = *(const bf16x8*)(qd + (mi * 32 + r) * 136 + s * 16 + h * 8);
      const bf16x8 B = *(const bf16x8*)(ki + (nj * 32 + r) * 136 + s * 16 + h * 8);
      a = mfma32(A, B, a);
    }
#pragma unroll
    for (int i = 0; i < 16; ++i) {
      const int it = mi * 32 + crow(i, h), jt = nj * 32 + r;
      at[it * 72 + jt] = f2bf(jt <= it ? a[i] : 0.f);
    }
  }
  f32x16 o[2][2];
#pragma unroll
  for (int i = 0; i < 2; ++i)
#pragma unroll
    for (int j = 0; j < 2; ++j) o[i][j] = zero16();
#pragma unroll
  for (int vh = 0; vh < 2; ++vh) {
    __syncthreads();
    fill_vT(QKVR, t0, hh, vh, vT);
    __syncthreads();
#pragma unroll
    for (int s = 0; s < 4; ++s) {
      const bf16x8 B = *(const bf16x8*)(vT + (w * 32 + r) * LDK + s * 16 + h * 8);
#pragma unroll
      for (int mt = 0; mt < 2; ++mt) {
        const bf16x8 A = *(const bf16x8*)(at + (mt * 32 + r) * 72 + s * 16 + h * 8);
        o[vh][mt] = mfma32(A, B, o[vh][mt]);
      }
    }
    const bf16_t* Sg = ST + (size_t)item * 32768 + (size_t)(vh * 128 + w * 32 + r) * 128 + h * 8;
#pragma unroll
    for (int s = 0; s < 8; ++s) {
      const bf16x8 B = *(const bf16x8*)(Sg + s * 16);
#pragma unroll
      for (int mt = 0; mt < 2; ++mt) {
        const bf16x8 A = *(const bf16x8*)(qd + (mt * 32 + r) * 136 + s * 16 + h * 8);
        o[vh][mt] = mfma32(A, B, o[vh][mt]);
      }
    }
  }
  __syncthreads();
#pragma unroll
  for (int vh = 0; vh < 2; ++vh)
#pragma unroll
    for (int mt = 0; mt < 2; ++mt)
#pragma unroll
      for (int i = 0; i < 16; ++i) ot[(mt * 32 + crow(i, h)) * 264 + vh * 128 + w * 32 + r] = f2bf(o[vh][mt][i]);
  __syncthreads();
  {
    const int row = tid >> 2, seg = tid & 3;
    const bf16_t* orow = ot + row * 264 + seg * 64;
    float ss = 0.f;
#pragma unroll
    for (int c8 = 0; c8 < 8; ++c8) {
      const uint4 ov = *(const uint4*)(orow + c8 * 8);
      const float f0 = bflo(ov.x), f1 = bfhi(ov.x), f2 = bflo(ov.y), f3 = bfhi(ov.y), f4 = bflo(ov.z), f5 = bfhi(ov.z), f6 = bflo(ov.w), f7 = bfhi(ov.w);
      ss += f0 * f0 + f1 * f1 + f2 * f2 + f3 * f3 + f4 * f4 + f5 * f5 + f6 * f6 + f7 * f7;
    }
    ss += __shfl_xor(ss, 1);
    ss += __shfl_xor(ss, 2);
    const float rs = rsqrtf(ss * (1.f / 256.f) + 1e-6f);
    const bf16_t* rrow = QKVR + (size_t)(t0 + row) * 3072 + 2048 + hh * 256 + seg * 64;
    const float* grow = p.gla_norm + hh * 256 + seg * 64;
    bf16_t* dst = OG + (size_t)(t0 + row) * 1024 + hh * 256 + seg * 64;
#pragma unroll
    for (int c8 = 0; c8 < 8; ++c8) {
      const uint4 ov = *(const uint4*)(orow + c8 * 8);
      const uint4 rv = *(const uint4*)(rrow + c8 * 8);
      const float4 g0 = *(const float4*)(grow + c8 * 8), g1 = *(const float4*)(grow + c8 * 8 + 4);
      float of[8] = {bflo(ov.x), bfhi(ov.x), bflo(ov.y), bfhi(ov.y), bflo(ov.z), bfhi(ov.z), bflo(ov.w), bfhi(ov.w)};
      float rf[8] = {bflo(rv.x), bfhi(rv.x), bflo(rv.y), bfhi(rv.y), bflo(rv.z), bfhi(rv.z), bflo(rv.w), bfhi(rv.w)};
      float gf[8] = {g0.x, g0.y, g0.z, g0.w, g1.x, g1.y, g1.z, g1.w};
      float res[8];
#pragma unroll
      for (int e = 0; e < 8; ++e) res[e] = of[e] * rs * gf[e] * (rf[e] / (1.f + __expf(-rf[e])));
      *(uint4*)(dst + c8 * 8) = make_uint4(pk(res[0], res[1]), pk(res[2], res[3]), pk(res[4], res[5]), pk(res[6], res[7]));
    }
  }
  __syncthreads();
}

DI void swa_qknorm(const Params& p) {
  bf16_t* QKV = (bf16_t*)(p.ws + OFF_BIG);
  const int tid = threadIdx.x, sub = tid & 7;
  const int ngroups = T_TOK * 18;
  for (int g = blockIdx.x * 32 + (tid >> 3); g < ngroups; g += gridDim.x * 32) {
    const int tok = g / 18, slot = g - tok * 18;
    bf16_t* ptr = QKV + (size_t)tok * 1280 + slot * 64 + sub * 8;
    const uint4 wv = *(const uint4*)ptr;
    float v[8] = {bflo(wv.x), bfhi(wv.x), bflo(wv.y), bfhi(wv.y), bflo(wv.z), bfhi(wv.z), bflo(wv.w), bfhi(wv.w)};
    float ss = 0.f;
#pragma unroll
    for (int e = 0; e < 8; ++e) ss += v[e] * v[e];
    ss += __shfl_xor(ss, 1);
    ss += __shfl_xor(ss, 2);
    ss += __shfl_xor(ss, 4);
    const float rs = rsqrtf(ss * (1.f / 64.f) + 1e-6f);
    const float* gain = (slot < 16 ? p.swa_qn : p.swa_kn) + sub * 8;
#pragma unroll
    for (int e = 0; e < 8; ++e) v[e] = v[e] * rs * gain[e];
    const float posf = (float)p.pos[tok];
    const float invf[8] = {1.0f, 0.1939227432012558f, 0.03760603070259094f, 0.007292664609849453f,
                           0.0014142135623842478f, 0.00027424818836152554f, 5.318296098266728e-05f, 1.0313386155758053e-05f};
#pragma unroll
    for (int e = 0; e < 8; ++e) {
      const float other = __shfl_xor(v[e], 1);
      if (sub < 2) {
        const float ang = posf * invf[e];
        const double rev = (double)ang * 0.15915494309189535;
        const float fr = (float)(rev - rint(rev));
        const float sn = __builtin_amdgcn_sinf(fr), cs = __builtin_amdgcn_cosf(fr);
        v[e] = (sub == 0) ? (v[e] * cs - other * sn) : (v[e] * cs + other * sn);
      }
    }
    if (slot < 16) {
#pragma unroll
      for (int e = 0; e < 8; ++e) v[e] *= 0.125f;
    }
    *(uint4*)ptr = make_uint4(pk(v[0], v[1]), pk(v[2], v[3]), pk(v[4], v[5]), pk(v[6], v[7]));
  }
}

DI void swa_attn(const Params& p, int item, char* smem) {
  const int hq = item & 15, n = (item >> 4) & 127, b = item >> 11, hkv = hq >> 3;
  const int tok0 = b * SEQ + n * 128;
  bf16_t* Ks = (bf16_t*)smem;
  bf16_t* vT = Ks + 256 * 72;
  const bf16_t* QKV = (const bf16_t*)(p.ws + OFF_BIG);
  bf16_t* OUT = (bf16_t*)(p.ws + OFF_ACT_B);
  const int tid = threadIdx.x, lane = tid & 63, w = tid >> 6, r = lane & 31, h = lane >> 5;
  __syncthreads();
#pragma unroll
  for (int i = 0; i < 8; ++i) {
    const int cidx = tid + 256 * i, kk = cidx >> 3, kc = cidx & 7;
    const int pos = n * 128 - 128 + kk;
    uint4 kw = make_uint4(0, 0, 0, 0), vw = make_uint4(0, 0, 0, 0);
    if (pos >= 0) {
      const bf16_t* base = QKV + (size_t)(b * SEQ + pos) * 1280;
      kw = *(const uint4*)(base + 1024 + hkv * 64 + kc * 8);
      vw = *(const uint4*)(base + 1152 + hkv * 64 + kc * 8);
    }
    *(uint4*)(Ks + kk * 72 + kc * 8) = kw;
    bf16_t* vd = vT + (kc * 8) * 264 + kk;
    vd[0 * 264] = (bf16_t)(vw.x & 0xffff); vd[1 * 264] = (bf16_t)(vw.x >> 16);
    vd[2 * 264] = (bf16_t)(vw.y & 0xffff); vd[3 * 264] = (bf16_t)(vw.y >> 16);
    vd[4 * 264] = (bf16_t)(vw.z & 0xffff); vd[5 * 264] = (bf16_t)(vw.z >> 16);
    vd[6 * 264] = (bf16_t)(vw.w & 0xffff); vd[7 * 264] = (bf16_t)(vw.w >> 16);
  }
  __syncthreads();
  const int iq = 32 * w + r;
  const bf16_t* qrow = QKV + (size_t)(tok0 + iq) * 1280 + hq * 64 + h * 8;
  bf16x8 qf[4];
#pragma unroll
  for (int s = 0; s < 4; ++s) qf[s] = *(const bf16x8*)(qrow + s * 16);
  f32x16 X[5];
#pragma unroll
  for (int kt = 0; kt < 5; ++kt) {
    X[kt] = zero16();
#pragma unroll
    for (int s = 0; s < 4; ++s) {
      const bf16x8 A = *(const bf16x8*)(Ks + ((w + kt) * 32 + r) * 72 + s * 16 + h * 8);
      X[kt] = mfma32(A, qf[s], X[kt]);
    }
  }
  const float sink = p.swa_sinks[hq];
  float m = sink;
#pragma unroll
  for (int kt = 0; kt < 5; ++kt)
#pragma unroll
    for (int i = 0; i < 16; ++i) {
      const int kk = (w + kt) * 32 + crow(i, h);
      const bool valid = (kk > iq) && (kk <= iq + 128) && (n > 0 || kk >= 128);
      const float xv = valid ? X[kt][i] : -INFINITY;
      X[kt][i] = xv;
      m = fmaxf(m, xv);
    }
  m = fmaxf(m, __shfl_xor(m, 32));
  float l = 0.f;
#pragma unroll
  for (int kt = 0; kt < 5; ++kt)
#pragma unroll
    for (int i = 0; i < 16; ++i) {
      const float pv = __expf(X[kt][i] - m);
      X[kt][i] = pv;
      l += pv;
    }
  l += __shfl_xor(l, 32);
  l += __expf(sink - m);
  f32x16 O[2];
  O[0] = zero16(); O[1] = zero16();
#pragma unroll
  for (int kt = 0; kt < 5; ++kt)
#pragma unroll
    for (int s2 = 0; s2 < 2; ++s2) {
      const uint4 pw = make_uint4(pk(X[kt][8 * s2 + 0], X[kt][8 * s2 + 1]), pk(X[kt][8 * s2 + 2], X[kt][8 * s2 + 3]),
                                  pk(X[kt][8 * s2 + 4], X[kt][8 * s2 + 5]), pk(X[kt][8 * s2 + 6], X[kt][8 * s2 + 7]));
      const bf16x8 P = __builtin_bit_cast(bf16x8, pw);
#pragma unroll
      for (int mt = 0; mt < 2; ++mt) {
        const bf16_t* vp = vT + (mt * 32 + r) * 264 + (w + kt) * 32 + 16 * s2 + 4 * h;
        const uint2 lo = *(const uint2*)vp, hi = *(const uint2*)(vp + 8);
        const bf16x8 A = __builtin_bit_cast(bf16x8, make_uint4(lo.x, lo.y, hi.x, hi.y));
        O[mt] = mfma32(A, P, O[mt]);
      }
    }
  const float inv = 1.f / l;
  bf16_t* orow = OUT + (size_t)(tok0 + iq) * 1024 + hq * 64 + 4 * h;
#pragma unroll
  for (int mt = 0; mt < 2; ++mt)
#pragma unroll
    for (int g = 0; g < 4; ++g)
      *(uint2*)(orow + mt * 32 + 8 * g) = make_uint2(pk(O[mt][4 * g] * inv, O[mt][4 * g + 1] * inv), pk(O[mt][4 * g + 2] * inv, O[mt][4 * g + 3] * inv));
}

DI unsigned fkey_u(unsigned u) { return u ^ ((unsigned)((int)u >> 31) | 0x80000000u); }
DI float unfkey(unsigned k) { return __uint_as_float(k ^ ((~(unsigned)((int)k >> 31)) | 0x80000000u)); }
DI void cswap(unsigned& a, unsigned& b) { const unsigned hi = a > b ? a : b, lo = a > b ? b : a; a = hi; b = lo; }
DI void sort16(unsigned (&t)[16]) {
#pragma unroll
  for (int k = 2; k <= 16; k <<= 1)
#pragma unroll
    for (int j = k >> 1; j > 0; j >>= 1)
#pragma unroll
      for (int i = 0; i < 16; ++i) {
        const int l = i ^ j;
        if (l > i) { if ((i & k) == 0) cswap(t[i], t[l]); else cswap(t[l], t[i]); }
      }
}
DI void merge16(unsigned (&a)[16], const unsigned (&b)[16]) {
#pragma unroll
  for (int j = 0; j < 16; ++j) a[j] = a[j] > b[15 - j] ? a[j] : b[15 - j];
#pragma unroll
  for (int j = 8; j > 0; j >>= 1)
#pragma unroll
    for (int i = 0; i < 16; ++i) { const int l = i ^ j; if (l > i) cswap(a[i], a[l]); }
}
DI void cswap2(unsigned& ak, int& ap, unsigned& bk, int& bp) {
  const bool sw = bk > ak;
  const unsigned hk = sw ? bk : ak, lk = sw ? ak : bk;
  const int hp = sw ? bp : ap, lp = sw ? ap : bp;
  ak = hk; ap = hp; bk = lk; bp = lp;
}
DI void sort16p(unsigned (&t)[16], int (&q)[16]) {
#pragma unroll
  for (int k = 2; k <= 16; k <<= 1)
#pragma unroll
    for (int j = k >> 1; j > 0; j >>= 1)
#pragma unroll
      for (int i = 0; i < 16; ++i) {
        const int l = i ^ j;
        if (l > i) { if ((i & k) == 0) cswap2(t[i], q[i], t[l], q[l]); else cswap2(t[l], q[l], t[i], q[i]); }
      }
}
__device__ constexpr int CIA[25] = {0,0,0,0,0,0,0,0,0,0,0,0,0,0,0,0, 2,2,2,2,2, 3,3,3,3};
__device__ constexpr int CJA[25] = {0,1,2,3,4,5,6,7,8,9,10,11,12,13,14,15, 0,1,2,3,4, 0,1,2,3};
__device__ constexpr int CIB[25] = {1,1,1,1,1,1,1,1, 4,4,4, 5,5,6,6,7,7, 8,9,10,11,12,13,14,15};
__device__ constexpr int CJB[25] = {0,1,2,3,4,5,6,7, 0,1,2, 0,1,0,1,0,1, 0,0,0,0,0,0,0,0};

DI void peer_topk_wave(const Params& p, int layer, int item) {
  const int head = item >> 10, tok0 = (item & 1023) * 32;
  const bf16_t* Q = (const bf16_t*)(p.ws + OFF_BIG);
  const bf16_t* KEYS = (const bf16_t*)(p.ws + OFF_KEYS) + (size_t)(layer * 8 + head) * 256 * 64;
  int* E = (int*)(p.ws + OFF_E);
  float* G = (float*)(p.ws + OFF_G);
  const int lane = threadIdx.x & 63, r = lane & 31, h = lane >> 5;
  const unsigned h4 = 4u * (1u - (unsigned)h);
  unsigned tl[2][16];
#pragma unroll
  for (int set = 0; set < 2; ++set) {
    bf16x8 qf[4];
    const bf16_t* qrow = Q + (size_t)(tok0 + r) * 1024 + head * 128 + set * 64 + h * 8;
#pragma unroll
    for (int s = 0; s < 4; ++s) qf[s] = *(const bf16x8*)(qrow + s * 16);
#pragma unroll
    for (int kt = 0; kt < 4; ++kt) {
      const bf16_t* krow = KEYS + (size_t)(set * 128 + kt * 32 + r) * 64 + h * 8;
      f32x16 X = zero16();
#pragma unroll
      for (int s = 0; s < 4; ++s) X = mfma32(*(const bf16x8*)(krow + s * 16), qf[s], X);
      unsigned kk[16];
#pragma unroll
      for (int i = 0; i < 16; ++i)
        kk[i] = (fkey_u(__float_as_uint(X[i])) & ~127u) + ((unsigned)(127 - kt * 32 - (i & 3) - 8 * (i >> 2) - 4) + h4);
      sort16(kk);
      if (kt == 0) {
#pragma unroll
        for (int i = 0; i < 16; ++i) tl[set][i] = kk[i];
      } else merge16(tl[set], kk);
    }
  }
  unsigned mine[16], oth[16];
#pragma unroll
  for (int j = 0; j < 16; ++j) {
    const unsigned send = h ? tl[0][j] : tl[1][j];
    oth[j] = (unsigned)__shfl_xor((int)send, 32);
    mine[j] = h ? tl[1][j] : tl[0][j];
  }
  merge16(mine, oth);
  float v1[16], v2[16]; int i1[16], i2[16];
#pragma unroll
  for (int j = 0; j < 16; ++j) {
    const unsigned o = (unsigned)__shfl_xor((int)mine[j], 32);
    const unsigned A = h ? o : mine[j], B = h ? mine[j] : o;
    v1[j] = unfkey(A & ~127u); i1[j] = 127 - (int)(A & 127u);
    v2[j] = unfkey(B & ~127u); i2[j] = 127 - (int)(B & 127u);
  }
  unsigned ck[16], dk[16]; int cp[16], dp[16];
#pragma unroll
  for (int n = 0; n < 32; ++n) {
    unsigned key = 0u; int e = 0;
    if (n < 25) {
      const float sA = v1[CIA[n]] + v2[CJA[n]], sB = v1[CIB[n]] + v2[CJB[n]];
      const int eA = i1[CIA[n]] * 128 + i2[CJA[n]], eB = i1[CIB[n]] * 128 + i2[CJB[n]];
      key = fkey_u(__float_as_uint(h ? sB : sA)); e = h ? eB : eA;
    }
    if (n < 16) { ck[n] = key; cp[n] = e; } else { dk[n - 16] = key; dp[n - 16] = e; }
  }
  sort16p(ck, cp);
  sort16p(dk, dp);
#pragma unroll
  for (int j = 0; j < 16; ++j) { const bool sw = dk[15 - j] > ck[j]; ck[j] = sw ? dk[15 - j] : ck[j]; cp[j] = sw ? dp[15 - j] : cp[j]; }
#pragma unroll
  for (int j = 8; j > 0; j >>= 1)
#pragma unroll
    for (int i = 0; i < 16; ++i) { const int l = i ^ j; if (l > i) cswap2(ck[i], cp[i], ck[l], cp[l]); }
  unsigned fk[16]; int fe[16];
#pragma unroll
  for (int j = 0; j < 16; ++j) { dk[j] = (unsigned)__shfl_xor((int)ck[j], 32); dp[j] = __shfl_xor(cp[j], 32); }
#pragma unroll
  for (int j = 0; j < 16; ++j) {
    const bool sw = (dk[15 - j] > ck[j]) || (dk[15 - j] == ck[j] && dp[15 - j] > cp[j]);
    fk[j] = sw ? dk[15 - j] : ck[j]; fe[j] = sw ? dp[15 - j] : cp[j];
  }
  float sv[16], mx = -INFINITY;
#pragma unroll
  for (int j = 0; j < 16; ++j) { sv[j] = unfkey(fk[j]); mx = fmaxf(mx, sv[j]); }
  float sm = 0.f;
#pragma unroll
  for (int j = 0; j < 16; ++j) { sv[j] = __expf(sv[j] - mx); sm += sv[j]; }
  const float inv = 1.f / sm;
  const size_t o = ((size_t)(tok0 + r) * 8 + head) * 16 + h * 8;
  *(int4*)(E + o) = make_int4(fe[0], fe[1], fe[2], fe[3]);
  *(int4*)(E + o + 4) = make_int4(fe[4], fe[5], fe[6], fe[7]);
  *(float4*)(G + o) = make_float4(sv[0] * inv, sv[1] * inv, sv[2] * inv, sv[3] * inv);
  *(float4*)(G + o + 4) = make_float4(sv[4] * inv, sv[5] * inv, sv[6] * inv, sv[7] * inv);
}

DI v32f fp6x32(const uint2* p) {
  const uint2 a = p[0], b = p[1], c = p[2];
  v6u x; x[0] = a.x; x[1] = a.y; x[2] = b.x; x[3] = b.y; x[4] = c.x; x[5] = c.y;
  return __builtin_amdgcn_cvt_scalef32_pk32_f32_fp6(x, 1.0f);
}

DI void peer_gather(const Params& p, int layer, char* smem) {
  const int tid = threadIdx.x, lane = tid & 63, w = tid >> 6, grp = lane >> 4, i16 = lane & 15, r = lane & 31, h = lane >> 5;
  float* a_s = (float*)smem + w * 512;
  float* su_s = a_s + 128;
  float* gv_s = a_s + 256;
  int* e_s = (int*)(a_s + 384);
  const bf16_t* HN = (const bf16_t*)(p.ws + OFF_ACT_A);
  const unsigned char* U = (const unsigned char*)(p.ws + OFF_TBL_U) + (size_t)layer * 16 * MiB;
  const unsigned char* V = (const unsigned char*)(p.ws + OFF_TBL_V) + (size_t)layer * 16 * MiB;
  const float* IU = (const float*)(p.ws + OFF_INV) + (layer * 2 + 0) * 16384;
  const float* IV = (const float*)(p.ws + OFF_INV) + (layer * 2 + 1) * 16384;
  const int* E = (const int*)(p.ws + OFF_E);
  const float* G = (const float*)(p.ws + OFF_G);
  for (int tok = blockIdx.x * 4 + w; tok < T_TOK; tok += gridDim.x * 4) {
    float xf[2][32];
#pragma unroll
    for (int c = 0; c < 2; ++c) {
      const uint4* xp = (const uint4*)(HN + (size_t)tok * 1024 + c * 512 + i16 * 32);
#pragma unroll
      for (int q = 0; q < 4; ++q) {
        const uint4 x0 = xp[q];
        xf[c][8 * q + 0] = bflo(x0.x); xf[c][8 * q + 1] = bfhi(x0.x); xf[c][8 * q + 2] = bflo(x0.y); xf[c][8 * q + 3] = bfhi(x0.y);
        xf[c][8 * q + 4] = bflo(x0.z); xf[c][8 * q + 5] = bfhi(x0.z); xf[c][8 * q + 6] = bflo(x0.w); xf[c][8 * q + 7] = bfhi(x0.w);
      }
    }
    {
      const int e0 = E[(size_t)tok * 128 + lane], e1 = E[(size_t)tok * 128 + 64 + lane];
      e_s[lane] = e0; e_s[64 + lane] = e1;
      su_s[lane] = IU[e0]; su_s[64 + lane] = IU[e1];
      gv_s[lane] = G[(size_t)tok * 128 + lane] * IV[e0]; gv_s[64 + lane] = G[(size_t)tok * 128 + 64 + lane] * IV[e1];
    }
    wave_sync();
#pragma unroll 4
    for (int mm = 0; mm < 32; ++mm) {
      const int pidx = 4 * mm + grp;
      const unsigned char* up = U + (size_t)e_s[pidx] * 768 + i16 * 24;
      const v32f u0 = fp6x32((const uint2*)up), u1 = fp6x32((const uint2*)(up + 384));
      float acc0 = 0.f, acc1 = 0.f;
#pragma unroll
      for (int i = 0; i < 32; ++i) { acc0 = fmaf(u0[i], xf[0][i], acc0); acc1 = fmaf(u1[i], xf[1][i], acc1); }
      float acc = acc0 + acc1;
      acc += __shfl_xor(acc, 1); acc += __shfl_xor(acc, 2); acc += __shfl_xor(acc, 4); acc += __shfl_xor(acc, 8);
      acc *= su_s[pidx];
      const float a = 0.5f * acc * (1.f + erff(acc * 0.7071067811865476f)) * gv_s[pidx];
      if (i16 == 0) a_s[pidx] = a;
    }
    wave_sync();
    float o[32];
#pragma unroll
    for (int i = 0; i < 32; ++i) o[i] = 0.f;
#pragma unroll 8
    for (int mm = 0; mm < 64; ++mm) {
      const int pidx = 2 * mm + h;
      const float a = a_s[pidx];
      const v32f vv = fp6x32((const uint2*)(V + (size_t)e_s[pidx] * 768 + r * 24));
#pragma unroll
      for (int i = 0; i < 32; ++i) o[i] = fmaf(a, vv[i], o[i]);
    }
#pragma unroll
    for (int i = 0; i < 32; ++i) o[i] += __shfl_xor(o[i], 32);
    float4* hp = (float4*)(p.out + (size_t)tok * 1024 + r * 32 + h * 16);
#pragma unroll
    for (int q = 0; q < 4; ++q) {
      float4 t = hp[q];
      t.x += h ? o[16 + 4 * q] : o[4 * q]; t.y += h ? o[17 + 4 * q] : o[4 * q + 1];
      t.z += h ? o[18 + 4 * q] : o[4 * q + 2]; t.w += h ? o[19 + 4 * q] : o[4 * q + 3];
      hp[q] = t;
    }
    wave_sync();
  }
}

DI void run_phase(const Params& p, int ph, char* smem) {
  bf16_t* actA = (bf16_t*)(p.ws + OFF_ACT_A);
  bf16_t* big = (bf16_t*)(p.ws + OFF_BIG);
  switch (ph) {
    case 0: phase_convert(p, smem); phase_cvt_tables(p, 0); phase_cvt_tables(p, 1); break;
    case 1: phase_rmsnorm(p.x, p.ln_mix, actA); break;
    case 2: phase_gemm<EPI_GLA_IN>(p, actA, (const bf16_t*)(p.ws + OFF_WT_GLA_IN), 25, big, 3072, nullptr, smem); break;
    case 3: for (int it = blockIdx.x; it < 2048; it += gridDim.x) gla_phase1(p, it, smem); break;
    case 4: gla_scan(p); break;
    case 5: for (int it = blockIdx.x; it < 2048; it += gridDim.x) gla_phase3(p, it, smem); break;
    case 6: phase_gemm<EPI_RESID_X>(p, actA, (const bf16_t*)(p.ws + OFF_WT_GLA_OUT), 8, nullptr, 0, nullptr, smem); break;
    case 7: phase_rmsnorm(p.out, p.ln_ffn, actA); break;
    case 8: phase_gemm<EPI_BF16>(p, actA, (const bf16_t*)(p.ws + OFF_WT_PQ), 8, big, 1024, nullptr, smem); break;
    case 9: for (int it = blockIdx.x * 4 + (threadIdx.x >> 6); it < 8192; it += gridDim.x * 4) peer_topk_wave(p, 0, it); break;
    case 10: peer_gather(p, 0, smem); break;
    case 11: phase_rmsnorm(p.out, p.ln_mix + 1024, actA); break;
    case 12: phase_gemm<EPI_BF16>(p, actA, (const bf16_t*)(p.ws + OFF_WT_SWA_IN), 10, big, 1280, p.swa_b_in, smem); break;
    case 13: swa_qknorm(p); break;
    case 14: for (int it = blockIdx.x; it < 4096; it += gridDim.x) swa_attn(p, it, smem); break;
    case 15: phase_gemm<EPI_RESID_INPLACE>(p, (const bf16_t*)(p.ws + OFF_ACT_B), (const bf16_t*)(p.ws + OFF_WT_SWA_OUT), 8, nullptr, 0, p.swa_b_out, smem); break;
    case 16: phase_rmsnorm(p.out, p.ln_ffn + 1024, actA); break;
    case 17: phase_gemm<EPI_BF16>(p, actA, (const bf16_t*)(p.ws + OFF_WT_PQ) + (size_t)1024 * 1024, 8, big, 1024, nullptr, smem); break;
    case 18: for (int it = blockIdx.x * 4 + (threadIdx.x >> 6); it < 8192; it += gridDim.x * 4) peer_topk_wave(p, 1, it); break;
    case 19: peer_gather(p, 1, smem); break;
    default: break;
  }
}

template <int PH>
__global__ void __launch_bounds__(256, 2) phase_kernel(Params p) {
  __shared__ __attribute__((aligned(16))) char smem[SMEM_BYTES];
  run_phase(p, PH, smem);
}

template <int PH>
static void launch_phases(const Params& p, int grid, hipStream_t stream) {
  hipLaunchKernelGGL(phase_kernel<PH>, dim3(grid), dim3(256), 0, stream, p);
  if constexpr (PH + 1 < NPHASE) launch_phases<PH + 1>(p, grid, stream);
}


#define XB_TMO      128
#define XB_XCNT(j)  (256  + 64 * (j))
#define XB_XSUB(j)  (1280 + 64 * (j))
#define XB_XGEN(j)  (2304 + 64 * (j))
#define XB_TOP      3328
#define XB_TOPGEN   3392
#define XCD_BAR_WORDS 3456
#define XB_SPIN_CAP (1u << 23)
#define LAS __attribute__((address_space(3)))
DI unsigned xb_ld(unsigned* p) { return __hip_atomic_load(p, __ATOMIC_RELAXED, __HIP_MEMORY_SCOPE_AGENT); }
DI unsigned xb_add(unsigned* p, unsigned v) { return __hip_atomic_fetch_add(p, v, __ATOMIC_RELAXED, __HIP_MEMORY_SCOPE_AGENT); }
DI unsigned xb_xcc_id() { return (unsigned)__builtin_amdgcn_s_getreg((3 << 11) | 20) & 0xFu; }
#define XB_SPIN(cond, bar) do { unsigned _sp = 0; while (cond) { __builtin_amdgcn_s_sleep(1); \
    if ((++_sp & 255u) == 0u) { if (xb_ld(&(bar)[XB_TMO])) break; if (_sp > XB_SPIN_CAP) { atomicAdd(&(bar)[XB_TMO], 1u); break; } } } } while (0)
struct XcdBarrier { unsigned* bar; unsigned x; volatile LAS unsigned* st; };
DI XcdBarrier xcd_barrier_post(unsigned* bar, volatile LAS unsigned* st) {
  XcdBarrier b; b.bar = bar; b.x = xb_xcc_id(); b.st = st;
  if (threadIdx.x == 0) (void)xb_add(&bar[XB_XCNT(b.x)], 1u);
  return b;
}
DI void xcd_barrier_complete(unsigned* bar, unsigned x, unsigned& nloc, unsigned& nx) {
  const unsigned G = gridDim.x * gridDim.y * gridDim.z;
  unsigned sum, cnt, mine, sp = 0u;
  for (;;) {
    sum = 0u; cnt = 0u; mine = 0u;
#pragma unroll
    for (unsigned j = 0; j < 16; ++j) { const unsigned c = xb_ld(&bar[XB_XCNT(j)]); sum += c; cnt += (c > 0u) ? 1u : 0u; mine = (j == x) ? c : mine; }
    if (sum == G) break;
    __builtin_amdgcn_s_sleep(1);
    if ((++sp & 255u) == 0u) { if (xb_ld(&bar[XB_TMO])) break; if (sp > XB_SPIN_CAP) { atomicAdd(&bar[XB_TMO], 1u); break; } }
  }
  nloc = mine > 0u ? mine : 1u; nx = cnt > 0u ? cnt : 1u;
}
DI void xcd_barrier(const XcdBarrier& b) {
  asm volatile("s_waitcnt vmcnt(0)" ::: "memory");
  __syncthreads();
  if (threadIdx.x == 0) {
    unsigned* bar = b.bar;
    __builtin_amdgcn_s_waitcnt(0);
    unsigned nloc = b.st[0], nx = b.st[1];
    if (nloc == 0u) { xcd_barrier_complete(bar, b.x, nloc, nx); b.st[0] = nloc; b.st[1] = nx; }
    const unsigned old = xb_add(&bar[XB_XSUB(b.x)], 1u);
    const unsigned gen = old / nloc;
    if (old + 1u == (gen + 1u) * nloc) {
      __builtin_amdgcn_fence(__ATOMIC_RELEASE, "agent");
      asm volatile("s_waitcnt vmcnt(0)" ::: "memory");
      const unsigned og = xb_add(&bar[XB_TOP], 1u);
      const unsigned tg = og / nx;
      if (og + 1u == (tg + 1u) * nx) xb_add(&bar[XB_TOPGEN], 1u);
      else XB_SPIN(xb_ld(&bar[XB_TOPGEN]) == tg, bar);
      __builtin_amdgcn_fence(__ATOMIC_ACQUIRE, "agent");
      xb_add(&bar[XB_XGEN(b.x)], 1u);
      asm volatile("s_waitcnt vmcnt(0)" ::: "memory");
    } else {
      XB_SPIN(xb_ld(&bar[XB_XGEN(b.x)]) == gen, bar);
      __builtin_amdgcn_fence(__ATOMIC_ACQUIRE, "agent");
      asm volatile("s_waitcnt vmcnt(0)" ::: "memory");
    }
  }
  __syncthreads();
}

#if !MULTI_LAUNCH
template <int PH>
DI void run_all(const Params& p, char* smem, const XcdBarrier& xb) {
  run_phase(p, PH, smem);
  if constexpr (PH + 1 < NPHASE) {
    if constexpr (PH == 0) cg::this_grid().sync();
    else xcd_barrier(xb);
    run_all<PH + 1>(p, smem, xb);
  }
}
__global__ void __launch_bounds__(256, 2) trunk_kernel(Params p) {
  __shared__ __attribute__((aligned(16))) char smem[SMEM_BYTES];
  __shared__ uint4 xb_words;
  if (threadIdx.x == 0) xb_words = make_uint4(0u, 0u, 0u, 0u);
  __syncthreads();
  const XcdBarrier xb = xcd_barrier_post((unsigned*)(p.ws + OFF_BAR), (volatile LAS unsigned*)&xb_words);
  run_all<0>(p, smem, xb);
}
#endif

extern "C" void kernel_launch(void* const* d_in, const int* in_sizes, int n_in, void* d_out, int out_size, void* d_ws, size_t ws_size,
                              hipStream_t stream) {
  Params p{};
  p.x = (const float*)d_in[0]; p.pos = (const int*)d_in[1]; p.ln_mix = (const float*)d_in[2]; p.ln_ffn = (const float*)d_in[3];
  p.gla_w_in = (const float*)d_in[4]; p.gla_w_alpha = (const float*)d_in[5]; p.gla_b_alpha = (const float*)d_in[6];
  p.gla_norm = (const float*)d_in[7]; p.gla_w_out = (const float*)d_in[8];
  p.swa_w_in = (const float*)d_in[9]; p.swa_b_in = (const float*)d_in[10]; p.swa_qn = (const float*)d_in[11]; p.swa_kn = (const float*)d_in[12];
  p.swa_sinks = (const float*)d_in[13]; p.swa_w_out = (const float*)d_in[14]; p.swa_b_out = (const float*)d_in[15];
  p.peer_wq = (const float*)d_in[16]; p.peer_keys = (const float*)d_in[17]; p.peer_u = (const float*)d_in[18]; p.peer_v = (const float*)d_in[19];
  p.out = (float*)d_out; p.ws = (char*)d_ws;
  static int grid_blocks = 0;
  if (!grid_blocks) {
    int dev = 0, cus = 0, per_cu = 0;
    (void)hipGetDevice(&dev);
    (void)hipDeviceGetAttribute(&cus, hipDeviceAttributeMultiprocessorCount, dev);
    #if MULTI_LAUNCH
    per_cu = 2;
#else
    (void)hipOccupancyMaxActiveBlocksPerMultiprocessor(&per_cu, trunk_kernel, 256, 0);
#endif
    if (per_cu < 1) per_cu = 1;
    if (per_cu > 2) per_cu = 2;
    grid_blocks = cus * per_cu;
  }
#if MULTI_LAUNCH
  p.phase_lo = 0; p.phase_hi = 0;
  launch_phases<0>(p, grid_blocks, stream);
#else
  p.phase_lo = 0; p.phase_hi = NPHASE - 1;
  void* args[] = {&p};
  (void)hipMemsetAsync((char*)d_ws + OFF_BAR, 0, XCD_BAR_WORDS * 4, stream);
  hipError_t e = hipLaunchCooperativeKernel((void*)trunk_kernel, dim3(grid_blocks), dim3(256), args, 0, stream);
  if (e != hipSuccess) fprintf(stderr, "cooperative launch failed: %s (grid %d)\n", hipGetErrorString(e), grid_blocks);
#endif
}
```

```cpp
#include <hip/hip_runtime.h>
#include <hip/hip_cooperative_groups.h>
#include <stdint.h>
#include <stdio.h>
namespace cg = cooperative_groups;

#ifndef MULTI_LAUNCH
#define MULTI_LAUNCH 0
#endif

#define DI __device__ __forceinline__
typedef unsigned short bf16_t;
typedef __attribute__((ext_vector_type(8))) short bf16x8;
typedef __attribute__((ext_vector_type(16))) float f32x16;
typedef __bf16 bf16x2_t __attribute__((ext_vector_type(2)));
typedef float f32x2_t __attribute__((ext_vector_type(2)));
typedef float f2 __attribute__((ext_vector_type(2)));

constexpr int T_TOK = 32768;
constexpr int SEQ = 16384;
constexpr int DM = 1024;
constexpr int NPHASE = 22;

constexpr size_t MiB = 1048576;
constexpr size_t OFF_WT_GLA_IN = 0;
constexpr size_t OFF_WT_GLA_OUT = 7 * MiB;
constexpr size_t OFF_WT_SWA_IN = 9 * MiB;
constexpr size_t OFF_WT_SWA_OUT = 12 * MiB;
constexpr size_t OFF_WT_PQ = 14 * MiB;
constexpr size_t OFF_KEYS = 18 * MiB;
constexpr size_t OFF_INV = 20 * MiB;
constexpr size_t OFF_TBL_U = 24 * MiB;
constexpr size_t OFF_TBL_V = 56 * MiB;
constexpr size_t OFF_ACT_A = 88 * MiB;
constexpr size_t OFF_BIG = 152 * MiB;
constexpr size_t OFF_E = OFF_BIG + 64 * MiB;
constexpr size_t OFF_G = OFF_BIG + 80 * MiB;
constexpr size_t OFF_A = OFF_BIG + 96 * MiB;
constexpr size_t OFF_KVT = 344 * MiB;
constexpr size_t OFF_ACT_B = OFF_KVT;
constexpr size_t OFF_LR = 472 * MiB;
constexpr size_t OFF_DECAY = 474 * MiB;
constexpr size_t OFF_BAR = 476 * MiB;

constexpr int SMEM_BYTES = 73728;
constexpr int LDK = 72;

struct Params {
  const float* x; const int* pos; const float* ln_mix; const float* ln_ffn;
  const float* gla_w_in; const float* gla_w_alpha; const float* gla_b_alpha; const float* gla_norm; const float* gla_w_out;
  const float* swa_w_in; const float* swa_b_in; const float* swa_qn; const float* swa_kn; const float* swa_sinks;
  const float* swa_w_out; const float* swa_b_out;
  const float* peer_wq; const float* peer_keys; const float* peer_u; const float* peer_v;
  float* out; char* ws;
  int phase_lo, phase_hi;
};

DI unsigned pk(float lo, float hi) { f32x2_t v = {lo, hi}; bf16x2_t b = __builtin_convertvector(v, bf16x2_t); return __builtin_bit_cast(unsigned, b); }
DI bf16_t f2bf(float x) { return (bf16_t)(pk(x, 0.f) & 0xffffu); }
DI float bflo(unsigned w) { return __uint_as_float(w << 16); }
DI float bfhi(unsigned w) { return __uint_as_float(w & 0xffff0000u); }
DI float bf2f(bf16_t b) { return __uint_as_float(((unsigned)b) << 16); }
DI float dot2(unsigned a, unsigned b, float c) { return __builtin_amdgcn_fdot2_f32_bf16(__builtin_bit_cast(bf16x2_t, a), __builtin_bit_cast(bf16x2_t, b), c, false); }
DI int crow(int i, int h) { return (i & 3) + 8 * (i >> 2) + 4 * h; }
DI f32x16 mfma32(bf16x8 a, bf16x8 b, f32x16 c) { return __builtin_amdgcn_mfma_f32_32x32x16_bf16(a, b, c, 0, 0, 0); }
DI f32x16 zero16() { f32x16 z; for (int i = 0; i < 16; ++i) z[i] = 0.f; return z; }
DI void wave_sync() { __builtin_amdgcn_fence(__ATOMIC_RELEASE, "wavefront"); __builtin_amdgcn_wave_barrier(); __builtin_amdgcn_fence(__ATOMIC_ACQUIRE, "wavefront"); }
DI int mbcnt64(unsigned long long m) { return __builtin_amdgcn_mbcnt_hi((unsigned)(m >> 32), __builtin_amdgcn_mbcnt_lo((unsigned)m, 0)); }
DI float logsig(float z) { return fminf(z, 0.f) - log1pf(__expf(-fabsf(z))); }

DI void transpose_tile(const float* __restrict__ src, int N, bf16_t* __restrict__ dst, int kt, int nt, float* sT) {
  const int tid = threadIdx.x;
  const int r = tid >> 4, c4 = (tid & 15) * 4;
#pragma unroll
  for (int i = 0; i < 4; ++i) {
    const int k = kt * 64 + r + 16 * i, n = nt * 64 + c4;
    float4 v = make_float4(0.f, 0.f, 0.f, 0.f);
    if (n + 3 < N) v = *(const float4*)(src + (size_t)k * N + n);
    float* d = sT + (r + 16 * i) * 65 + c4;
    d[0] = v.x; d[1] = v.y; d[2] = v.z; d[3] = v.w;
  }
  __syncthreads();
  const int n = tid >> 2, seg = tid & 3;
  unsigned w[8];
#pragma unroll
  for (int j = 0; j < 8; ++j) w[j] = pk(sT[(seg * 16 + 2 * j) * 65 + n], sT[(seg * 16 + 2 * j + 1) * 65 + n]);
  uint4* d = (uint4*)(dst + (size_t)(nt * 64 + n) * 1024 + kt * 64 + seg * 16);
  d[0] = make_uint4(w[0], w[1], w[2], w[3]);
  d[1] = make_uint4(w[4], w[5], w[6], w[7]);
  __syncthreads();
}

DI void cvt_elems(const float* __restrict__ src, bf16_t* __restrict__ dst, size_t n8) {
  for (size_t i = (size_t)blockIdx.x * 256 + threadIdx.x; i < n8; i += (size_t)gridDim.x * 256) {
    const float4 a = ((const float4*)src)[2 * i], b = ((const float4*)src)[2 * i + 1];
    ((uint4*)dst)[i] = make_uint4(pk(a.x, a.y), pk(a.z, a.w), pk(b.x, b.y), pk(b.z, b.w));
  }
}

DI void phase_convert(const Params& p, char* smem) {
  float* sT = (float*)smem;
  for (int t = blockIdx.x; t < 2144; t += gridDim.x) {
    const float* src; int N, ntn; bf16_t* dst; int local;
    if (t < 800) { src = p.gla_w_in; N = 3088; ntn = 50; dst = (bf16_t*)(p.ws + OFF_WT_GLA_IN); local = t; }
    else if (t < 1056) { src = p.gla_w_out; N = 1024; ntn = 16; dst = (bf16_t*)(p.ws + OFF_WT_GLA_OUT); local = t - 800; }
    else if (t < 1376) { src = p.swa_w_in; N = 1280; ntn = 20; dst = (bf16_t*)(p.ws + OFF_WT_SWA_IN); local = t - 1056; }
    else if (t < 1632) { src = p.swa_w_out; N = 1024; ntn = 16; dst = (bf16_t*)(p.ws + OFF_WT_SWA_OUT); local = t - 1376; }
    else if (t < 1888) { src = p.peer_wq; N = 1024; ntn = 16; dst = (bf16_t*)(p.ws + OFF_WT_PQ); local = t - 1632; }
    else { src = p.peer_wq + (size_t)1024 * 1024; N = 1024; ntn = 16; dst = (bf16_t*)(p.ws + OFF_WT_PQ) + (size_t)1024 * 1024; local = t - 1888; }
    transpose_tile(src, N, dst, local / ntn, local % ntn, sT);
  }
  cvt_elems(p.peer_keys, (bf16_t*)(p.ws + OFF_KEYS), (size_t)2 * 8 * 2 * 128 * 64 / 8);
}

typedef unsigned v6u __attribute__((ext_vector_type(6)));
typedef float v32f __attribute__((ext_vector_type(32)));
DI unsigned fp6_code(float y) {
  const float a = fminf(fabsf(y), 7.5f);
  float c = rintf(a * 8.f);
  c = a >= 2.f ? rintf(a * 4.f) + 8.f : c;
  c = a >= 4.f ? rintf(a * 2.f) + 16.f : c;
  unsigned u = (unsigned)c;
  u = u > 31u ? 31u : u;
  return u | ((__float_as_uint(y) >> 26) & 32u);
}
DI void cvt_table_fp6(const float* __restrict__ src, unsigned char* __restrict__ dst, float* __restrict__ inv, int bid, int nb) {
  const int lane = threadIdx.x & 63, w = threadIdx.x >> 6, r = lane & 31, h = lane >> 5;
  for (int rp = bid * 4 + w; rp < 8192; rp += nb * 4) {
    const int row = rp * 2 + h;
    const float4* sp = (const float4*)(src + (size_t)row * 1024 + r * 32);
    float v[32];
    float mx = 0.f;
#pragma unroll
    for (int i = 0; i < 8; ++i) {
      const float4 t = sp[i];
      v[4 * i] = t.x; v[4 * i + 1] = t.y; v[4 * i + 2] = t.z; v[4 * i + 3] = t.w;
      mx = fmaxf(fmaxf(mx, fmaxf(fabsf(t.x), fabsf(t.y))), fmaxf(fabsf(t.z), fabsf(t.w)));
    }
#pragma unroll
    for (int o = 16; o >= 1; o >>= 1) mx = fmaxf(mx, __shfl_xor(mx, o));
    const float sc = mx > 0.f ? 7.5f / mx : 1.f;
    unsigned c[32];
#pragma unroll
    for (int i = 0; i < 32; ++i) c[i] = fp6_code(v[i] * sc);
    unsigned d[6];
#pragma unroll
    for (int g = 0; g < 2; ++g) {
      const unsigned* q = c + 16 * g;
      d[3 * g + 0] = q[0] | (q[1] << 6) | (q[2] << 12) | (q[3] << 18) | (q[4] << 24) | (q[5] << 30);
      d[3 * g + 1] = (q[5] >> 2) | (q[6] << 4) | (q[7] << 10) | (q[8] << 16) | (q[9] << 22) | (q[10] << 28);
      d[3 * g + 2] = (q[10] >> 4) | (q[11] << 2) | (q[12] << 8) | (q[13] << 14) | (q[14] << 20) | (q[15] << 26);
    }
    uint2* dp = (uint2*)(dst + (size_t)row * 768 + r * 24);
    dp[0] = make_uint2(d[0], d[1]); dp[1] = make_uint2(d[2], d[3]); dp[2] = make_uint2(d[4], d[5]);
    if (r == 0) inv[row] = mx > 0.f ? mx * (1.f / 7.5f) : 1.f;
  }
}
DI void phase_cvt_tables(const Params& p, int layer) {
  const int nb = gridDim.x / 2, bid = blockIdx.x % nb;
  const int rows_lo = (blockIdx.x < nb) ? 0 : 1;
  cvt_table_fp6(p.peer_u + (size_t)layer * 16384 * 1024, (unsigned char*)(p.ws + OFF_TBL_U) + (size_t)layer * 16 * MiB, (float*)(p.ws + OFF_INV) + (layer * 2 + 0) * 16384, bid * 2 + rows_lo, nb * 2);
  cvt_table_fp6(p.peer_v + (size_t)layer * 16384 * 1024, (unsigned char*)(p.ws + OFF_TBL_V) + (size_t)layer * 16 * MiB, (float*)(p.ws + OFF_INV) + (layer * 2 + 1) * 16384, bid * 2 + rows_lo, nb * 2);
}

DI void phase_rmsnorm(const float* __restrict__ src, const float* __restrict__ gain, bf16_t* __restrict__ dst) {
  const int lane = threadIdx.x & 63, w = threadIdx.x >> 6;
  for (int row = blockIdx.x * 4 + w; row < T_TOK; row += gridDim.x * 4) {
    const float4* sp = (const float4*)(src + (size_t)row * DM);
    float4 v[4];
    float ss = 0.f;
#pragma unroll
    for (int i = 0; i < 4; ++i) { v[i] = sp[lane + 64 * i]; ss += v[i].x * v[i].x + v[i].y * v[i].y + v[i].z * v[i].z + v[i].w * v[i].w; }
#pragma unroll
    for (int o = 32; o >= 1; o >>= 1) ss += __shfl_xor(ss, o);
    const float rs = rsqrtf(ss * (1.f / 1024.f) + 1e-6f);
#pragma unroll
    for (int i = 0; i < 4; ++i) {
      const float4 g = ((const float4*)gain)[lane + 64 * i];
      uint2 o2 = make_uint2(pk(v[i].x * rs * g.x, v[i].y * rs * g.y), pk(v[i].z * rs * g.z, v[i].w * rs * g.w));
      *(uint2*)(dst + (size_t)row * DM + (lane + 64 * i) * 4) = o2;
    }
  }
}

DI void mma_64x64(const bf16_t* sA, const bf16_t* sB, int arow0, int brow0, f32x16 (&acc)[2][2], int lane) {
  const int r = lane & 31, h = lane >> 5;
#pragma unroll
  for (int s = 0; s < 4; ++s) {
    bf16x8 a[2], b[2];
#pragma unroll
    for (int mi = 0; mi < 2; ++mi) a[mi] = *(const bf16x8*)(sA + (arow0 + mi * 32 + r) * LDK + s * 16 + h * 8);
#pragma unroll
    for (int ni = 0; ni < 2; ++ni) b[ni] = *(const bf16x8*)(sB + (brow0 + ni * 32 + r) * LDK + s * 16 + h * 8);
#pragma unroll
    for (int mi = 0; mi < 2; ++mi)
#pragma unroll
      for (int ni = 0; ni < 2; ++ni) acc[mi][ni] = mfma32(a[mi], b[ni], acc[mi][ni]);
  }
}

enum { EPI_GLA_IN = 0, EPI_RESID_X = 1, EPI_BF16 = 2, EPI_RESID_INPLACE = 3 };

template <int MODE>
DI void gemm_tile(const Params& p, const bf16_t* __restrict__ A, const bf16_t* __restrict__ Bt, int m0, int n0,
                  bf16_t* dstb, int ldc, const float* __restrict__ bias, char* smem) {
  bf16_t* sA = (bf16_t*)smem;
  bf16_t* sB = sA + 128 * LDK;
  const int tid = threadIdx.x, lane = tid & 63, w = tid >> 6, wm = w >> 1, wn = w & 1;
  f32x16 acc[2][2];
#pragma unroll
  for (int i = 0; i < 2; ++i)
#pragma unroll
    for (int j = 0; j < 2; ++j) acc[i][j] = zero16();
  bf16x8 ra[4], rb[4];
  const int lrow = tid >> 3, kc = tid & 7;
  const bf16_t* ap = A + (size_t)(m0 + lrow) * 1024 + kc * 8;
  const bf16_t* bp = Bt + (size_t)(n0 + lrow) * 1024 + kc * 8;
#pragma unroll
  for (int i = 0; i < 4; ++i) { ra[i] = *(const bf16x8*)(ap + (size_t)i * 32 * 1024); rb[i] = *(const bf16x8*)(bp + (size_t)i * 32 * 1024); }
  __syncthreads();
#pragma unroll
  for (int i = 0; i < 4; ++i) { *(bf16x8*)(sA + (lrow + 32 * i) * LDK + kc * 8) = ra[i]; *(bf16x8*)(sB + (lrow + 32 * i) * LDK + kc * 8) = rb[i]; }
  __syncthreads();
  for (int kt = 0; kt < 16; ++kt) {
    if (kt + 1 < 16) {
#pragma unroll
      for (int i = 0; i < 4; ++i) { ra[i] = *(const bf16x8*)(ap + (size_t)i * 32 * 1024 + (kt + 1) * 64); rb[i] = *(const bf16x8*)(bp + (size_t)i * 32 * 1024 + (kt + 1) * 64); }
    }
    mma_64x64(sA, sB, wm * 64, wn * 64, acc, lane);
    __syncthreads();
    if (kt + 1 < 16) {
#pragma unroll
      for (int i = 0; i < 4; ++i) { *(bf16x8*)(sA + (lrow + 32 * i) * LDK + kc * 8) = ra[i]; *(bf16x8*)(sB + (lrow + 32 * i) * LDK + kc * 8) = rb[i]; }
      __syncthreads();
    }
  }
  const int r = lane & 31, h = lane >> 5;
#pragma unroll
  for (int mi = 0; mi < 2; ++mi)
#pragma unroll
    for (int ni = 0; ni < 2; ++ni) {
      const int col = n0 + wn * 64 + ni * 32 + r;
#pragma unroll
      for (int i = 0; i < 16; ++i) {
        const int row = m0 + wm * 64 + mi * 32 + crow(i, h);
        const float v = acc[mi][ni][i];
        if (MODE == EPI_GLA_IN) {
          if (col < 3072) dstb[(size_t)row * 3072 + col] = f2bf(v);
          else if (col < 3088) ((float*)(p.ws + OFF_LR))[(size_t)row * 16 + (col - 3072)] = v;
        } else if (MODE == EPI_RESID_X) {
          p.out[(size_t)row * 1024 + col] = p.x[(size_t)row * 1024 + col] + v;
        } else if (MODE == EPI_BF16) {
          dstb[(size_t)row * ldc + col] = f2bf(bias ? v + bias[col] : v);
        } else {
          p.out[(size_t)row * 1024 + col] += v + bias[col];
        }
      }
    }
}

template <int MODE>
DI void phase_gemm(const Params& p, const bf16_t* A, const bf16_t* Bt, int NT, bf16_t* dstb, int ldc, const float* bias, char* smem) {
  const int ntiles = (T_TOK / 128) * NT;
  for (int t = blockIdx.x; t < ntiles; t += gridDim.x) gemm_tile<MODE>(p, A, Bt, (t / NT) * 128, (t % NT) * 128, dstb, ldc, bias, smem);
}

DI float gate_la(const float* lr_s, int t, const float (&wa)[16], float ba) {
  float z = ba;
#pragma unroll
  for (int j = 0; j < 16; ++j) z += lr_s[t * 16 + j] * wa[j];
  return logsig(z) * (1.f / 16.f);
}
DI void gla_gates(const Params& p, int t0, int hh, float (&wa)[16], float& ba, float& offset, float& blast, float* lr_s, float* tot_s) {
  const int tid = threadIdx.x, d = tid & 127, half = tid >> 7;
  const float* LR = (const float*)(p.ws + OFF_LR);
  ((float4*)lr_s)[tid] = ((const float4*)(LR + (size_t)t0 * 16))[tid];
#pragma unroll
  for (int j = 0; j < 16; ++j) wa[j] = p.gla_w_alpha[j * 512 + hh * 128 + d];
  ba = p.gla_b_alpha[hh * 128 + d];
  __syncthreads();
  float sum = 0.f;
#pragma unroll 4
  for (int tt = 0; tt < 32; ++tt) sum += gate_la(lr_s, half * 32 + tt, wa, ba);
  tot_s[half * 128 + d] = sum;
  __syncthreads();
  offset = half ? tot_s[d] : 0.f;
  blast = tot_s[d] + tot_s[128 + d];
}

DI void fill_vT(const bf16_t* __restrict__ QKVR, int t0, int hh, int vh, bf16_t* vT) {
  const int tid = threadIdx.x, v = tid & 127, half = tid >> 7;
#pragma unroll 8
  for (int tt = 0; tt < 32; ++tt) {
    const int t = half * 32 + tt;
    vT[v * LDK + t] = QKVR[(size_t)(t0 + t) * 3072 + 1024 + hh * 256 + vh * 128 + v];
  }
}

DI void gla_phase1(const Params& p, int item, char* smem) {
  const int hh = item & 3, c = (item >> 2) & 255, b = item >> 10;
  const int t0 = b * SEQ + c * 64;
  float* lr_s = (float*)smem;
  float* tot_s = (float*)(smem + 4096);
  bf16_t* kfT = (bf16_t*)(smem + 5120);
  bf16_t* vT = kfT + 128 * LDK;
  const bf16_t* QKVR = (const bf16_t*)(p.ws + OFF_BIG);
  bf16_t* KVT = (bf16_t*)(p.ws + OFF_KVT);
  float* DECAY = (float*)(p.ws + OFF_DECAY);
  const int tid = threadIdx.x, lane = tid & 63, w = tid >> 6, wm = w >> 1, wn = w & 1;
  const int d = tid & 127, half = tid >> 7;
  float wa[16], ba, offset, blast;
  gla_gates(p, t0, hh, wa, ba, offset, blast, lr_s, tot_s);
  float run = offset;
#pragma unroll 4
  for (int tt = 0; tt < 32; ++tt) {
    const int t = half * 32 + tt;
    run += gate_la(lr_s, t, wa, ba);
    const float kv = bf2f(QKVR[(size_t)(t0 + t) * 3072 + 512 + hh * 128 + d]);
    kfT[d * LDK + t] = f2bf(kv * __expf(blast - run));
  }
  if (half == 0) DECAY[(size_t)item * 128 + d] = __expf(blast);
  const int r = lane & 31, h = lane >> 5;
  for (int vh = 0; vh < 2; ++vh) {
    __syncthreads();
    fill_vT(QKVR, t0, hh, vh, vT);
    __syncthreads();
    f32x16 acc[2][2];
#pragma unroll
    for (int i = 0; i < 2; ++i)
#pragma unroll
      for (int j = 0; j < 2; ++j) acc[i][j] = zero16();
    mma_64x64(vT, kfT, wm * 64, wn * 64, acc, lane);
    bf16_t* kbase = KVT + (size_t)item * 32768 + (vh * 128 + wm * 64 + 4 * h) * 128 + wn * 64 + r;
#pragma unroll
    for (int mi = 0; mi < 2; ++mi)
#pragma unroll
      for (int ni = 0; ni < 2; ++ni)
#pragma unroll
        for (int i = 0; i < 16; ++i) kbase[(mi * 32 + (i & 3) + 8 * (i >> 2)) * 128 + ni * 32] = f2bf(acc[mi][ni][i]);
  }
  __syncthreads();
}

DI void gla_scan(const Params& p) {
  bf16_t* KVT = (bf16_t*)(p.ws + OFF_KVT);
  const float* DECAY = (const float*)(p.ws + OFF_DECAY);
  for (int idx = blockIdx.x * 256 + threadIdx.x; idx < 8 * 16384; idx += gridDim.x * 256) {
    const int bh = idx >> 14, e2 = idx & 16383, b = bh >> 2, hh = bh & 3, d0 = (2 * e2) & 127;
    float s0 = 0.f, s1 = 0.f;
    for (int c0 = 0; c0 < 256; c0 += 8) {
      unsigned kv[8]; float2 dc[8];
#pragma unroll
      for (int u = 0; u < 8; ++u) {
        const size_t item = (size_t)(b * 256 + c0 + u) * 4 + hh;
        kv[u] = *(const unsigned*)(KVT + item * 32768 + 2 * e2);
        dc[u] = *(const float2*)(DECAY + item * 128 + d0);
      }
#pragma unroll
      for (int u = 0; u < 8; ++u) {
        const size_t item = (size_t)(b * 256 + c0 + u) * 4 + hh;
        *(unsigned*)(KVT + item * 32768 + 2 * e2) = pk(s0, s1);
        s0 = dc[u].x * s0 + bflo(kv[u]);
        s1 = dc[u].y * s1 + bfhi(kv[u]);
      }
    }
  }
}

DI void gla_phase3(const Params& p, int item, char* smem) {
  const int hh = item & 3, c = (item >> 2) & 255, b = item >> 10;
  const int t0 = b * SEQ + c * 64;
  float* lr_s = (float*)smem;
  float* tot_s = (float*)(smem + 4096);
  bf16_t* qd = (bf16_t*)(smem + 5120);
  bf16_t* ki = qd + 64 * 136;
  bf16_t* at = ki + 64 * 136;
  bf16_t* vT = at + 64 * 72;
  bf16_t* ot = qd;
  const bf16_t* QKVR = (const bf16_t*)(p.ws + OFF_BIG);
  const bf16_t* ST = (const bf16_t*)(p.ws + OFF_KVT);
  bf16_t* OG = (bf16_t*)(p.ws + OFF_ACT_A);
  const int tid = threadIdx.x, lane = tid & 63, w = tid >> 6;
  const int d = tid & 127, half = tid >> 7;
  const int r = lane & 31, h = lane >> 5;
  {
    float wa[16], ba, offset, blast;
    gla_gates(p, t0, hh, wa, ba, offset, blast, lr_s, tot_s);
    float run = offset;
#pragma unroll 4
    for (int tt = 0; tt < 32; ++tt) {
      const int t = half * 32 + tt;
      run += gate_la(lr_s, t, wa, ba);
      const float q = bf2f(QKVR[(size_t)(t0 + t) * 3072 + hh * 128 + d]);
      const float k = bf2f(QKVR[(size_t)(t0 + t) * 3072 + 512 + hh * 128 + d]);
      qd[t * 136 + d] = f2bf(q * 0.08838834764831845f * __expf(run));
      ki[t * 136 + d] = f2bf(k * __expf(-run));
    }
  }
  __syncthreads();
  {
    const int mi = w >> 1, nj = w & 1;
    f32x16 a = zero16();
#pragma unroll
    for (int s = 0; s < 8; ++s) {
      const bf16x8 A = *(const bf16x8*)(qd + (mi * 32 + r) * 136 + s * 16 + h * 8);
      const bf16x8 B = *(const bf16x8*)(ki + (nj * 32 + r) * 136 + s * 16 + h * 8);
      a = mfma32(A, B, a);
    }
#pragma unroll
    for (int i = 0; i < 16; ++i) {
      const int it = mi * 32 + crow(i, h), jt = nj * 32 + r;
      at[it * 72 + jt] = f2bf(jt <= it ? a[i] : 0.f);
    }
  }
  f32x16 o[2][2];
#pragma unroll
  for (int i = 0; i < 2; ++i)
#pragma unroll
    for (int j = 0; j < 2; ++j) o[i][j] = zero16();
#pragma unroll
  for (int vh = 0; vh < 2; ++vh) {
    __syncthreads();
    fill_vT(QKVR, t0, hh, vh, vT);
    __syncthreads();
#pragma unroll
    for (int s = 0; s < 4; ++s) {
      const bf16x8 B = *(const bf16x8*)(vT + (w * 32 + r) * LDK + s * 16 + h * 8);
#pragma unroll
      for (int mt = 0; mt < 2; ++mt) {
        const bf16x8 A = *(const bf16x8*)(at + (mt * 32 + r) * 72 + s * 16 + h * 8);
        o[vh][mt] = mfma32(A, B, o[vh][mt]);
      }
    }
    const bf16_t* Sg = ST + (size_t)item * 32768 + (size_t)(vh * 128 + w * 32 + r) * 128 + h * 8;
#pragma unroll
    for (int s = 0; s < 8; ++s) {
      const bf16x8 B = *(const bf16x8*)(Sg + s * 16);
#pragma unroll
      for (int mt = 0; mt < 2; ++mt) {
        const bf16x8 A = *(const bf16x8*)(qd + (mt * 32 + r) * 136 + s * 16 + h * 8);
        o[vh][mt] = mfma32(A, B, o[vh][mt]);
      }
    }
  }
  __syncthreads();
#pragma unroll
  for (int vh = 0; vh < 2; ++vh)
#pragma unroll
    for (int mt = 0; mt < 2; ++mt)
#pragma unroll
      for (int i = 0; i < 16; ++i) ot[(mt * 32 + crow(i, h)) * 264 + vh * 128 + w * 32 + r] = f2bf(o[vh][mt][i]);
  __syncthreads();
  {
    const int row = tid >> 2, seg = tid & 3;
    const bf16_t* orow = ot + row * 264 + seg * 64;
    float ss = 0.f;
#pragma unroll
    for (int c8 = 0; c8 < 8; ++c8) {
      const uint4 ov = *(const uint4*)(orow + c8 * 8);
      const float f0 = bflo(ov.x), f1 = bfhi(ov.x), f2 = bflo(ov.y), f3 = bfhi(ov.y), f4 = bflo(ov.z), f5 = bfhi(ov.z), f6 = bflo(ov.w), f7 = bfhi(ov.w);
      ss += f0 * f0 + f1 * f1 + f2 * f2 + f3 * f3 + f4 * f4 + f5 * f5 + f6 * f6 + f7 * f7;
    }
    ss += __shfl_xor(ss, 1);
    ss += __shfl_xor(ss, 2);
    const float rs = rsqrtf(ss * (1.f / 256.f) + 1e-6f);
    const bf16_t* rrow = QKVR + (size_t)(t0 + row) * 3072 + 2048 + hh * 256 + seg * 64;
    const float* grow = p.gla_norm + hh * 256 + seg * 64;
    bf16_t* dst = OG + (size_t)(t0 + row) * 1024 + hh * 256 + seg * 64;
#pragma unroll
    for (int c8 = 0; c8 < 8; ++c8) {
      const uint4 ov = *(const uint4*)(orow + c8 * 8);
      const uint4 rv = *(const uint4*)(rrow + c8 * 8);
      const float4 g0 = *(const float4*)(grow + c8 * 8), g1 = *(const float4*)(grow + c8 * 8 + 4);
      float of[8] = {bflo(ov.x), bfhi(ov.x), bflo(ov.y), bfhi(ov.y), bflo(ov.z), bfhi(ov.z), bflo(ov.w), bfhi(ov.w)};
      float rf[8] = {bflo(rv.x), bfhi(rv.x), bflo(rv.y), bfhi(rv.y), bflo(rv.z), bfhi(rv.z), bflo(rv.w), bfhi(rv.w)};
      float gf[8] = {g0.x, g0.y, g0.z, g0.w, g1.x, g1.y, g1.z, g1.w};
      float res[8];
#pragma unroll
      for (int e = 0; e < 8; ++e) res[e] = of[e] * rs * gf[e] * (rf[e] / (1.f + __expf(-rf[e])));
      *(uint4*)(dst + c8 * 8) = make_uint4(pk(res[0], res[1]), pk(res[2], res[3]), pk(res[4], res[5]), pk(res[6], res[7]));
    }
  }
  __syncthreads();
}

DI void swa_qknorm(const Params& p) {
  bf16_t* QKV = (bf16_t*)(p.ws + OFF_BIG);
  const int tid = threadIdx.x, sub = tid & 7;
  const int ngroups = T_TOK * 18;
  for (int g = blockIdx.x * 32 + (tid >> 3); g < ngroups; g += gridDim.x * 32) {
    const int tok = g / 18, slot = g - tok * 18;
    bf16_t* ptr = QKV + (size_t)tok * 1280 + slot * 64 + sub * 8;
    const uint4 wv = *(const uint4*)ptr;
    float v[8] = {bflo(wv.x), bfhi(wv.x), bflo(wv.y), bfhi(wv.y), bflo(wv.z), bfhi(wv.z), bflo(wv.w), bfhi(wv.w)};
    float ss = 0.f;
#pragma unroll
    for (int e = 0; e < 8; ++e) ss += v[e] * v[e];
    ss += __shfl_xor(ss, 1);
    ss += __shfl_xor(ss, 2);
    ss += __shfl_xor(ss, 4);
    const float rs = rsqrtf(ss * (1.f / 64.f) + 1e-6f);
    const float* gain = (slot < 16 ? p.swa_qn : p.swa_kn) + sub * 8;
#pragma unroll
    for (int e = 0; e < 8; ++e) v[e] = v[e] * rs * gain[e];
    const float posf = (float)p.pos[tok];
    const float invf[8] = {1.0f, 0.1939227432012558f, 0.03760603070259094f, 0.007292664609849453f,
                           0.0014142135623842478f, 0.00027424818836152554f, 5.318296098266728e-05f, 1.0313386155758053e-05f};
#pragma unroll
    for (int e = 0; e < 8; ++e) {
      const float other = __shfl_xor(v[e], 1);
      if (sub < 2) {
        const float ang = posf * invf[e];
        const double rev = (double)ang * 0.15915494309189535;
        const float fr = (float)(rev - rint(rev));
        const float sn = __builtin_amdgcn_sinf(fr), cs = __builtin_amdgcn_cosf(fr);
        v[e] = (sub == 0) ? (v[e] * cs - other * sn) : (v[e] * cs + other * sn);
      }
    }
    if (slot < 16) {
#pragma unroll
      for (int e = 0; e < 8; ++e) v[e] *= 0.125f;
    }
    *(uint4*)ptr = make_uint4(pk(v[0], v[1]), pk(v[2], v[3]), pk(v[4], v[5]), pk(v[6], v[7]));
  }
}

DI void swa_attn(const Params& p, int item, char* smem) {
  const int hq = item & 15, n = (item >> 4) & 127, b = item >> 11, hkv = hq >> 3;
  const int tok0 = b * SEQ + n * 128;
  bf16_t* Ks = (bf16_t*)smem;
  bf16_t* vT = Ks + 256 * 72;
  const bf16_t* QKV = (const bf16_t*)(p.ws + OFF_BIG);
  bf16_t* OUT = (bf16_t*)(p.ws + OFF_ACT_B);
  const int tid = threadIdx.x, lane = tid & 63, w = tid >> 6, r = lane & 31, h = lane >> 5;
  __syncthreads();
#pragma unroll
  for (int i = 0; i < 8; ++i) {
    const int cidx = tid + 256 * i, kk = cidx >> 3, kc = cidx & 7;
    const int pos = n * 128 - 128 + kk;
    uint4 kw = make_uint4(0, 0, 0, 0), vw = make_uint4(0, 0, 0, 0);
    if (pos >= 0) {
      const bf16_t* base = QKV + (size_t)(b * SEQ + pos) * 1280;
      kw = *(const uint4*)(base + 1024 + hkv * 64 + kc * 8);
      vw = *(const uint4*)(base + 1152 + hkv * 64 + kc * 8);
    }
    *(uint4*)(Ks + kk * 72 + kc * 8) = kw;
    bf16_t* vd = vT + (kc * 8) * 264 + kk;
    vd[0 * 264] = (bf16_t)(vw.x & 0xffff); vd[1 * 264] = (bf16_t)(vw.x >> 16);
    vd[2 * 264] = (bf16_t)(vw.y & 0xffff); vd[3 * 264] = (bf16_t)(vw.y >> 16);
    vd[4 * 264] = (bf16_t)(vw.z & 0xffff); vd[5 * 264] = (bf16_t)(vw.z >> 16);
    vd[6 * 264] = (bf16_t)(vw.w & 0xffff); vd[7 * 264] = (bf16_t)(vw.w >> 16);
  }
  __syncthreads();
  const int iq = 32 * w + r;
  const bf16_t* qrow = QKV + (size_t)(tok0 + iq) * 1280 + hq * 64 + h * 8;
  bf16x8 qf[4];
#pragma unroll
  for (int s = 0; s < 4; ++s) qf[s] = *(const bf16x8*)(qrow + s * 16);
  f32x16 X[5];
#pragma unroll
  for (int kt = 0; kt < 5; ++kt) {
    X[kt] = zero16();
#pragma unroll
    for (int s = 0; s < 4; ++s) {
      const bf16x8 A = *(const bf16x8*)(Ks + ((w + kt) * 32 + r) * 72 + s * 16 + h * 8);
      X[kt] = mfma32(A, qf[s], X[kt]);
    }
  }
  const float sink = p.swa_sinks[hq];
  float m = sink;
#pragma unroll
  for (int kt = 0; kt < 5; ++kt)
#pragma unroll
    for (int i = 0; i < 16; ++i) {
      const int kk = (w + kt) * 32 + crow(i, h);
      const bool valid = (kk > iq) && (kk <= iq + 128) && (n > 0 || kk >= 128);
      const float xv = valid ? X[kt][i] : -INFINITY;
      X[kt][i] = xv;
      m = fmaxf(m, xv);
    }
  m = fmaxf(m, __shfl_xor(m, 32));
  float l = 0.f;
#pragma unroll
  for (int kt = 0; kt < 5; ++kt)
#pragma unroll
    for (int i = 0; i < 16; ++i) {
      const float pv = __expf(X[kt][i] - m);
      X[kt][i] = pv;
      l += pv;
    }
  l += __shfl_xor(l, 32);
  l += __expf(sink - m);
  f32x16 O[2];
  O[0] = zero16(); O[1] = zero16();
#pragma unroll
  for (int kt = 0; kt < 5; ++kt)
#pragma unroll
    for (int s2 = 0; s2 < 2; ++s2) {
      const uint4 pw = make_uint4(pk(X[kt][8 * s2 + 0], X[kt][8 * s2 + 1]), pk(X[kt][8 * s2 + 2], X[kt][8 * s2 + 3]),
                                  pk(X[kt][8 * s2 + 4], X[kt][8 * s2 + 5]), pk(X[kt][8 * s2 + 6], X[kt][8 * s2 + 7]));
      const bf16x8 P = __builtin_bit_cast(bf16x8, pw);
#pragma unroll
      for (int mt = 0; mt < 2; ++mt) {
        const bf16_t* vp = vT + (mt * 32 + r) * 264 + (w + kt) * 32 + 16 * s2 + 4 * h;
        const uint2 lo = *(const uint2*)vp, hi = *(const uint2*)(vp + 8);
        const bf16x8 A = __builtin_bit_cast(bf16x8, make_uint4(lo.x, lo.y, hi.x, hi.y));
        O[mt] = mfma32(A, P, O[mt]);
      }
    }
  const float inv = 1.f / l;
  bf16_t* orow = OUT + (size_t)(tok0 + iq) * 1024 + hq * 64 + 4 * h;
#pragma unroll
  for (int mt = 0; mt < 2; ++mt)
#pragma unroll
    for (int g = 0; g < 4; ++g)
      *(uint2*)(orow + mt * 32 + 8 * g) = make_uint2(pk(O[mt][4 * g] * inv, O[mt][4 * g + 1] * inv), pk(O[mt][4 * g + 2] * inv, O[mt][4 * g + 3] * inv));
}

DI unsigned fkey_u(unsigned u) { return u ^ ((unsigned)((int)u >> 31) | 0x80000000u); }
DI float unfkey(unsigned k) { return __uint_as_float(k ^ ((~(unsigned)((int)k >> 31)) | 0x80000000u)); }
DI void cswap(unsigned& a, unsigned& b) { const unsigned hi = a > b ? a : b, lo = a > b ? b : a; a = hi; b = lo; }
DI void sort16(unsigned (&t)[16]) {
#pragma unroll
  for (int k = 2; k <= 16; k <<= 1)
#pragma unroll
    for (int j = k >> 1; j > 0; j >>= 1)
#pragma unroll
      for (int i = 0; i < 16; ++i) {
        const int l = i ^ j;
        if (l > i) { if ((i & k) == 0) cswap(t[i], t[l]); else cswap(t[l], t[i]); }
      }
}
DI void merge16(unsigned (&a)[16], const unsigned (&b)[16]) {
#pragma unroll
  for (int j = 0; j < 16; ++j) a[j] = a[j] > b[15 - j] ? a[j] : b[15 - j];
#pragma unroll
  for (int j = 8; j > 0; j >>= 1)
#pragma unroll
    for (int i = 0; i < 16; ++i) { const int l = i ^ j; if (l > i) cswap(a[i], a[l]); }
}
DI void cswap2(unsigned& ak, int& ap, unsigned& bk, int& bp) {
  const bool sw = bk > ak;
  const unsigned hk = sw ? bk : ak, lk = sw ? ak : bk;
  const int hp = sw ? bp : ap, lp = sw ? ap : bp;
  ak = hk; ap = hp; bk = lk; bp = lp;
}
DI void sort16p(unsigned (&t)[16], int (&q)[16]) {
#pragma unroll
  for (int k = 2; k <= 16; k <<= 1)
#pragma unroll
    for (int j = k >> 1; j > 0; j >>= 1)
#pragma unroll
      for (int i = 0; i < 16; ++i) {
        const int l = i ^ j;
        if (l > i) { if ((i & k) == 0) cswap2(t[i], q[i], t[l], q[l]); else cswap2(t[l], q[l], t[i], q[i]); }
      }
}
__device__ constexpr int CIA[25] = {0,0,0,0,0,0,0,0,0,0,0,0,0,0,0,0, 2,2,2,2,2, 3,3,3,3};
__device__ constexpr int CJA[25] = {0,1,2,3,4,5,6,7,8,9,10,11,12,13,14,15, 0,1,2,3,4, 0,1,2,3};
__device__ constexpr int CIB[25] = {1,1,1,1,1,1,1,1, 4,4,4, 5,5,6,6,7,7, 8,9,10,11,12,13,14,15};
__device__ constexpr int CJB[25] = {0,1,2,3,4,5,6,7, 0,1,2, 0,1,0,1,0,1, 0,0,0,0,0,0,0,0};

DI void peer_topk_wave(const Params& p, int layer, int item) {
  const int head = item >> 10, tok0 = (item & 1023) * 32;
  const bf16_t* Q = (const bf16_t*)(p.ws + OFF_BIG);
  const bf16_t* KEYS = (const bf16_t*)(p.ws + OFF_KEYS) + (size_t)(layer * 8 + head) * 256 * 64;
  int* E = (int*)(p.ws + OFF_E);
  float* G = (float*)(p.ws + OFF_G);
  const int lane = threadIdx.x & 63, r = lane & 31, h = lane >> 5;
  const unsigned h4 = 4u * (1u - (unsigned)h);
  unsigned tl[2][16];
#pragma unroll
  for (int set = 0; set < 2; ++set) {
    bf16x8 qf[4];
    const bf16_t* qrow = Q + (size_t)(tok0 + r) * 1024 + head * 128 + set * 64 + h * 8;
#pragma unroll
    for (int s = 0; s < 4; ++s) qf[s] = *(const bf16x8*)(qrow + s * 16);
#pragma unroll
    for (int kt = 0; kt < 4; ++kt) {
      const bf16_t* krow = KEYS + (size_t)(set * 128 + kt * 32 + r) * 64 + h * 8;
      f32x16 X = zero16();
#pragma unroll
      for (int s = 0; s < 4; ++s) X = mfma32(*(const bf16x8*)(krow + s * 16), qf[s], X);
      unsigned kk[16];
#pragma unroll
      for (int i = 0; i < 16; ++i)
        kk[i] = (fkey_u(__float_as_uint(X[i])) & ~127u) + ((unsigned)(127 - kt * 32 - (i & 3) - 8 * (i >> 2) - 4) + h4);
      sort16(kk);
      if (kt == 0) {
#pragma unroll
        for (int i = 0; i < 16; ++i) tl[set][i] = kk[i];
      } else merge16(tl[set], kk);
    }
  }
  unsigned mine[16], oth[16];
#pragma unroll
  for (int j = 0; j < 16; ++j) {
    const unsigned send = h ? tl[0][j] : tl[1][j];
    oth[j] = (unsigned)__shfl_xor((int)send, 32);
    mine[j] = h ? tl[1][j] : tl[0][j];
  }
  merge16(mine, oth);
  float v1[16], v2[16]; int i1[16], i2[16];
#pragma unroll
  for (int j = 0; j < 16; ++j) {
    const unsigned o = (unsigned)__shfl_xor((int)mine[j], 32);
    const unsigned A = h ? o : mine[j], B = h ? mine[j] : o;
    v1[j] = unfkey(A & ~127u); i1[j] = 127 - (int)(A & 127u);
    v2[j] = unfkey(B & ~127u); i2[j] = 127 - (int)(B & 127u);
  }
  unsigned ck[16], dk[16]; int cp[16], dp[16];
#pragma unroll
  for (int n = 0; n < 32; ++n) {
    unsigned key = 0u; int e = 0;
    if (n < 25) {
      const float sA = v1[CIA[n]] + v2[CJA[n]], sB = v1[CIB[n]] + v2[CJB[n]];
      const int eA = i1[CIA[n]] * 128 + i2[CJA[n]], eB = i1[CIB[n]] * 128 + i2[CJB[n]];
      key = fkey_u(__float_as_uint(h ? sB : sA)); e = h ? eB : eA;
    }
    if (n < 16) { ck[n] = key; cp[n] = e; } else { dk[n - 16] = key; dp[n - 16] = e; }
  }
  sort16p(ck, cp);
  sort16p(dk, dp);
#pragma unroll
  for (int j = 0; j < 16; ++j) { const bool sw = dk[15 - j] > ck[j]; ck[j] = sw ? dk[15 - j] : ck[j]; cp[j] = sw ? dp[15 - j] : cp[j]; }
#pragma unroll
  for (int j = 8; j > 0; j >>= 1)
#pragma unroll
    for (int i = 0; i < 16; ++i) { const int l = i ^ j; if (l > i) cswap2(ck[i], cp[i], ck[l], cp[l]); }
  unsigned fk[16]; int fe[16];
#pragma unroll
  for (int j = 0; j < 16; ++j) { dk[j] = (unsigned)__shfl_xor((int)ck[j], 32); dp[j] = __shfl_xor(cp[j], 32); }
#pragma unroll
  for (int j = 0; j < 16; ++j) {
    const bool sw = (dk[15 - j] > ck[j]) || (dk[15 - j] == ck[j] && dp[15 - j] > cp[j]);
    fk[j] = sw ? dk[15 - j] : ck[j]; fe[j] = sw ? dp[15 - j] : cp[j];
  }
  float sv[16], mx = -INFINITY;
#pragma unroll
  for (int j = 0; j < 16; ++j) { sv[j] = unfkey(fk[j]); mx = fmaxf(mx, sv[j]); }
  float sm = 0.f;
#pragma unroll
  for (int j = 0; j < 16; ++j) { sv[j] = __expf(sv[j] - mx); sm += sv[j]; }
  const float inv = 1.f / sm;
  const size_t o = ((size_t)(tok0 + r) * 8 + head) * 16 + h * 8;
  *(int4*)(E + o) = make_int4(fe[0], fe[1], fe[2], fe[3]);
  *(int4*)(E + o + 4) = make_int4(fe[4], fe[5], fe[6], fe[7]);
  *(float4*)(G + o) = make_float4(sv[0] * inv, sv[1] * inv, sv[2] * inv, sv[3] * inv);
  *(float4*)(G + o + 4) = make_float4(sv[4] * inv, sv[5] * inv, sv[6] * inv, sv[7] * inv);
}

DI v32f fp6x32(const uint2* p) {
  const uint2 a = p[0], b = p[1], c = p[2];
  v6u x; x[0] = a.x; x[1] = a.y; x[2] = b.x; x[3] = b.y; x[4] = c.x; x[5] = c.y;
  return __builtin_amdgcn_cvt_scalef32_pk32_f32_fp6(x, 1.0f);
}

DI void peer_gather_u(const Params& p, int layer, char* smem) {
  const int tid = threadIdx.x, lane = tid & 63, w = tid >> 6, grp = lane >> 4, i16 = lane & 15;
  float* a_s = (float*)smem + w * 512;
  float* su_s = a_s + 128;
  float* gv_s = a_s + 256;
  int* e_s = (int*)(a_s + 384);
  const bf16_t* HN = (const bf16_t*)(p.ws + OFF_ACT_A);
  const unsigned char* U = (const unsigned char*)(p.ws + OFF_TBL_U) + (size_t)layer * 16 * MiB;
  const float* IU = (const float*)(p.ws + OFF_INV) + (layer * 2 + 0) * 16384;
  const float* IV = (const float*)(p.ws + OFF_INV) + (layer * 2 + 1) * 16384;
  const int* E = (const int*)(p.ws + OFF_E);
  const float* G = (const float*)(p.ws + OFF_G);
  float* A = (float*)(p.ws + OFF_A);
  for (int tok = blockIdx.x * 4 + w; tok < T_TOK; tok += gridDim.x * 4) {
    float xf[2][32];
#pragma unroll
    for (int c = 0; c < 2; ++c) {
      const uint4* xp = (const uint4*)(HN + (size_t)tok * 1024 + c * 512 + i16 * 32);
#pragma unroll
      for (int q = 0; q < 4; ++q) {
        const uint4 x0 = xp[q];
        xf[c][8 * q + 0] = bflo(x0.x); xf[c][8 * q + 1] = bfhi(x0.x); xf[c][8 * q + 2] = bflo(x0.y); xf[c][8 * q + 3] = bfhi(x0.y);
        xf[c][8 * q + 4] = bflo(x0.z); xf[c][8 * q + 5] = bfhi(x0.z); xf[c][8 * q + 6] = bflo(x0.w); xf[c][8 * q + 7] = bfhi(x0.w);
      }
    }
    {
      const int e0 = E[(size_t)tok * 128 + lane], e1 = E[(size_t)tok * 128 + 64 + lane];
      e_s[lane] = e0; e_s[64 + lane] = e1;
      su_s[lane] = IU[e0]; su_s[64 + lane] = IU[e1];
      gv_s[lane] = G[(size_t)tok * 128 + lane] * IV[e0]; gv_s[64 + lane] = G[(size_t)tok * 128 + 64 + lane] * IV[e1];
    }
    wave_sync();
#pragma unroll 4
    for (int mm = 0; mm < 32; ++mm) {
      const int pidx = 4 * mm + grp;
      const unsigned char* up = U + (size_t)e_s[pidx] * 768 + i16 * 24;
      const v32f u0 = fp6x32((const uint2*)up), u1 = fp6x32((const uint2*)(up + 384));
      float acc0 = 0.f, acc1 = 0.f;
#pragma unroll
      for (int i = 0; i < 32; ++i) { acc0 = fmaf(u0[i], xf[0][i], acc0); acc1 = fmaf(u1[i], xf[1][i], acc1); }
      float acc = acc0 + acc1;
      acc += __shfl_xor(acc, 1); acc += __shfl_xor(acc, 2); acc += __shfl_xor(acc, 4); acc += __shfl_xor(acc, 8);
      acc *= su_s[pidx];
      const float a = 0.5f * acc * (1.f + erff(acc * 0.7071067811865476f)) * gv_s[pidx];
      if (i16 == 0) a_s[pidx] = a;
    }
    wave_sync();
    A[(size_t)tok * 128 + lane] = a_s[lane];
    A[(size_t)tok * 128 + 64 + lane] = a_s[64 + lane];
    wave_sync();
  }
}

DI void peer_gather_v(const Params& p, int layer, char* smem, const float* __restrict__ next_gain) {
  const int tid = threadIdx.x, lane = tid & 63, w = tid >> 6, r = lane & 31, h = lane >> 5;
  float* a_s = (float*)smem + w * 256;
  int* e_s = (int*)(a_s + 128);
  const unsigned char* V = (const unsigned char*)(p.ws + OFF_TBL_V) + (size_t)layer * 16 * MiB;
  const int* E = (const int*)(p.ws + OFF_E);
  const float* A = (const float*)(p.ws + OFF_A);
  for (int tok = blockIdx.x * 4 + w; tok < T_TOK; tok += gridDim.x * 4) {
    e_s[lane] = E[(size_t)tok * 128 + lane]; e_s[64 + lane] = E[(size_t)tok * 128 + 64 + lane];
    a_s[lane] = A[(size_t)tok * 128 + lane]; a_s[64 + lane] = A[(size_t)tok * 128 + 64 + lane];
    wave_sync();
    float o[32];
#pragma unroll
    for (int i = 0; i < 32; ++i) o[i] = 0.f;
#pragma unroll 8
    for (int mm = 0; mm < 64; ++mm) {
      const int pidx = 2 * mm + h;
      const float a = a_s[pidx];
      const v32f vv = fp6x32((const uint2*)(V + (size_t)e_s[pidx] * 768 + r * 24));
#pragma unroll
      for (int i = 0; i < 32; ++i) o[i] = fmaf(a, vv[i], o[i]);
    }
#pragma unroll
    for (int i = 0; i < 32; ++i) o[i] += __shfl_xor(o[i], 32);
    float4* hp = (float4*)(p.out + (size_t)tok * 1024 + r * 32 + h * 16);
    float4 hv[4];
    float ss = 0.f;
#pragma unroll
    for (int q = 0; q < 4; ++q) {
      float4 t = hp[q];
      t.x += h ? o[16 + 4 * q] : o[4 * q]; t.y += h ? o[17 + 4 * q] : o[4 * q + 1];
      t.z += h ? o[18 + 4 * q] : o[4 * q + 2]; t.w += h ? o[19 + 4 * q] : o[4 * q + 3];
      hp[q] = t; hv[q] = t;
      ss += t.x * t.x + t.y * t.y + t.z * t.z + t.w * t.w;
    }
    if (next_gain) {
#pragma unroll
      for (int o2 = 32; o2 >= 1; o2 >>= 1) ss += __shfl_xor(ss, o2);
      const float rs = rsqrtf(ss * (1.f / 1024.f) + 1e-6f);
      const float4* gp = (const float4*)(next_gain + r * 32 + h * 16);
      unsigned pw[8];
#pragma unroll
      for (int q = 0; q < 4; ++q) {
        const float4 g = gp[q];
        pw[2 * q] = pk(hv[q].x * rs * g.x, hv[q].y * rs * g.y); pw[2 * q + 1] = pk(hv[q].z * rs * g.z, hv[q].w * rs * g.w);
      }
      uint4* dp = (uint4*)((bf16_t*)(p.ws + OFF_ACT_A) + (size_t)tok * 1024 + r * 32 + h * 16);
      dp[0] = make_uint4(pw[0], pw[1], pw[2], pw[3]); dp[1] = make_uint4(pw[4], pw[5], pw[6], pw[7]);
    }
    wave_sync();
  }
}

DI void run_phase(const Params& p, int ph, char* smem) {
  bf16_t* actA = (bf16_t*)(p.ws + OFF_ACT_A);
  bf16_t* big = (bf16_t*)(p.ws + OFF_BIG);
  switch (ph) {
    case 0: phase_convert(p, smem); phase_cvt_tables(p, 0); phase_cvt_tables(p, 1); break;
    case 1: phase_rmsnorm(p.x, p.ln_mix, actA); break;
    case 2: phase_gemm<EPI_GLA_IN>(p, actA, (const bf16_t*)(p.ws + OFF_WT_GLA_IN), 25, big, 3072, nullptr, smem); break;
    case 3: for (int it = blockIdx.x; it < 2048; it += gridDim.x) gla_phase1(p, it, smem); break;
    case 4: gla_scan(p); break;
    case 5: for (int it = blockIdx.x; it < 2048; it += gridDim.x) gla_phase3(p, it, smem); break;
    case 6: phase_gemm<EPI_RESID_X>(p, actA, (const bf16_t*)(p.ws + OFF_WT_GLA_OUT), 8, nullptr, 0, nullptr, smem); break;
    case 7: phase_rmsnorm(p.out, p.ln_ffn, actA); break;
    case 8: phase_gemm<EPI_BF16>(p, actA, (const bf16_t*)(p.ws + OFF_WT_PQ), 8, big, 1024, nullptr, smem); break;
    case 9: for (int it = blockIdx.x * 4 + (threadIdx.x >> 6); it < 8192; it += gridDim.x * 4) peer_topk_wave(p, 0, it); break;
    case 10: peer_gather_u(p, 0, smem); break;
    case 11: peer_gather_v(p, 0, smem, p.ln_mix + 1024); break;
    case 12: break;
    case 13: phase_gemm<EPI_BF16>(p, actA, (const bf16_t*)(p.ws + OFF_WT_SWA_IN), 10, big, 1280, p.swa_b_in, smem); break;
    case 14: swa_qknorm(p); break;
    case 15: for (int it = blockIdx.x; it < 4096; it += gridDim.x) swa_attn(p, it, smem); break;
    case 16: phase_gemm<EPI_RESID_INPLACE>(p, (const bf16_t*)(p.ws + OFF_ACT_B), (const bf16_t*)(p.ws + OFF_WT_SWA_OUT), 8, nullptr, 0, p.swa_b_out, smem); break;
    case 17: phase_rmsnorm(p.out, p.ln_ffn + 1024, actA); break;
    case 18: phase_gemm<EPI_BF16>(p, actA, (const bf16_t*)(p.ws + OFF_WT_PQ) + (size_t)1024 * 1024, 8, big, 1024, nullptr, smem); break;
    case 19: for (int it = blockIdx.x * 4 + (threadIdx.x >> 6); it < 8192; it += gridDim.x * 4) peer_topk_wave(p, 1, it); break;
    case 20: peer_gather_u(p, 1, smem); break;
    case 21: peer_gather_v(p, 1, smem, nullptr); break;
    default: break;
  }
}

template <int PH>
__global__ void __launch_bounds__(256, 2) phase_kernel(Params p) {
  __shared__ __attribute__((aligned(16))) char smem[SMEM_BYTES];
  run_phase(p, PH, smem);
}

template <int PH>
static void launch_phases(const Params& p, int grid, hipStream_t stream) {
  hipLaunchKernelGGL(phase_kernel<PH>, dim3(grid), dim3(256), 0, stream, p);
  if constexpr (PH + 1 < NPHASE) launch_phases<PH + 1>(p, grid, stream);
}


#define XB_TMO      128
#define XB_XCNT(j)  (256  + 64 * (j))
#define XB_XSUB(j)  (1280 + 64 * (j))
#define XB_XGEN(j)  (2304 + 64 * (j))
#define XB_TOP      3328
#define XB_TOPGEN   3392
#define XCD_BAR_WORDS 3456
#define XB_SPIN_CAP (1u << 23)
#define LAS __attribute__((address_space(3)))
DI unsigned xb_ld(unsigned* p) { return __hip_atomic_load(p, __ATOMIC_RELAXED, __HIP_MEMORY_SCOPE_AGENT); }
DI unsigned xb_add(unsigned* p, unsigned v) { return __hip_atomic_fetch_add(p, v, __ATOMIC_RELAXED, __HIP_MEMORY_SCOPE_AGENT); }
DI unsigned xb_xcc_id() { return (unsigned)__builtin_amdgcn_s_getreg((3 << 11) | 20) & 0xFu; }
#define XB_SPIN(cond, bar) do { unsigned _sp = 0; while (cond) { __builtin_amdgcn_s_sleep(1); \
    if ((++_sp & 255u) == 0u) { if (xb_ld(&(bar)[XB_TMO])) break; if (_sp > XB_SPIN_CAP) { atomicAdd(&(bar)[XB_TMO], 1u); break; } } } } while (0)
struct XcdBarrier { unsigned* bar; unsigned x; volatile LAS unsigned* st; };
DI XcdBarrier xcd_barrier_post(unsigned* bar, volatile LAS unsigned* st) {
  XcdBarrier b; b.bar = bar; b.x = xb_xcc_id(); b.st = st;
  if (threadIdx.x == 0) (void)xb_add(&bar[XB_XCNT(b.x)], 1u);
  return b;
}
DI void xcd_barrier_complete(unsigned* bar, unsigned x, unsigned& nloc, unsigned& nx) {
  const unsigned G = gridDim.x * gridDim.y * gridDim.z;
  unsigned sum, cnt, mine, sp = 0u;
  for (;;) {
    sum = 0u; cnt = 0u; mine = 0u;
#pragma unroll
    for (unsigned j = 0; j < 16; ++j) { const unsigned c = xb_ld(&bar[XB_XCNT(j)]); sum += c; cnt += (c > 0u) ? 1u : 0u; mine = (j == x) ? c : mine; }
    if (sum == G) break;
    __builtin_amdgcn_s_sleep(1);
    if ((++sp & 255u) == 0u) { if (xb_ld(&bar[XB_TMO])) break; if (sp > XB_SPIN_CAP) { atomicAdd(&bar[XB_TMO], 1u); break; } }
  }
  nloc = mine > 0u ? mine : 1u; nx = cnt > 0u ? cnt : 1u;
}
DI void xcd_barrier(const XcdBarrier& b) {
  asm volatile("s_waitcnt vmcnt(0)" ::: "memory");
  __syncthreads();
  if (threadIdx.x == 0) {
    unsigned* bar = b.bar;
    __builtin_amdgcn_s_waitcnt(0);
    unsigned nloc = b.st[0], nx = b.st[1];
    if (nloc == 0u) { xcd_barrier_complete(bar, b.x, nloc, nx); b.st[0] = nloc; b.st[1] = nx; }
    const unsigned old = xb_add(&bar[XB_XSUB(b.x)], 1u);
    const unsigned gen = old / nloc;
    if (old + 1u == (gen + 1u) * nloc) {
      __builtin_amdgcn_fence(__ATOMIC_RELEASE, "agent");
      asm volatile("s_waitcnt vmcnt(0)" ::: "memory");
      const unsigned og = xb_add(&bar[XB_TOP], 1u);
      const unsigned tg = og / nx;
      if (og + 1u == (tg + 1u) * nx) xb_add(&bar[XB_TOPGEN], 1u);
      else XB_SPIN(xb_ld(&bar[XB_TOPGEN]) == tg, bar);
      __builtin_amdgcn_fence(__ATOMIC_ACQUIRE, "agent");
      xb_add(&bar[XB_XGEN(b.x)], 1u);
      asm volatile("s_waitcnt vmcnt(0)" ::: "memory");
    } else {
      XB_SPIN(xb_ld(&bar[XB_XGEN(b.x)]) == gen, bar);
      __builtin_amdgcn_fence(__ATOMIC_ACQUIRE, "agent");
      asm volatile("s_waitcnt vmcnt(0)" ::: "memory");
    }
  }
  __syncthreads();
}

#if !MULTI_LAUNCH
template <int PH>
DI void run_all(const Params& p, char* smem, const XcdBarrier& xb) {
  if constexpr (PH != 12) {
    run_phase(p, PH, smem);
    if constexpr (PH + 1 < NPHASE) {
      if constexpr (PH == 0) cg::this_grid().sync();
      else xcd_barrier(xb);
    }
  }
  if constexpr (PH + 1 < NPHASE) run_all<PH + 1>(p, smem, xb);
}
__global__ void __launch_bounds__(256, 2) trunk_kernel(Params p) {
  __shared__ __attribute__((aligned(16))) char smem[SMEM_BYTES];
  __shared__ uint4 xb_words;
  if (threadIdx.x == 0) xb_words = make_uint4(0u, 0u, 0u, 0u);
  __syncthreads();
  const XcdBarrier xb = xcd_barrier_post((unsigned*)(p.ws + OFF_BAR), (volatile LAS unsigned*)&xb_words);
  run_all<0>(p, smem, xb);
}
#endif

extern "C" void kernel_launch(void* const* d_in, const int* in_sizes, int n_in, void* d_out, int out_size, void* d_ws, size_t ws_size,
                              hipStream_t stream) {
  Params p{};
  p.x = (const float*)d_in[0]; p.pos = (const int*)d_in[1]; p.ln_mix = (const float*)d_in[2]; p.ln_ffn = (const float*)d_in[3];
  p.gla_w_in = (const float*)d_in[4]; p.gla_w_alpha = (const float*)d_in[5]; p.gla_b_alpha = (const float*)d_in[6];
  p.gla_norm = (const float*)d_in[7]; p.gla_w_out = (const float*)d_in[8];
  p.swa_w_in = (const float*)d_in[9]; p.swa_b_in = (const float*)d_in[10]; p.swa_qn = (const float*)d_in[11]; p.swa_kn = (const float*)d_in[12];
  p.swa_sinks = (const float*)d_in[13]; p.swa_w_out = (const float*)d_in[14]; p.swa_b_out = (const float*)d_in[15];
  p.peer_wq = (const float*)d_in[16]; p.peer_keys = (const float*)d_in[17]; p.peer_u = (const float*)d_in[18]; p.peer_v = (const float*)d_in[19];
  p.out = (float*)d_out; p.ws = (char*)d_ws;
  static int grid_blocks = 0;
  if (!grid_blocks) {
    int dev = 0, cus = 0, per_cu = 0;
    (void)hipGetDevice(&dev);
    (void)hipDeviceGetAttribute(&cus, hipDeviceAttributeMultiprocessorCount, dev);
    #if MULTI_LAUNCH
    per_cu = 2;
#else
    (void)hipOccupancyMaxActiveBlocksPerMultiprocessor(&per_cu, trunk_kernel, 256, 0);
#endif
    if (per_cu < 1) per_cu = 1;
    if (per_cu > 2) per_cu = 2;
    grid_blocks = cus * per_cu;
  }
#if MULTI_LAUNCH
  p.phase_lo = 0; p.phase_hi = 0;
  launch_phases<0>(p, grid_blocks, stream);
#else
  p.phase_lo = 0; p.phase_hi = NPHASE - 1;
  void* args[] = {&p};
  (void)hipMemsetAsync((char*)d_ws + OFF_BAR, 0, XCD_BAR_WORDS * 4, stream);
  hipError_t e = hipLaunchCooperativeKernel((void*)trunk_kernel, dim3(grid_blocks), dim3(256), args, 0, stream);
  if (e != hipSuccess) fprintf(stderr, "cooperative launch failed: %s (grid %d)\n", hipGetErrorString(e), grid_blocks);
#endif
}
```

```cpp
#include <hip/hip_runtime.h>
#include <hip/hip_cooperative_groups.h>
#include <stdint.h>
#include <stdio.h>
namespace cg = cooperative_groups;

#ifndef MULTI_LAUNCH
#define MULTI_LAUNCH 0
#endif

#define DI __device__ __forceinline__
typedef unsigned short bf16_t;
typedef __attribute__((ext_vector_type(8))) short bf16x8;
typedef __attribute__((ext_vector_type(16))) float f32x16;
typedef __bf16 bf16x2_t __attribute__((ext_vector_type(2)));
typedef float f32x2_t __attribute__((ext_vector_type(2)));
typedef float f2 __attribute__((ext_vector_type(2)));

constexpr int T_TOK = 32768;
constexpr int SEQ = 16384;
constexpr int DM = 1024;
constexpr int NPHASE = 22;

constexpr size_t MiB = 1048576;
constexpr size_t OFF_WT_GLA_IN = 0;
constexpr size_t OFF_WT_GLA_OUT = 7 * MiB;
constexpr size_t OFF_WT_SWA_IN = 9 * MiB;
constexpr size_t OFF_WT_SWA_OUT = 12 * MiB;
constexpr size_t OFF_WT_PQ = 14 * MiB;
constexpr size_t OFF_KEYS = 18 * MiB;
constexpr size_t OFF_INV = 20 * MiB;
constexpr size_t OFF_TBL_U = 24 * MiB;
constexpr size_t OFF_TBL_V = 56 * MiB;
constexpr size_t OFF_ACT_A = 88 * MiB;
constexpr size_t OFF_BIG = 152 * MiB;
constexpr size_t OFF_E = OFF_BIG + 64 * MiB;
constexpr size_t OFF_G = OFF_BIG + 80 * MiB;
constexpr size_t OFF_A = OFF_BIG + 96 * MiB;
constexpr size_t OFF_KVT = 344 * MiB;
constexpr size_t OFF_ACT_B = OFF_KVT;
constexpr size_t OFF_LR = 472 * MiB;
constexpr size_t OFF_DECAY = 474 * MiB;
constexpr size_t OFF_BAR = 476 * MiB;

constexpr int SMEM_BYTES = 73728;
constexpr int LDK = 72;

struct Params {
  const float* x; const int* pos; const float* ln_mix; const float* ln_ffn;
  const float* gla_w_in; const float* gla_w_alpha; const float* gla_b_alpha; const float* gla_norm; const float* gla_w_out;
  const float* swa_w_in; const float* swa_b_in; const float* swa_qn; const float* swa_kn; const float* swa_sinks;
  const float* swa_w_out; const float* swa_b_out;
  const float* peer_wq; const float* peer_keys; const float* peer_u; const float* peer_v;
  float* out; char* ws;
  int phase_lo, phase_hi;
};

DI unsigned pk(float lo, float hi) { f32x2_t v = {lo, hi}; bf16x2_t b = __builtin_convertvector(v, bf16x2_t); return __builtin_bit_cast(unsigned, b); }
DI bf16_t f2bf(float x) { return (bf16_t)(pk(x, 0.f) & 0xffffu); }
DI float bflo(unsigned w) { return __uint_as_float(w << 16); }
DI float bfhi(unsigned w) { return __uint_as_float(w & 0xffff0000u); }
DI float bf2f(bf16_t b) { return __uint_as_float(((unsigned)b) << 16); }
DI float dot2(unsigned a, unsigned b, float c) { return __builtin_amdgcn_fdot2_f32_bf16(__builtin_bit_cast(bf16x2_t, a), __builtin_bit_cast(bf16x2_t, b), c, false); }
DI int crow(int i, int h) { return (i & 3) + 8 * (i >> 2) + 4 * h; }
DI f32x16 mfma32(bf16x8 a, bf16x8 b, f32x16 c) { return __builtin_amdgcn_mfma_f32_32x32x16_bf16(a, b, c, 0, 0, 0); }
DI f32x16 zero16() { f32x16 z; for (int i = 0; i < 16; ++i) z[i] = 0.f; return z; }
DI void wave_sync() { __builtin_amdgcn_fence(__ATOMIC_RELEASE, "wavefront"); __builtin_amdgcn_wave_barrier(); __builtin_amdgcn_fence(__ATOMIC_ACQUIRE, "wavefront"); }
DI int mbcnt64(unsigned long long m) { return __builtin_amdgcn_mbcnt_hi((unsigned)(m >> 32), __builtin_amdgcn_mbcnt_lo((unsigned)m, 0)); }
DI float logsig(float z) { return fminf(z, 0.f) - __logf(1.f + __expf(-fabsf(z))); }

DI void transpose_tile(const float* __restrict__ src, int N, bf16_t* __restrict__ dst, int kt, int nt, float* sT) {
  const int tid = threadIdx.x;
  const int r = tid >> 4, c4 = (tid & 15) * 4;
#pragma unroll
  for (int i = 0; i < 4; ++i) {
    const int k = kt * 64 + r + 16 * i, n = nt * 64 + c4;
    float4 v = make_float4(0.f, 0.f, 0.f, 0.f);
    if (n + 3 < N) v = *(const float4*)(src + (size_t)k * N + n);
    float* d = sT + (r + 16 * i) * 65 + c4;
    d[0] = v.x; d[1] = v.y; d[2] = v.z; d[3] = v.w;
  }
  __syncthreads();
  const int n = tid >> 2, seg = tid & 3;
  unsigned w[8];
#pragma unroll
  for (int j = 0; j < 8; ++j) w[j] = pk(sT[(seg * 16 + 2 * j) * 65 + n], sT[(seg * 16 + 2 * j + 1) * 65 + n]);
  uint4* d = (uint4*)(dst + (size_t)(nt * 64 + n) * 1024 + kt * 64 + seg * 16);
  d[0] = make_uint4(w[0], w[1], w[2], w[3]);
  d[1] = make_uint4(w[4], w[5], w[6], w[7]);
  __syncthreads();
}

DI void cvt_elems(const float* __restrict__ src, bf16_t* __restrict__ dst, size_t n8) {
  for (size_t i = (size_t)blockIdx.x * 256 + threadIdx.x; i < n8; i += (size_t)gridDim.x * 256) {
    const float4 a = ((const float4*)src)[2 * i], b = ((const float4*)src)[2 * i + 1];
    ((uint4*)dst)[i] = make_uint4(pk(a.x, a.y), pk(a.z, a.w), pk(b.x, b.y), pk(b.z, b.w));
  }
}

DI void phase_convert(const Params& p, char* smem) {
  float* sT = (float*)smem;
  for (int t = blockIdx.x; t < 2144; t += gridDim.x) {
    const float* src; int N, ntn; bf16_t* dst; int local;
    if (t < 800) { src = p.gla_w_in; N = 3088; ntn = 50; dst = (bf16_t*)(p.ws + OFF_WT_GLA_IN); local = t; }
    else if (t < 1056) { src = p.gla_w_out; N = 1024; ntn = 16; dst = (bf16_t*)(p.ws + OFF_WT_GLA_OUT); local = t - 800; }
    else if (t < 1376) { src = p.swa_w_in; N = 1280; ntn = 20; dst = (bf16_t*)(p.ws + OFF_WT_SWA_IN); local = t - 1056; }
    else if (t < 1632) { src = p.swa_w_out; N = 1024; ntn = 16; dst = (bf16_t*)(p.ws + OFF_WT_SWA_OUT); local = t - 1376; }
    else if (t < 1888) { src = p.peer_wq; N = 1024; ntn = 16; dst = (bf16_t*)(p.ws + OFF_WT_PQ); local = t - 1632; }
    else { src = p.peer_wq + (size_t)1024 * 1024; N = 1024; ntn = 16; dst = (bf16_t*)(p.ws + OFF_WT_PQ) + (size_t)1024 * 1024; local = t - 1888; }
    transpose_tile(src, N, dst, local / ntn, local % ntn, sT);
  }
  cvt_elems(p.peer_keys, (bf16_t*)(p.ws + OFF_KEYS), (size_t)2 * 8 * 2 * 128 * 64 / 8);
}

typedef unsigned v6u __attribute__((ext_vector_type(6)));
typedef float v32f __attribute__((ext_vector_type(32)));
DI unsigned fp6_code(float y) {
  const float a = fminf(fabsf(y), 7.5f);
  float c = rintf(a * 8.f);
  c = a >= 2.f ? rintf(a * 4.f) + 8.f : c;
  c = a >= 4.f ? rintf(a * 2.f) + 16.f : c;
  unsigned u = (unsigned)c;
  u = u > 31u ? 31u : u;
  return u | ((__float_as_uint(y) >> 26) & 32u);
}
DI void cvt_table_fp6(const float* __restrict__ src, unsigned char* __restrict__ dst, float* __restrict__ inv, int bid, int nb) {
  const int lane = threadIdx.x & 63, w = threadIdx.x >> 6, r = lane & 31, h = lane >> 5;
  for (int rp = bid * 4 + w; rp < 8192; rp += nb * 4) {
    const int row = rp * 2 + h;
    const float4* sp = (const float4*)(src + (size_t)row * 1024 + r * 32);
    float v[32];
    float mx = 0.f;
#pragma unroll
    for (int i = 0; i < 8; ++i) {
      const float4 t = sp[i];
      v[4 * i] = t.x; v[4 * i + 1] = t.y; v[4 * i + 2] = t.z; v[4 * i + 3] = t.w;
      mx = fmaxf(fmaxf(mx, fmaxf(fabsf(t.x), fabsf(t.y))), fmaxf(fabsf(t.z), fabsf(t.w)));
    }
#pragma unroll
    for (int o = 16; o >= 1; o >>= 1) mx = fmaxf(mx, __shfl_xor(mx, o));
    const float sc = mx > 0.f ? 7.5f / mx : 1.f;
    unsigned c[32];
#pragma unroll
    for (int i = 0; i < 32; ++i) c[i] = fp6_code(v[i] * sc);
    unsigned d[6];
#pragma unroll
    for (int g = 0; g < 2; ++g) {
      const unsigned* q = c + 16 * g;
      d[3 * g + 0] = q[0] | (q[1] << 6) | (q[2] << 12) | (q[3] << 18) | (q[4] << 24) | (q[5] << 30);
      d[3 * g + 1] = (q[5] >> 2) | (q[6] << 4) | (q[7] << 10) | (q[8] << 16) | (q[9] << 22) | (q[10] << 28);
      d[3 * g + 2] = (q[10] >> 4) | (q[11] << 2) | (q[12] << 8) | (q[13] << 14) | (q[14] << 20) | (q[15] << 26);
    }
    uint2* dp = (uint2*)(dst + (size_t)row * 768 + r * 24);
    dp[0] = make_uint2(d[0], d[1]); dp[1] = make_uint2(d[2], d[3]); dp[2] = make_uint2(d[4], d[5]);
    if (r == 0) inv[row] = mx > 0.f ? mx * (1.f / 7.5f) : 1.f;
  }
}
DI void phase_cvt_tables(const Params& p, int layer) {
  const int nb = gridDim.x / 2, bid = blockIdx.x % nb;
  const int rows_lo = (blockIdx.x < nb) ? 0 : 1;
  cvt_table_fp6(p.peer_u + (size_t)layer * 16384 * 1024, (unsigned char*)(p.ws + OFF_TBL_U) + (size_t)layer * 16 * MiB, (float*)(p.ws + OFF_INV) + (layer * 2 + 0) * 16384, bid * 2 + rows_lo, nb * 2);
  cvt_table_fp6(p.peer_v + (size_t)layer * 16384 * 1024, (unsigned char*)(p.ws + OFF_TBL_V) + (size_t)layer * 16 * MiB, (float*)(p.ws + OFF_INV) + (layer * 2 + 1) * 16384, bid * 2 + rows_lo, nb * 2);
}

DI void phase_rmsnorm(const float* __restrict__ src, const float* __restrict__ gain, bf16_t* __restrict__ dst) {
  const int lane = threadIdx.x & 63, w = threadIdx.x >> 6;
  for (int row = blockIdx.x * 4 + w; row < T_TOK; row += gridDim.x * 4) {
    const float4* sp = (const float4*)(src + (size_t)row * DM);
    float4 v[4];
    float ss = 0.f;
#pragma unroll
    for (int i = 0; i < 4; ++i) { v[i] = sp[lane + 64 * i]; ss += v[i].x * v[i].x + v[i].y * v[i].y + v[i].z * v[i].z + v[i].w * v[i].w; }
#pragma unroll
    for (int o = 32; o >= 1; o >>= 1) ss += __shfl_xor(ss, o);
    const float rs = rsqrtf(ss * (1.f / 1024.f) + 1e-6f);
#pragma unroll
    for (int i = 0; i < 4; ++i) {
      const float4 g = ((const float4*)gain)[lane + 64 * i];
      uint2 o2 = make_uint2(pk(v[i].x * rs * g.x, v[i].y * rs * g.y), pk(v[i].z * rs * g.z, v[i].w * rs * g.w));
      *(uint2*)(dst + (size_t)row * DM + (lane + 64 * i) * 4) = o2;
    }
  }
}

DI void mma_64x64(const bf16_t* sA, const bf16_t* sB, int arow0, int brow0, f32x16 (&acc)[2][2], int lane) {
  const int r = lane & 31, h = lane >> 5;
#pragma unroll
  for (int s = 0; s < 4; ++s) {
    bf16x8 a[2], b[2];
#pragma unroll
    for (int mi = 0; mi < 2; ++mi) a[mi] = *(const bf16x8*)(sA + (arow0 + mi * 32 + r) * LDK + s * 16 + h * 8);
#pragma unroll
    for (int ni = 0; ni < 2; ++ni) b[ni] = *(const bf16x8*)(sB + (brow0 + ni * 32 + r) * LDK + s * 16 + h * 8);
#pragma unroll
    for (int mi = 0; mi < 2; ++mi)
#pragma unroll
      for (int ni = 0; ni < 2; ++ni) acc[mi][ni] = mfma32(a[mi], b[ni], acc[mi][ni]);
  }
}

enum { EPI_GLA_IN = 0, EPI_RESID_X = 1, EPI_BF16 = 2, EPI_RESID_INPLACE = 3 };

template <int MODE>
DI void phase_gemm(const Params& p, const bf16_t* __restrict__ A, const bf16_t* __restrict__ Bt, int NT, bf16_t* dstb, int ldc,
                   const float* __restrict__ bias, char* smem) {
  const int ntiles = (T_TOK / 128) * NT;
  int t = blockIdx.x;
  if (t >= ntiles) return;
  bf16_t* sA = (bf16_t*)smem;
  bf16_t* sB = sA + 128 * LDK;
  bf16_t* ct = (bf16_t*)smem;
  const int tid = threadIdx.x, lane = tid & 63, w = tid >> 6, wm = w >> 1, wn = w & 1;
  const int r = lane & 31, h = lane >> 5;
  const int lrow = tid >> 3, kc = tid & 7;
  bf16_t* wa = sA + lrow * LDK + kc * 8;
  bf16_t* wb = sB + lrow * LDK + kc * 8;
  bf16x8 ra0[4], rb0[4], ra1[4], rb1[4];
  int m0 = (t / NT) * 128, n0 = (t % NT) * 128;
  const bf16_t* ap = A + (size_t)(m0 + lrow) * 1024 + kc * 8;
  const bf16_t* bp = Bt + (size_t)(n0 + lrow) * 1024 + kc * 8;
#define GLOAD(RA, RB, KT) _Pragma("unroll") for (int i = 0; i < 4; ++i) { RA[i] = *(const bf16x8*)(ap + (size_t)i * 32 * 1024 + (KT) * 64); RB[i] = *(const bf16x8*)(bp + (size_t)i * 32 * 1024 + (KT) * 64); }
#define SSTORE(RA, RB) _Pragma("unroll") for (int i = 0; i < 4; ++i) { *(bf16x8*)(wa + 32 * i * LDK) = RA[i]; *(bf16x8*)(wb + 32 * i * LDK) = RB[i]; }
  GLOAD(ra0, rb0, 0)
  GLOAD(ra1, rb1, 1)
  for (; t < ntiles; t += gridDim.x) {
    f32x16 acc[2][2];
#pragma unroll
    for (int i = 0; i < 2; ++i)
#pragma unroll
      for (int j = 0; j < 2; ++j) acc[i][j] = zero16();
    __syncthreads();
    SSTORE(ra0, rb0)
    __syncthreads();
    for (int kt = 0; kt < 16; kt += 2) {
      if (kt + 2 < 16) { GLOAD(ra0, rb0, kt + 2) }
      mma_64x64(sA, sB, wm * 64, wn * 64, acc, lane);
      __syncthreads();
      SSTORE(ra1, rb1)
      __syncthreads();
      if (kt + 3 < 16) { GLOAD(ra1, rb1, kt + 3) }
      mma_64x64(sA, sB, wm * 64, wn * 64, acc, lane);
      __syncthreads();
      if (kt + 2 < 16) {
        SSTORE(ra0, rb0)
        __syncthreads();
      }
    }
    const int cm0 = m0, cn0 = n0;
    {
      const int tn = t + gridDim.x;
      if (tn < ntiles) {
        m0 = (tn / NT) * 128; n0 = (tn % NT) * 128;
        ap = A + (size_t)(m0 + lrow) * 1024 + kc * 8;
        bp = Bt + (size_t)(n0 + lrow) * 1024 + kc * 8;
        GLOAD(ra0, rb0, 0)
        GLOAD(ra1, rb1, 1)
      }
    }
    const bool staged = (MODE == EPI_BF16) || (MODE == EPI_GLA_IN && cn0 < 3072);
    if (staged) {
#pragma unroll
      for (int ni = 0; ni < 2; ++ni) {
        const int col = wn * 64 + ni * 32 + r;
        const float bv = (MODE == EPI_BF16 && bias) ? bias[cn0 + col] : 0.f;
#pragma unroll
        for (int mi = 0; mi < 2; ++mi)
#pragma unroll
          for (int i = 0; i < 16; ++i) ct[(wm * 64 + mi * 32 + crow(i, h)) * 136 + col] = f2bf(acc[mi][ni][i] + bv);
      }
      __syncthreads();
      const int ldo = (MODE == EPI_GLA_IN) ? 3072 : ldc;
#pragma unroll
      for (int j = 0; j < 8; ++j) {
        const int c = tid + 256 * j, row = c >> 4, cc = c & 15;
        *(uint4*)(dstb + (size_t)(cm0 + row) * ldo + cn0 + cc * 8) = *(const uint4*)(ct + row * 136 + cc * 8);
      }
    } else {
      const unsigned row0 = (unsigned)(cm0 + wm * 64 + 4 * h), col0 = (unsigned)(cn0 + wn * 64 + r);
      float* __restrict__ lrp = (float*)(p.ws + OFF_LR);
#pragma unroll
      for (int ni = 0; ni < 2; ++ni) {
        const unsigned col = col0 + ni * 32;
        float bv = 0.f;
        if (MODE == EPI_RESID_INPLACE) bv = bias[col];
        const unsigned i0 = row0 * 1024u + col;
        const unsigned l0 = row0 * 16u + (col - 3072u);
#pragma unroll
        for (int mi = 0; mi < 2; ++mi)
#pragma unroll
          for (int i = 0; i < 16; ++i) {
            const unsigned ro = (unsigned)(mi * 32 + (i & 3) + 8 * (i >> 2));
            const float v = acc[mi][ni][i];
            if (MODE == EPI_GLA_IN) { if (col < 3088u) lrp[l0 + ro * 16u] = v; }
            else if (MODE == EPI_RESID_X) p.out[i0 + ro * 1024u] = p.x[i0 + ro * 1024u] + v;
            else if (MODE == EPI_RESID_INPLACE) p.out[i0 + ro * 1024u] += v + bv;
          }
      }
    }
  }
#undef GLOAD
#undef SSTORE
}

DI float gate_la(const float* lr_s, int t, const float (&wa)[16], float ba) {
  float z = ba;
#pragma unroll
  for (int j = 0; j < 16; ++j) z += lr_s[t * 16 + j] * wa[j];
  return logsig(z) * (1.f / 16.f);
}
DI void gla_gates(const Params& p, int t0, int hh, float (&wa)[16], float& ba, float& offset, float& blast, float* lr_s, float* tot_s) {
  const int tid = threadIdx.x, d = tid & 127, half = tid >> 7;
  const float* LR = (const float*)(p.ws + OFF_LR);
  ((float4*)lr_s)[tid] = ((const float4*)(LR + (size_t)t0 * 16))[tid];
#pragma unroll
  for (int j = 0; j < 16; ++j) wa[j] = p.gla_w_alpha[j * 512 + hh * 128 + d];
  ba = p.gla_b_alpha[hh * 128 + d];
  __syncthreads();
  float sum = 0.f;
#pragma unroll 4
  for (int tt = 0; tt < 32; ++tt) sum += gate_la(lr_s, half * 32 + tt, wa, ba);
  tot_s[half * 128 + d] = sum;
  __syncthreads();
  offset = half ? tot_s[d] : 0.f;
  blast = tot_s[d] + tot_s[128 + d];
}

DI void fill_vT(const bf16_t* __restrict__ QKVR, int t0, int hh, int vh, bf16_t* vT) {
  const int tid = threadIdx.x, v = tid & 127, half = tid >> 7;
#pragma unroll 8
  for (int tt = 0; tt < 32; ++tt) {
    const int t = half * 32 + tt;
    vT[v * LDK + t] = QKVR[(size_t)(t0 + t) * 3072 + 1024 + hh * 256 + vh * 128 + v];
  }
}

DI void gla_phase1(const Params& p, int item, char* smem) {
  const int hh = item & 3, c = (item >> 2) & 255, b = item >> 10;
  const int t0 = b * SEQ + c * 64;
  float* lr_s = (float*)smem;
  float* tot_s = (float*)(smem + 4096);
  bf16_t* kfT = (bf16_t*)(smem + 5120);
  bf16_t* vT = kfT + 128 * LDK;
  const bf16_t* QKVR = (const bf16_t*)(p.ws + OFF_BIG);
  bf16_t* KVT = (bf16_t*)(p.ws + OFF_KVT);
  float* DECAY = (float*)(p.ws + OFF_DECAY);
  const int tid = threadIdx.x, lane = tid & 63, w = tid >> 6, wm = w >> 1, wn = w & 1;
  const int d = tid & 127, half = tid >> 7;
  float wa[16], ba, offset, blast;
  gla_gates(p, t0, hh, wa, ba, offset, blast, lr_s, tot_s);
  float run = offset;
#pragma unroll 4
  for (int tt = 0; tt < 32; ++tt) {
    const int t = half * 32 + tt;
    run += gate_la(lr_s, t, wa, ba);
    ((float*)(p.ws + OFF_ACT_A))[(size_t)(t0 + t) * 512 + hh * 128 + d] = run;
    const float kv = bf2f(QKVR[(size_t)(t0 + t) * 3072 + 512 + hh * 128 + d]);
    kfT[d * LDK + t] = f2bf(kv * __expf(blast - run));
  }
  if (half == 0) DECAY[(size_t)item * 128 + d] = __expf(blast);
  const int r = lane & 31, h = lane >> 5;
  for (int vh = 0; vh < 2; ++vh) {
    __syncthreads();
    fill_vT(QKVR, t0, hh, vh, vT);
    __syncthreads();
    f32x16 acc[2][2];
#pragma unroll
    for (int i = 0; i < 2; ++i)
#pragma unroll
      for (int j = 0; j < 2; ++j) acc[i][j] = zero16();
    mma_64x64(vT, kfT, wm * 64, wn * 64, acc, lane);
    bf16_t* kbase = KVT + (size_t)item * 32768 + (vh * 128 + wm * 64 + 4 * h) * 128 + wn * 64 + r;
#pragma unroll
    for (int mi = 0; mi < 2; ++mi)
#pragma unroll
      for (int ni = 0; ni < 2; ++ni)
#pragma unroll
        for (int i = 0; i < 16; ++i) kbase[(mi * 32 + (i & 3) + 8 * (i >> 2)) * 128 + ni * 32] = f2bf(acc[mi][ni][i]);
  }
  __syncthreads();
}

DI void gla_scan(const Params& p) {
  bf16_t* KVT = (bf16_t*)(p.ws + OFF_KVT);
  const float* DECAY = (const float*)(p.ws + OFF_DECAY);
  for (int idx = blockIdx.x * 256 + threadIdx.x; idx < 8 * 16384; idx += gridDim.x * 256) {
    const int bh = idx >> 14, e2 = idx & 16383, b = bh >> 2, hh = bh & 3, d0 = (2 * e2) & 127;
    float s0 = 0.f, s1 = 0.f;
    for (int c0 = 0; c0 < 256; c0 += 8) {
      unsigned kv[8]; float2 dc[8];
#pragma unroll
      for (int u = 0; u < 8; ++u) {
        const size_t item = (size_t)(b * 256 + c0 + u) * 4 + hh;
        kv[u] = *(const unsigned*)(KVT + item * 32768 + 2 * e2);
        dc[u] = *(const float2*)(DECAY + item * 128 + d0);
      }
#pragma unroll
      for (int u = 0; u < 8; ++u) {
        const size_t item = (size_t)(b * 256 + c0 + u) * 4 + hh;
        *(unsigned*)(KVT + item * 32768 + 2 * e2) = pk(s0, s1);
        s0 = dc[u].x * s0 + bflo(kv[u]);
        s1 = dc[u].y * s1 + bfhi(kv[u]);
      }
    }
  }
}

DI void gla_phase3(const Params& p, int item, char* smem) {
  const int hh = item & 3, c = (item >> 2) & 255, b = item >> 10;
  const int t0 = b * SEQ + c * 64;
  float* lr_s = (float*)smem;
  float* tot_s = (float*)(smem + 4096);
  bf16_t* qd = (bf16_t*)(smem + 5120);
  bf16_t* ki = qd + 64 * 136;
  bf16_t* at = ki + 64 * 136;
  bf16_t* vT = at + 64 * 72;
  bf16_t* ot = qd;
  const bf16_t* QKVR = (const bf16_t*)(p.ws + OFF_BIG);
  const bf16_t* ST = (const bf16_t*)(p.ws + OFF_KVT);
  bf16_t* OG = (bf16_t*)(p.ws + OFF_ACT_A);
  const int tid = threadIdx.x, lane = tid & 63, w = tid >> 6;
  const int d = tid & 127, half = tid >> 7;
  const int r = lane & 31, h = lane >> 5;
  {
    const float* Bc = (const float*)(p.ws + OFF_ACT_A);
#pragma unroll 8
    for (int tt = 0; tt < 32; ++tt) {
      const int t = half * 32 + tt;
      const float run = Bc[(size_t)(t0 + t) * 512 + hh * 128 + d];
      const float q = bf2f(QKVR[(size_t)(t0 + t) * 3072 + hh * 128 + d]);
      const float k = bf2f(QKVR[(size_t)(t0 + t) * 3072 + 512 + hh * 128 + d]);
      qd[t * 136 + d] = f2bf(q * 0.08838834764831845f * __expf(run));
      ki[t * 136 + d] = f2bf(k * __expf(-run));
    }
  }
  __syncthreads();
  {
    const int mi = w >> 1, nj = w & 1;
    f32x16 a = zero16();
#pragma unroll
    for (int s = 0; s < 8; ++s) {
      const bf16x8 A = *(const bf16x8*)(qd + (mi * 32 + r) * 136 + s * 16 + h * 8);
      const bf16x8 B = *(const bf16x8*)(ki + (nj * 32 + r) * 136 + s * 16 + h * 8);
      a = mfma32(A, B, a);
    }
#pragma unroll
    for (int i = 0; i < 16; ++i) {
      const int it = mi * 32 + crow(i, h), jt = nj * 32 + r;
      at[it * 72 + jt] = f2bf(jt <= it ? a[i] : 0.f);
    }
  }
  f32x16 o[2][2];
#pragma unroll
  for (int i = 0; i < 2; ++i)
#pragma unroll
    for (int j = 0; j < 2; ++j) o[i][j] = zero16();
#pragma unroll
  for (int vh = 0; vh < 2; ++vh) {
    __syncthreads();
    fill_vT(QKVR, t0, hh, vh, vT);
    __syncthreads();
#pragma unroll
    for (int s = 0; s < 4; ++s) {
      const bf16x8 B = *(const bf16x8*)(vT + (w * 32 + r) * LDK + s * 16 + h * 8);
#pragma unroll
      for (int mt = 0; mt < 2; ++mt) {
        const bf16x8 A = *(const bf16x8*)(at + (mt * 32 + r) * 72 + s * 16 + h * 8);
        o[vh][mt] = mfma32(A, B, o[vh][mt]);
      }
    }
    const bf16_t* Sg = ST + (size_t)item * 32768 + (size_t)(vh * 128 + w * 32 + r) * 128 + h * 8;
#pragma unroll
    for (int s = 0; s < 8; ++s) {
      const bf16x8 B = *(const bf16x8*)(Sg + s * 16);
#pragma unroll
      for (int mt = 0; mt < 2; ++mt) {
        const bf16x8 A = *(const bf16x8*)(qd + (mt * 32 + r) * 136 + s * 16 + h * 8);
        o[vh][mt] = mfma32(A, B, o[vh][mt]);
      }
    }
  }
  __syncthreads();
#pragma unroll
  for (int vh = 0; vh < 2; ++vh)
#pragma unroll
    for (int mt = 0; mt < 2; ++mt)
#pragma unroll
      for (int i = 0; i < 16; ++i) ot[(mt * 32 + crow(i, h)) * 264 + vh * 128 + w * 32 + r] = f2bf(o[vh][mt][i]);
  __syncthreads();
  {
    const int row = tid >> 2, seg = tid & 3;
    const bf16_t* orow = ot + row * 264 + seg * 64;
    float ss = 0.f;
#pragma unroll
    for (int c8 = 0; c8 < 8; ++c8) {
      const uint4 ov = *(const uint4*)(orow + c8 * 8);
      const float f0 = bflo(ov.x), f1 = bfhi(ov.x), f2 = bflo(ov.y), f3 = bfhi(ov.y), f4 = bflo(ov.z), f5 = bfhi(ov.z), f6 = bflo(ov.w), f7 = bfhi(ov.w);
      ss += f0 * f0 + f1 * f1 + f2 * f2 + f3 * f3 + f4 * f4 + f5 * f5 + f6 * f6 + f7 * f7;
    }
    ss += __shfl_xor(ss, 1);
    ss += __shfl_xor(ss, 2);
    const float rs = rsqrtf(ss * (1.f / 256.f) + 1e-6f);
    const bf16_t* rrow = QKVR + (size_t)(t0 + row) * 3072 + 2048 + hh * 256 + seg * 64;
    const float* grow = p.gla_norm + hh * 256 + seg * 64;
    bf16_t* dst = OG + (size_t)(t0 + row) * 1024 + hh * 256 + seg * 64;
#pragma unroll
    for (int c8 = 0; c8 < 8; ++c8) {
      const uint4 ov = *(const uint4*)(orow + c8 * 8);
      const uint4 rv = *(const uint4*)(rrow + c8 * 8);
      const float4 g0 = *(const float4*)(grow + c8 * 8), g1 = *(const float4*)(grow + c8 * 8 + 4);
      float of[8] = {bflo(ov.x), bfhi(ov.x), bflo(ov.y), bfhi(ov.y), bflo(ov.z), bfhi(ov.z), bflo(ov.w), bfhi(ov.w)};
      float rf[8] = {bflo(rv.x), bfhi(rv.x), bflo(rv.y), bfhi(rv.y), bflo(rv.z), bfhi(rv.z), bflo(rv.w), bfhi(rv.w)};
      float gf[8] = {g0.x, g0.y, g0.z, g0.w, g1.x, g1.y, g1.z, g1.w};
      float res[8];
#pragma unroll
      for (int e = 0; e < 8; ++e) res[e] = of[e] * rs * gf[e] * (rf[e] / (1.f + __expf(-rf[e])));
      *(uint4*)(dst + c8 * 8) = make_uint4(pk(res[0], res[1]), pk(res[2], res[3]), pk(res[4], res[5]), pk(res[6], res[7]));
    }
  }
  __syncthreads();
}

DI void swa_qknorm(const Params& p) {
  bf16_t* QKV = (bf16_t*)(p.ws + OFF_BIG);
  const int tid = threadIdx.x, sub = tid & 7;
  const int ngroups = T_TOK * 18;
  for (int g = blockIdx.x * 32 + (tid >> 3); g < ngroups; g += gridDim.x * 32) {
    const int tok = g / 18, slot = g - tok * 18;
    bf16_t* ptr = QKV + (size_t)tok * 1280 + slot * 64 + sub * 8;
    const uint4 wv = *(const uint4*)ptr;
    float v[8] = {bflo(wv.x), bfhi(wv.x), bflo(wv.y), bfhi(wv.y), bflo(wv.z), bfhi(wv.z), bflo(wv.w), bfhi(wv.w)};
    float ss = 0.f;
#pragma unroll
    for (int e = 0; e < 8; ++e) ss += v[e] * v[e];
    ss += __shfl_xor(ss, 1);
    ss += __shfl_xor(ss, 2);
    ss += __shfl_xor(ss, 4);
    const float rs = rsqrtf(ss * (1.f / 64.f) + 1e-6f);
    const float* gain = (slot < 16 ? p.swa_qn : p.swa_kn) + sub * 8;
#pragma unroll
    for (int e = 0; e < 8; ++e) v[e] = v[e] * rs * gain[e];
    const float posf = (float)p.pos[tok];
    const float invf[8] = {1.0f, 0.1939227432012558f, 0.03760603070259094f, 0.007292664609849453f,
                           0.0014142135623842478f, 0.00027424818836152554f, 5.318296098266728e-05f, 1.0313386155758053e-05f};
#pragma unroll
    for (int e = 0; e < 8; ++e) {
      const float other = __shfl_xor(v[e], 1);
      if (sub < 2) {
        const float ang = posf * invf[e];
        const double rev = (double)ang * 0.15915494309189535;
        const float fr = (float)(rev - rint(rev));
        const float sn = __builtin_amdgcn_sinf(fr), cs = __builtin_amdgcn_cosf(fr);
        v[e] = (sub == 0) ? (v[e] * cs - other * sn) : (v[e] * cs + other * sn);
      }
    }
    if (slot < 16) {
#pragma unroll
      for (int e = 0; e < 8; ++e) v[e] *= 0.125f;
    }
    *(uint4*)ptr = make_uint4(pk(v[0], v[1]), pk(v[2], v[3]), pk(v[4], v[5]), pk(v[6], v[7]));
  }
}

DI void swa_attn(const Params& p, int item, char* smem) {
  const int hq = item & 15, n = (item >> 4) & 127, b = item >> 11, hkv = hq >> 3;
  const int tok0 = b * SEQ + n * 128;
  bf16_t* Ks = (bf16_t*)smem;
  bf16_t* vT = Ks + 256 * 72;
  const bf16_t* QKV = (const bf16_t*)(p.ws + OFF_BIG);
  bf16_t* OUT = (bf16_t*)(p.ws + OFF_ACT_B);
  const int tid = threadIdx.x, lane = tid & 63, w = tid >> 6, r = lane & 31, h = lane >> 5;
  __syncthreads();
#pragma unroll
  for (int i = 0; i < 8; ++i) {
    const int cidx = tid + 256 * i, kk = cidx >> 3, kc = cidx & 7;
    const int pos = n * 128 - 128 + kk;
    uint4 kw = make_uint4(0, 0, 0, 0), vw = make_uint4(0, 0, 0, 0);
    if (pos >= 0) {
      const bf16_t* base = QKV + (size_t)(b * SEQ + pos) * 1280;
      kw = *(const uint4*)(base + 1024 + hkv * 64 + kc * 8);
      vw = *(const uint4*)(base + 1152 + hkv * 64 + kc * 8);
    }
    *(uint4*)(Ks + kk * 72 + kc * 8) = kw;
    bf16_t* vd = vT + (kc * 8) * 264 + kk;
    vd[0 * 264] = (bf16_t)(vw.x & 0xffff); vd[1 * 264] = (bf16_t)(vw.x >> 16);
    vd[2 * 264] = (bf16_t)(vw.y & 0xffff); vd[3 * 264] = (bf16_t)(vw.y >> 16);
    vd[4 * 264] = (bf16_t)(vw.z & 0xffff); vd[5 * 264] = (bf16_t)(vw.z >> 16);
    vd[6 * 264] = (bf16_t)(vw.w & 0xffff); vd[7 * 264] = (bf16_t)(vw.w >> 16);
  }
  __syncthreads();
  const int iq = 32 * w + r;
  const bf16_t* qrow = QKV + (size_t)(tok0 + iq) * 1280 + hq * 64 + h * 8;
  bf16x8 qf[4];
#pragma unroll
  for (int s = 0; s < 4; ++s) qf[s] = *(const bf16x8*)(qrow + s * 16);
  f32x16 X[5];
#pragma unroll
  for (int kt = 0; kt < 5; ++kt) {
    X[kt] = zero16();
#pragma unroll
    for (int s = 0; s < 4; ++s) {
      const bf16x8 A = *(const bf16x8*)(Ks + ((w + kt) * 32 + r) * 72 + s * 16 + h * 8);
      X[kt] = mfma32(A, qf[s], X[kt]);
    }
  }
  const float sink = p.swa_sinks[hq];
  float m = sink;
#pragma unroll
  for (int kt = 0; kt < 5; ++kt)
#pragma unroll
    for (int i = 0; i < 16; ++i) {
      const int kk = (w + kt) * 32 + crow(i, h);
      const bool valid = (kk > iq) && (kk <= iq + 128) && (n > 0 || kk >= 128);
      const float xv = valid ? X[kt][i] : -INFINITY;
      X[kt][i] = xv;
      m = fmaxf(m, xv);
    }
  m = fmaxf(m, __shfl_xor(m, 32));
  float l = 0.f;
#pragma unroll
  for (int kt = 0; kt < 5; ++kt)
#pragma unroll
    for (int i = 0; i < 16; ++i) {
      const float pv = __expf(X[kt][i] - m);
      X[kt][i] = pv;
      l += pv;
    }
  l += __shfl_xor(l, 32);
  l += __expf(sink - m);
  f32x16 O[2];
  O[0] = zero16(); O[1] = zero16();
#pragma unroll
  for (int kt = 0; kt < 5; ++kt)
#pragma unroll
    for (int s2 = 0; s2 < 2; ++s2) {
      const uint4 pw = make_uint4(pk(X[kt][8 * s2 + 0], X[kt][8 * s2 + 1]), pk(X[kt][8 * s2 + 2], X[kt][8 * s2 + 3]),
                                  pk(X[kt][8 * s2 + 4], X[kt][8 * s2 + 5]), pk(X[kt][8 * s2 + 6], X[kt][8 * s2 + 7]));
      const bf16x8 P = __builtin_bit_cast(bf16x8, pw);
#pragma unroll
      for (int mt = 0; mt < 2; ++mt) {
        const bf16_t* vp = vT + (mt * 32 + r) * 264 + (w + kt) * 32 + 16 * s2 + 4 * h;
        const uint2 lo = *(const uint2*)vp, hi = *(const uint2*)(vp + 8);
        const bf16x8 A = __builtin_bit_cast(bf16x8, make_uint4(lo.x, lo.y, hi.x, hi.y));
        O[mt] = mfma32(A, P, O[mt]);
      }
    }
  const float inv = 1.f / l;
  bf16_t* orow = OUT + (size_t)(tok0 + iq) * 1024 + hq * 64 + 4 * h;
#pragma unroll
  for (int mt = 0; mt < 2; ++mt)
#pragma unroll
    for (int g = 0; g < 4; ++g)
      *(uint2*)(orow + mt * 32 + 8 * g) = make_uint2(pk(O[mt][4 * g] * inv, O[mt][4 * g + 1] * inv), pk(O[mt][4 * g + 2] * inv, O[mt][4 * g + 3] * inv));
}

DI unsigned fkey_u(unsigned u) { return u ^ ((unsigned)((int)u >> 31) | 0x80000000u); }
DI float unfkey(unsigned k) { return __uint_as_float(k ^ ((~(unsigned)((int)k >> 31)) | 0x80000000u)); }
DI void cswap(unsigned& a, unsigned& b) { const unsigned hi = a > b ? a : b, lo = a > b ? b : a; a = hi; b = lo; }
DI void sort16(unsigned (&t)[16]) {
#pragma unroll
  for (int k = 2; k <= 16; k <<= 1)
#pragma unroll
    for (int j = k >> 1; j > 0; j >>= 1)
#pragma unroll
      for (int i = 0; i < 16; ++i) {
        const int l = i ^ j;
        if (l > i) { if ((i & k) == 0) cswap(t[i], t[l]); else cswap(t[l], t[i]); }
      }
}
DI void merge16(unsigned (&a)[16], const unsigned (&b)[16]) {
#pragma unroll
  for (int j = 0; j < 16; ++j) a[j] = a[j] > b[15 - j] ? a[j] : b[15 - j];
#pragma unroll
  for (int j = 8; j > 0; j >>= 1)
#pragma unroll
    for (int i = 0; i < 16; ++i) { const int l = i ^ j; if (l > i) cswap(a[i], a[l]); }
}
DI void cswap2(unsigned& ak, int& ap, unsigned& bk, int& bp) {
  const bool sw = bk > ak;
  const unsigned hk = sw ? bk : ak, lk = sw ? ak : bk;
  const int hp = sw ? bp : ap, lp = sw ? ap : bp;
  ak = hk; ap = hp; bk = lk; bp = lp;
}
DI void sort16p(unsigned (&t)[16], int (&q)[16]) {
#pragma unroll
  for (int k = 2; k <= 16; k <<= 1)
#pragma unroll
    for (int j = k >> 1; j > 0; j >>= 1)
#pragma unroll
      for (int i = 0; i < 16; ++i) {
        const int l = i ^ j;
        if (l > i) { if ((i & k) == 0) cswap2(t[i], q[i], t[l], q[l]); else cswap2(t[l], q[l], t[i], q[i]); }
      }
}
__device__ constexpr int CIA[25] = {0,0,0,0,0,0,0,0,0,0,0,0,0,0,0,0, 2,2,2,2,2, 3,3,3,3};
__device__ constexpr int CJA[25] = {0,1,2,3,4,5,6,7,8,9,10,11,12,13,14,15, 0,1,2,3,4, 0,1,2,3};
__device__ constexpr int CIB[25] = {1,1,1,1,1,1,1,1, 4,4,4, 5,5,6,6,7,7, 8,9,10,11,12,13,14,15};
__device__ constexpr int CJB[25] = {0,1,2,3,4,5,6,7, 0,1,2, 0,1,0,1,0,1, 0,0,0,0,0,0,0,0};

DI void peer_topk_wave(const Params& p, int layer, int item) {
  const int head = item >> 10, tok0 = (item & 1023) * 32;
  const bf16_t* Q = (const bf16_t*)(p.ws + OFF_BIG);
  const bf16_t* KEYS = (const bf16_t*)(p.ws + OFF_KEYS) + (size_t)(layer * 8 + head) * 256 * 64;
  int* E = (int*)(p.ws + OFF_E);
  float* G = (float*)(p.ws + OFF_G);
  const int lane = threadIdx.x & 63, r = lane & 31, h = lane >> 5;
  const unsigned h4 = 4u * (1u - (unsigned)h);
  unsigned tl[2][16];
#pragma unroll
  for (int set = 0; set < 2; ++set) {
    bf16x8 qf[4];
    const bf16_t* qrow = Q + (size_t)(tok0 + r) * 1024 + head * 128 + set * 64 + h * 8;
#pragma unroll
    for (int s = 0; s < 4; ++s) qf[s] = *(const bf16x8*)(qrow + s * 16);
#pragma unroll
    for (int kt = 0; kt < 4; ++kt) {
      const bf16_t* krow = KEYS + (size_t)(set * 128 + kt * 32 + r) * 64 + h * 8;
      f32x16 X = zero16();
#pragma unroll
      for (int s = 0; s < 4; ++s) X = mfma32(*(const bf16x8*)(krow + s * 16), qf[s], X);
      unsigned kk[16];
#pragma unroll
      for (int i = 0; i < 16; ++i)
        kk[i] = (fkey_u(__float_as_uint(X[i])) & ~127u) + ((unsigned)(127 - kt * 32 - (i & 3) - 8 * (i >> 2) - 4) + h4);
      sort16(kk);
      if (kt == 0) {
#pragma unroll
        for (int i = 0; i < 16; ++i) tl[set][i] = kk[i];
      } else merge16(tl[set], kk);
    }
  }
  unsigned mine[16], oth[16];
#pragma unroll
  for (int j = 0; j < 16; ++j) {
    const unsigned send = h ? tl[0][j] : tl[1][j];
    oth[j] = (unsigned)__shfl_xor((int)send, 32);
    mine[j] = h ? tl[1][j] : tl[0][j];
  }
  merge16(mine, oth);
  float v1[16], v2[16]; int i1[16], i2[16];
#pragma unroll
  for (int j = 0; j < 16; ++j) {
    const unsigned o = (unsigned)__shfl_xor((int)mine[j], 32);
    const unsigned A = h ? o : mine[j], B = h ? mine[j] : o;
    v1[j] = unfkey(A & ~127u); i1[j] = 127 - (int)(A & 127u);
    v2[j] = unfkey(B & ~127u); i2[j] = 127 - (int)(B & 127u);
  }
  unsigned ck[16], dk[16]; int cp[16], dp[16];
#pragma unroll
  for (int n = 0; n < 32; ++n) {
    unsigned key = 0u; int e = 0;
    if (n < 25) {
      const float sA = v1[CIA[n]] + v2[CJA[n]], sB = v1[CIB[n]] + v2[CJB[n]];
      const int eA = i1[CIA[n]] * 128 + i2[CJA[n]], eB = i1[CIB[n]] * 128 + i2[CJB[n]];
      key = fkey_u(__float_as_uint(h ? sB : sA)); e = h ? eB : eA;
    }
    if (n < 16) { ck[n] = key; cp[n] = e; } else { dk[n - 16] = key; dp[n - 16] = e; }
  }
  sort16p(ck, cp);
  sort16p(dk, dp);
#pragma unroll
  for (int j = 0; j < 16; ++j) { const bool sw = dk[15 - j] > ck[j]; ck[j] = sw ? dk[15 - j] : ck[j]; cp[j] = sw ? dp[15 - j] : cp[j]; }
#pragma unroll
  for (int j = 8; j > 0; j >>= 1)
#pragma unroll
    for (int i = 0; i < 16; ++i) { const int l = i ^ j; if (l > i) cswap2(ck[i], cp[i], ck[l], cp[l]); }
  unsigned fk[16]; int fe[16];
#pragma unroll
  for (int j = 0; j < 16; ++j) { dk[j] = (unsigned)__shfl_xor((int)ck[j], 32); dp[j] = __shfl_xor(cp[j], 32); }
#pragma unroll
  for (int j = 0; j < 16; ++j) {
    const bool sw = (dk[15 - j] > ck[j]) || (dk[15 - j] == ck[j] && dp[15 - j] > cp[j]);
    fk[j] = sw ? dk[15 - j] : ck[j]; fe[j] = sw ? dp[15 - j] : cp[j];
  }
  float sv[16], mx = -INFINITY;
#pragma unroll
  for (int j = 0; j < 16; ++j) { sv[j] = unfkey(fk[j]); mx = fmaxf(mx, sv[j]); }
  float sm = 0.f;
#pragma unroll
  for (int j = 0; j < 16; ++j) { sv[j] = __expf(sv[j] - mx); sm += sv[j]; }
  const float inv = 1.f / sm;
  const size_t o = ((size_t)(tok0 + r) * 8 + head) * 16 + h * 8;
  *(int4*)(E + o) = make_int4(fe[0], fe[1], fe[2], fe[3]);
  *(int4*)(E + o + 4) = make_int4(fe[4], fe[5], fe[6], fe[7]);
  *(float4*)(G + o) = make_float4(sv[0] * inv, sv[1] * inv, sv[2] * inv, sv[3] * inv);
  *(float4*)(G + o + 4) = make_float4(sv[4] * inv, sv[5] * inv, sv[6] * inv, sv[7] * inv);
}

DI v32f fp6x32(const uint2* p) {
  const uint2 a = p[0], b = p[1], c = p[2];
  v6u x; x[0] = a.x; x[1] = a.y; x[2] = b.x; x[3] = b.y; x[4] = c.x; x[5] = c.y;
  return __builtin_amdgcn_cvt_scalef32_pk32_f32_fp6(x, 1.0f);
}

DI void peer_gather_u(const Params& p, int layer, char* smem) {
  const int tid = threadIdx.x, lane = tid & 63, w = tid >> 6, grp = lane >> 4, i16 = lane & 15;
  float* a_s = (float*)smem + w * 512;
  float* su_s = a_s + 128;
  float* gv_s = a_s + 256;
  int* e_s = (int*)(a_s + 384);
  const bf16_t* HN = (const bf16_t*)(p.ws + OFF_ACT_A);
  const unsigned char* U = (const unsigned char*)(p.ws + OFF_TBL_U) + (size_t)layer * 16 * MiB;
  const float* IU = (const float*)(p.ws + OFF_INV) + (layer * 2 + 0) * 16384;
  const float* IV = (const float*)(p.ws + OFF_INV) + (layer * 2 + 1) * 16384;
  const int* E = (const int*)(p.ws + OFF_E);
  const float* G = (const float*)(p.ws + OFF_G);
  float* A = (float*)(p.ws + OFF_A);
  for (int tok = blockIdx.x * 4 + w; tok < T_TOK; tok += gridDim.x * 4) {
    float xf[2][32];
#pragma unroll
    for (int c = 0; c < 2; ++c) {
      const uint4* xp = (const uint4*)(HN + (size_t)tok * 1024 + c * 512 + i16 * 32);
#pragma unroll
      for (int q = 0; q < 4; ++q) {
        const uint4 x0 = xp[q];
        xf[c][8 * q + 0] = bflo(x0.x); xf[c][8 * q + 1] = bfhi(x0.x); xf[c][8 * q + 2] = bflo(x0.y); xf[c][8 * q + 3] = bfhi(x0.y);
        xf[c][8 * q + 4] = bflo(x0.z); xf[c][8 * q + 5] = bfhi(x0.z); xf[c][8 * q + 6] = bflo(x0.w); xf[c][8 * q + 7] = bfhi(x0.w);
      }
    }
    {
      const int e0 = E[(size_t)tok * 128 + lane], e1 = E[(size_t)tok * 128 + 64 + lane];
      e_s[lane] = e0; e_s[64 + lane] = e1;
      su_s[lane] = IU[e0]; su_s[64 + lane] = IU[e1];
      gv_s[lane] = G[(size_t)tok * 128 + lane] * IV[e0]; gv_s[64 + lane] = G[(size_t)tok * 128 + 64 + lane] * IV[e1];
    }
    wave_sync();
#pragma unroll 4
    for (int mm = 0; mm < 32; ++mm) {
      const int pidx = 4 * mm + grp;
      const unsigned char* up = U + (size_t)e_s[pidx] * 768 + i16 * 24;
      const v32f u0 = fp6x32((const uint2*)up), u1 = fp6x32((const uint2*)(up + 384));
      float acc0 = 0.f, acc1 = 0.f;
#pragma unroll
      for (int i = 0; i < 32; ++i) { acc0 = fmaf(u0[i], xf[0][i], acc0); acc1 = fmaf(u1[i], xf[1][i], acc1); }
      float acc = acc0 + acc1;
      acc += __shfl_xor(acc, 1); acc += __shfl_xor(acc, 2); acc += __shfl_xor(acc, 4); acc += __shfl_xor(acc, 8);
      acc *= su_s[pidx];
      const float a = 0.5f * acc * (1.f + erff(acc * 0.7071067811865476f)) * gv_s[pidx];
      if (i16 == 0) a_s[pidx] = a;
    }
    wave_sync();
    A[(size_t)tok * 128 + lane] = a_s[lane];
    A[(size_t)tok * 128 + 64 + lane] = a_s[64 + lane];
    wave_sync();
  }
}

DI void peer_gather_v(const Params& p, int layer, char* smem, const float* __restrict__ next_gain) {
  const int tid = threadIdx.x, lane = tid & 63, w = tid >> 6, r = lane & 31, h = lane >> 5;
  float* a_s = (float*)smem + w * 256;
  int* e_s = (int*)(a_s + 128);
  const unsigned char* V = (const unsigned char*)(p.ws + OFF_TBL_V) + (size_t)layer * 16 * MiB;
  const int* E = (const int*)(p.ws + OFF_E);
  const float* A = (const float*)(p.ws + OFF_A);
  for (int tok = blockIdx.x * 4 + w; tok < T_TOK; tok += gridDim.x * 4) {
    e_s[lane] = E[(size_t)tok * 128 + lane]; e_s[64 + lane] = E[(size_t)tok * 128 + 64 + lane];
    a_s[lane] = A[(size_t)tok * 128 + lane]; a_s[64 + lane] = A[(size_t)tok * 128 + 64 + lane];
    wave_sync();
    float o[32];
#pragma unroll
    for (int i = 0; i < 32; ++i) o[i] = 0.f;
#pragma unroll 8
    for (int mm = 0; mm < 64; ++mm) {
      const int pidx = 2 * mm + h;
      const float a = a_s[pidx];
      const v32f vv = fp6x32((const uint2*)(V + (size_t)e_s[pidx] * 768 + r * 24));
#pragma unroll
      for (int i = 0; i < 32; ++i) o[i] = fmaf(a, vv[i], o[i]);
    }
#pragma unroll
    for (int i = 0; i < 32; ++i) o[i] += __shfl_xor(o[i], 32);
    float4* hp = (float4*)(p.out + (size_t)tok * 1024 + r * 32 + h * 16);
    float4 hv[4];
    float ss = 0.f;
#pragma unroll
    for (int q = 0; q < 4; ++q) {
      float4 t = hp[q];
      t.x += h ? o[16 + 4 * q] : o[4 * q]; t.y += h ? o[17 + 4 * q] : o[4 * q + 1];
      t.z += h ? o[18 + 4 * q] : o[4 * q + 2]; t.w += h ? o[19 + 4 * q] : o[4 * q + 3];
      hp[q] = t; hv[q] = t;
      ss += t.x * t.x + t.y * t.y + t.z * t.z + t.w * t.w;
    }
    if (next_gain) {
#pragma unroll
      for (int o2 = 32; o2 >= 1; o2 >>= 1) ss += __shfl_xor(ss, o2);
      const float rs = rsqrtf(ss * (1.f / 1024.f) + 1e-6f);
      const float4* gp = (const float4*)(next_gain + r * 32 + h * 16);
      unsigned pw[8];
#pragma unroll
      for (int q = 0; q < 4; ++q) {
        const float4 g = gp[q];
        pw[2 * q] = pk(hv[q].x * rs * g.x, hv[q].y * rs * g.y); pw[2 * q + 1] = pk(hv[q].z * rs * g.z, hv[q].w * rs * g.w);
      }
      uint4* dp = (uint4*)((bf16_t*)(p.ws + OFF_ACT_A) + (size_t)tok * 1024 + r * 32 + h * 16);
      dp[0] = make_uint4(pw[0], pw[1], pw[2], pw[3]); dp[1] = make_uint4(pw[4], pw[5], pw[6], pw[7]);
    }
    wave_sync();
  }
}

DI void run_phase(const Params& p, int ph, char* smem) {
  bf16_t* actA = (bf16_t*)(p.ws + OFF_ACT_A);
  bf16_t* big = (bf16_t*)(p.ws + OFF_BIG);
  switch (ph) {
    case 0: phase_convert(p, smem); phase_cvt_tables(p, 0); phase_cvt_tables(p, 1); break;
    case 1: phase_rmsnorm(p.x, p.ln_mix, actA); break;
    case 2: phase_gemm<EPI_GLA_IN>(p, actA, (const bf16_t*)(p.ws + OFF_WT_GLA_IN), 25, big, 3072, nullptr, smem); break;
    case 3: for (int it = blockIdx.x; it < 2048; it += gridDim.x) gla_phase1(p, it, smem); break;
    case 4: gla_scan(p); break;
    case 5: for (int it = blockIdx.x; it < 2048; it += gridDim.x) gla_phase3(p, it, smem); break;
    case 6: phase_gemm<EPI_RESID_X>(p, actA, (const bf16_t*)(p.ws + OFF_WT_GLA_OUT), 8, nullptr, 0, nullptr, smem); break;
    case 7: phase_rmsnorm(p.out, p.ln_ffn, actA); break;
    case 8: phase_gemm<EPI_BF16>(p, actA, (const bf16_t*)(p.ws + OFF_WT_PQ), 8, big, 1024, nullptr, smem); break;
    case 9: for (int it = blockIdx.x * 4 + (threadIdx.x >> 6); it < 8192; it += gridDim.x * 4) peer_topk_wave(p, 0, it); break;
    case 10: peer_gather_u(p, 0, smem); break;
    case 11: peer_gather_v(p, 0, smem, p.ln_mix + 1024); break;
    case 12: break;
    case 13: phase_gemm<EPI_BF16>(p, actA, (const bf16_t*)(p.ws + OFF_WT_SWA_IN), 10, big, 1280, p.swa_b_in, smem); break;
    case 14: swa_qknorm(p); break;
    case 15: for (int it = blockIdx.x; it < 4096; it += gridDim.x) swa_attn(p, it, smem); break;
    case 16: phase_gemm<EPI_RESID_INPLACE>(p, (const bf16_t*)(p.ws + OFF_ACT_B), (const bf16_t*)(p.ws + OFF_WT_SWA_OUT), 8, nullptr, 0, p.swa_b_out, smem); break;
    case 17: phase_rmsnorm(p.out, p.ln_ffn + 1024, actA); break;
    case 18: phase_gemm<EPI_BF16>(p, actA, (const bf16_t*)(p.ws + OFF_WT_PQ) + (size_t)1024 * 1024, 8, big, 1024, nullptr, smem); break;
    case 19: for (int it = blockIdx.x * 4 + (threadIdx.x >> 6); it < 8192; it += gridDim.x * 4) peer_topk_wave(p, 1, it); break;
    case 20: peer_gather_u(p, 1, smem); break;
    case 21: peer_gather_v(p, 1, smem, nullptr); break;
    default: break;
  }
}

template <int PH>
__global__ void __launch_bounds__(256, 2) phase_kernel(Params p) {
  __shared__ __attribute__((aligned(16))) char smem[SMEM_BYTES];
  run_phase(p, PH, smem);
}

template <int PH>
static void launch_phases(const Params& p, int grid, hipStream_t stream) {
  hipLaunchKernelGGL(phase_kernel<PH>, dim3(grid), dim3(256), 0, stream, p);
  if constexpr (PH + 1 < NPHASE) launch_phases<PH + 1>(p, grid, stream);
}


#define XB_TMO      128
#define XB_XCNT(j)  (256  + 64 * (j))
#define XB_XSUB(j)  (1280 + 64 * (j))
#define XB_XGEN(j)  (2304 + 64 * (j))
#define XB_TOP      3328
#define XB_TOPGEN   3392
#define XCD_BAR_WORDS 3456
#define XB_SPIN_CAP (1u << 23)
#define LAS __attribute__((address_space(3)))
DI unsigned xb_ld(unsigned* p) { return __hip_atomic_load(p, __ATOMIC_RELAXED, __HIP_MEMORY_SCOPE_AGENT); }
DI unsigned xb_add(unsigned* p, unsigned v) { return __hip_atomic_fetch_add(p, v, __ATOMIC_RELAXED, __HIP_MEMORY_SCOPE_AGENT); }
DI unsigned xb_xcc_id() { return (unsigned)__builtin_amdgcn_s_getreg((3 << 11) | 20) & 0xFu; }
#define XB_SPIN(cond, bar) do { unsigned _sp = 0; while (cond) { __builtin_amdgcn_s_sleep(1); \
    if ((++_sp & 255u) == 0u) { if (xb_ld(&(bar)[XB_TMO])) break; if (_sp > XB_SPIN_CAP) { atomicAdd(&(bar)[XB_TMO], 1u); break; } } } } while (0)
struct XcdBarrier { unsigned* bar; unsigned x; volatile LAS unsigned* st; };
DI XcdBarrier xcd_barrier_post(unsigned* bar, volatile LAS unsigned* st) {
  XcdBarrier b; b.bar = bar; b.x = xb_xcc_id(); b.st = st;
  if (threadIdx.x == 0) (void)xb_add(&bar[XB_XCNT(b.x)], 1u);
  return b;
}
DI void xcd_barrier_complete(unsigned* bar, unsigned x, unsigned& nloc, unsigned& nx) {
  const unsigned G = gridDim.x * gridDim.y * gridDim.z;
  unsigned sum, cnt, mine, sp = 0u;
  for (;;) {
    sum = 0u; cnt = 0u; mine = 0u;
#pragma unroll
    for (unsigned j = 0; j < 16; ++j) { const unsigned c = xb_ld(&bar[XB_XCNT(j)]); sum += c; cnt += (c > 0u) ? 1u : 0u; mine = (j == x) ? c : mine; }
    if (sum == G) break;
    __builtin_amdgcn_s_sleep(1);
    if ((++sp & 255u) == 0u) { if (xb_ld(&bar[XB_TMO])) break; if (sp > XB_SPIN_CAP) { atomicAdd(&bar[XB_TMO], 1u); break; } }
  }
  nloc = mine > 0u ? mine : 1u; nx = cnt > 0u ? cnt : 1u;
}
DI void xcd_barrier(const XcdBarrier& b) {
  asm volatile("s_waitcnt vmcnt(0)" ::: "memory");
  __syncthreads();
  if (threadIdx.x == 0) {
    unsigned* bar = b.bar;
    __builtin_amdgcn_s_waitcnt(0);
    unsigned nloc = b.st[0], nx = b.st[1];
    if (nloc == 0u) { xcd_barrier_complete(bar, b.x, nloc, nx); b.st[0] = nloc; b.st[1] = nx; }
    const unsigned old = xb_add(&bar[XB_XSUB(b.x)], 1u);
    const unsigned gen = old / nloc;
    if (old + 1u == (gen + 1u) * nloc) {
      __builtin_amdgcn_fence(__ATOMIC_RELEASE, "agent");
      asm volatile("s_waitcnt vmcnt(0)" ::: "memory");
      const unsigned og = xb_add(&bar[XB_TOP], 1u);
      const unsigned tg = og / nx;
      if (og + 1u == (tg + 1u) * nx) xb_add(&bar[XB_TOPGEN], 1u);
      else XB_SPIN(xb_ld(&bar[XB_TOPGEN]) == tg, bar);
      __builtin_amdgcn_fence(__ATOMIC_ACQUIRE, "agent");
      xb_add(&bar[XB_XGEN(b.x)], 1u);
      asm volatile("s_waitcnt vmcnt(0)" ::: "memory");
    } else {
      XB_SPIN(xb_ld(&bar[XB_XGEN(b.x)]) == gen, bar);
      __builtin_amdgcn_fence(__ATOMIC_ACQUIRE, "agent");
      asm volatile("s_waitcnt vmcnt(0)" ::: "memory");
    }
  }
  __syncthreads();
}

#if !MULTI_LAUNCH
template <int PH>
DI void run_all(const Params& p, char* smem, const XcdBarrier& xb) {
  if constexpr (PH != 12) {
    run_phase(p, PH, smem);
    if constexpr (PH + 1 < NPHASE) {
      if constexpr (PH == 0) cg::this_grid().sync();
      else xcd_barrier(xb);
    }
  }
  if constexpr (PH + 1 < NPHASE) run_all<PH + 1>(p, smem, xb);
}
__global__ void __launch_bounds__(256, 2) trunk_kernel(Params p) {
  __shared__ __attribute__((aligned(16))) char smem[SMEM_BYTES];
  __shared__ uint4 xb_words;
  if (threadIdx.x == 0) xb_words = make_uint4(0u, 0u, 0u, 0u);
  __syncthreads();
  const XcdBarrier xb = xcd_barrier_post((unsigned*)(p.ws + OFF_BAR), (volatile LAS unsigned*)&xb_words);
  run_all<0>(p, smem, xb);
}
#endif

extern "C" void kernel_launch(void* const* d_in, const int* in_sizes, int n_in, void* d_out, int out_size, void* d_ws, size_t ws_size,
                              hipStream_t stream) {
  Params p{};
  p.x = (const float*)d_in[0]; p.pos = (const int*)d_in[1]; p.ln_mix = (const float*)d_in[2]; p.ln_ffn = (const float*)d_in[3];
  p.gla_w_in = (const float*)d_in[4]; p.gla_w_alpha = (const float*)d_in[5]; p.gla_b_alpha = (const float*)d_in[6];
  p.gla_norm = (const float*)d_in[7]; p.gla_w_out = (const float*)d_in[8];
  p.swa_w_in = (const float*)d_in[9]; p.swa_b_in = (const float*)d_in[10]; p.swa_qn = (const float*)d_in[11]; p.swa_kn = (const float*)d_in[12];
  p.swa_sinks = (const float*)d_in[13]; p.swa_w_out = (const float*)d_in[14]; p.swa_b_out = (const float*)d_in[15];
  p.peer_wq = (const float*)d_in[16]; p.peer_keys = (const float*)d_in[17]; p.peer_u = (const float*)d_in[18]; p.peer_v = (const float*)d_in[19];
  p.out = (float*)d_out; p.ws = (char*)d_ws;
  static int grid_blocks = 0;
  if (!grid_blocks) {
    int dev = 0, cus = 0, per_cu = 0;
    (void)hipGetDevice(&dev);
    (void)hipDeviceGetAttribute(&cus, hipDeviceAttributeMultiprocessorCount, dev);
    #if MULTI_LAUNCH
    per_cu = 2;
#else
    (void)hipOccupancyMaxActiveBlocksPerMultiprocessor(&per_cu, trunk_kernel, 256, 0);
#endif
    if (per_cu < 1) per_cu = 1;
    if (per_cu > 2) per_cu = 2;
    grid_blocks = cus * per_cu;
  }
#if MULTI_LAUNCH
  p.phase_lo = 0; p.phase_hi = 0;
  launch_phases<0>(p, grid_blocks, stream);
#else
  p.phase_lo = 0; p.phase_hi = NPHASE - 1;
  void* args[] = {&p};
  (void)hipMemsetAsync((char*)d_ws + OFF_BAR, 0, XCD_BAR_WORDS * 4, stream);
  hipError_t e = hipLaunchCooperativeKernel((void*)trunk_kernel, dim3(grid_blocks), dim3(256), args, 0, stream);
  if (e != hipSuccess) fprintf(stderr, "cooperative launch failed: %s (grid %d)\n", hipGetErrorString(e), grid_blocks);
#endif
}
```

```cpp
#include <hip/hip_runtime.h>
#include <hip/hip_cooperative_groups.h>
#include <stdint.h>
#include <stdio.h>
namespace cg = cooperative_groups;

#ifndef MULTI_LAUNCH
#define MULTI_LAUNCH 0
#endif

#define DI __device__ __forceinline__
typedef unsigned short bf16_t;
typedef __attribute__((ext_vector_type(8))) short bf16x8;
typedef __attribute__((ext_vector_type(16))) float f32x16;
typedef __bf16 bf16x2_t __attribute__((ext_vector_type(2)));
typedef float f32x2_t __attribute__((ext_vector_type(2)));
typedef float f2 __attribute__((ext_vector_type(2)));

constexpr int T_TOK = 32768;
constexpr int SEQ = 16384;
constexpr int DM = 1024;
constexpr int NPHASE = 22;

constexpr size_t MiB = 1048576;
constexpr size_t OFF_WT_GLA_IN = 0;
constexpr size_t OFF_WT_GLA_OUT = 7 * MiB;
constexpr size_t OFF_WT_SWA_IN = 9 * MiB;
constexpr size_t OFF_WT_SWA_OUT = 12 * MiB;
constexpr size_t OFF_WT_PQ = 14 * MiB;
constexpr size_t OFF_KEYS = 18 * MiB;
constexpr size_t OFF_INV = 20 * MiB;
constexpr size_t OFF_TBL_U = 24 * MiB;
constexpr size_t OFF_TBL_V = 56 * MiB;
constexpr size_t OFF_ACT_A = 88 * MiB;
constexpr size_t OFF_BIG = 152 * MiB;
constexpr size_t OFF_E = OFF_BIG + 64 * MiB;
constexpr size_t OFF_G = OFF_BIG + 80 * MiB;
constexpr size_t OFF_A = OFF_BIG + 96 * MiB;
constexpr size_t OFF_KVT = 344 * MiB;
constexpr size_t OFF_ACT_B = OFF_KVT;
constexpr size_t OFF_LR = 472 * MiB;
constexpr size_t OFF_DECAY = 474 * MiB;
constexpr size_t OFF_BAR = 476 * MiB;

constexpr int SMEM_BYTES = 73728;
constexpr int LDK = 72;

struct Params {
  const float* x; const int* pos; const float* ln_mix; const float* ln_ffn;
  const float* gla_w_in; const float* gla_w_alpha; const float* gla_b_alpha; const float* gla_norm; const float* gla_w_out;
  const float* swa_w_in; const float* swa_b_in; const float* swa_qn; const float* swa_kn; const float* swa_sinks;
  const float* swa_w_out; const float* swa_b_out;
  const float* peer_wq; const float* peer_keys; const float* peer_u; const float* peer_v;
  float* out; char* ws;
  int phase_lo, phase_hi;
};

DI unsigned pk(float lo, float hi) { f32x2_t v = {lo, hi}; bf16x2_t b = __builtin_convertvector(v, bf16x2_t); return __builtin_bit_cast(unsigned, b); }
DI bf16_t f2bf(float x) { return (bf16_t)(pk(x, 0.f) & 0xffffu); }
DI float bflo(unsigned w) { return __uint_as_float(w << 16); }
DI float bfhi(unsigned w) { return __uint_as_float(w & 0xffff0000u); }
DI float bf2f(bf16_t b) { return __uint_as_float(((unsigned)b) << 16); }
DI float dot2(unsigned a, unsigned b, float c) { return __builtin_amdgcn_fdot2_f32_bf16(__builtin_bit_cast(bf16x2_t, a), __builtin_bit_cast(bf16x2_t, b), c, false); }
DI int crow(int i, int h) { return (i & 3) + 8 * (i >> 2) + 4 * h; }
DI f32x16 mfma32(bf16x8 a, bf16x8 b, f32x16 c) { return __builtin_amdgcn_mfma_f32_32x32x16_bf16(a, b, c, 0, 0, 0); }
DI f32x16 zero16() { f32x16 z; for (int i = 0; i < 16; ++i) z[i] = 0.f; return z; }
DI void wave_sync() { __builtin_amdgcn_fence(__ATOMIC_RELEASE, "wavefront"); __builtin_amdgcn_wave_barrier(); __builtin_amdgcn_fence(__ATOMIC_ACQUIRE, "wavefront"); }
DI int mbcnt64(unsigned long long m) { return __builtin_amdgcn_mbcnt_hi((unsigned)(m >> 32), __builtin_amdgcn_mbcnt_lo((unsigned)m, 0)); }
DI float logsig(float z) { return fminf(z, 0.f) - __logf(1.f + __expf(-fabsf(z))); }

DI void transpose_tile(const float* __restrict__ src, int N, bf16_t* __restrict__ dst, int kt, int nt, float* sT) {
  const int tid = threadIdx.x;
  const int r = tid >> 4, c4 = (tid & 15) * 4;
#pragma unroll
  for (int i = 0; i < 4; ++i) {
    const int k = kt * 64 + r + 16 * i, n = nt * 64 + c4;
    float4 v = make_float4(0.f, 0.f, 0.f, 0.f);
    if (n + 3 < N) v = *(const float4*)(src + (size_t)k * N + n);
    float* d = sT + (r + 16 * i) * 65 + c4;
    d[0] = v.x; d[1] = v.y; d[2] = v.z; d[3] = v.w;
  }
  __syncthreads();
  const int n = tid >> 2, seg = tid & 3;
  unsigned w[8];
#pragma unroll
  for (int j = 0; j < 8; ++j) w[j] = pk(sT[(seg * 16 + 2 * j) * 65 + n], sT[(seg * 16 + 2 * j + 1) * 65 + n]);
  uint4* d = (uint4*)(dst + (size_t)(nt * 64 + n) * 1024 + kt * 64 + seg * 16);
  d[0] = make_uint4(w[0], w[1], w[2], w[3]);
  d[1] = make_uint4(w[4], w[5], w[6], w[7]);
  __syncthreads();
}

DI void cvt_elems(const float* __restrict__ src, bf16_t* __restrict__ dst, size_t n8) {
  for (size_t i = (size_t)blockIdx.x * 256 + threadIdx.x; i < n8; i += (size_t)gridDim.x * 256) {
    const float4 a = ((const float4*)src)[2 * i], b = ((const float4*)src)[2 * i + 1];
    ((uint4*)dst)[i] = make_uint4(pk(a.x, a.y), pk(a.z, a.w), pk(b.x, b.y), pk(b.z, b.w));
  }
}

DI void phase_convert(const Params& p, char* smem) {
  float* sT = (float*)smem;
  for (int t = blockIdx.x; t < 2144; t += gridDim.x) {
    const float* src; int N, ntn; bf16_t* dst; int local;
    if (t < 800) { src = p.gla_w_in; N = 3088; ntn = 50; dst = (bf16_t*)(p.ws + OFF_WT_GLA_IN); local = t; }
    else if (t < 1056) { src = p.gla_w_out; N = 1024; ntn = 16; dst = (bf16_t*)(p.ws + OFF_WT_GLA_OUT); local = t - 800; }
    else if (t < 1376) { src = p.swa_w_in; N = 1280; ntn = 20; dst = (bf16_t*)(p.ws + OFF_WT_SWA_IN); local = t - 1056; }
    else if (t < 1632) { src = p.swa_w_out; N = 1024; ntn = 16; dst = (bf16_t*)(p.ws + OFF_WT_SWA_OUT); local = t - 1376; }
    else if (t < 1888) { src = p.peer_wq; N = 1024; ntn = 16; dst = (bf16_t*)(p.ws + OFF_WT_PQ); local = t - 1632; }
    else { src = p.peer_wq + (size_t)1024 * 1024; N = 1024; ntn = 16; dst = (bf16_t*)(p.ws + OFF_WT_PQ) + (size_t)1024 * 1024; local = t - 1888; }
    transpose_tile(src, N, dst, local / ntn, local % ntn, sT);
  }
  cvt_elems(p.peer_keys, (bf16_t*)(p.ws + OFF_KEYS), (size_t)2 * 8 * 2 * 128 * 64 / 8);
}

typedef unsigned v6u __attribute__((ext_vector_type(6)));
typedef float v32f __attribute__((ext_vector_type(32)));
DI unsigned fp6_code(float y) {
  const float a = fminf(fabsf(y), 7.5f);
  float c = rintf(a * 8.f);
  c = a >= 2.f ? rintf(a * 4.f) + 8.f : c;
  c = a >= 4.f ? rintf(a * 2.f) + 16.f : c;
  unsigned u = (unsigned)c;
  u = u > 31u ? 31u : u;
  return u | ((__float_as_uint(y) >> 26) & 32u);
}
DI void cvt_table_fp6(const float* __restrict__ src, unsigned char* __restrict__ dst, float* __restrict__ inv, int bid, int nb) {
  const int lane = threadIdx.x & 63, w = threadIdx.x >> 6, r = lane & 31, h = lane >> 5;
  for (int rp = bid * 4 + w; rp < 8192; rp += nb * 4) {
    const int row = rp * 2 + h;
    const float4* sp = (const float4*)(src + (size_t)row * 1024 + r * 32);
    float v[32];
    float mx = 0.f;
#pragma unroll
    for (int i = 0; i < 8; ++i) {
      const float4 t = sp[i];
      v[4 * i] = t.x; v[4 * i + 1] = t.y; v[4 * i + 2] = t.z; v[4 * i + 3] = t.w;
      mx = fmaxf(fmaxf(mx, fmaxf(fabsf(t.x), fabsf(t.y))), fmaxf(fabsf(t.z), fabsf(t.w)));
    }
#pragma unroll
    for (int o = 16; o >= 1; o >>= 1) mx = fmaxf(mx, __shfl_xor(mx, o));
    const float sc = mx > 0.f ? 7.5f / mx : 1.f;
    unsigned c[32];
#pragma unroll
    for (int i = 0; i < 32; ++i) c[i] = fp6_code(v[i] * sc);
    unsigned d[6];
#pragma unroll
    for (int g = 0; g < 2; ++g) {
      const unsigned* q = c + 16 * g;
      d[3 * g + 0] = q[0] | (q[1] << 6) | (q[2] << 12) | (q[3] << 18) | (q[4] << 24) | (q[5] << 30);
      d[3 * g + 1] = (q[5] >> 2) | (q[6] << 4) | (q[7] << 10) | (q[8] << 16) | (q[9] << 22) | (q[10] << 28);
      d[3 * g + 2] = (q[10] >> 4) | (q[11] << 2) | (q[12] << 8) | (q[13] << 14) | (q[14] << 20) | (q[15] << 26);
    }
    uint2* dp = (uint2*)(dst + (size_t)row * 768 + r * 24);
    dp[0] = make_uint2(d[0], d[1]); dp[1] = make_uint2(d[2], d[3]); dp[2] = make_uint2(d[4], d[5]);
    if (r == 0) inv[row] = mx > 0.f ? mx * (1.f / 7.5f) : 1.f;
  }
}
DI void phase_cvt_tables(const Params& p, int layer) {
  const int nb = gridDim.x / 2, bid = blockIdx.x % nb;
  const int rows_lo = (blockIdx.x < nb) ? 0 : 1;
  cvt_table_fp6(p.peer_u + (size_t)layer * 16384 * 1024, (unsigned char*)(p.ws + OFF_TBL_U) + (size_t)layer * 16 * MiB, (float*)(p.ws + OFF_INV) + (layer * 2 + 0) * 16384, bid * 2 + rows_lo, nb * 2);
  cvt_table_fp6(p.peer_v + (size_t)layer * 16384 * 1024, (unsigned char*)(p.ws + OFF_TBL_V) + (size_t)layer * 16 * MiB, (float*)(p.ws + OFF_INV) + (layer * 2 + 1) * 16384, bid * 2 + rows_lo, nb * 2);
}

DI void phase_rmsnorm(const float* __restrict__ src, const float* __restrict__ gain, bf16_t* __restrict__ dst) {
  const int lane = threadIdx.x & 63, w = threadIdx.x >> 6;
  for (int row = blockIdx.x * 4 + w; row < T_TOK; row += gridDim.x * 4) {
    const float4* sp = (const float4*)(src + (size_t)row * DM);
    float4 v[4];
    float ss = 0.f;
#pragma unroll
    for (int i = 0; i < 4; ++i) { v[i] = sp[lane + 64 * i]; ss += v[i].x * v[i].x + v[i].y * v[i].y + v[i].z * v[i].z + v[i].w * v[i].w; }
#pragma unroll
    for (int o = 32; o >= 1; o >>= 1) ss += __shfl_xor(ss, o);
    const float rs = rsqrtf(ss * (1.f / 1024.f) + 1e-6f);
#pragma unroll
    for (int i = 0; i < 4; ++i) {
      const float4 g = ((const float4*)gain)[lane + 64 * i];
      uint2 o2 = make_uint2(pk(v[i].x * rs * g.x, v[i].y * rs * g.y), pk(v[i].z * rs * g.z, v[i].w * rs * g.w));
      *(uint2*)(dst + (size_t)row * DM + (lane + 64 * i) * 4) = o2;
    }
  }
}

DI void mma_64x64(const bf16_t* sA, const bf16_t* sB, int arow0, int brow0, f32x16 (&acc)[2][2], int lane) {
  const int r = lane & 31, h = lane >> 5;
#pragma unroll
  for (int s = 0; s < 4; ++s) {
    bf16x8 a[2], b[2];
#pragma unroll
    for (int mi = 0; mi < 2; ++mi) a[mi] = *(const bf16x8*)(sA + (arow0 + mi * 32 + r) * LDK + s * 16 + h * 8);
#pragma unroll
    for (int ni = 0; ni < 2; ++ni) b[ni] = *(const bf16x8*)(sB + (brow0 + ni * 32 + r) * LDK + s * 16 + h * 8);
#pragma unroll
    for (int mi = 0; mi < 2; ++mi)
#pragma unroll
      for (int ni = 0; ni < 2; ++ni) acc[mi][ni] = mfma32(a[mi], b[ni], acc[mi][ni]);
  }
}

enum { EPI_GLA_IN = 0, EPI_RESID_X = 1, EPI_BF16 = 2, EPI_RESID_INPLACE = 3 };

template <int MODE>
DI void phase_gemm(const Params& p, const bf16_t* __restrict__ A, const bf16_t* __restrict__ Bt, int NT, bf16_t* dstb, int ldc,
                   const float* __restrict__ bias, char* smem) {
  const int ntiles = (T_TOK / 128) * NT;
  int t = blockIdx.x;
  if (t >= ntiles) return;
  bf16_t* sA = (bf16_t*)smem;
  bf16_t* sB = sA + 128 * LDK;
  bf16_t* ct = (bf16_t*)smem;
  const int tid = threadIdx.x, lane = tid & 63, w = tid >> 6, wm = w >> 1, wn = w & 1;
  const int r = lane & 31, h = lane >> 5;
  const int lrow = tid >> 3, kc = tid & 7;
  bf16_t* wa = sA + lrow * LDK + kc * 8;
  bf16_t* wb = sB + lrow * LDK + kc * 8;
  bf16x8 ra0[4], rb0[4], ra1[4], rb1[4];
  int m0 = (t / NT) * 128, n0 = (t % NT) * 128;
  const bf16_t* ap = A + (size_t)(m0 + lrow) * 1024 + kc * 8;
  const bf16_t* bp = Bt + (size_t)(n0 + lrow) * 1024 + kc * 8;
#define GLOAD(RA, RB, KT) _Pragma("unroll") for (int i = 0; i < 4; ++i) { RA[i] = *(const bf16x8*)(ap + (size_t)i * 32 * 1024 + (KT) * 64); RB[i] = *(const bf16x8*)(bp + (size_t)i * 32 * 1024 + (KT) * 64); }
#define SSTORE(RA, RB) _Pragma("unroll") for (int i = 0; i < 4; ++i) { *(bf16x8*)(wa + 32 * i * LDK) = RA[i]; *(bf16x8*)(wb + 32 * i * LDK) = RB[i]; }
  GLOAD(ra0, rb0, 0)
  GLOAD(ra1, rb1, 1)
  for (; t < ntiles; t += gridDim.x) {
    f32x16 acc[2][2];
#pragma unroll
    for (int i = 0; i < 2; ++i)
#pragma unroll
      for (int j = 0; j < 2; ++j) acc[i][j] = zero16();
    __syncthreads();
    SSTORE(ra0, rb0)
    __syncthreads();
    for (int kt = 0; kt < 16; kt += 2) {
      if (kt + 2 < 16) { GLOAD(ra0, rb0, kt + 2) }
      mma_64x64(sA, sB, wm * 64, wn * 64, acc, lane);
      __syncthreads();
      SSTORE(ra1, rb1)
      __syncthreads();
      if (kt + 3 < 16) { GLOAD(ra1, rb1, kt + 3) }
      mma_64x64(sA, sB, wm * 64, wn * 64, acc, lane);
      __syncthreads();
      if (kt + 2 < 16) {
        SSTORE(ra0, rb0)
        __syncthreads();
      }
    }
    const int cm0 = m0, cn0 = n0;
    {
      const int tn = t + gridDim.x;
      if (tn < ntiles) {
        m0 = (tn / NT) * 128; n0 = (tn % NT) * 128;
        ap = A + (size_t)(m0 + lrow) * 1024 + kc * 8;
        bp = Bt + (size_t)(n0 + lrow) * 1024 + kc * 8;
        GLOAD(ra0, rb0, 0)
        GLOAD(ra1, rb1, 1)
      }
    }
    const bool staged = (MODE == EPI_BF16) || (MODE == EPI_GLA_IN && cn0 < 3072);
    if (staged) {
#pragma unroll
      for (int ni = 0; ni < 2; ++ni) {
        const int col = wn * 64 + ni * 32 + r;
        const float bv = (MODE == EPI_BF16 && bias) ? bias[cn0 + col] : 0.f;
#pragma unroll
        for (int mi = 0; mi < 2; ++mi)
#pragma unroll
          for (int i = 0; i < 16; ++i) ct[(wm * 64 + mi * 32 + crow(i, h)) * 136 + col] = f2bf(acc[mi][ni][i] + bv);
      }
      __syncthreads();
      const int ldo = (MODE == EPI_GLA_IN) ? 3072 : ldc;
#pragma unroll
      for (int j = 0; j < 8; ++j) {
        const int c = tid + 256 * j, row = c >> 4, cc = c & 15;
        *(uint4*)(dstb + (size_t)(cm0 + row) * ldo + cn0 + cc * 8) = *(const uint4*)(ct + row * 136 + cc * 8);
      }
    } else {
      const unsigned row0 = (unsigned)(cm0 + wm * 64 + 4 * h), col0 = (unsigned)(cn0 + wn * 64 + r);
      float* __restrict__ lrp = (float*)(p.ws + OFF_LR);
#pragma unroll
      for (int ni = 0; ni < 2; ++ni) {
        const unsigned col = col0 + ni * 32;
        float bv = 0.f;
        if (MODE == EPI_RESID_INPLACE) bv = bias[col];
        const unsigned i0 = row0 * 1024u + col;
        const unsigned l0 = row0 * 16u + (col - 3072u);
#pragma unroll
        for (int mi = 0; mi < 2; ++mi)
#pragma unroll
          for (int i = 0; i < 16; ++i) {
            const unsigned ro = (unsigned)(mi * 32 + (i & 3) + 8 * (i >> 2));
            const float v = acc[mi][ni][i];
            if (MODE == EPI_GLA_IN) { if (col < 3088u) lrp[l0 + ro * 16u] = v; }
            else if (MODE == EPI_RESID_X) p.out[i0 + ro * 1024u] = p.x[i0 + ro * 1024u] + v;
            else if (MODE == EPI_RESID_INPLACE) p.out[i0 + ro * 1024u] += v + bv;
          }
      }
    }
  }
#undef GLOAD
#undef SSTORE
}

DI float gate_la(const float* lr_s, int t, const float (&wa)[16], float ba) {
  float z = ba;
#pragma unroll
  for (int j = 0; j < 16; ++j) z += lr_s[t * 16 + j] * wa[j];
  return logsig(z) * (1.f / 16.f);
}
DI void gla_gates(const Params& p, int t0, int hh, float (&wa)[16], float& ba, float& offset, float& blast, float* lr_s, float* tot_s) {
  const int tid = threadIdx.x, d = tid & 127, half = tid >> 7;
  const float* LR = (const float*)(p.ws + OFF_LR);
  ((float4*)lr_s)[tid] = ((const float4*)(LR + (size_t)t0 * 16))[tid];
#pragma unroll
  for (int j = 0; j < 16; ++j) wa[j] = p.gla_w_alpha[j * 512 + hh * 128 + d];
  ba = p.gla_b_alpha[hh * 128 + d];
  __syncthreads();
  float sum = 0.f;
#pragma unroll 4
  for (int tt = 0; tt < 32; ++tt) sum += gate_la(lr_s, half * 32 + tt, wa, ba);
  tot_s[half * 128 + d] = sum;
  __syncthreads();
  offset = half ? tot_s[d] : 0.f;
  blast = tot_s[d] + tot_s[128 + d];
}

DI void fill_vT(const bf16_t* __restrict__ QKVR, int t0, int hh, int vh, bf16_t* vT) {
  const int tid = threadIdx.x, v = tid & 127, half = tid >> 7;
#pragma unroll 8
  for (int tt = 0; tt < 32; ++tt) {
    const int t = half * 32 + tt;
    vT[v * LDK + t] = QKVR[(size_t)(t0 + t) * 3072 + 1024 + hh * 256 + vh * 128 + v];
  }
}

DI void gla_phase1(const Params& p, int item, char* smem) {
  const int hh = item & 3, c = (item >> 2) & 255, b = item >> 10;
  const int t0 = b * SEQ + c * 64;
  float* lr_s = (float*)smem;
  float* tot_s = (float*)(smem + 4096);
  bf16_t* kfT = (bf16_t*)(smem + 5120);
  bf16_t* vT = kfT + 128 * LDK;
  const bf16_t* QKVR = (const bf16_t*)(p.ws + OFF_BIG);
  bf16_t* KVT = (bf16_t*)(p.ws + OFF_KVT);
  float* DECAY = (float*)(p.ws + OFF_DECAY);
  const int tid = threadIdx.x, lane = tid & 63, w = tid >> 6, wm = w >> 1, wn = w & 1;
  const int d = tid & 127, half = tid >> 7;
  float wa[16], ba, offset, blast;
  gla_gates(p, t0, hh, wa, ba, offset, blast, lr_s, tot_s);
  float run = offset;
#pragma unroll 4
  for (int tt = 0; tt < 32; ++tt) {
    const int t = half * 32 + tt;
    run += gate_la(lr_s, t, wa, ba);
    ((float*)(p.ws + OFF_ACT_A))[(size_t)(t0 + t) * 512 + hh * 128 + d] = run;
    const float kv = bf2f(QKVR[(size_t)(t0 + t) * 3072 + 512 + hh * 128 + d]);
    kfT[d * LDK + t] = f2bf(kv * __expf(blast - run));
  }
  if (half == 0) DECAY[(size_t)item * 128 + d] = __expf(blast);
  const int r = lane & 31, h = lane >> 5;
  for (int vh = 0; vh < 2; ++vh) {
    __syncthreads();
    fill_vT(QKVR, t0, hh, vh, vT);
    __syncthreads();
    f32x16 acc[2][2];
#pragma unroll
    for (int i = 0; i < 2; ++i)
#pragma unroll
      for (int j = 0; j < 2; ++j) acc[i][j] = zero16();
    mma_64x64(vT, kfT, wm * 64, wn * 64, acc, lane);
    bf16_t* kbase = KVT + (size_t)item * 32768 + (vh * 128 + wm * 64 + 4 * h) * 128 + wn * 64 + r;
#pragma unroll
    for (int mi = 0; mi < 2; ++mi)
#pragma unroll
      for (int ni = 0; ni < 2; ++ni)
#pragma unroll
        for (int i = 0; i < 16; ++i) kbase[(mi * 32 + (i & 3) + 8 * (i >> 2)) * 128 + ni * 32] = f2bf(acc[mi][ni][i]);
  }
  __syncthreads();
}

DI void gla_scan(const Params& p) {
  bf16_t* KVT = (bf16_t*)(p.ws + OFF_KVT);
  const float* DECAY = (const float*)(p.ws + OFF_DECAY);
  for (int idx = blockIdx.x * 256 + threadIdx.x; idx < 8 * 16384; idx += gridDim.x * 256) {
    const int bh = idx >> 14, e2 = idx & 16383, b = bh >> 2, hh = bh & 3, d0 = (2 * e2) & 127;
    float s0 = 0.f, s1 = 0.f;
    for (int c0 = 0; c0 < 256; c0 += 8) {
      unsigned kv[8]; float2 dc[8];
#pragma unroll
      for (int u = 0; u < 8; ++u) {
        const size_t item = (size_t)(b * 256 + c0 + u) * 4 + hh;
        kv[u] = *(const unsigned*)(KVT + item * 32768 + 2 * e2);
        dc[u] = *(const float2*)(DECAY + item * 128 + d0);
      }
#pragma unroll
      for (int u = 0; u < 8; ++u) {
        const size_t item = (size_t)(b * 256 + c0 + u) * 4 + hh;
        *(unsigned*)(KVT + item * 32768 + 2 * e2) = pk(s0, s1);
        s0 = dc[u].x * s0 + bflo(kv[u]);
        s1 = dc[u].y * s1 + bfhi(kv[u]);
      }
    }
  }
}

DI void gla_phase3(const Params& p, int item, char* smem) {
  const int hh = item & 3, c = (item >> 2) & 255, b = item >> 10;
  const int t0 = b * SEQ + c * 64;
  float* lr_s = (float*)smem;
  float* tot_s = (float*)(smem + 4096);
  bf16_t* qd = (bf16_t*)(smem + 5120);
  bf16_t* ki = qd + 64 * 136;
  bf16_t* at = ki + 64 * 136;
  bf16_t* vT = at + 64 * 72;
  bf16_t* ot = qd;
  const bf16_t* QKVR = (const bf16_t*)(p.ws + OFF_BIG);
  const bf16_t* ST = (const bf16_t*)(p.ws + OFF_KVT);
  bf16_t* OG = (bf16_t*)(p.ws + OFF_ACT_A);
  const int tid = threadIdx.x, lane = tid & 63, w = tid >> 6;
  const int d = tid & 127, half = tid >> 7;
  const int r = lane & 31, h = lane >> 5;
  {
    const float* Bc = (const float*)(p.ws + OFF_ACT_A);
#pragma unroll 8
    for (int tt = 0; tt < 32; ++tt) {
      const int t = half * 32 + tt;
      const float run = Bc[(size_t)(t0 + t) * 512 + hh * 128 + d];
      const float q = bf2f(QKVR[(size_t)(t0 + t) * 3072 + hh * 128 + d]);
      const float k = bf2f(QKVR[(size_t)(t0 + t) * 3072 + 512 + hh * 128 + d]);
      qd[t * 136 + d] = f2bf(q * 0.08838834764831845f * __expf(run));
      ki[t * 136 + d] = f2bf(k * __expf(-run));
    }
  }
  __syncthreads();
  {
    const int mi = w >> 1, nj = w & 1;
    f32x16 a = zero16();
#pragma unroll
    for (int s = 0; s < 8; ++s) {
      const bf16x8 A = *(const bf16x8*)(qd + (mi * 32 + r) * 136 + s * 16 + h * 8);
      const bf16x8 B = *(const bf16x8*)(ki + (nj * 32 + r) * 136 + s * 16 + h * 8);
      a = mfma32(A, B, a);
    }
#pragma unroll
    for (int i = 0; i < 16; ++i) {
      const int it = mi * 32 + crow(i, h), jt = nj * 32 + r;
      at[it * 72 + jt] = f2bf(jt <= it ? a[i] : 0.f);
    }
  }
  f32x16 o[2][2];
#pragma unroll
  for (int i = 0; i < 2; ++i)
#pragma unroll
    for (int j = 0; j < 2; ++j) o[i][j] = zero16();
#pragma unroll
  for (int vh = 0; vh < 2; ++vh) {
    __syncthreads();
    fill_vT(QKVR, t0, hh, vh, vT);
    __syncthreads();
#pragma unroll
    for (int s = 0; s < 4; ++s) {
      const bf16x8 B = *(const bf16x8*)(vT + (w * 32 + r) * LDK + s * 16 + h * 8);
#pragma unroll
      for (int mt = 0; mt < 2; ++mt) {
        const bf16x8 A = *(const bf16x8*)(at + (mt * 32 + r) * 72 + s * 16 + h * 8);
        o[vh][mt] = mfma32(A, B, o[vh][mt]);
      }
    }
    const bf16_t* Sg = ST + (size_t)item * 32768 + (size_t)(vh * 128 + w * 32 + r) * 128 + h * 8;
#pragma unroll
    for (int s = 0; s < 8; ++s) {
      const bf16x8 B = *(const bf16x8*)(Sg + s * 16);
#pragma unroll
      for (int mt = 0; mt < 2; ++mt) {
        const bf16x8 A = *(const bf16x8*)(qd + (mt * 32 + r) * 136 + s * 16 + h * 8);
        o[vh][mt] = mfma32(A, B, o[vh][mt]);
      }
    }
  }
  __syncthreads();
#pragma unroll
  for (int vh = 0; vh < 2; ++vh)
#pragma unroll
    for (int mt = 0; mt < 2; ++mt)
#pragma unroll
      for (int i = 0; i < 16; ++i) ot[(mt * 32 + crow(i, h)) * 264 + vh * 128 + w * 32 + r] = f2bf(o[vh][mt][i]);
  __syncthreads();
  {
    const int row = tid >> 2, seg = tid & 3;
    const bf16_t* orow = ot + row * 264 + seg * 64;
    float ss = 0.f;
#pragma unroll
    for (int c8 = 0; c8 < 8; ++c8) {
      const uint4 ov = *(const uint4*)(orow + c8 * 8);
      const float f0 = bflo(ov.x), f1 = bfhi(ov.x), f2 = bflo(ov.y), f3 = bfhi(ov.y), f4 = bflo(ov.z), f5 = bfhi(ov.z), f6 = bflo(ov.w), f7 = bfhi(ov.w);
      ss += f0 * f0 + f1 * f1 + f2 * f2 + f3 * f3 + f4 * f4 + f5 * f5 + f6 * f6 + f7 * f7;
    }
    ss += __shfl_xor(ss, 1);
    ss += __shfl_xor(ss, 2);
    const float rs = rsqrtf(ss * (1.f / 256.f) + 1e-6f);
    const bf16_t* rrow = QKVR + (size_t)(t0 + row) * 3072 + 2048 + hh * 256 + seg * 64;
    const float* grow = p.gla_norm + hh * 256 + seg * 64;
    bf16_t* dst = OG + (size_t)(t0 + row) * 1024 + hh * 256 + seg * 64;
#pragma unroll
    for (int c8 = 0; c8 < 8; ++c8) {
      const uint4 ov = *(const uint4*)(orow + c8 * 8);
      const uint4 rv = *(const uint4*)(rrow + c8 * 8);
      const float4 g0 = *(const float4*)(grow + c8 * 8), g1 = *(const float4*)(grow + c8 * 8 + 4);
      float of[8] = {bflo(ov.x), bfhi(ov.x), bflo(ov.y), bfhi(ov.y), bflo(ov.z), bfhi(ov.z), bflo(ov.w), bfhi(ov.w)};
      float rf[8] = {bflo(rv.x), bfhi(rv.x), bflo(rv.y), bfhi(rv.y), bflo(rv.z), bfhi(rv.z), bflo(rv.w), bfhi(rv.w)};
      float gf[8] = {g0.x, g0.y, g0.z, g0.w, g1.x, g1.y, g1.z, g1.w};
      float res[8];
#pragma unroll
      for (int e = 0; e < 8; ++e) res[e] = of[e] * rs * gf[e] * (rf[e] / (1.f + __expf(-rf[e])));
      *(uint4*)(dst + c8 * 8) = make_uint4(pk(res[0], res[1]), pk(res[2], res[3]), pk(res[4], res[5]), pk(res[6], res[7]));
    }
  }
  __syncthreads();
}

DI void swa_qknorm(const Params& p) {
  bf16_t* QKV = (bf16_t*)(p.ws + OFF_BIG);
  const int tid = threadIdx.x, sub = tid & 7;
  const int ngroups = T_TOK * 18;
  for (int g = blockIdx.x * 32 + (tid >> 3); g < ngroups; g += gridDim.x * 32) {
    const int tok = g / 18, slot = g - tok * 18;
    bf16_t* ptr = QKV + (size_t)tok * 1280 + slot * 64 + sub * 8;
    const uint4 wv = *(const uint4*)ptr;
    float v[8] = {bflo(wv.x), bfhi(wv.x), bflo(wv.y), bfhi(wv.y), bflo(wv.z), bfhi(wv.z), bflo(wv.w), bfhi(wv.w)};
    float ss = 0.f;
#pragma unroll
    for (int e = 0; e < 8; ++e) ss += v[e] * v[e];
    ss += __shfl_xor(ss, 1);
    ss += __shfl_xor(ss, 2);
    ss += __shfl_xor(ss, 4);
    const float rs = rsqrtf(ss * (1.f / 64.f) + 1e-6f);
    const float* gain = (slot < 16 ? p.swa_qn : p.swa_kn) + sub * 8;
#pragma unroll
    for (int e = 0; e < 8; ++e) v[e] = v[e] * rs * gain[e];
    const float posf = (float)p.pos[tok];
    const float invf[8] = {1.0f, 0.1939227432012558f, 0.03760603070259094f, 0.007292664609849453f,
                           0.0014142135623842478f, 0.00027424818836152554f, 5.318296098266728e-05f, 1.0313386155758053e-05f};
#pragma unroll
    for (int e = 0; e < 8; ++e) {
      const float other = __shfl_xor(v[e], 1);
      if (sub < 2) {
        const float ang = posf * invf[e];
        const double rev = (double)ang * 0.15915494309189535;
        const float fr = (float)(rev - rint(rev));
        const float sn = __builtin_amdgcn_sinf(fr), cs = __builtin_amdgcn_cosf(fr);
        v[e] = (sub == 0) ? (v[e] * cs - other * sn) : (v[e] * cs + other * sn);
      }
    }
    if (slot < 16) {
#pragma unroll
      for (int e = 0; e < 8; ++e) v[e] *= 0.125f;
    }
    *(uint4*)ptr = make_uint4(pk(v[0], v[1]), pk(v[2], v[3]), pk(v[4], v[5]), pk(v[6], v[7]));
  }
}

DI void swa_attn(const Params& p, int item, char* smem) {
  const int hq = item & 15, n = (item >> 4) & 127, b = item >> 11, hkv = hq >> 3;
  const int tok0 = b * SEQ + n * 128;
  bf16_t* Ks = (bf16_t*)smem;
  bf16_t* vT = Ks + 256 * 72;
  const bf16_t* QKV = (const bf16_t*)(p.ws + OFF_BIG);
  bf16_t* OUT = (bf16_t*)(p.ws + OFF_ACT_B);
  const int tid = threadIdx.x, lane = tid & 63, w = tid >> 6, r = lane & 31, h = lane >> 5;
  __syncthreads();
#pragma unroll
  for (int i = 0; i < 8; ++i) {
    const int cidx = tid + 256 * i, kk = cidx >> 3, kc = cidx & 7;
    const int pos = n * 128 - 128 + kk;
    uint4 kw = make_uint4(0, 0, 0, 0), vw = make_uint4(0, 0, 0, 0);
    if (pos >= 0) {
      const bf16_t* base = QKV + (size_t)(b * SEQ + pos) * 1280;
      kw = *(const uint4*)(base + 1024 + hkv * 64 + kc * 8);
      vw = *(const uint4*)(base + 1152 + hkv * 64 + kc * 8);
    }
    *(uint4*)(Ks + kk * 72 + kc * 8) = kw;
    bf16_t* vd = vT + (kc * 8) * 264 + kk;
    vd[0 * 264] = (bf16_t)(vw.x & 0xffff); vd[1 * 264] = (bf16_t)(vw.x >> 16);
    vd[2 * 264] = (bf16_t)(vw.y & 0xffff); vd[3 * 264] = (bf16_t)(vw.y >> 16);
    vd[4 * 264] = (bf16_t)(vw.z & 0xffff); vd[5 * 264] = (bf16_t)(vw.z >> 16);
    vd[6 * 264] = (bf16_t)(vw.w & 0xffff); vd[7 * 264] = (bf16_t)(vw.w >> 16);
  }
  __syncthreads();
  const int iq = 32 * w + r;
  const bf16_t* qrow = QKV + (size_t)(tok0 + iq) * 1280 + hq * 64 + h * 8;
  bf16x8 qf[4];
#pragma unroll
  for (int s = 0; s < 4; ++s) qf[s] = *(const bf16x8*)(qrow + s * 16);
  f32x16 X[5];
#pragma unroll
  for (int kt = 0; kt < 5; ++kt) {
    X[kt] = zero16();
#pragma unroll
    for (int s = 0; s < 4; ++s) {
      const bf16x8 A = *(const bf16x8*)(Ks + ((w + kt) * 32 + r) * 72 + s * 16 + h * 8);
      X[kt] = mfma32(A, qf[s], X[kt]);
    }
  }
  const float sink = p.swa_sinks[hq];
  float m = sink;
#pragma unroll
  for (int kt = 0; kt < 5; ++kt)
#pragma unroll
    for (int i = 0; i < 16; ++i) {
      const int kk = (w + kt) * 32 + crow(i, h);
      const bool valid = (kk > iq) && (kk <= iq + 128) && (n > 0 || kk >= 128);
      const float xv = valid ? X[kt][i] : -INFINITY;
      X[kt][i] = xv;
      m = fmaxf(m, xv);
    }
  m = fmaxf(m, __shfl_xor(m, 32));
  float l = 0.f;
#pragma unroll
  for (int kt = 0; kt < 5; ++kt)
#pragma unroll
    for (int i = 0; i < 16; ++i) {
      const float pv = __expf(X[kt][i] - m);
      X[kt][i] = pv;
      l += pv;
    }
  l += __shfl_xor(l, 32);
  l += __expf(sink - m);
  f32x16 O[2];
  O[0] = zero16(); O[1] = zero16();
#pragma unroll
  for (int kt = 0; kt < 5; ++kt)
#pragma unroll
    for (int s2 = 0; s2 < 2; ++s2) {
      const uint4 pw = make_uint4(pk(X[kt][8 * s2 + 0], X[kt][8 * s2 + 1]), pk(X[kt][8 * s2 + 2], X[kt][8 * s2 + 3]),
                                  pk(X[kt][8 * s2 + 4], X[kt][8 * s2 + 5]), pk(X[kt][8 * s2 + 6], X[kt][8 * s2 + 7]));
      const bf16x8 P = __builtin_bit_cast(bf16x8, pw);
#pragma unroll
      for (int mt = 0; mt < 2; ++mt) {
        const bf16_t* vp = vT + (mt * 32 + r) * 264 + (w + kt) * 32 + 16 * s2 + 4 * h;
        const uint2 lo = *(const uint2*)vp, hi = *(const uint2*)(vp + 8);
        const bf16x8 A = __builtin_bit_cast(bf16x8, make_uint4(lo.x, lo.y, hi.x, hi.y));
        O[mt] = mfma32(A, P, O[mt]);
      }
    }
  const float inv = 1.f / l;
  bf16_t* orow = OUT + (size_t)(tok0 + iq) * 1024 + hq * 64 + 4 * h;
#pragma unroll
  for (int mt = 0; mt < 2; ++mt)
#pragma unroll
    for (int g = 0; g < 4; ++g)
      *(uint2*)(orow + mt * 32 + 8 * g) = make_uint2(pk(O[mt][4 * g] * inv, O[mt][4 * g + 1] * inv), pk(O[mt][4 * g + 2] * inv, O[mt][4 * g + 3] * inv));
}

DI unsigned fkey_u(unsigned u) { return u ^ ((unsigned)((int)u >> 31) | 0x80000000u); }
DI float unfkey(unsigned k) { return __uint_as_float(k ^ ((~(unsigned)((int)k >> 31)) | 0x80000000u)); }
DI void cswap(unsigned& a, unsigned& b) { const unsigned hi = a > b ? a : b, lo = a > b ? b : a; a = hi; b = lo; }
DI void sort16(unsigned (&t)[16]) {
#pragma unroll
  for (int k = 2; k <= 16; k <<= 1)
#pragma unroll
    for (int j = k >> 1; j > 0; j >>= 1)
#pragma unroll
      for (int i = 0; i < 16; ++i) {
        const int l = i ^ j;
        if (l > i) { if ((i & k) == 0) cswap(t[i], t[l]); else cswap(t[l], t[i]); }
      }
}
DI void merge16(unsigned (&a)[16], const unsigned (&b)[16]) {
#pragma unroll
  for (int j = 0; j < 16; ++j) a[j] = a[j] > b[15 - j] ? a[j] : b[15 - j];
#pragma unroll
  for (int j = 8; j > 0; j >>= 1)
#pragma unroll
    for (int i = 0; i < 16; ++i) { const int l = i ^ j; if (l > i) cswap(a[i], a[l]); }
}
DI void cswap2(unsigned& ak, int& ap, unsigned& bk, int& bp) {
  const bool sw = bk > ak;
  const unsigned hk = sw ? bk : ak, lk = sw ? ak : bk;
  const int hp = sw ? bp : ap, lp = sw ? ap : bp;
  ak = hk; ap = hp; bk = lk; bp = lp;
}
DI void sort16p(unsigned (&t)[16], int (&q)[16]) {
#pragma unroll
  for (int k = 2; k <= 16; k <<= 1)
#pragma unroll
    for (int j = k >> 1; j > 0; j >>= 1)
#pragma unroll
      for (int i = 0; i < 16; ++i) {
        const int l = i ^ j;
        if (l > i) { if ((i & k) == 0) cswap2(t[i], q[i], t[l], q[l]); else cswap2(t[l], q[l], t[i], q[i]); }
      }
}
__device__ constexpr int CIA[25] = {0,0,0,0,0,0,0,0,0,0,0,0,0,0,0,0, 2,2,2,2,2, 3,3,3,3};
__device__ constexpr int CJA[25] = {0,1,2,3,4,5,6,7,8,9,10,11,12,13,14,15, 0,1,2,3,4, 0,1,2,3};
__device__ constexpr int CIB[25] = {1,1,1,1,1,1,1,1, 4,4,4, 5,5,6,6,7,7, 8,9,10,11,12,13,14,15};
__device__ constexpr int CJB[25] = {0,1,2,3,4,5,6,7, 0,1,2, 0,1,0,1,0,1, 0,0,0,0,0,0,0,0};

DI void peer_topk_wave(const Params& p, int layer, int item) {
  const int head = item >> 10, tok0 = (item & 1023) * 32;
  const bf16_t* Q = (const bf16_t*)(p.ws + OFF_BIG);
  const bf16_t* KEYS = (const bf16_t*)(p.ws + OFF_KEYS) + (size_t)(layer * 8 + head) * 256 * 64;
  int* E = (int*)(p.ws + OFF_E);
  float* G = (float*)(p.ws + OFF_G);
  const int lane = threadIdx.x & 63, r = lane & 31, h = lane >> 5;
  const unsigned h4 = 4u * (1u - (unsigned)h);
  unsigned tl[2][16];
  bf16x8 qf[2][4], kf[4][4];
#pragma unroll
  for (int set = 0; set < 2; ++set) {
    const bf16_t* qrow = Q + (size_t)(tok0 + r) * 1024 + head * 128 + set * 64 + h * 8;
#pragma unroll
    for (int s = 0; s < 4; ++s) qf[set][s] = *(const bf16x8*)(qrow + s * 16);
  }
#pragma unroll
  for (int kt = 0; kt < 4; ++kt)
#pragma unroll
    for (int s = 0; s < 4; ++s) kf[kt][s] = *(const bf16x8*)(KEYS + (size_t)(kt * 32 + r) * 64 + h * 8 + s * 16);
#pragma unroll
  for (int set = 0; set < 2; ++set) {
    f32x16 X[4];
#pragma unroll
    for (int kt = 0; kt < 4; ++kt) {
      X[kt] = zero16();
#pragma unroll
      for (int s = 0; s < 4; ++s) X[kt] = mfma32(kf[kt][s], qf[set][s], X[kt]);
    }
#pragma unroll
    for (int kt = 0; kt < 4; ++kt) {
      if (set == 0 && kt == 2) {
#pragma unroll
        for (int k2 = 0; k2 < 4; ++k2)
#pragma unroll
          for (int s = 0; s < 4; ++s) kf[k2][s] = *(const bf16x8*)(KEYS + (size_t)(128 + k2 * 32 + r) * 64 + h * 8 + s * 16);
      }
      unsigned kk[16];
#pragma unroll
      for (int i = 0; i < 16; ++i)
        kk[i] = (fkey_u(__float_as_uint(X[kt][i])) & ~127u) + ((unsigned)(127 - kt * 32 - (i & 3) - 8 * (i >> 2) - 4) + h4);
      sort16(kk);
      if (kt == 0) {
#pragma unroll
        for (int i = 0; i < 16; ++i) tl[set][i] = kk[i];
      } else merge16(tl[set], kk);
    }
  }
  unsigned mine[16], oth[16];
#pragma unroll
  for (int j = 0; j < 16; ++j) {
    const unsigned send = h ? tl[0][j] : tl[1][j];
    oth[j] = (unsigned)__shfl_xor((int)send, 32);
    mine[j] = h ? tl[1][j] : tl[0][j];
  }
  merge16(mine, oth);
  float v1[16], v2[16]; int i1[16], i2[16];
#pragma unroll
  for (int j = 0; j < 16; ++j) {
    const unsigned o = (unsigned)__shfl_xor((int)mine[j], 32);
    const unsigned A = h ? o : mine[j], B = h ? mine[j] : o;
    v1[j] = unfkey(A & ~127u); i1[j] = 127 - (int)(A & 127u);
    v2[j] = unfkey(B & ~127u); i2[j] = 127 - (int)(B & 127u);
  }
  unsigned ck[16], dk[16]; int cp[16], dp[16];
#pragma unroll
  for (int n = 0; n < 32; ++n) {
    unsigned key = 0u; int e = 0;
    if (n < 25) {
      const float sA = v1[CIA[n]] + v2[CJA[n]], sB = v1[CIB[n]] + v2[CJB[n]];
      const int eA = i1[CIA[n]] * 128 + i2[CJA[n]], eB = i1[CIB[n]] * 128 + i2[CJB[n]];
      key = fkey_u(__float_as_uint(h ? sB : sA)); e = h ? eB : eA;
    }
    if (n < 16) { ck[n] = key; cp[n] = e; } else { dk[n - 16] = key; dp[n - 16] = e; }
  }
  sort16p(ck, cp);
  sort16p(dk, dp);
#pragma unroll
  for (int j = 0; j < 16; ++j) { const bool sw = dk[15 - j] > ck[j]; ck[j] = sw ? dk[15 - j] : ck[j]; cp[j] = sw ? dp[15 - j] : cp[j]; }
#pragma unroll
  for (int j = 8; j > 0; j >>= 1)
#pragma unroll
    for (int i = 0; i < 16; ++i) { const int l = i ^ j; if (l > i) cswap2(ck[i], cp[i], ck[l], cp[l]); }
  unsigned fk[16]; int fe[16];
#pragma unroll
  for (int j = 0; j < 16; ++j) { dk[j] = (unsigned)__shfl_xor((int)ck[j], 32); dp[j] = __shfl_xor(cp[j], 32); }
#pragma unroll
  for (int j = 0; j < 16; ++j) {
    const bool sw = (dk[15 - j] > ck[j]) || (dk[15 - j] == ck[j] && dp[15 - j] > cp[j]);
    fk[j] = sw ? dk[15 - j] : ck[j]; fe[j] = sw ? dp[15 - j] : cp[j];
  }
  float sv[16], mx = -INFINITY;
#pragma unroll
  for (int j = 0; j < 16; ++j) { sv[j] = unfkey(fk[j]); mx = fmaxf(mx, sv[j]); }
  float sm = 0.f;
#pragma unroll
  for (int j = 0; j < 16; ++j) { sv[j] = __expf(sv[j] - mx); sm += sv[j]; }
  const float inv = 1.f / sm;
  const size_t o = ((size_t)(tok0 + r) * 8 + head) * 16 + h * 8;
  *(int4*)(E + o) = make_int4(fe[0], fe[1], fe[2], fe[3]);
  *(int4*)(E + o + 4) = make_int4(fe[4], fe[5], fe[6], fe[7]);
  *(float4*)(G + o) = make_float4(sv[0] * inv, sv[1] * inv, sv[2] * inv, sv[3] * inv);
  *(float4*)(G + o + 4) = make_float4(sv[4] * inv, sv[5] * inv, sv[6] * inv, sv[7] * inv);
}

DI v32f fp6x32(const uint2* p) {
  const uint2 a = p[0], b = p[1], c = p[2];
  v6u x; x[0] = a.x; x[1] = a.y; x[2] = b.x; x[3] = b.y; x[4] = c.x; x[5] = c.y;
  return __builtin_amdgcn_cvt_scalef32_pk32_f32_fp6(x, 1.0f);
}

DI void peer_gather_u(const Params& p, int layer, char* smem) {
  const int tid = threadIdx.x, lane = tid & 63, w = tid >> 6, grp = lane >> 4, i16 = lane & 15;
  float* a_s = (float*)smem + w * 512;
  float* su_s = a_s + 128;
  float* gv_s = a_s + 256;
  int* e_s = (int*)(a_s + 384);
  const bf16_t* HN = (const bf16_t*)(p.ws + OFF_ACT_A);
  const unsigned char* U = (const unsigned char*)(p.ws + OFF_TBL_U) + (size_t)layer * 16 * MiB;
  const float* IU = (const float*)(p.ws + OFF_INV) + (layer * 2 + 0) * 16384;
  const float* IV = (const float*)(p.ws + OFF_INV) + (layer * 2 + 1) * 16384;
  const int* E = (const int*)(p.ws + OFF_E);
  const float* G = (const float*)(p.ws + OFF_G);
  float* A = (float*)(p.ws + OFF_A);
  for (int tok = blockIdx.x * 4 + w; tok < T_TOK; tok += gridDim.x * 4) {
    float xf[2][32];
#pragma unroll
    for (int c = 0; c < 2; ++c) {
      const uint4* xp = (const uint4*)(HN + (size_t)tok * 1024 + c * 512 + i16 * 32);
#pragma unroll
      for (int q = 0; q < 4; ++q) {
        const uint4 x0 = xp[q];
        xf[c][8 * q + 0] = bflo(x0.x); xf[c][8 * q + 1] = bfhi(x0.x); xf[c][8 * q + 2] = bflo(x0.y); xf[c][8 * q + 3] = bfhi(x0.y);
        xf[c][8 * q + 4] = bflo(x0.z); xf[c][8 * q + 5] = bfhi(x0.z); xf[c][8 * q + 6] = bflo(x0.w); xf[c][8 * q + 7] = bfhi(x0.w);
      }
    }
    {
      const int e0 = E[(size_t)tok * 128 + lane], e1 = E[(size_t)tok * 128 + 64 + lane];
      e_s[lane] = e0; e_s[64 + lane] = e1;
      su_s[lane] = IU[e0]; su_s[64 + lane] = IU[e1];
      gv_s[lane] = G[(size_t)tok * 128 + lane] * IV[e0]; gv_s[64 + lane] = G[(size_t)tok * 128 + 64 + lane] * IV[e1];
    }
    wave_sync();
#pragma unroll 4
    for (int mm = 0; mm < 32; ++mm) {
      const int pidx = 4 * mm + grp;
      const unsigned char* up = U + (size_t)e_s[pidx] * 768 + i16 * 24;
      const v32f u0 = fp6x32((const uint2*)up), u1 = fp6x32((const uint2*)(up + 384));
      float acc0 = 0.f, acc1 = 0.f;
#pragma unroll
      for (int i = 0; i < 32; ++i) { acc0 = fmaf(u0[i], xf[0][i], acc0); acc1 = fmaf(u1[i], xf[1][i], acc1); }
      float acc = acc0 + acc1;
      acc += __shfl_xor(acc, 1); acc += __shfl_xor(acc, 2); acc += __shfl_xor(acc, 4); acc += __shfl_xor(acc, 8);
      acc *= su_s[pidx];
      const float a = 0.5f * acc * (1.f + erff(acc * 0.7071067811865476f)) * gv_s[pidx];
      if (i16 == 0) a_s[pidx] = a;
    }
    wave_sync();
    A[(size_t)tok * 128 + lane] = a_s[lane];
    A[(size_t)tok * 128 + 64 + lane] = a_s[64 + lane];
    wave_sync();
  }
}

DI void peer_gather_v(const Params& p, int layer, char* smem, const float* __restrict__ next_gain) {
  const int tid = threadIdx.x, lane = tid & 63, w = tid >> 6, r = lane & 31, h = lane >> 5;
  float* a_s = (float*)smem + w * 256;
  int* e_s = (int*)(a_s + 128);
  const unsigned char* V = (const unsigned char*)(p.ws + OFF_TBL_V) + (size_t)layer * 16 * MiB;
  const int* E = (const int*)(p.ws + OFF_E);
  const float* A = (const float*)(p.ws + OFF_A);
  for (int tok = blockIdx.x * 4 + w; tok < T_TOK; tok += gridDim.x * 4) {
    e_s[lane] = E[(size_t)tok * 128 + lane]; e_s[64 + lane] = E[(size_t)tok * 128 + 64 + lane];
    a_s[lane] = A[(size_t)tok * 128 + lane]; a_s[64 + lane] = A[(size_t)tok * 128 + 64 + lane];
    wave_sync();
    float o[32];
#pragma unroll
    for (int i = 0; i < 32; ++i) o[i] = 0.f;
#pragma unroll 8
    for (int mm = 0; mm < 64; ++mm) {
      const int pidx = 2 * mm + h;
      const float a = a_s[pidx];
      const v32f vv = fp6x32((const uint2*)(V + (size_t)e_s[pidx] * 768 + r * 24));
#pragma unroll
      for (int i = 0; i < 32; ++i) o[i] = fmaf(a, vv[i], o[i]);
    }
#pragma unroll
    for (int i = 0; i < 32; ++i) o[i] += __shfl_xor(o[i], 32);
    float4* hp = (float4*)(p.out + (size_t)tok * 1024 + r * 32 + h * 16);
    float4 hv[4];
    float ss = 0.f;
#pragma unroll
    for (int q = 0; q < 4; ++q) {
      float4 t = hp[q];
      t.x += h ? o[16 + 4 * q] : o[4 * q]; t.y += h ? o[17 + 4 * q] : o[4 * q + 1];
      t.z += h ? o[18 + 4 * q] : o[4 * q + 2]; t.w += h ? o[19 + 4 * q] : o[4 * q + 3];
      hp[q] = t; hv[q] = t;
      ss += t.x * t.x + t.y * t.y + t.z * t.z + t.w * t.w;
    }
    if (next_gain) {
#pragma unroll
      for (int o2 = 32; o2 >= 1; o2 >>= 1) ss += __shfl_xor(ss, o2);
      const float rs = rsqrtf(ss * (1.f / 1024.f) + 1e-6f);
      const float4* gp = (const float4*)(next_gain + r * 32 + h * 16);
      unsigned pw[8];
#pragma unroll
      for (int q = 0; q < 4; ++q) {
        const float4 g = gp[q];
        pw[2 * q] = pk(hv[q].x * rs * g.x, hv[q].y * rs * g.y); pw[2 * q + 1] = pk(hv[q].z * rs * g.z, hv[q].w * rs * g.w);
      }
      uint4* dp = (uint4*)((bf16_t*)(p.ws + OFF_ACT_A) + (size_t)tok * 1024 + r * 32 + h * 16);
      dp[0] = make_uint4(pw[0], pw[1], pw[2], pw[3]); dp[1] = make_uint4(pw[4], pw[5], pw[6], pw[7]);
    }
    wave_sync();
  }
}

DI void run_phase(const Params& p, int ph, char* smem) {
  bf16_t* actA = (bf16_t*)(p.ws + OFF_ACT_A);
  bf16_t* big = (bf16_t*)(p.ws + OFF_BIG);
  switch (ph) {
    case 0: phase_convert(p, smem); phase_cvt_tables(p, 0); phase_cvt_tables(p, 1); break;
    case 1: phase_rmsnorm(p.x, p.ln_mix, actA); break;
    case 2: phase_gemm<EPI_GLA_IN>(p, actA, (const bf16_t*)(p.ws + OFF_WT_GLA_IN), 25, big, 3072, nullptr, smem); break;
    case 3: for (int it = blockIdx.x; it < 2048; it += gridDim.x) gla_phase1(p, it, smem); break;
    case 4: gla_scan(p); break;
    case 5: for (int it = blockIdx.x; it < 2048; it += gridDim.x) gla_phase3(p, it, smem); break;
    case 6: phase_gemm<EPI_RESID_X>(p, actA, (const bf16_t*)(p.ws + OFF_WT_GLA_OUT), 8, nullptr, 0, nullptr, smem); break;
    case 7: phase_rmsnorm(p.out, p.ln_ffn, actA); break;
    case 8: phase_gemm<EPI_BF16>(p, actA, (const bf16_t*)(p.ws + OFF_WT_PQ), 8, big, 1024, nullptr, smem); break;
    case 9: for (int it = blockIdx.x * 4 + (threadIdx.x >> 6); it < 8192; it += gridDim.x * 4) peer_topk_wave(p, 0, it); break;
    case 10: peer_gather_u(p, 0, smem); break;
    case 11: peer_gather_v(p, 0, smem, p.ln_mix + 1024); break;
    case 12: break;
    case 13: phase_gemm<EPI_BF16>(p, actA, (const bf16_t*)(p.ws + OFF_WT_SWA_IN), 10, big, 1280, p.swa_b_in, smem); break;
    case 14: swa_qknorm(p); break;
    case 15: for (int it = blockIdx.x; it < 4096; it += gridDim.x) swa_attn(p, it, smem); break;
    case 16: phase_gemm<EPI_RESID_INPLACE>(p, (const bf16_t*)(p.ws + OFF_ACT_B), (const bf16_t*)(p.ws + OFF_WT_SWA_OUT), 8, nullptr, 0, p.swa_b_out, smem); break;
    case 17: phase_rmsnorm(p.out, p.ln_ffn + 1024, actA); break;
    case 18: phase_gemm<EPI_BF16>(p, actA, (const bf16_t*)(p.ws + OFF_WT_PQ) + (size_t)1024 * 1024, 8, big, 1024, nullptr, smem); break;
    case 19: for (int it = blockIdx.x * 4 + (threadIdx.x >> 6); it < 8192; it += gridDim.x * 4) peer_topk_wave(p, 1, it); break;
    case 20: peer_gather_u(p, 1, smem); break;
    case 21: peer_gather_v(p, 1, smem, nullptr); break;
    default: break;
  }
}

template <int PH>
__global__ void __launch_bounds__(256, 2) phase_kernel(Params p) {
  __shared__ __attribute__((aligned(16))) char smem[SMEM_BYTES];
  run_phase(p, PH, smem);
}

template <int PH>
static void launch_phases(const Params& p, int grid, hipStream_t stream) {
  hipLaunchKernelGGL(phase_kernel<PH>, dim3(grid), dim3(256), 0, stream, p);
  if constexpr (PH + 1 < NPHASE) launch_phases<PH + 1>(p, grid, stream);
}


#define XB_TMO      128
#define XB_XCNT(j)  (256  + 64 * (j))
#define XB_XSUB(j)  (1280 + 64 * (j))
#define XB_XGEN(j)  (2304 + 64 * (j))
#define XB_TOP      3328
#define XB_TOPGEN   3392
#define XCD_BAR_WORDS 3456
#define XB_SPIN_CAP (1u << 23)
#define LAS __attribute__((address_space(3)))
DI unsigned xb_ld(unsigned* p) { return __hip_atomic_load(p, __ATOMIC_RELAXED, __HIP_MEMORY_SCOPE_AGENT); }
DI unsigned xb_add(unsigned* p, unsigned v) { return __hip_atomic_fetch_add(p, v, __ATOMIC_RELAXED, __HIP_MEMORY_SCOPE_AGENT); }
DI unsigned xb_xcc_id() { return (unsigned)__builtin_amdgcn_s_getreg((3 << 11) | 20) & 0xFu; }
#define XB_SPIN(cond, bar) do { unsigned _sp = 0; while (cond) { __builtin_amdgcn_s_sleep(1); \
    if ((++_sp & 255u) == 0u) { if (xb_ld(&(bar)[XB_TMO])) break; if (_sp > XB_SPIN_CAP) { atomicAdd(&(bar)[XB_TMO], 1u); break; } } } } while (0)
struct XcdBarrier { unsigned* bar; unsigned x; volatile LAS unsigned* st; };
DI XcdBarrier xcd_barrier_post(unsigned* bar, volatile LAS unsigned* st) {
  XcdBarrier b; b.bar = bar; b.x = xb_xcc_id(); b.st = st;
  if (threadIdx.x == 0) (void)xb_add(&bar[XB_XCNT(b.x)], 1u);
  return b;
}
DI void xcd_barrier_complete(unsigned* bar, unsigned x, unsigned& nloc, unsigned& nx) {
  const unsigned G = gridDim.x * gridDim.y * gridDim.z;
  unsigned sum, cnt, mine, sp = 0u;
  for (;;) {
    sum = 0u; cnt = 0u; mine = 0u;
#pragma unroll
    for (unsigned j = 0; j < 16; ++j) { const unsigned c = xb_ld(&bar[XB_XCNT(j)]); sum += c; cnt += (c > 0u) ? 1u : 0u; mine = (j == x) ? c : mine; }
    if (sum == G) break;
    __builtin_amdgcn_s_sleep(1);
    if ((++sp & 255u) == 0u) { if (xb_ld(&bar[XB_TMO])) break; if (sp > XB_SPIN_CAP) { atomicAdd(&bar[XB_TMO], 1u); break; } }
  }
  nloc = mine > 0u ? mine : 1u; nx = cnt > 0u ? cnt : 1u;
}
DI void xcd_barrier(const XcdBarrier& b) {
  asm volatile("s_waitcnt vmcnt(0)" ::: "memory");
  __syncthreads();
  if (threadIdx.x == 0) {
    unsigned* bar = b.bar;
    __builtin_amdgcn_s_waitcnt(0);
    unsigned nloc = b.st[0], nx = b.st[1];
    if (nloc == 0u) { xcd_barrier_complete(bar, b.x, nloc, nx); b.st[0] = nloc; b.st[1] = nx; }
    const unsigned old = xb_add(&bar[XB_XSUB(b.x)], 1u);
    const unsigned gen = old / nloc;
    if (old + 1u == (gen + 1u) * nloc) {
      __builtin_amdgcn_fence(__ATOMIC_RELEASE, "agent");
      asm volatile("s_waitcnt vmcnt(0)" ::: "memory");
      const unsigned og = xb_add(&bar[XB_TOP], 1u);
      const unsigned tg = og / nx;
      if (og + 1u == (tg + 1u) * nx) xb_add(&bar[XB_TOPGEN], 1u);
      else XB_SPIN(xb_ld(&bar[XB_TOPGEN]) == tg, bar);
      __builtin_amdgcn_fence(__ATOMIC_ACQUIRE, "agent");
      xb_add(&bar[XB_XGEN(b.x)], 1u);
      asm volatile("s_waitcnt vmcnt(0)" ::: "memory");
    } else {
      XB_SPIN(xb_ld(&bar[XB_XGEN(b.x)]) == gen, bar);
      __builtin_amdgcn_fence(__ATOMIC_ACQUIRE, "agent");
      asm volatile("s_waitcnt vmcnt(0)" ::: "memory");
    }
  }
  __syncthreads();
}

#if !MULTI_LAUNCH
template <int PH>
DI void run_all(const Params& p, char* smem, const XcdBarrier& xb) {
  if constexpr (PH != 12) {
    run_phase(p, PH, smem);
    if constexpr (PH + 1 < NPHASE) {
      if constexpr (PH == 0) cg::this_grid().sync();
      else xcd_barrier(xb);
    }
  }
  if constexpr (PH + 1 < NPHASE) run_all<PH + 1>(p, smem, xb);
}
__global__ void __launch_bounds__(256, 2) trunk_kernel(Params p) {
  __shared__ __attribute__((aligned(16))) char smem[SMEM_BYTES];
  __shared__ uint4 xb_words;
  if (threadIdx.x == 0) xb_words = make_uint4(0u, 0u, 0u, 0u);
  __syncthreads();
  const XcdBarrier xb = xcd_barrier_post((unsigned*)(p.ws + OFF_BAR), (volatile LAS unsigned*)&xb_words);
  run_all<0>(p, smem, xb);
}
#endif

extern "C" void kernel_launch(void* const* d_in, const int* in_sizes, int n_in, void* d_out, int out_size, void* d_ws, size_t ws_size,
                              hipStream_t stream) {
  Params p{};
  p.x = (const float*)d_in[0]; p.pos = (const int*)d_in[1]; p.ln_mix = (const float*)d_in[2]; p.ln_ffn = (const float*)d_in[3];
  p.gla_w_in = (const float*)d_in[4]; p.gla_w_alpha = (const float*)d_in[5]; p.gla_b_alpha = (const float*)d_in[6];
  p.gla_norm = (const float*)d_in[7]; p.gla_w_out = (const float*)d_in[8];
  p.swa_w_in = (const float*)d_in[9]; p.swa_b_in = (const float*)d_in[10]; p.swa_qn = (const float*)d_in[11]; p.swa_kn = (const float*)d_in[12];
  p.swa_sinks = (const float*)d_in[13]; p.swa_w_out = (const float*)d_in[14]; p.swa_b_out = (const float*)d_in[15];
  p.peer_wq = (const float*)d_in[16]; p.peer_keys = (const float*)d_in[17]; p.peer_u = (const float*)d_in[18]; p.peer_v = (const float*)d_in[19];
  p.out = (float*)d_out; p.ws = (char*)d_ws;
  static int grid_blocks = 0;
  if (!grid_blocks) {
    int dev = 0, cus = 0, per_cu = 0;
    (void)hipGetDevice(&dev);
    (void)hipDeviceGetAttribute(&cus, hipDeviceAttributeMultiprocessorCount, dev);
    #if MULTI_LAUNCH
    per_cu = 2;
#else
    (void)hipOccupancyMaxActiveBlocksPerMultiprocessor(&per_cu, trunk_kernel, 256, 0);
#endif
    if (per_cu < 1) per_cu = 1;
    if (per_cu > 2) per_cu = 2;
    grid_blocks = cus * per_cu;
  }
#if MULTI_LAUNCH
  p.phase_lo = 0; p.phase_hi = 0;
  launch_phases<0>(p, grid_blocks, stream);
#else
  p.phase_lo = 0; p.phase_hi = NPHASE - 1;
  void* args[] = {&p};
  (void)hipMemsetAsync((char*)d_ws + OFF_BAR, 0, XCD_BAR_WORDS * 4, stream);
  hipError_t e = hipLaunchCooperativeKernel((void*)trunk_kernel, dim3(grid_blocks), dim3(256), args, 0, stream);
  if (e != hipSuccess) fprintf(stderr, "cooperative launch failed: %s (grid %d)\n", hipGetErrorString(e), grid_blocks);
#endif
}
```

```cpp
#include <hip/hip_runtime.h>
#include <hip/hip_cooperative_groups.h>
#include <stdint.h>
#include <stdio.h>
namespace cg = cooperative_groups;

#ifndef MULTI_LAUNCH
#define MULTI_LAUNCH 0
#endif

#define DI __device__ __forceinline__
typedef unsigned short bf16_t;
typedef __attribute__((ext_vector_type(8))) short bf16x8;
typedef __attribute__((ext_vector_type(16))) float f32x16;
typedef __bf16 bf16x2_t __attribute__((ext_vector_type(2)));
typedef float f32x2_t __attribute__((ext_vector_type(2)));
typedef float f2 __attribute__((ext_vector_type(2)));

constexpr int T_TOK = 32768;
constexpr int SEQ = 16384;
constexpr int DM = 1024;
constexpr int NPHASE = 22;

constexpr size_t MiB = 1048576;
constexpr size_t OFF_WT_GLA_IN = 0;
constexpr size_t OFF_WT_GLA_OUT = 7 * MiB;
constexpr size_t OFF_WT_SWA_IN = 9 * MiB;
constexpr size_t OFF_WT_SWA_OUT = 12 * MiB;
constexpr size_t OFF_WT_PQ = 14 * MiB;
constexpr size_t OFF_KEYS = 18 * MiB;
constexpr size_t OFF_INV = 20 * MiB;
constexpr size_t OFF_TBL_U = 24 * MiB;
constexpr size_t OFF_TBL_V = 56 * MiB;
constexpr size_t OFF_ACT_A = 88 * MiB;
constexpr size_t OFF_BIG = 152 * MiB;
constexpr size_t OFF_E = OFF_BIG + 64 * MiB;
constexpr size_t OFF_G = OFF_BIG + 80 * MiB;
constexpr size_t OFF_A = OFF_BIG + 96 * MiB;
constexpr size_t OFF_KVT = 344 * MiB;
constexpr size_t OFF_ACT_B = OFF_KVT;
constexpr size_t OFF_LR = 472 * MiB;
constexpr size_t OFF_DECAY = 474 * MiB;
constexpr size_t OFF_BAR = 476 * MiB;

constexpr int SMEM_BYTES = 73728;
constexpr int LDK = 72;

struct Params {
  const float* x; const int* pos; const float* ln_mix; const float* ln_ffn;
  const float* gla_w_in; const float* gla_w_alpha; const float* gla_b_alpha; const float* gla_norm; const float* gla_w_out;
  const float* swa_w_in; const float* swa_b_in; const float* swa_qn; const float* swa_kn; const float* swa_sinks;
  const float* swa_w_out; const float* swa_b_out;
  const float* peer_wq; const float* peer_keys; const float* peer_u; const float* peer_v;
  float* out; char* ws;
  int phase_lo, phase_hi;
};

DI unsigned pk(float lo, float hi) { f32x2_t v = {lo, hi}; bf16x2_t b = __builtin_convertvector(v, bf16x2_t); return __builtin_bit_cast(unsigned, b); }
DI bf16_t f2bf(float x) { return (bf16_t)(pk(x, 0.f) & 0xffffu); }
DI float bflo(unsigned w) { return __uint_as_float(w << 16); }
DI float bfhi(unsigned w) { return __uint_as_float(w & 0xffff0000u); }
DI float bf2f(bf16_t b) { return __uint_as_float(((unsigned)b) << 16); }
DI float dot2(unsigned a, unsigned b, float c) { return __builtin_amdgcn_fdot2_f32_bf16(__builtin_bit_cast(bf16x2_t, a), __builtin_bit_cast(bf16x2_t, b), c, false); }
DI int crow(int i, int h) { return (i & 3) + 8 * (i >> 2) + 4 * h; }
DI f32x16 mfma32(bf16x8 a, bf16x8 b, f32x16 c) { return __builtin_amdgcn_mfma_f32_32x32x16_bf16(a, b, c, 0, 0, 0); }
DI f32x16 zero16() { f32x16 z; for (int i = 0; i < 16; ++i) z[i] = 0.f; return z; }
DI void wave_sync() { __builtin_amdgcn_fence(__ATOMIC_RELEASE, "wavefront"); __builtin_amdgcn_wave_barrier(); __builtin_amdgcn_fence(__ATOMIC_ACQUIRE, "wavefront"); }
DI int mbcnt64(unsigned long long m) { return __builtin_amdgcn_mbcnt_hi((unsigned)(m >> 32), __builtin_amdgcn_mbcnt_lo((unsigned)m, 0)); }
DI float logsig(float z) { return fminf(z, 0.f) - __logf(1.f + __expf(-fabsf(z))); }

DI void transpose_tile(const float* __restrict__ src, int N, bf16_t* __restrict__ dst, int kt, int nt, float* sT) {
  const int tid = threadIdx.x;
  const int r = tid >> 4, c4 = (tid & 15) * 4;
#pragma unroll
  for (int i = 0; i < 4; ++i) {
    const int k = kt * 64 + r + 16 * i, n = nt * 64 + c4;
    float4 v = make_float4(0.f, 0.f, 0.f, 0.f);
    if (n + 3 < N) v = *(const float4*)(src + (size_t)k * N + n);
    float* d = sT + (r + 16 * i) * 65 + c4;
    d[0] = v.x; d[1] = v.y; d[2] = v.z; d[3] = v.w;
  }
  __syncthreads();
  const int n = tid >> 2, seg = tid & 3;
  unsigned w[8];
#pragma unroll
  for (int j = 0; j < 8; ++j) w[j] = pk(sT[(seg * 16 + 2 * j) * 65 + n], sT[(seg * 16 + 2 * j + 1) * 65 + n]);
  uint4* d = (uint4*)(dst + (size_t)(nt * 64 + n) * 1024 + kt * 64 + seg * 16);
  d[0] = make_uint4(w[0], w[1], w[2], w[3]);
  d[1] = make_uint4(w[4], w[5], w[6], w[7]);
  __syncthreads();
}

DI void cvt_elems(const float* __restrict__ src, bf16_t* __restrict__ dst, size_t n8) {
  for (size_t i = (size_t)blockIdx.x * 256 + threadIdx.x; i < n8; i += (size_t)gridDim.x * 256) {
    const float4 a = ((const float4*)src)[2 * i], b = ((const float4*)src)[2 * i + 1];
    ((uint4*)dst)[i] = make_uint4(pk(a.x, a.y), pk(a.z, a.w), pk(b.x, b.y), pk(b.z, b.w));
  }
}

DI void phase_convert(const Params& p, char* smem) {
  float* sT = (float*)smem;
  for (int t = blockIdx.x; t < 2144; t += gridDim.x) {
    const float* src; int N, ntn; bf16_t* dst; int local;
    if (t < 800) { src = p.gla_w_in; N = 3088; ntn = 50; dst = (bf16_t*)(p.ws + OFF_WT_GLA_IN); local = t; }
    else if (t < 1056) { src = p.gla_w_out; N = 1024; ntn = 16; dst = (bf16_t*)(p.ws + OFF_WT_GLA_OUT); local = t - 800; }
    else if (t < 1376) { src = p.swa_w_in; N = 1280; ntn = 20; dst = (bf16_t*)(p.ws + OFF_WT_SWA_IN); local = t - 1056; }
    else if (t < 1632) { src = p.swa_w_out; N = 1024; ntn = 16; dst = (bf16_t*)(p.ws + OFF_WT_SWA_OUT); local = t - 1376; }
    else if (t < 1888) { src = p.peer_wq; N = 1024; ntn = 16; dst = (bf16_t*)(p.ws + OFF_WT_PQ); local = t - 1632; }
    else { src = p.peer_wq + (size_t)1024 * 1024; N = 1024; ntn = 16; dst = (bf16_t*)(p.ws + OFF_WT_PQ) + (size_t)1024 * 1024; local = t - 1888; }
    transpose_tile(src, N, dst, local / ntn, local % ntn, sT);
  }
  cvt_elems(p.peer_keys, (bf16_t*)(p.ws + OFF_KEYS), (size_t)2 * 8 * 2 * 128 * 64 / 8);
}

typedef unsigned v6u __attribute__((ext_vector_type(6)));
typedef float v32f __attribute__((ext_vector_type(32)));
DI unsigned fp6_code(float y) {
  const float a = fminf(fabsf(y), 7.5f);
  float c = rintf(a * 8.f);
  c = a >= 2.f ? rintf(a * 4.f) + 8.f : c;
  c = a >= 4.f ? rintf(a * 2.f) + 16.f : c;
  unsigned u = (unsigned)c;
  u = u > 31u ? 31u : u;
  return u | ((__float_as_uint(y) >> 26) & 32u);
}
DI void cvt_table_fp6(const float* __restrict__ src, unsigned char* __restrict__ dst, float* __restrict__ inv, int bid, int nb) {
  const int lane = threadIdx.x & 63, w = threadIdx.x >> 6, r = lane & 31, h = lane >> 5;
  for (int rp = bid * 4 + w; rp < 8192; rp += nb * 4) {
    const int row = rp * 2 + h;
    const float4* sp = (const float4*)(src + (size_t)row * 1024 + r * 32);
    float v[32];
    float mx = 0.f;
#pragma unroll
    for (int i = 0; i < 8; ++i) {
      const float4 t = sp[i];
      v[4 * i] = t.x; v[4 * i + 1] = t.y; v[4 * i + 2] = t.z; v[4 * i + 3] = t.w;
      mx = fmaxf(fmaxf(mx, fmaxf(fabsf(t.x), fabsf(t.y))), fmaxf(fabsf(t.z), fabsf(t.w)));
    }
#pragma unroll
    for (int o = 16; o >= 1; o >>= 1) mx = fmaxf(mx, __shfl_xor(mx, o));
    const float sc = mx > 0.f ? 7.5f / mx : 1.f;
    unsigned c[32];
#pragma unroll
    for (int i = 0; i < 32; ++i) c[i] = fp6_code(v[i] * sc);
    unsigned d[6];
#pragma unroll
    for (int g = 0; g < 2; ++g) {
      const unsigned* q = c + 16 * g;
      d[3 * g + 0] = q[0] | (q[1] << 6) | (q[2] << 12) | (q[3] << 18) | (q[4] << 24) | (q[5] << 30);
      d[3 * g + 1] = (q[5] >> 2) | (q[6] << 4) | (q[7] << 10) | (q[8] << 16) | (q[9] << 22) | (q[10] << 28);
      d[3 * g + 2] = (q[10] >> 4) | (q[11] << 2) | (q[12] << 8) | (q[13] << 14) | (q[14] << 20) | (q[15] << 26);
    }
    uint2* dp = (uint2*)(dst + (size_t)row * 768 + r * 24);
    dp[0] = make_uint2(d[0], d[1]); dp[1] = make_uint2(d[2], d[3]); dp[2] = make_uint2(d[4], d[5]);
    if (r == 0) inv[row] = mx > 0.f ? mx * (1.f / 7.5f) : 1.f;
  }
}
DI void phase_cvt_tables(const Params& p, int layer) {
  const int nb = gridDim.x / 2, bid = blockIdx.x % nb;
  const int rows_lo = (blockIdx.x < nb) ? 0 : 1;
  cvt_table_fp6(p.peer_u + (size_t)layer * 16384 * 1024, (unsigned char*)(p.ws + OFF_TBL_U) + (size_t)layer * 16 * MiB, (float*)(p.ws + OFF_INV) + (layer * 2 + 0) * 16384, bid * 2 + rows_lo, nb * 2);
  cvt_table_fp6(p.peer_v + (size_t)layer * 16384 * 1024, (unsigned char*)(p.ws + OFF_TBL_V) + (size_t)layer * 16 * MiB, (float*)(p.ws + OFF_INV) + (layer * 2 + 1) * 16384, bid * 2 + rows_lo, nb * 2);
}

DI void phase_rmsnorm(const float* __restrict__ src, const float* __restrict__ gain, bf16_t* __restrict__ dst) {
  const int lane = threadIdx.x & 63, w = threadIdx.x >> 6;
  for (int row = blockIdx.x * 4 + w; row < T_TOK; row += gridDim.x * 4) {
    const float4* sp = (const float4*)(src + (size_t)row * DM);
    float4 v[4];
    float ss = 0.f;
#pragma unroll
    for (int i = 0; i < 4; ++i) { v[i] = sp[lane + 64 * i]; ss += v[i].x * v[i].x + v[i].y * v[i].y + v[i].z * v[i].z + v[i].w * v[i].w; }
#pragma unroll
    for (int o = 32; o >= 1; o >>= 1) ss += __shfl_xor(ss, o);
    const float rs = rsqrtf(ss * (1.f / 1024.f) + 1e-6f);
#pragma unroll
    for (int i = 0; i < 4; ++i) {
      const float4 g = ((const float4*)gain)[lane + 64 * i];
      uint2 o2 = make_uint2(pk(v[i].x * rs * g.x, v[i].y * rs * g.y), pk(v[i].z * rs * g.z, v[i].w * rs * g.w));
      *(uint2*)(dst + (size_t)row * DM + (lane + 64 * i) * 4) = o2;
    }
  }
}

DI void mma_64x64(const bf16_t* sA, const bf16_t* sB, int arow0, int brow0, f32x16 (&acc)[2][2], int lane) {
  const int r = lane & 31, h = lane >> 5;
#pragma unroll
  for (int s = 0; s < 4; ++s) {
    bf16x8 a[2], b[2];
#pragma unroll
    for (int mi = 0; mi < 2; ++mi) a[mi] = *(const bf16x8*)(sA + (arow0 + mi * 32 + r) * LDK + s * 16 + h * 8);
#pragma unroll
    for (int ni = 0; ni < 2; ++ni) b[ni] = *(const bf16x8*)(sB + (brow0 + ni * 32 + r) * LDK + s * 16 + h * 8);
#pragma unroll
    for (int mi = 0; mi < 2; ++mi)
#pragma unroll
      for (int ni = 0; ni < 2; ++ni) acc[mi][ni] = mfma32(a[mi], b[ni], acc[mi][ni]);
  }
}

enum { EPI_GLA_IN = 0, EPI_RESID_X = 1, EPI_BF16 = 2, EPI_RESID_INPLACE = 3 };

template <int MODE>
DI void phase_gemm(const Params& p, const bf16_t* __restrict__ A, const bf16_t* __restrict__ Bt, int NT, bf16_t* dstb, int ldc,
                   const float* __restrict__ bias, char* smem) {
  const int ntiles = (T_TOK / 128) * NT;
  int t = (gridDim.x & 7) ? (int)blockIdx.x : (int)((blockIdx.x & 7) * (gridDim.x >> 3) + (blockIdx.x >> 3));
  if (t >= ntiles) return;
  bf16_t* sA = (bf16_t*)smem;
  bf16_t* sB = sA + 128 * LDK;
  bf16_t* ct = (bf16_t*)smem;
  const int tid = threadIdx.x, lane = tid & 63, w = tid >> 6, wm = w >> 1, wn = w & 1;
  const int r = lane & 31, h = lane >> 5;
  const int lrow = tid >> 3, kc = tid & 7;
  bf16_t* wa = sA + lrow * LDK + kc * 8;
  bf16_t* wb = sB + lrow * LDK + kc * 8;
  bf16x8 ra0[4], rb0[4], ra1[4], rb1[4];
  int m0 = (t / NT) * 128, n0 = (t % NT) * 128;
  const bf16_t* ap = A + (size_t)(m0 + lrow) * 1024 + kc * 8;
  const bf16_t* bp = Bt + (size_t)(n0 + lrow) * 1024 + kc * 8;
#define GLOAD(RA, RB, KT) _Pragma("unroll") for (int i = 0; i < 4; ++i) { RA[i] = *(const bf16x8*)(ap + (size_t)i * 32 * 1024 + (KT) * 64); RB[i] = *(const bf16x8*)(bp + (size_t)i * 32 * 1024 + (KT) * 64); }
#define SSTORE(RA, RB) _Pragma("unroll") for (int i = 0; i < 4; ++i) { *(bf16x8*)(wa + 32 * i * LDK) = RA[i]; *(bf16x8*)(wb + 32 * i * LDK) = RB[i]; }
  GLOAD(ra0, rb0, 0)
  GLOAD(ra1, rb1, 1)
  for (; t < ntiles; t += gridDim.x) {
    f32x16 acc[2][2];
#pragma unroll
    for (int i = 0; i < 2; ++i)
#pragma unroll
      for (int j = 0; j < 2; ++j) acc[i][j] = zero16();
    __syncthreads();
    SSTORE(ra0, rb0)
    __syncthreads();
    for (int kt = 0; kt < 16; kt += 2) {
      if (kt + 2 < 16) { GLOAD(ra0, rb0, kt + 2) }
      mma_64x64(sA, sB, wm * 64, wn * 64, acc, lane);
      __syncthreads();
      SSTORE(ra1, rb1)
      __syncthreads();
      if (kt + 3 < 16) { GLOAD(ra1, rb1, kt + 3) }
      mma_64x64(sA, sB, wm * 64, wn * 64, acc, lane);
      __syncthreads();
      if (kt + 2 < 16) {
        SSTORE(ra0, rb0)
        __syncthreads();
      }
    }
    const int cm0 = m0, cn0 = n0;
    {
      const int tn = t + gridDim.x;
      if (tn < ntiles) {
        m0 = (tn / NT) * 128; n0 = (tn % NT) * 128;
        ap = A + (size_t)(m0 + lrow) * 1024 + kc * 8;
        bp = Bt + (size_t)(n0 + lrow) * 1024 + kc * 8;
        GLOAD(ra0, rb0, 0)
        GLOAD(ra1, rb1, 1)
      }
    }
    const bool staged = (MODE == EPI_BF16) || (MODE == EPI_GLA_IN && cn0 < 3072);
    if (staged) {
#pragma unroll
      for (int ni = 0; ni < 2; ++ni) {
        const int col = wn * 64 + ni * 32 + r;
        const float bv = (MODE == EPI_BF16 && bias) ? bias[cn0 + col] : 0.f;
#pragma unroll
        for (int mi = 0; mi < 2; ++mi)
#pragma unroll
          for (int i = 0; i < 16; ++i) ct[(wm * 64 + mi * 32 + crow(i, h)) * 136 + col] = f2bf(acc[mi][ni][i] + bv);
      }
      __syncthreads();
      const int ldo = (MODE == EPI_GLA_IN) ? 3072 : ldc;
#pragma unroll
      for (int j = 0; j < 8; ++j) {
        const int c = tid + 256 * j, row = c >> 4, cc = c & 15;
        *(uint4*)(dstb + (size_t)(cm0 + row) * ldo + cn0 + cc * 8) = *(const uint4*)(ct + row * 136 + cc * 8);
      }
    } else {
      const unsigned row0 = (unsigned)(cm0 + wm * 64 + 4 * h), col0 = (unsigned)(cn0 + wn * 64 + r);
      float* __restrict__ lrp = (float*)(p.ws + OFF_LR);
#pragma unroll
      for (int ni = 0; ni < 2; ++ni) {
        const unsigned col = col0 + ni * 32;
        float bv = 0.f;
        if (MODE == EPI_RESID_INPLACE) bv = bias[col];
        const unsigned i0 = row0 * 1024u + col;
        const unsigned l0 = row0 * 16u + (col - 3072u);
#pragma unroll
        for (int mi = 0; mi < 2; ++mi)
#pragma unroll
          for (int i = 0; i < 16; ++i) {
            const unsigned ro = (unsigned)(mi * 32 + (i & 3) + 8 * (i >> 2));
            const float v = acc[mi][ni][i];
            if (MODE == EPI_GLA_IN) { if (col < 3088u) lrp[l0 + ro * 16u] = v; }
            else if (MODE == EPI_RESID_X) p.out[i0 + ro * 1024u] = p.x[i0 + ro * 1024u] + v;
            else if (MODE == EPI_RESID_INPLACE) p.out[i0 + ro * 1024u] += v + bv;
          }
      }
    }
  }
#undef GLOAD
#undef SSTORE
}

DI float gate_la(const float* lr_s, int t, const float (&wa)[16], float ba) {
  float z = ba;
#pragma unroll
  for (int j = 0; j < 16; ++j) z += lr_s[t * 16 + j] * wa[j];
  return logsig(z) * (1.f / 16.f);
}
DI void gla_gates(const Params& p, int t0, int hh, float (&wa)[16], float& ba, float& offset, float& blast, float* lr_s, float* tot_s) {
  const int tid = threadIdx.x, d = tid & 127, half = tid >> 7;
  const float* LR = (const float*)(p.ws + OFF_LR);
  ((float4*)lr_s)[tid] = ((const float4*)(LR + (size_t)t0 * 16))[tid];
#pragma unroll
  for (int j = 0; j < 16; ++j) wa[j] = p.gla_w_alpha[j * 512 + hh * 128 + d];
  ba = p.gla_b_alpha[hh * 128 + d];
  __syncthreads();
  float sum = 0.f;
#pragma unroll 4
  for (int tt = 0; tt < 32; ++tt) sum += gate_la(lr_s, half * 32 + tt, wa, ba);
  tot_s[half * 128 + d] = sum;
  __syncthreads();
  offset = half ? tot_s[d] : 0.f;
  blast = tot_s[d] + tot_s[128 + d];
}

DI void fill_vT(const bf16_t* __restrict__ QKVR, int t0, int hh, int vh, bf16_t* vT) {
  const int tid = threadIdx.x, v = tid & 127, half = tid >> 7;
#pragma unroll 8
  for (int tt = 0; tt < 32; ++tt) {
    const int t = half * 32 + tt;
    vT[v * LDK + t] = QKVR[(size_t)(t0 + t) * 3072 + 1024 + hh * 256 + vh * 128 + v];
  }
}

DI void gla_phase1(const Params& p, int item, char* smem) {
  const int hh = item & 3, c = (item >> 2) & 255, b = item >> 10;
  const int t0 = b * SEQ + c * 64;
  float* lr_s = (float*)smem;
  float* tot_s = (float*)(smem + 4096);
  bf16_t* kfT = (bf16_t*)(smem + 5120);
  bf16_t* vT = kfT + 128 * LDK;
  const bf16_t* QKVR = (const bf16_t*)(p.ws + OFF_BIG);
  bf16_t* KVT = (bf16_t*)(p.ws + OFF_KVT);
  float* DECAY = (float*)(p.ws + OFF_DECAY);
  const int tid = threadIdx.x, lane = tid & 63, w = tid >> 6, wm = w >> 1, wn = w & 1;
  const int d = tid & 127, half = tid >> 7;
  float wa[16], ba, offset, blast;
  gla_gates(p, t0, hh, wa, ba, offset, blast, lr_s, tot_s);
  float run = offset;
#pragma unroll 4
  for (int tt = 0; tt < 32; ++tt) {
    const int t = half * 32 + tt;
    run += gate_la(lr_s, t, wa, ba);
    ((float*)(p.ws + OFF_ACT_A))[(size_t)(t0 + t) * 512 + hh * 128 + d] = run;
    const float kv = bf2f(QKVR[(size_t)(t0 + t) * 3072 + 512 + hh * 128 + d]);
    kfT[d * LDK + t] = f2bf(kv * __expf(blast - run));
  }
  if (half == 0) DECAY[(size_t)item * 128 + d] = __expf(blast);
  const int r = lane & 31, h = lane >> 5;
  for (int vh = 0; vh < 2; ++vh) {
    __syncthreads();
    fill_vT(QKVR, t0, hh, vh, vT);
    __syncthreads();
    f32x16 acc[2][2];
#pragma unroll
    for (int i = 0; i < 2; ++i)
#pragma unroll
      for (int j = 0; j < 2; ++j) acc[i][j] = zero16();
    mma_64x64(vT, kfT, wm * 64, wn * 64, acc, lane);
    bf16_t* kbase = KVT + (size_t)item * 32768 + (vh * 128 + wm * 64 + 4 * h) * 128 + wn * 64 + r;
#pragma unroll
    for (int mi = 0; mi < 2; ++mi)
#pragma unroll
      for (int ni = 0; ni < 2; ++ni)
#pragma unroll
        for (int i = 0; i < 16; ++i) kbase[(mi * 32 + (i & 3) + 8 * (i >> 2)) * 128 + ni * 32] = f2bf(acc[mi][ni][i]);
  }
  __syncthreads();
}

DI void gla_scan(const Params& p) {
  bf16_t* KVT = (bf16_t*)(p.ws + OFF_KVT);
  const float* DECAY = (const float*)(p.ws + OFF_DECAY);
  for (int idx = blockIdx.x * 256 + threadIdx.x; idx < 8 * 16384; idx += gridDim.x * 256) {
    const int bh = idx >> 14, e2 = idx & 16383, b = bh >> 2, hh = bh & 3, d0 = (2 * e2) & 127;
    float s0 = 0.f, s1 = 0.f;
    for (int c0 = 0; c0 < 256; c0 += 8) {
      unsigned kv[8]; float2 dc[8];
#pragma unroll
      for (int u = 0; u < 8; ++u) {
        const size_t item = (size_t)(b * 256 + c0 + u) * 4 + hh;
        kv[u] = *(const unsigned*)(KVT + item * 32768 + 2 * e2);
        dc[u] = *(const float2*)(DECAY + item * 128 + d0);
      }
#pragma unroll
      for (int u = 0; u < 8; ++u) {
        const size_t item = (size_t)(b * 256 + c0 + u) * 4 + hh;
        *(unsigned*)(KVT + item * 32768 + 2 * e2) = pk(s0, s1);
        s0 = dc[u].x * s0 + bflo(kv[u]);
        s1 = dc[u].y * s1 + bfhi(kv[u]);
      }
    }
  }
}

DI void gla_phase3(const Params& p, int item, char* smem) {
  const int hh = item & 3, c = (item >> 2) & 255, b = item >> 10;
  const int t0 = b * SEQ + c * 64;
  float* lr_s = (float*)smem;
  float* tot_s = (float*)(smem + 4096);
  bf16_t* qd = (bf16_t*)(smem + 5120);
  bf16_t* ki = qd + 64 * 136;
  bf16_t* at = ki + 64 * 136;
  bf16_t* vT = at + 64 * 72;
  bf16_t* ot = qd;
  const bf16_t* QKVR = (const bf16_t*)(p.ws + OFF_BIG);
  const bf16_t* ST = (const bf16_t*)(p.ws + OFF_KVT);
  bf16_t* OG = (bf16_t*)(p.ws + OFF_ACT_A);
  const int tid = threadIdx.x, lane = tid & 63, w = tid >> 6;
  const int d = tid & 127, half = tid >> 7;
  const int r = lane & 31, h = lane >> 5;
  {
    const float* Bc = (const float*)(p.ws + OFF_ACT_A);
#pragma unroll 8
    for (int tt = 0; tt < 32; ++tt) {
      const int t = half * 32 + tt;
      const float run = Bc[(size_t)(t0 + t) * 512 + hh * 128 + d];
      const float q = bf2f(QKVR[(size_t)(t0 + t) * 3072 + hh * 128 + d]);
      const float k = bf2f(QKVR[(size_t)(t0 + t) * 3072 + 512 + hh * 128 + d]);
      qd[t * 136 + d] = f2bf(q * 0.08838834764831845f * __expf(run));
      ki[t * 136 + d] = f2bf(k * __expf(-run));
    }
  }
  __syncthreads();
  {
    const int mi = w >> 1, nj = w & 1;
    f32x16 a = zero16();
#pragma unroll
    for (int s = 0; s < 8; ++s) {
      const bf16x8 A = *(const bf16x8*)(qd + (mi * 32 + r) * 136 + s * 16 + h * 8);
      const bf16x8 B = *(const bf16x8*)(ki + (nj * 32 + r) * 136 + s * 16 + h * 8);
      a = mfma32(A, B, a);
    }
#pragma unroll
    for (int i = 0; i < 16; ++i) {
      const int it = mi * 32 + crow(i, h), jt = nj * 32 + r;
      at[it * 72 + jt] = f2bf(jt <= it ? a[i] : 0.f);
    }
  }
  f32x16 o[2][2];
#pragma unroll
  for (int i = 0; i < 2; ++i)
#pragma unroll
    for (int j = 0; j < 2; ++j) o[i][j] = zero16();
#pragma unroll
  for (int vh = 0; vh < 2; ++vh) {
    __syncthreads();
    fill_vT(QKVR, t0, hh, vh, vT);
    __syncthreads();
#pragma unroll
    for (int s = 0; s < 4; ++s) {
      const bf16x8 B = *(const bf16x8*)(vT + (w * 32 + r) * LDK + s * 16 + h * 8);
#pragma unroll
      for (int mt = 0; mt < 2; ++mt) {
        const bf16x8 A = *(const bf16x8*)(at + (mt * 32 + r) * 72 + s * 16 + h * 8);
        o[vh][mt] = mfma32(A, B, o[vh][mt]);
      }
    }
    const bf16_t* Sg = ST + (size_t)item * 32768 + (size_t)(vh * 128 + w * 32 + r) * 128 + h * 8;
#pragma unroll
    for (int s = 0; s < 8; ++s) {
      const bf16x8 B = *(const bf16x8*)(Sg + s * 16);
#pragma unroll
      for (int mt = 0; mt < 2; ++mt) {
        const bf16x8 A = *(const bf16x8*)(qd + (mt * 32 + r) * 136 + s * 16 + h * 8);
        o[vh][mt] = mfma32(A, B, o[vh][mt]);
      }
    }
  }
  __syncthreads();
#pragma unroll
  for (int vh = 0; vh < 2; ++vh)
#pragma unroll
    for (int mt = 0; mt < 2; ++mt)
#pragma unroll
      for (int i = 0; i < 16; ++i) ot[(mt * 32 + crow(i, h)) * 264 + vh * 128 + w * 32 + r] = f2bf(o[vh][mt][i]);
  __syncthreads();
  {
    const int row = tid >> 2, seg = tid & 3;
    const bf16_t* orow = ot + row * 264 + seg * 64;
    float ss = 0.f;
#pragma unroll
    for (int c8 = 0; c8 < 8; ++c8) {
      const uint4 ov = *(const uint4*)(orow + c8 * 8);
      const float f0 = bflo(ov.x), f1 = bfhi(ov.x), f2 = bflo(ov.y), f3 = bfhi(ov.y), f4 = bflo(ov.z), f5 = bfhi(ov.z), f6 = bflo(ov.w), f7 = bfhi(ov.w);
      ss += f0 * f0 + f1 * f1 + f2 * f2 + f3 * f3 + f4 * f4 + f5 * f5 + f6 * f6 + f7 * f7;
    }
    ss += __shfl_xor(ss, 1);
    ss += __shfl_xor(ss, 2);
    const float rs = rsqrtf(ss * (1.f / 256.f) + 1e-6f);
    const bf16_t* rrow = QKVR + (size_t)(t0 + row) * 3072 + 2048 + hh * 256 + seg * 64;
    const float* grow = p.gla_norm + hh * 256 + seg * 64;
    bf16_t* dst = OG + (size_t)(t0 + row) * 1024 + hh * 256 + seg * 64;
#pragma unroll
    for (int c8 = 0; c8 < 8; ++c8) {
      const uint4 ov = *(const uint4*)(orow + c8 * 8);
      const uint4 rv = *(const uint4*)(rrow + c8 * 8);
      const float4 g0 = *(const float4*)(grow + c8 * 8), g1 = *(const float4*)(grow + c8 * 8 + 4);
      float of[8] = {bflo(ov.x), bfhi(ov.x), bflo(ov.y), bfhi(ov.y), bflo(ov.z), bfhi(ov.z), bflo(ov.w), bfhi(ov.w)};
      float rf[8] = {bflo(rv.x), bfhi(rv.x), bflo(rv.y), bfhi(rv.y), bflo(rv.z), bfhi(rv.z), bflo(rv.w), bfhi(rv.w)};
      float gf[8] = {g0.x, g0.y, g0.z, g0.w, g1.x, g1.y, g1.z, g1.w};
      float res[8];
#pragma unroll
      for (int e = 0; e < 8; ++e) res[e] = of[e] * rs * gf[e] * (rf[e] / (1.f + __expf(-rf[e])));
      *(uint4*)(dst + c8 * 8) = make_uint4(pk(res[0], res[1]), pk(res[2], res[3]), pk(res[4], res[5]), pk(res[6], res[7]));
    }
  }
  __syncthreads();
}

DI void swa_qknorm(const Params& p) {
  bf16_t* QKV = (bf16_t*)(p.ws + OFF_BIG);
  const int tid = threadIdx.x, sub = tid & 7;
  const int ngroups = T_TOK * 18;
  for (int g = blockIdx.x * 32 + (tid >> 3); g < ngroups; g += gridDim.x * 32) {
    const int tok = g / 18, slot = g - tok * 18;
    bf16_t* ptr = QKV + (size_t)tok * 1280 + slot * 64 + sub * 8;
    const uint4 wv = *(const uint4*)ptr;
    float v[8] = {bflo(wv.x), bfhi(wv.x), bflo(wv.y), bfhi(wv.y), bflo(wv.z), bfhi(wv.z), bflo(wv.w), bfhi(wv.w)};
    float ss = 0.f;
#pragma unroll
    for (int e = 0; e < 8; ++e) ss += v[e] * v[e];
    ss += __shfl_xor(ss, 1);
    ss += __shfl_xor(ss, 2);
    ss += __shfl_xor(ss, 4);
    const float rs = rsqrtf(ss * (1.f / 64.f) + 1e-6f);
    const float* gain = (slot < 16 ? p.swa_qn : p.swa_kn) + sub * 8;
#pragma unroll
    for (int e = 0; e < 8; ++e) v[e] = v[e] * rs * gain[e];
    const float posf = (float)p.pos[tok];
    const float invf[8] = {1.0f, 0.1939227432012558f, 0.03760603070259094f, 0.007292664609849453f,
                           0.0014142135623842478f, 0.00027424818836152554f, 5.318296098266728e-05f, 1.0313386155758053e-05f};
#pragma unroll
    for (int e = 0; e < 8; ++e) {
      const float other = __shfl_xor(v[e], 1);
      if (sub < 2) {
        const float ang = posf * invf[e];
        const double rev = (double)ang * 0.15915494309189535;
        const float fr = (float)(rev - rint(rev));
        const float sn = __builtin_amdgcn_sinf(fr), cs = __builtin_amdgcn_cosf(fr);
        v[e] = (sub == 0) ? (v[e] * cs - other * sn) : (v[e] * cs + other * sn);
      }
    }
    if (slot < 16) {
#pragma unroll
      for (int e = 0; e < 8; ++e) v[e] *= 0.125f;
    }
    *(uint4*)ptr = make_uint4(pk(v[0], v[1]), pk(v[2], v[3]), pk(v[4], v[5]), pk(v[6], v[7]));
  }
}

DI void swa_attn(const Params& p, int item, char* smem) {
  const int hq = item & 15, n = (item >> 4) & 127, b = item >> 11, hkv = hq >> 3;
  const int tok0 = b * SEQ + n * 128;
  bf16_t* Ks = (bf16_t*)smem;
  bf16_t* vT = Ks + 256 * 72;
  const bf16_t* QKV = (const bf16_t*)(p.ws + OFF_BIG);
  bf16_t* OUT = (bf16_t*)(p.ws + OFF_ACT_B);
  const int tid = threadIdx.x, lane = tid & 63, w = tid >> 6, r = lane & 31, h = lane >> 5;
  __syncthreads();
#pragma unroll
  for (int i = 0; i < 8; ++i) {
    const int cidx = tid + 256 * i, kk = cidx >> 3, kc = cidx & 7;
    const int pos = n * 128 - 128 + kk;
    uint4 kw = make_uint4(0, 0, 0, 0), vw = make_uint4(0, 0, 0, 0);
    if (pos >= 0) {
      const bf16_t* base = QKV + (size_t)(b * SEQ + pos) * 1280;
      kw = *(const uint4*)(base + 1024 + hkv * 64 + kc * 8);
      vw = *(const uint4*)(base + 1152 + hkv * 64 + kc * 8);
    }
    *(uint4*)(Ks + kk * 72 + kc * 8) = kw;
    bf16_t* vd = vT + (kc * 8) * 264 + kk;
    vd[0 * 264] = (bf16_t)(vw.x & 0xffff); vd[1 * 264] = (bf16_t)(vw.x >> 16);
    vd[2 * 264] = (bf16_t)(vw.y & 0xffff); vd[3 * 264] = (bf16_t)(vw.y >> 16);
    vd[4 * 264] = (bf16_t)(vw.z & 0xffff); vd[5 * 264] = (bf16_t)(vw.z >> 16);
    vd[6 * 264] = (bf16_t)(vw.w & 0xffff); vd[7 * 264] = (bf16_t)(vw.w >> 16);
  }
  __syncthreads();
  const int iq = 32 * w + r;
  const bf16_t* qrow = QKV + (size_t)(tok0 + iq) * 1280 + hq * 64 + h * 8;
  bf16x8 qf[4];
#pragma unroll
  for (int s = 0; s < 4; ++s) qf[s] = *(const bf16x8*)(qrow + s * 16);
  f32x16 X[5];
#pragma unroll
  for (int kt = 0; kt < 5; ++kt) {
    X[kt] = zero16();
#pragma unroll
    for (int s = 0; s < 4; ++s) {
      const bf16x8 A = *(const bf16x8*)(Ks + ((w + kt) * 32 + r) * 72 + s * 16 + h * 8);
      X[kt] = mfma32(A, qf[s], X[kt]);
    }
  }
  const float sink = p.swa_sinks[hq];
  float m = sink;
#pragma unroll
  for (int kt = 0; kt < 5; ++kt)
#pragma unroll
    for (int i = 0; i < 16; ++i) {
      const int kk = (w + kt) * 32 + crow(i, h);
      const bool valid = (kk > iq) && (kk <= iq + 128) && (n > 0 || kk >= 128);
      const float xv = valid ? X[kt][i] : -INFINITY;
      X[kt][i] = xv;
      m = fmaxf(m, xv);
    }
  m = fmaxf(m, __shfl_xor(m, 32));
  float l = 0.f;
#pragma unroll
  for (int kt = 0; kt < 5; ++kt)
#pragma unroll
    for (int i = 0; i < 16; ++i) {
      const float pv = __expf(X[kt][i] - m);
      X[kt][i] = pv;
      l += pv;
    }
  l += __shfl_xor(l, 32);
  l += __expf(sink - m);
  f32x16 O[2];
  O[0] = zero16(); O[1] = zero16();
#pragma unroll
  for (int kt = 0; kt < 5; ++kt)
#pragma unroll
    for (int s2 = 0; s2 < 2; ++s2) {
      const uint4 pw = make_uint4(pk(X[kt][8 * s2 + 0], X[kt][8 * s2 + 1]), pk(X[kt][8 * s2 + 2], X[kt][8 * s2 + 3]),
                                  pk(X[kt][8 * s2 + 4], X[kt][8 * s2 + 5]), pk(X[kt][8 * s2 + 6], X[kt][8 * s2 + 7]));
      const bf16x8 P = __builtin_bit_cast(bf16x8, pw);
#pragma unroll
      for (int mt = 0; mt < 2; ++mt) {
        const bf16_t* vp = vT + (mt * 32 + r) * 264 + (w + kt) * 32 + 16 * s2 + 4 * h;
        const uint2 lo = *(const uint2*)vp, hi = *(const uint2*)(vp + 8);
        const bf16x8 A = __builtin_bit_cast(bf16x8, make_uint4(lo.x, lo.y, hi.x, hi.y));
        O[mt] = mfma32(A, P, O[mt]);
      }
    }
  const float inv = 1.f / l;
  bf16_t* orow = OUT + (size_t)(tok0 + iq) * 1024 + hq * 64 + 4 * h;
#pragma unroll
  for (int mt = 0; mt < 2; ++mt)
#pragma unroll
    for (int g = 0; g < 4; ++g)
      *(uint2*)(orow + mt * 32 + 8 * g) = make_uint2(pk(O[mt][4 * g] * inv, O[mt][4 * g + 1] * inv), pk(O[mt][4 * g + 2] * inv, O[mt][4 * g + 3] * inv));
}

DI unsigned fkey_u(unsigned u) { return u ^ ((unsigned)((int)u >> 31) | 0x80000000u); }
DI float unfkey(unsigned k) { return __uint_as_float(k ^ ((~(unsigned)((int)k >> 31)) | 0x80000000u)); }
DI void cswap(unsigned& a, unsigned& b) { const unsigned hi = a > b ? a : b, lo = a > b ? b : a; a = hi; b = lo; }
DI void sort16(unsigned (&t)[16]) {
#pragma unroll
  for (int k = 2; k <= 16; k <<= 1)
#pragma unroll
    for (int j = k >> 1; j > 0; j >>= 1)
#pragma unroll
      for (int i = 0; i < 16; ++i) {
        const int l = i ^ j;
        if (l > i) { if ((i & k) == 0) cswap(t[i], t[l]); else cswap(t[l], t[i]); }
      }
}
DI void merge16(unsigned (&a)[16], const unsigned (&b)[16]) {
#pragma unroll
  for (int j = 0; j < 16; ++j) a[j] = a[j] > b[15 - j] ? a[j] : b[15 - j];
#pragma unroll
  for (int j = 8; j > 0; j >>= 1)
#pragma unroll
    for (int i = 0; i < 16; ++i) { const int l = i ^ j; if (l > i) cswap(a[i], a[l]); }
}
DI void cswap2(unsigned& ak, int& ap, unsigned& bk, int& bp) {
  const bool sw = bk > ak;
  const unsigned hk = sw ? bk : ak, lk = sw ? ak : bk;
  const int hp = sw ? bp : ap, lp = sw ? ap : bp;
  ak = hk; ap = hp; bk = lk; bp = lp;
}
DI void sort16p(unsigned (&t)[16], int (&q)[16]) {
#pragma unroll
  for (int k = 2; k <= 16; k <<= 1)
#pragma unroll
    for (int j = k >> 1; j > 0; j >>= 1)
#pragma unroll
      for (int i = 0; i < 16; ++i) {
        const int l = i ^ j;
        if (l > i) { if ((i & k) == 0) cswap2(t[i], q[i], t[l], q[l]); else cswap2(t[l], q[l], t[i], q[i]); }
      }
}
__device__ constexpr int CIA[25] = {0,0,0,0,0,0,0,0,0,0,0,0,0,0,0,0, 2,2,2,2,2, 3,3,3,3};
__device__ constexpr int CJA[25] = {0,1,2,3,4,5,6,7,8,9,10,11,12,13,14,15, 0,1,2,3,4, 0,1,2,3};
__device__ constexpr int CIB[25] = {1,1,1,1,1,1,1,1, 4,4,4, 5,5,6,6,7,7, 8,9,10,11,12,13,14,15};
__device__ constexpr int CJB[25] = {0,1,2,3,4,5,6,7, 0,1,2, 0,1,0,1,0,1, 0,0,0,0,0,0,0,0};

DI void peer_topk_wave(const Params& p, int layer, int item) {
  const int head = item >> 10, tok0 = (item & 1023) * 32;
  const bf16_t* Q = (const bf16_t*)(p.ws + OFF_BIG);
  const bf16_t* KEYS = (const bf16_t*)(p.ws + OFF_KEYS) + (size_t)(layer * 8 + head) * 256 * 64;
  int* E = (int*)(p.ws + OFF_E);
  float* G = (float*)(p.ws + OFF_G);
  const int lane = threadIdx.x & 63, r = lane & 31, h = lane >> 5;
  const unsigned h4 = 4u * (1u - (unsigned)h);
  unsigned tl[2][16];
  bf16x8 qf[2][4], kf[4][4];
#pragma unroll
  for (int set = 0; set < 2; ++set) {
    const bf16_t* qrow = Q + (size_t)(tok0 + r) * 1024 + head * 128 + set * 64 + h * 8;
#pragma unroll
    for (int s = 0; s < 4; ++s) qf[set][s] = *(const bf16x8*)(qrow + s * 16);
  }
#pragma unroll
  for (int kt = 0; kt < 4; ++kt)
#pragma unroll
    for (int s = 0; s < 4; ++s) kf[kt][s] = *(const bf16x8*)(KEYS + (size_t)(kt * 32 + r) * 64 + h * 8 + s * 16);
#pragma unroll
  for (int set = 0; set < 2; ++set) {
    f32x16 X[4];
#pragma unroll
    for (int kt = 0; kt < 4; ++kt) {
      X[kt] = zero16();
#pragma unroll
      for (int s = 0; s < 4; ++s) X[kt] = mfma32(kf[kt][s], qf[set][s], X[kt]);
    }
#pragma unroll
    for (int kt = 0; kt < 4; ++kt) {
      if (set == 0 && kt == 2) {
#pragma unroll
        for (int k2 = 0; k2 < 4; ++k2)
#pragma unroll
          for (int s = 0; s < 4; ++s) kf[k2][s] = *(const bf16x8*)(KEYS + (size_t)(128 + k2 * 32 + r) * 64 + h * 8 + s * 16);
      }
      unsigned kk[16];
#pragma unroll
      for (int i = 0; i < 16; ++i)
        kk[i] = (fkey_u(__float_as_uint(X[kt][i])) & ~127u) + ((unsigned)(127 - kt * 32 - (i & 3) - 8 * (i >> 2) - 4) + h4);
      sort16(kk);
      if (kt == 0) {
#pragma unroll
        for (int i = 0; i < 16; ++i) tl[set][i] = kk[i];
      } else merge16(tl[set], kk);
    }
  }
  unsigned mine[16], oth[16];
#pragma unroll
  for (int j = 0; j < 16; ++j) {
    const unsigned send = h ? tl[0][j] : tl[1][j];
    oth[j] = (unsigned)__shfl_xor((int)send, 32);
    mine[j] = h ? tl[1][j] : tl[0][j];
  }
  merge16(mine, oth);
  float v1[16], v2[16]; int i1[16], i2[16];
#pragma unroll
  for (int j = 0; j < 16; ++j) {
    const unsigned o = (unsigned)__shfl_xor((int)mine[j], 32);
    const unsigned A = h ? o : mine[j], B = h ? mine[j] : o;
    v1[j] = unfkey(A & ~127u); i1[j] = 127 - (int)(A & 127u);
    v2[j] = unfkey(B & ~127u); i2[j] = 127 - (int)(B & 127u);
  }
  unsigned ck[16], dk[16]; int cp[16], dp[16];
#pragma unroll
  for (int n = 0; n < 32; ++n) {
    unsigned key = 0u; int e = 0;
    if (n < 25) {
      const float sA = v1[CIA[n]] + v2[CJA[n]], sB = v1[CIB[n]] + v2[CJB[n]];
      const int eA = i1[CIA[n]] * 128 + i2[CJA[n]], eB = i1[CIB[n]] * 128 + i2[CJB[n]];
      key = fkey_u(__float_as_uint(h ? sB : sA)); e = h ? eB : eA;
    }
    if (n < 16) { ck[n] = key; cp[n] = e; } else { dk[n - 16] = key; dp[n - 16] = e; }
  }
  sort16p(ck, cp);
  sort16p(dk, dp);
#pragma unroll
  for (int j = 0; j < 16; ++j) { const bool sw = dk[15 - j] > ck[j]; ck[j] = sw ? dk[15 - j] : ck[j]; cp[j] = sw ? dp[15 - j] : cp[j]; }
#pragma unroll
  for (int j = 8; j > 0; j >>= 1)
#pragma unroll
    for (int i = 0; i < 16; ++i) { const int l = i ^ j; if (l > i) cswap2(ck[i], cp[i], ck[l], cp[l]); }
  unsigned fk[16]; int fe[16];
#pragma unroll
  for (int j = 0; j < 16; ++j) { dk[j] = (unsigned)__shfl_xor((int)ck[j], 32); dp[j] = __shfl_xor(cp[j], 32); }
#pragma unroll
  for (int j = 0; j < 16; ++j) {
    const bool sw = (dk[15 - j] > ck[j]) || (dk[15 - j] == ck[j] && dp[15 - j] > cp[j]);
    fk[j] = sw ? dk[15 - j] : ck[j]; fe[j] = sw ? dp[15 - j] : cp[j];
  }
  float sv[16], mx = -INFINITY;
#pragma unroll
  for (int j = 0; j < 16; ++j) { sv[j] = unfkey(fk[j]); mx = fmaxf(mx, sv[j]); }
  float sm = 0.f;
#pragma unroll
  for (int j = 0; j < 16; ++j) { sv[j] = __expf(sv[j] - mx); sm += sv[j]; }
  const float inv = 1.f / sm;
  const size_t o = ((size_t)(tok0 + r) * 8 + head) * 16 + h * 8;
  *(int4*)(E + o) = make_int4(fe[0], fe[1], fe[2], fe[3]);
  *(int4*)(E + o + 4) = make_int4(fe[4], fe[5], fe[6], fe[7]);
  *(float4*)(G + o) = make_float4(sv[0] * inv, sv[1] * inv, sv[2] * inv, sv[3] * inv);
  *(float4*)(G + o + 4) = make_float4(sv[4] * inv, sv[5] * inv, sv[6] * inv, sv[7] * inv);
}

DI v32f fp6x32(const uint2* p) {
  const uint2 a = p[0], b = p[1], c = p[2];
  v6u x; x[0] = a.x; x[1] = a.y; x[2] = b.x; x[3] = b.y; x[4] = c.x; x[5] = c.y;
  return __builtin_amdgcn_cvt_scalef32_pk32_f32_fp6(x, 1.0f);
}

DI void peer_gather_u(const Params& p, int layer, char* smem) {
  const int tid = threadIdx.x, lane = tid & 63, w = tid >> 6, grp = lane >> 4, i16 = lane & 15;
  float* a_s = (float*)smem + w * 512;
  float* su_s = a_s + 128;
  float* gv_s = a_s + 256;
  int* e_s = (int*)(a_s + 384);
  const bf16_t* HN = (const bf16_t*)(p.ws + OFF_ACT_A);
  const unsigned char* U = (const unsigned char*)(p.ws + OFF_TBL_U) + (size_t)layer * 16 * MiB;
  const float* IU = (const float*)(p.ws + OFF_INV) + (layer * 2 + 0) * 16384;
  const float* IV = (const float*)(p.ws + OFF_INV) + (layer * 2 + 1) * 16384;
  const int* E = (const int*)(p.ws + OFF_E);
  const float* G = (const float*)(p.ws + OFF_G);
  float* A = (float*)(p.ws + OFF_A);
  for (int tok = blockIdx.x * 4 + w; tok < T_TOK; tok += gridDim.x * 4) {
    float xf[2][32];
#pragma unroll
    for (int c = 0; c < 2; ++c) {
      const uint4* xp = (const uint4*)(HN + (size_t)tok * 1024 + c * 512 + i16 * 32);
#pragma unroll
      for (int q = 0; q < 4; ++q) {
        const uint4 x0 = xp[q];
        xf[c][8 * q + 0] = bflo(x0.x); xf[c][8 * q + 1] = bfhi(x0.x); xf[c][8 * q + 2] = bflo(x0.y); xf[c][8 * q + 3] = bfhi(x0.y);
        xf[c][8 * q + 4] = bflo(x0.z); xf[c][8 * q + 5] = bfhi(x0.z); xf[c][8 * q + 6] = bflo(x0.w); xf[c][8 * q + 7] = bfhi(x0.w);
      }
    }
    {
      const int e0 = E[(size_t)tok * 128 + lane], e1 = E[(size_t)tok * 128 + 64 + lane];
      e_s[lane] = e0; e_s[64 + lane] = e1;
      su_s[lane] = IU[e0]; su_s[64 + lane] = IU[e1];
      gv_s[lane] = G[(size_t)tok * 128 + lane] * IV[e0]; gv_s[64 + lane] = G[(size_t)tok * 128 + 64 + lane] * IV[e1];
    }
    wave_sync();
#pragma unroll 4
    for (int mm = 0; mm < 32; ++mm) {
      const int pidx = 4 * mm + grp;
      const unsigned char* up = U + (size_t)e_s[pidx] * 768 + i16 * 24;
      const v32f u0 = fp6x32((const uint2*)up), u1 = fp6x32((const uint2*)(up + 384));
      float acc0 = 0.f, acc1 = 0.f;
#pragma unroll
      for (int i = 0; i < 32; ++i) { acc0 = fmaf(u0[i], xf[0][i], acc0); acc1 = fmaf(u1[i], xf[1][i], acc1); }
      float acc = acc0 + acc1;
      acc += __shfl_xor(acc, 1); acc += __shfl_xor(acc, 2); acc += __shfl_xor(acc, 4); acc += __shfl_xor(acc, 8);
      acc *= su_s[pidx];
      const float a = 0.5f * acc * (1.f + erff(acc * 0.7071067811865476f)) * gv_s[pidx];
      if (i16 == 0) a_s[pidx] = a;
    }
    wave_sync();
    A[(size_t)tok * 128 + lane] = a_s[lane];
    A[(size_t)tok * 128 + 64 + lane] = a_s[64 + lane];
    wave_sync();
  }
}

DI void peer_gather_v(const Params& p, int layer, char* smem, const float* __restrict__ next_gain) {
  const int tid = threadIdx.x, lane = tid & 63, w = tid >> 6, r = lane & 31, h = lane >> 5;
  float* a_s = (float*)smem + w * 256;
  int* e_s = (int*)(a_s + 128);
  const unsigned char* V = (const unsigned char*)(p.ws + OFF_TBL_V) + (size_t)layer * 16 * MiB;
  const int* E = (const int*)(p.ws + OFF_E);
  const float* A = (const float*)(p.ws + OFF_A);
  for (int tok = blockIdx.x * 4 + w; tok < T_TOK; tok += gridDim.x * 4) {
    e_s[lane] = E[(size_t)tok * 128 + lane]; e_s[64 + lane] = E[(size_t)tok * 128 + 64 + lane];
    a_s[lane] = A[(size_t)tok * 128 + lane]; a_s[64 + lane] = A[(size_t)tok * 128 + 64 + lane];
    wave_sync();
    float o[32];
#pragma unroll
    for (int i = 0; i < 32; ++i) o[i] = 0.f;
#pragma unroll 8
    for (int mm = 0; mm < 64; ++mm) {
      const int pidx = 2 * mm + h;
      const float a = a_s[pidx];
      const v32f vv = fp6x32((const uint2*)(V + (size_t)e_s[pidx] * 768 + r * 24));
#pragma unroll
      for (int i = 0; i < 32; ++i) o[i] = fmaf(a, vv[i], o[i]);
    }
#pragma unroll
    for (int i = 0; i < 32; ++i) o[i] += __shfl_xor(o[i], 32);
    float4* hp = (float4*)(p.out + (size_t)tok * 1024 + r * 32 + h * 16);
    float4 hv[4];
    float ss = 0.f;
#pragma unroll
    for (int q = 0; q < 4; ++q) {
      float4 t = hp[q];
      t.x += h ? o[16 + 4 * q] : o[4 * q]; t.y += h ? o[17 + 4 * q] : o[4 * q + 1];
      t.z += h ? o[18 + 4 * q] : o[4 * q + 2]; t.w += h ? o[19 + 4 * q] : o[4 * q + 3];
      hp[q] = t; hv[q] = t;
      ss += t.x * t.x + t.y * t.y + t.z * t.z + t.w * t.w;
    }
    if (next_gain) {
#pragma unroll
      for (int o2 = 32; o2 >= 1; o2 >>= 1) ss += __shfl_xor(ss, o2);
      const float rs = rsqrtf(ss * (1.f / 1024.f) + 1e-6f);
      const float4* gp = (const float4*)(next_gain + r * 32 + h * 16);
      unsigned pw[8];
#pragma unroll
      for (int q = 0; q < 4; ++q) {
        const float4 g = gp[q];
        pw[2 * q] = pk(hv[q].x * rs * g.x, hv[q].y * rs * g.y); pw[2 * q + 1] = pk(hv[q].z * rs * g.z, hv[q].w * rs * g.w);
      }
      uint4* dp = (uint4*)((bf16_t*)(p.ws + OFF_ACT_A) + (size_t)tok * 1024 + r * 32 + h * 16);
      dp[0] = make_uint4(pw[0], pw[1], pw[2], pw[3]); dp[1] = make_uint4(pw[4], pw[5], pw[6], pw[7]);
    }
    wave_sync();
  }
}

DI void run_phase(const Params& p, int ph, char* smem) {
  bf16_t* actA = (bf16_t*)(p.ws + OFF_ACT_A);
  bf16_t* big = (bf16_t*)(p.ws + OFF_BIG);
  switch (ph) {
    case 0: phase_convert(p, smem); phase_cvt_tables(p, 0); phase_cvt_tables(p, 1); break;
    case 1: phase_rmsnorm(p.x, p.ln_mix, actA); break;
    case 2: phase_gemm<EPI_GLA_IN>(p, actA, (const bf16_t*)(p.ws + OFF_WT_GLA_IN), 25, big, 3072, nullptr, smem); break;
    case 3: for (int it = blockIdx.x; it < 2048; it += gridDim.x) gla_phase1(p, it, smem); break;
    case 4: gla_scan(p); break;
    case 5: for (int it = blockIdx.x; it < 2048; it += gridDim.x) gla_phase3(p, it, smem); break;
    case 6: phase_gemm<EPI_RESID_X>(p, actA, (const bf16_t*)(p.ws + OFF_WT_GLA_OUT), 8, nullptr, 0, nullptr, smem); break;
    case 7: phase_rmsnorm(p.out, p.ln_ffn, actA); break;
    case 8: phase_gemm<EPI_BF16>(p, actA, (const bf16_t*)(p.ws + OFF_WT_PQ), 8, big, 1024, nullptr, smem); break;
    case 9: for (int it = blockIdx.x * 4 + (threadIdx.x >> 6); it < 8192; it += gridDim.x * 4) peer_topk_wave(p, 0, it); break;
    case 10: peer_gather_u(p, 0, smem); break;
    case 11: peer_gather_v(p, 0, smem, p.ln_mix + 1024); break;
    case 12: break;
    case 13: phase_gemm<EPI_BF16>(p, actA, (const bf16_t*)(p.ws + OFF_WT_SWA_IN), 10, big, 1280, p.swa_b_in, smem); break;
    case 14: swa_qknorm(p); break;
    case 15: for (int it = blockIdx.x; it < 4096; it += gridDim.x) swa_attn(p, it, smem); break;
    case 16: phase_gemm<EPI_RESID_INPLACE>(p, (const bf16_t*)(p.ws + OFF_ACT_B), (const bf16_t*)(p.ws + OFF_WT_SWA_OUT), 8, nullptr, 0, p.swa_b_out, smem); break;
    case 17: phase_rmsnorm(p.out, p.ln_ffn + 1024, actA); break;
    case 18: phase_gemm<EPI_BF16>(p, actA, (const bf16_t*)(p.ws + OFF_WT_PQ) + (size_t)1024 * 1024, 8, big, 1024, nullptr, smem); break;
    case 19: for (int it = blockIdx.x * 4 + (threadIdx.x >> 6); it < 8192; it += gridDim.x * 4) peer_topk_wave(p, 1, it); break;
    case 20: peer_gather_u(p, 1, smem); break;
    case 21: peer_gather_v(p, 1, smem, nullptr); break;
    default: break;
  }
}

template <int PH>
__global__ void __launch_bounds__(256, 2) phase_kernel(Params p) {
  __shared__ __attribute__((aligned(16))) char smem[SMEM_BYTES];
  run_phase(p, PH, smem);
}

template <int PH>
static void launch_phases(const Params& p, int grid, hipStream_t stream) {
  hipLaunchKernelGGL(phase_kernel<PH>, dim3(grid), dim3(256), 0, stream, p);
  if constexpr (PH + 1 < NPHASE) launch_phases<PH + 1>(p, grid, stream);
}


#define XB_TMO      128
#define XB_XCNT(j)  (256  + 64 * (j))
#define XB_XSUB(j)  (1280 + 64 * (j))
#define XB_XGEN(j)  (2304 + 64 * (j))
#define XB_TOP      3328
#define XB_TOPGEN   3392
#define XCD_BAR_WORDS 3456
#define XB_SPIN_CAP (1u << 23)
#define LAS __attribute__((address_space(3)))
DI unsigned xb_ld(unsigned* p) { return __hip_atomic_load(p, __ATOMIC_RELAXED, __HIP_MEMORY_SCOPE_AGENT); }
DI unsigned xb_add(unsigned* p, unsigned v) { return __hip_atomic_fetch_add(p, v, __ATOMIC_RELAXED, __HIP_MEMORY_SCOPE_AGENT); }
DI unsigned xb_xcc_id() { return (unsigned)__builtin_amdgcn_s_getreg((3 << 11) | 20) & 0xFu; }
#define XB_SPIN(cond, bar) do { unsigned _sp = 0; while (cond) { __builtin_amdgcn_s_sleep(1); \
    if ((++_sp & 255u) == 0u) { if (xb_ld(&(bar)[XB_TMO])) break; if (_sp > XB_SPIN_CAP) { atomicAdd(&(bar)[XB_TMO], 1u); break; } } } } while (0)
struct XcdBarrier { unsigned* bar; unsigned x; volatile LAS unsigned* st; };
DI XcdBarrier xcd_barrier_post(unsigned* bar, volatile LAS unsigned* st) {
  XcdBarrier b; b.bar = bar; b.x = xb_xcc_id(); b.st = st;
  if (threadIdx.x == 0) (void)xb_add(&bar[XB_XCNT(b.x)], 1u);
  return b;
}
DI void xcd_barrier_complete(unsigned* bar, unsigned x, unsigned& nloc, unsigned& nx) {
  const unsigned G = gridDim.x * gridDim.y * gridDim.z;
  unsigned sum, cnt, mine, sp = 0u;
  for (;;) {
    sum = 0u; cnt = 0u; mine = 0u;
#pragma unroll
    for (unsigned j = 0; j < 16; ++j) { const unsigned c = xb_ld(&bar[XB_XCNT(j)]); sum += c; cnt += (c > 0u) ? 1u : 0u; mine = (j == x) ? c : mine; }
    if (sum == G) break;
    __builtin_amdgcn_s_sleep(1);
    if ((++sp & 255u) == 0u) { if (xb_ld(&bar[XB_TMO])) break; if (sp > XB_SPIN_CAP) { atomicAdd(&bar[XB_TMO], 1u); break; } }
  }
  nloc = mine > 0u ? mine : 1u; nx = cnt > 0u ? cnt : 1u;
}
DI void xcd_barrier(const XcdBarrier& b) {
  asm volatile("s_waitcnt vmcnt(0)" ::: "memory");
  __syncthreads();
  if (threadIdx.x == 0) {
    unsigned* bar = b.bar;
    __builtin_amdgcn_s_waitcnt(0);
    unsigned nloc = b.st[0], nx = b.st[1];
    if (nloc == 0u) { xcd_barrier_complete(bar, b.x, nloc, nx); b.st[0] = nloc; b.st[1] = nx; }
    const unsigned old = xb_add(&bar[XB_XSUB(b.x)], 1u);
    const unsigned gen = old / nloc;
    if (old + 1u == (gen + 1u) * nloc) {
      __builtin_amdgcn_fence(__ATOMIC_RELEASE, "agent");
      asm volatile("s_waitcnt vmcnt(0)" ::: "memory");
      const unsigned og = xb_add(&bar[XB_TOP], 1u);
      const unsigned tg = og / nx;
      if (og + 1u == (tg + 1u) * nx) xb_add(&bar[XB_TOPGEN], 1u);
      else XB_SPIN(xb_ld(&bar[XB_TOPGEN]) == tg, bar);
      __builtin_amdgcn_fence(__ATOMIC_ACQUIRE, "agent");
      xb_add(&bar[XB_XGEN(b.x)], 1u);
      asm volatile("s_waitcnt vmcnt(0)" ::: "memory");
    } else {
      XB_SPIN(xb_ld(&bar[XB_XGEN(b.x)]) == gen, bar);
      __builtin_amdgcn_fence(__ATOMIC_ACQUIRE, "agent");
      asm volatile("s_waitcnt vmcnt(0)" ::: "memory");
    }
  }
  __syncthreads();
}

#if !MULTI_LAUNCH
template <int PH>
DI void run_all(const Params& p, char* smem, const XcdBarrier& xb) {
  if constexpr (PH != 12) {
    run_phase(p, PH, smem);
    if constexpr (PH + 1 < NPHASE) {
      if constexpr (PH == 0) cg::this_grid().sync();
      else xcd_barrier(xb);
    }
  }
  if constexpr (PH + 1 < NPHASE) run_all<PH + 1>(p, smem, xb);
}
__global__ void __launch_bounds__(256, 2) trunk_kernel(Params p) {
  __shared__ __attribute__((aligned(16))) char smem[SMEM_BYTES];
  __shared__ uint4 xb_words;
  if (threadIdx.x == 0) xb_words = make_uint4(0u, 0u, 0u, 0u);
  __syncthreads();
  const XcdBarrier xb = xcd_barrier_post((unsigned*)(p.ws + OFF_BAR), (volatile LAS unsigned*)&xb_words);
  run_all<0>(p, smem, xb);
}
#endif

extern "C" void kernel_launch(void* const* d_in, const int* in_sizes, int n_in, void* d_out, int out_size, void* d_ws, size_t ws_size,
                              hipStream_t stream) {
  Params p{};
  p.x = (const float*)d_in[0]; p.pos = (const int*)d_in[1]; p.ln_mix = (const float*)d_in[2]; p.ln_ffn = (const float*)d_in[3];
  p.gla_w_in = (const float*)d_in[4]; p.gla_w_alpha = (const float*)d_in[5]; p.gla_b_alpha = (const float*)d_in[6];
  p.gla_norm = (const float*)d_in[7]; p.gla_w_out = (const float*)d_in[8];
  p.swa_w_in = (const float*)d_in[9]; p.swa_b_in = (const float*)d_in[10]; p.swa_qn = (const float*)d_in[11]; p.swa_kn = (const float*)d_in[12];
  p.swa_sinks = (const float*)d_in[13]; p.swa_w_out = (const float*)d_in[14]; p.swa_b_out = (const float*)d_in[15];
  p.peer_wq = (const float*)d_in[16]; p.peer_keys = (const float*)d_in[17]; p.peer_u = (const float*)d_in[18]; p.peer_v = (const float*)d_in[19];
  p.out = (float*)d_out; p.ws = (char*)d_ws;
  static int grid_blocks = 0;
  if (!grid_blocks) {
    int dev = 0, cus = 0, per_cu = 0;
    (void)hipGetDevice(&dev);
    (void)hipDeviceGetAttribute(&cus, hipDeviceAttributeMultiprocessorCount, dev);
    #if MULTI_LAUNCH
    per_cu = 2;
#else
    (void)hipOccupancyMaxActiveBlocksPerMultiprocessor(&per_cu, trunk_kernel, 256, 0);
#endif
    if (per_cu < 1) per_cu = 1;
    if (per_cu > 2) per_cu = 2;
    grid_blocks = cus * per_cu;
  }
#if MULTI_LAUNCH
  p.phase_lo = 0; p.phase_hi = 0;
  launch_phases<0>(p, grid_blocks, stream);
#else
  p.phase_lo = 0; p.phase_hi = NPHASE - 1;
  void* args[] = {&p};
  (void)hipMemsetAsync((char*)d_ws + OFF_BAR, 0, XCD_BAR_WORDS * 4, stream);
  hipError_t e = hipLaunchCooperativeKernel((void*)trunk_kernel, dim3(grid_blocks), dim3(256), args, 0, stream);
  if (e != hipSuccess) fprintf(stderr, "cooperative launch failed: %s (grid %d)\n", hipGetErrorString(e), grid_blocks);
#endif
}
```

```cpp
#include <hip/hip_runtime.h>
#include <hip/hip_cooperative_groups.h>
#include <stdint.h>
#include <stdio.h>
namespace cg = cooperative_groups;

#ifndef MULTI_LAUNCH
#define MULTI_LAUNCH 0
#endif

#define DI __device__ __forceinline__
typedef unsigned short bf16_t;
typedef __attribute__((ext_vector_type(8))) short bf16x8;
typedef __attribute__((ext_vector_type(16))) float f32x16;
typedef __bf16 bf16x2_t __attribute__((ext_vector_type(2)));
typedef float f32x2_t __attribute__((ext_vector_type(2)));
typedef float f2 __attribute__((ext_vector_type(2)));

constexpr int T_TOK = 32768;
constexpr int SEQ = 16384;
constexpr int DM = 1024;
constexpr int NPHASE = 22;

constexpr size_t MiB = 1048576;
constexpr size_t OFF_WT_GLA_IN = 0;
constexpr size_t OFF_WT_GLA_OUT = 7 * MiB;
constexpr size_t OFF_WT_SWA_IN = 9 * MiB;
constexpr size_t OFF_WT_SWA_OUT = 12 * MiB;
constexpr size_t OFF_WT_PQ = 14 * MiB;
constexpr size_t OFF_KEYS = 18 * MiB;
constexpr size_t OFF_INV = 20 * MiB;
constexpr size_t OFF_TBL_U = 24 * MiB;
constexpr size_t OFF_TBL_V = 56 * MiB;
constexpr size_t OFF_ACT_A = 88 * MiB;
constexpr size_t OFF_BIG = 152 * MiB;
constexpr size_t OFF_E = OFF_BIG + 64 * MiB;
constexpr size_t OFF_G = OFF_BIG + 80 * MiB;
constexpr size_t OFF_A = OFF_BIG + 96 * MiB;
constexpr size_t OFF_KVT = 344 * MiB;
constexpr size_t OFF_ACT_B = OFF_KVT;
constexpr size_t OFF_LR = 472 * MiB;
constexpr size_t OFF_DECAY = 474 * MiB;
constexpr size_t OFF_BAR = 476 * MiB;

constexpr int SMEM_BYTES = 73728;
constexpr int LDK = 72;

struct Params {
  const float* x; const int* pos; const float* ln_mix; const float* ln_ffn;
  const float* gla_w_in; const float* gla_w_alpha; const float* gla_b_alpha; const float* gla_norm; const float* gla_w_out;
  const float* swa_w_in; const float* swa_b_in; const float* swa_qn; const float* swa_kn; const float* swa_sinks;
  const float* swa_w_out; const float* swa_b_out;
  const float* peer_wq; const float* peer_keys; const float* peer_u; const float* peer_v;
  float* out; char* ws;
  int phase_lo, phase_hi;
};

DI unsigned pk(float lo, float hi) { f32x2_t v = {lo, hi}; bf16x2_t b = __builtin_convertvector(v, bf16x2_t); return __builtin_bit_cast(unsigned, b); }
DI bf16_t f2bf(float x) { return (bf16_t)(pk(x, 0.f) & 0xffffu); }
DI float bflo(unsigned w) { return __uint_as_float(w << 16); }
DI float bfhi(unsigned w) { return __uint_as_float(w & 0xffff0000u); }
DI float bf2f(bf16_t b) { return __uint_as_float(((unsigned)b) << 16); }
DI float dot2(unsigned a, unsigned b, float c) { return __builtin_amdgcn_fdot2_f32_bf16(__builtin_bit_cast(bf16x2_t, a), __builtin_bit_cast(bf16x2_t, b), c, false); }
DI int crow(int i, int h) { return (i & 3) + 8 * (i >> 2) + 4 * h; }
DI f32x16 mfma32(bf16x8 a, bf16x8 b, f32x16 c) { return __builtin_amdgcn_mfma_f32_32x32x16_bf16(a, b, c, 0, 0, 0); }
DI f32x16 zero16() { f32x16 z; for (int i = 0; i < 16; ++i) z[i] = 0.f; return z; }
DI void wave_sync() { __builtin_amdgcn_fence(__ATOMIC_RELEASE, "wavefront"); __builtin_amdgcn_wave_barrier(); __builtin_amdgcn_fence(__ATOMIC_ACQUIRE, "wavefront"); }
DI int mbcnt64(unsigned long long m) { return __builtin_amdgcn_mbcnt_hi((unsigned)(m >> 32), __builtin_amdgcn_mbcnt_lo((unsigned)m, 0)); }
DI float logsig(float z) { return fminf(z, 0.f) - __logf(1.f + __expf(-fabsf(z))); }

DI void transpose_tile(const float* __restrict__ src, int N, bf16_t* __restrict__ dst, int kt, int nt, float* sT) {
  const int tid = threadIdx.x;
  const int r = tid >> 4, c4 = (tid & 15) * 4;
#pragma unroll
  for (int i = 0; i < 4; ++i) {
    const int k = kt * 64 + r + 16 * i, n = nt * 64 + c4;
    float4 v = make_float4(0.f, 0.f, 0.f, 0.f);
    if (n + 3 < N) v = *(const float4*)(src + (size_t)k * N + n);
    float* d = sT + (r + 16 * i) * 65 + c4;
    d[0] = v.x; d[1] = v.y; d[2] = v.z; d[3] = v.w;
  }
  __syncthreads();
  const int n = tid >> 2, seg = tid & 3;
  unsigned w[8];
#pragma unroll
  for (int j = 0; j < 8; ++j) w[j] = pk(sT[(seg * 16 + 2 * j) * 65 + n], sT[(seg * 16 + 2 * j + 1) * 65 + n]);
  uint4* d = (uint4*)(dst + (size_t)(nt * 64 + n) * 1024 + kt * 64 + seg * 16);
  d[0] = make_uint4(w[0], w[1], w[2], w[3]);
  d[1] = make_uint4(w[4], w[5], w[6], w[7]);
  __syncthreads();
}

DI void cvt_elems(const float* __restrict__ src, bf16_t* __restrict__ dst, size_t n8) {
  for (size_t i = (size_t)blockIdx.x * 256 + threadIdx.x; i < n8; i += (size_t)gridDim.x * 256) {
    const float4 a = ((const float4*)src)[2 * i], b = ((const float4*)src)[2 * i + 1];
    ((uint4*)dst)[i] = make_uint4(pk(a.x, a.y), pk(a.z, a.w), pk(b.x, b.y), pk(b.z, b.w));
  }
}

DI void phase_convert(const Params& p, char* smem) {
  float* sT = (float*)smem;
  for (int t = blockIdx.x; t < 2144; t += gridDim.x) {
    const float* src; int N, ntn; bf16_t* dst; int local;
    if (t < 800) { src = p.gla_w_in; N = 3088; ntn = 50; dst = (bf16_t*)(p.ws + OFF_WT_GLA_IN); local = t; }
    else if (t < 1056) { src = p.gla_w_out; N = 1024; ntn = 16; dst = (bf16_t*)(p.ws + OFF_WT_GLA_OUT); local = t - 800; }
    else if (t < 1376) { src = p.swa_w_in; N = 1280; ntn = 20; dst = (bf16_t*)(p.ws + OFF_WT_SWA_IN); local = t - 1056; }
    else if (t < 1632) { src = p.swa_w_out; N = 1024; ntn = 16; dst = (bf16_t*)(p.ws + OFF_WT_SWA_OUT); local = t - 1376; }
    else if (t < 1888) { src = p.peer_wq; N = 1024; ntn = 16; dst = (bf16_t*)(p.ws + OFF_WT_PQ); local = t - 1632; }
    else { src = p.peer_wq + (size_t)1024 * 1024; N = 1024; ntn = 16; dst = (bf16_t*)(p.ws + OFF_WT_PQ) + (size_t)1024 * 1024; local = t - 1888; }
    transpose_tile(src, N, dst, local / ntn, local % ntn, sT);
  }
  cvt_elems(p.peer_keys, (bf16_t*)(p.ws + OFF_KEYS), (size_t)2 * 8 * 2 * 128 * 64 / 8);
}

typedef unsigned v6u __attribute__((ext_vector_type(6)));
typedef float v32f __attribute__((ext_vector_type(32)));
DI unsigned fp6_code(float y) {
  const float a = fminf(fabsf(y), 7.5f);
  float c = rintf(a * 8.f);
  c = a >= 2.f ? rintf(a * 4.f) + 8.f : c;
  c = a >= 4.f ? rintf(a * 2.f) + 16.f : c;
  unsigned u = (unsigned)c;
  u = u > 31u ? 31u : u;
  return u | ((__float_as_uint(y) >> 26) & 32u);
}
DI void cvt_table_fp6(const float* __restrict__ src, unsigned char* __restrict__ dst, float* __restrict__ inv, int bid, int nb) {
  const int lane = threadIdx.x & 63, w = threadIdx.x >> 6, r = lane & 31, h = lane >> 5;
  for (int rp = bid * 4 + w; rp < 8192; rp += nb * 4) {
    const int row = rp * 2 + h;
    const float4* sp = (const float4*)(src + (size_t)row * 1024 + r * 32);
    float v[32];
    float mx = 0.f;
#pragma unroll
    for (int i = 0; i < 8; ++i) {
      const float4 t = sp[i];
      v[4 * i] = t.x; v[4 * i + 1] = t.y; v[4 * i + 2] = t.z; v[4 * i + 3] = t.w;
      mx = fmaxf(fmaxf(mx, fmaxf(fabsf(t.x), fabsf(t.y))), fmaxf(fabsf(t.z), fabsf(t.w)));
    }
#pragma unroll
    for (int o = 16; o >= 1; o >>= 1) mx = fmaxf(mx, __shfl_xor(mx, o));
    const float sc = mx > 0.f ? 7.5f / mx : 1.f;
    unsigned c[32];
#pragma unroll
    for (int i = 0; i < 32; ++i) c[i] = fp6_code(v[i] * sc);
    unsigned d[6];
#pragma unroll
    for (int g = 0; g < 2; ++g) {
      const unsigned* q = c + 16 * g;
      d[3 * g + 0] = q[0] | (q[1] << 6) | (q[2] << 12) | (q[3] << 18) | (q[4] << 24) | (q[5] << 30);
      d[3 * g + 1] = (q[5] >> 2) | (q[6] << 4) | (q[7] << 10) | (q[8] << 16) | (q[9] << 22) | (q[10] << 28);
      d[3 * g + 2] = (q[10] >> 4) | (q[11] << 2) | (q[12] << 8) | (q[13] << 14) | (q[14] << 20) | (q[15] << 26);
    }
    uint2* dp = (uint2*)(dst + (size_t)row * 768 + r * 24);
    dp[0] = make_uint2(d[0], d[1]); dp[1] = make_uint2(d[2], d[3]); dp[2] = make_uint2(d[4], d[5]);
    if (r == 0) inv[row] = mx > 0.f ? mx * (1.f / 7.5f) : 1.f;
  }
}
DI void phase_cvt_tables(const Params& p, int layer) {
  const int nb = gridDim.x / 2, bid = blockIdx.x % nb;
  const int rows_lo = (blockIdx.x < nb) ? 0 : 1;
  cvt_table_fp6(p.peer_u + (size_t)layer * 16384 * 1024, (unsigned char*)(p.ws + OFF_TBL_U) + (size_t)layer * 16 * MiB, (float*)(p.ws + OFF_INV) + (layer * 2 + 0) * 16384, bid * 2 + rows_lo, nb * 2);
  cvt_table_fp6(p.peer_v + (size_t)layer * 16384 * 1024, (unsigned char*)(p.ws + OFF_TBL_V) + (size_t)layer * 16 * MiB, (float*)(p.ws + OFF_INV) + (layer * 2 + 1) * 16384, bid * 2 + rows_lo, nb * 2);
}

DI void phase_rmsnorm(const float* __restrict__ src, const float* __restrict__ gain, bf16_t* __restrict__ dst) {
  const int lane = threadIdx.x & 63, w = threadIdx.x >> 6;
  for (int row = blockIdx.x * 4 + w; row < T_TOK; row += gridDim.x * 4) {
    const float4* sp = (const float4*)(src + (size_t)row * DM);
    float4 v[4];
    float ss = 0.f;
#pragma unroll
    for (int i = 0; i < 4; ++i) { v[i] = sp[lane + 64 * i]; ss += v[i].x * v[i].x + v[i].y * v[i].y + v[i].z * v[i].z + v[i].w * v[i].w; }
#pragma unroll
    for (int o = 32; o >= 1; o >>= 1) ss += __shfl_xor(ss, o);
    const float rs = rsqrtf(ss * (1.f / 1024.f) + 1e-6f);
#pragma unroll
    for (int i = 0; i < 4; ++i) {
      const float4 g = ((const float4*)gain)[lane + 64 * i];
      uint2 o2 = make_uint2(pk(v[i].x * rs * g.x, v[i].y * rs * g.y), pk(v[i].z * rs * g.z, v[i].w * rs * g.w));
      *(uint2*)(dst + (size_t)row * DM + (lane + 64 * i) * 4) = o2;
    }
  }
}

DI void mma_64x64(const bf16_t* sA, const bf16_t* sB, int arow0, int brow0, f32x16 (&acc)[2][2], int lane) {
  const int r = lane & 31, h = lane >> 5;
#pragma unroll
  for (int s = 0; s < 4; ++s) {
    bf16x8 a[2], b[2];
#pragma unroll
    for (int mi = 0; mi < 2; ++mi) a[mi] = *(const bf16x8*)(sA + (arow0 + mi * 32 + r) * LDK + s * 16 + h * 8);
#pragma unroll
    for (int ni = 0; ni < 2; ++ni) b[ni] = *(const bf16x8*)(sB + (brow0 + ni * 32 + r) * LDK + s * 16 + h * 8);
#pragma unroll
    for (int mi = 0; mi < 2; ++mi)
#pragma unroll
      for (int ni = 0; ni < 2; ++ni) acc[mi][ni] = mfma32(a[mi], b[ni], acc[mi][ni]);
  }
}

enum { EPI_GLA_IN = 0, EPI_RESID_X = 1, EPI_BF16 = 2, EPI_RESID_INPLACE = 3 };

template <int MODE>
DI void phase_gemm(const Params& p, const bf16_t* __restrict__ A, const bf16_t* __restrict__ Bt, int NT, bf16_t* dstb, int ldc,
                   const float* __restrict__ bias, char* smem) {
  const int ntiles = (T_TOK / 128) * NT;
  int t = (gridDim.x & 7) ? (int)blockIdx.x : (int)((blockIdx.x & 7) * (gridDim.x >> 3) + (blockIdx.x >> 3));
  if (t >= ntiles) return;
  bf16_t* sA = (bf16_t*)smem;
  bf16_t* sB = sA + 128 * LDK;
  bf16_t* ct = (bf16_t*)smem;
  const int tid = threadIdx.x, lane = tid & 63, w = tid >> 6, wm = w >> 1, wn = w & 1;
  const int r = lane & 31, h = lane >> 5;
  const int lrow = tid >> 3, kc = tid & 7;
  bf16_t* wa = sA + lrow * LDK + kc * 8;
  bf16_t* wb = sB + lrow * LDK + kc * 8;
  bf16x8 ra0[4], rb0[4], ra1[4], rb1[4];
  int m0 = (t / NT) * 128, n0 = (t % NT) * 128;
  const bf16_t* ap = A + (size_t)(m0 + lrow) * 1024 + kc * 8;
  const bf16_t* bp = Bt + (size_t)(n0 + lrow) * 1024 + kc * 8;
#define GLOAD(RA, RB, KT) _Pragma("unroll") for (int i = 0; i < 4; ++i) { RA[i] = *(const bf16x8*)(ap + (size_t)i * 32 * 1024 + (KT) * 64); RB[i] = *(const bf16x8*)(bp + (size_t)i * 32 * 1024 + (KT) * 64); }
#define SSTORE(RA, RB) _Pragma("unroll") for (int i = 0; i < 4; ++i) { *(bf16x8*)(wa + 32 * i * LDK) = RA[i]; *(bf16x8*)(wb + 32 * i * LDK) = RB[i]; }
  GLOAD(ra0, rb0, 0)
  GLOAD(ra1, rb1, 1)
  for (; t < ntiles; t += gridDim.x) {
    f32x16 acc[2][2];
#pragma unroll
    for (int i = 0; i < 2; ++i)
#pragma unroll
      for (int j = 0; j < 2; ++j) acc[i][j] = zero16();
    __syncthreads();
    SSTORE(ra0, rb0)
    __syncthreads();
    for (int kt = 0; kt < 16; kt += 2) {
      if (kt + 2 < 16) { GLOAD(ra0, rb0, kt + 2) }
      mma_64x64(sA, sB, wm * 64, wn * 64, acc, lane);
      __syncthreads();
      SSTORE(ra1, rb1)
      __syncthreads();
      if (kt + 3 < 16) { GLOAD(ra1, rb1, kt + 3) }
      mma_64x64(sA, sB, wm * 64, wn * 64, acc, lane);
      __syncthreads();
      if (kt + 2 < 16) {
        SSTORE(ra0, rb0)
        __syncthreads();
      }
    }
    const int cm0 = m0, cn0 = n0;
    {
      const int tn = t + gridDim.x;
      if (tn < ntiles) {
        m0 = (tn / NT) * 128; n0 = (tn % NT) * 128;
        ap = A + (size_t)(m0 + lrow) * 1024 + kc * 8;
        bp = Bt + (size_t)(n0 + lrow) * 1024 + kc * 8;
        GLOAD(ra0, rb0, 0)
        GLOAD(ra1, rb1, 1)
      }
    }
    const bool staged = (MODE == EPI_BF16) || (MODE == EPI_GLA_IN && cn0 < 3072);
    if (staged) {
#pragma unroll
      for (int ni = 0; ni < 2; ++ni) {
        const int col = wn * 64 + ni * 32 + r;
        const float bv = (MODE == EPI_BF16 && bias) ? bias[cn0 + col] : 0.f;
#pragma unroll
        for (int mi = 0; mi < 2; ++mi)
#pragma unroll
          for (int i = 0; i < 16; ++i) ct[(wm * 64 + mi * 32 + crow(i, h)) * 136 + col] = f2bf(acc[mi][ni][i] + bv);
      }
      __syncthreads();
      const int ldo = (MODE == EPI_GLA_IN) ? 3072 : ldc;
#pragma unroll
      for (int j = 0; j < 8; ++j) {
        const int c = tid + 256 * j, row = c >> 4, cc = c & 15;
        *(uint4*)(dstb + (size_t)(cm0 + row) * ldo + cn0 + cc * 8) = *(const uint4*)(ct + row * 136 + cc * 8);
      }
    } else {
      const unsigned row0 = (unsigned)(cm0 + wm * 64 + 4 * h), col0 = (unsigned)(cn0 + wn * 64 + r);
      float* __restrict__ lrp = (float*)(p.ws + OFF_LR);
#pragma unroll
      for (int ni = 0; ni < 2; ++ni) {
        const unsigned col = col0 + ni * 32;
        float bv = 0.f;
        if (MODE == EPI_RESID_INPLACE) bv = bias[col];
        const unsigned i0 = row0 * 1024u + col;
        const unsigned l0 = row0 * 16u + (col - 3072u);
#pragma unroll
        for (int mi = 0; mi < 2; ++mi)
#pragma unroll
          for (int i = 0; i < 16; ++i) {
            const unsigned ro = (unsigned)(mi * 32 + (i & 3) + 8 * (i >> 2));
            const float v = acc[mi][ni][i];
            if (MODE == EPI_GLA_IN) { if (col < 3088u) lrp[l0 + ro * 16u] = v; }
            else if (MODE == EPI_RESID_X) p.out[i0 + ro * 1024u] = p.x[i0 + ro * 1024u] + v;
            else if (MODE == EPI_RESID_INPLACE) p.out[i0 + ro * 1024u] += v + bv;
          }
      }
    }
  }
#undef GLOAD
#undef SSTORE
}

DI float gate_la(const float* lr_s, int t, const float (&wa)[16], float ba) {
  float z = ba;
#pragma unroll
  for (int j = 0; j < 16; ++j) z += lr_s[t * 16 + j] * wa[j];
  return logsig(z) * (1.f / 16.f);
}
DI void gla_gates(const Params& p, int t0, int hh, float (&wa)[16], float& ba, float& offset, float& blast, float* lr_s, float* tot_s) {
  const int tid = threadIdx.x, d = tid & 127, half = tid >> 7;
  const float* LR = (const float*)(p.ws + OFF_LR);
  ((float4*)lr_s)[tid] = ((const float4*)(LR + (size_t)t0 * 16))[tid];
#pragma unroll
  for (int j = 0; j < 16; ++j) wa[j] = p.gla_w_alpha[j * 512 + hh * 128 + d];
  ba = p.gla_b_alpha[hh * 128 + d];
  __syncthreads();
  float sum = 0.f;
#pragma unroll 4
  for (int tt = 0; tt < 32; ++tt) sum += gate_la(lr_s, half * 32 + tt, wa, ba);
  tot_s[half * 128 + d] = sum;
  __syncthreads();
  offset = half ? tot_s[d] : 0.f;
  blast = tot_s[d] + tot_s[128 + d];
}

DI void fill_vT(const bf16_t* __restrict__ QKVR, int t0, int hh, int vh, bf16_t* vT) {
  const int tid = threadIdx.x, v = tid & 127, half = tid >> 7;
#pragma unroll 8
  for (int tt = 0; tt < 32; ++tt) {
    const int t = half * 32 + tt;
    vT[v * LDK + t] = QKVR[(size_t)(t0 + t) * 3072 + 1024 + hh * 256 + vh * 128 + v];
  }
}

DI void gla_phase1(const Params& p, int item, char* smem) {
  const int hh = item & 3, c = (item >> 2) & 255, b = item >> 10;
  const int t0 = b * SEQ + c * 64;
  float* lr_s = (float*)smem;
  float* tot_s = (float*)(smem + 4096);
  bf16_t* kfT = (bf16_t*)(smem + 5120);
  bf16_t* vT = kfT + 128 * LDK;
  const bf16_t* QKVR = (const bf16_t*)(p.ws + OFF_BIG);
  bf16_t* KVT = (bf16_t*)(p.ws + OFF_KVT);
  float* DECAY = (float*)(p.ws + OFF_DECAY);
  const int tid = threadIdx.x, lane = tid & 63, w = tid >> 6, wm = w >> 1, wn = w & 1;
  const int d = tid & 127, half = tid >> 7;
  float wa[16], ba, offset, blast;
  gla_gates(p, t0, hh, wa, ba, offset, blast, lr_s, tot_s);
  float run = offset;
#pragma unroll 4
  for (int tt = 0; tt < 32; ++tt) {
    const int t = half * 32 + tt;
    run += gate_la(lr_s, t, wa, ba);
    ((float*)(p.ws + OFF_ACT_A))[(size_t)(t0 + t) * 512 + hh * 128 + d] = run;
    const float kv = bf2f(QKVR[(size_t)(t0 + t) * 3072 + 512 + hh * 128 + d]);
    kfT[d * LDK + t] = f2bf(kv * __expf(blast - run));
  }
  if (half == 0) DECAY[(size_t)item * 128 + d] = __expf(blast);
  const int r = lane & 31, h = lane >> 5;
  for (int vh = 0; vh < 2; ++vh) {
    __syncthreads();
    fill_vT(QKVR, t0, hh, vh, vT);
    __syncthreads();
    f32x16 acc[2][2];
#pragma unroll
    for (int i = 0; i < 2; ++i)
#pragma unroll
      for (int j = 0; j < 2; ++j) acc[i][j] = zero16();
    mma_64x64(vT, kfT, wm * 64, wn * 64, acc, lane);
    bf16_t* kbase = KVT + (size_t)item * 32768 + (vh * 128 + wm * 64 + 4 * h) * 128 + wn * 64 + r;
#pragma unroll
    for (int mi = 0; mi < 2; ++mi)
#pragma unroll
      for (int ni = 0; ni < 2; ++ni)
#pragma unroll
        for (int i = 0; i < 16; ++i) kbase[(mi * 32 + (i & 3) + 8 * (i >> 2)) * 128 + ni * 32] = f2bf(acc[mi][ni][i]);
  }
  __syncthreads();
}

DI void gla_scan(const Params& p) {
  bf16_t* KVT = (bf16_t*)(p.ws + OFF_KVT);
  const float* DECAY = (const float*)(p.ws + OFF_DECAY);
  for (int idx = blockIdx.x * 256 + threadIdx.x; idx < 8 * 16384; idx += gridDim.x * 256) {
    const int bh = idx >> 14, e2 = idx & 16383, b = bh >> 2, hh = bh & 3, d0 = (2 * e2) & 127;
    float s0 = 0.f, s1 = 0.f;
    for (int c0 = 0; c0 < 256; c0 += 8) {
      unsigned kv[8]; float2 dc[8];
#pragma unroll
      for (int u = 0; u < 8; ++u) {
        const size_t item = (size_t)(b * 256 + c0 + u) * 4 + hh;
        kv[u] = *(const unsigned*)(KVT + item * 32768 + 2 * e2);
        dc[u] = *(const float2*)(DECAY + item * 128 + d0);
      }
#pragma unroll
      for (int u = 0; u < 8; ++u) {
        const size_t item = (size_t)(b * 256 + c0 + u) * 4 + hh;
        *(unsigned*)(KVT + item * 32768 + 2 * e2) = pk(s0, s1);
        s0 = dc[u].x * s0 + bflo(kv[u]);
        s1 = dc[u].y * s1 + bfhi(kv[u]);
      }
    }
  }
}

DI void gla_phase3(const Params& p, int item, char* smem) {
  const int hh = item & 3, c = (item >> 2) & 255, b = item >> 10;
  const int t0 = b * SEQ + c * 64;
  float* lr_s = (float*)smem;
  float* tot_s = (float*)(smem + 4096);
  bf16_t* qd = (bf16_t*)(smem + 5120);
  bf16_t* ki = qd + 64 * 136;
  bf16_t* at = ki + 64 * 136;
  bf16_t* vT = at + 64 * 72;
  bf16_t* ot = qd;
  const bf16_t* QKVR = (const bf16_t*)(p.ws + OFF_BIG);
  const bf16_t* ST = (const bf16_t*)(p.ws + OFF_KVT);
  bf16_t* OG = (bf16_t*)(p.ws + OFF_ACT_A);
  const int tid = threadIdx.x, lane = tid & 63, w = tid >> 6;
  const int d = tid & 127, half = tid >> 7;
  const int r = lane & 31, h = lane >> 5;
  {
    const float* Bc = (const float*)(p.ws + OFF_ACT_A);
#pragma unroll 8
    for (int tt = 0; tt < 32; ++tt) {
      const int t = half * 32 + tt;
      const float run = Bc[(size_t)(t0 + t) * 512 + hh * 128 + d];
      const float q = bf2f(QKVR[(size_t)(t0 + t) * 3072 + hh * 128 + d]);
      const float k = bf2f(QKVR[(size_t)(t0 + t) * 3072 + 512 + hh * 128 + d]);
      qd[t * 136 + d] = f2bf(q * 0.08838834764831845f * __expf(run));
      ki[t * 136 + d] = f2bf(k * __expf(-run));
    }
  }
  __syncthreads();
  {
    const int mi = w >> 1, nj = w & 1;
    f32x16 a = zero16();
#pragma unroll
    for (int s = 0; s < 8; ++s) {
      const bf16x8 A = *(const bf16x8*)(qd + (mi * 32 + r) * 136 + s * 16 + h * 8);
      const bf16x8 B = *(const bf16x8*)(ki + (nj * 32 + r) * 136 + s * 16 + h * 8);
      a = mfma32(A, B, a);
    }
#pragma unroll
    for (int i = 0; i < 16; ++i) {
      const int it = mi * 32 + crow(i, h), jt = nj * 32 + r;
      at[it * 72 + jt] = f2bf(jt <= it ? a[i] : 0.f);
    }
  }
  f32x16 o[2][2];
#pragma unroll
  for (int i = 0; i < 2; ++i)
#pragma unroll
    for (int j = 0; j < 2; ++j) o[i][j] = zero16();
#pragma unroll
  for (int vh = 0; vh < 2; ++vh) {
    __syncthreads();
    fill_vT(QKVR, t0, hh, vh, vT);
    __syncthreads();
#pragma unroll
    for (int s = 0; s < 4; ++s) {
      const bf16x8 B = *(const bf16x8*)(vT + (w * 32 + r) * LDK + s * 16 + h * 8);
#pragma unroll
      for (int mt = 0; mt < 2; ++mt) {
        const bf16x8 A = *(const bf16x8*)(at + (mt * 32 + r) * 72 + s * 16 + h * 8);
        o[vh][mt] = mfma32(A, B, o[vh][mt]);
      }
    }
    const bf16_t* Sg = ST + (size_t)item * 32768 + (size_t)(vh * 128 + w * 32 + r) * 128 + h * 8;
#pragma unroll
    for (int s = 0; s < 8; ++s) {
      const bf16x8 B = *(const bf16x8*)(Sg + s * 16);
#pragma unroll
      for (int mt = 0; mt < 2; ++mt) {
        const bf16x8 A = *(const bf16x8*)(qd + (mt * 32 + r) * 136 + s * 16 + h * 8);
        o[vh][mt] = mfma32(A, B, o[vh][mt]);
      }
    }
  }
  __syncthreads();
#pragma unroll
  for (int vh = 0; vh < 2; ++vh)
#pragma unroll
    for (int mt = 0; mt < 2; ++mt)
#pragma unroll
      for (int i = 0; i < 16; ++i) ot[(mt * 32 + crow(i, h)) * 264 + vh * 128 + w * 32 + r] = f2bf(o[vh][mt][i]);
  __syncthreads();
  {
    const int row = tid >> 2, seg = tid & 3;
    const bf16_t* orow = ot + row * 264 + seg * 64;
    float ss = 0.f;
#pragma unroll
    for (int c8 = 0; c8 < 8; ++c8) {
      const uint4 ov = *(const uint4*)(orow + c8 * 8);
      const float f0 = bflo(ov.x), f1 = bfhi(ov.x), f2 = bflo(ov.y), f3 = bfhi(ov.y), f4 = bflo(ov.z), f5 = bfhi(ov.z), f6 = bflo(ov.w), f7 = bfhi(ov.w);
      ss += f0 * f0 + f1 * f1 + f2 * f2 + f3 * f3 + f4 * f4 + f5 * f5 + f6 * f6 + f7 * f7;
    }
    ss += __shfl_xor(ss, 1);
    ss += __shfl_xor(ss, 2);
    const float rs = rsqrtf(ss * (1.f / 256.f) + 1e-6f);
    const bf16_t* rrow = QKVR + (size_t)(t0 + row) * 3072 + 2048 + hh * 256 + seg * 64;
    const float* grow = p.gla_norm + hh * 256 + seg * 64;
    bf16_t* dst = OG + (size_t)(t0 + row) * 1024 + hh * 256 + seg * 64;
#pragma unroll
    for (int c8 = 0; c8 < 8; ++c8) {
      const uint4 ov = *(const uint4*)(orow + c8 * 8);
      const uint4 rv = *(const uint4*)(rrow + c8 * 8);
      const float4 g0 = *(const float4*)(grow + c8 * 8), g1 = *(const float4*)(grow + c8 * 8 + 4);
      float of[8] = {bflo(ov.x), bfhi(ov.x), bflo(ov.y), bfhi(ov.y), bflo(ov.z), bfhi(ov.z), bflo(ov.w), bfhi(ov.w)};
      float rf[8] = {bflo(rv.x), bfhi(rv.x), bflo(rv.y), bfhi(rv.y), bflo(rv.z), bfhi(rv.z), bflo(rv.w), bfhi(rv.w)};
      float gf[8] = {g0.x, g0.y, g0.z, g0.w, g1.x, g1.y, g1.z, g1.w};
      float res[8];
#pragma unroll
      for (int e = 0; e < 8; ++e) res[e] = of[e] * rs * gf[e] * (rf[e] / (1.f + __expf(-rf[e])));
      *(uint4*)(dst + c8 * 8) = make_uint4(pk(res[0], res[1]), pk(res[2], res[3]), pk(res[4], res[5]), pk(res[6], res[7]));
    }
  }
  __syncthreads();
}

DI void swa_qknorm(const Params& p) {
  bf16_t* QKV = (bf16_t*)(p.ws + OFF_BIG);
  const int tid = threadIdx.x, sub = tid & 7;
  const int ngroups = T_TOK * 18;
  for (int g = blockIdx.x * 32 + (tid >> 3); g < ngroups; g += gridDim.x * 32) {
    const int tok = g / 18, slot = g - tok * 18;
    bf16_t* ptr = QKV + (size_t)tok * 1280 + slot * 64 + sub * 8;
    const uint4 wv = *(const uint4*)ptr;
    float v[8] = {bflo(wv.x), bfhi(wv.x), bflo(wv.y), bfhi(wv.y), bflo(wv.z), bfhi(wv.z), bflo(wv.w), bfhi(wv.w)};
    float ss = 0.f;
#pragma unroll
    for (int e = 0; e < 8; ++e) ss += v[e] * v[e];
    ss += __shfl_xor(ss, 1);
    ss += __shfl_xor(ss, 2);
    ss += __shfl_xor(ss, 4);
    const float rs = rsqrtf(ss * (1.f / 64.f) + 1e-6f);
    const float* gain = (slot < 16 ? p.swa_qn : p.swa_kn) + sub * 8;
#pragma unroll
    for (int e = 0; e < 8; ++e) v[e] = v[e] * rs * gain[e];
    const float posf = (float)p.pos[tok];
    const float invf[8] = {1.0f, 0.1939227432012558f, 0.03760603070259094f, 0.007292664609849453f,
                           0.0014142135623842478f, 0.00027424818836152554f, 5.318296098266728e-05f, 1.0313386155758053e-05f};
#pragma unroll
    for (int e = 0; e < 8; ++e) {
      const float other = __shfl_xor(v[e], 1);
      if (sub < 2) {
        const float ang = posf * invf[e];
        const double rev = (double)ang * 0.15915494309189535;
        const float fr = (float)(rev - rint(rev));
        const float sn = __builtin_amdgcn_sinf(fr), cs = __builtin_amdgcn_cosf(fr);
        v[e] = (sub == 0) ? (v[e] * cs - other * sn) : (v[e] * cs + other * sn);
      }
    }
    if (slot < 16) {
#pragma unroll
      for (int e = 0; e < 8; ++e) v[e] *= 0.125f;
    }
    *(uint4*)ptr = make_uint4(pk(v[0], v[1]), pk(v[2], v[3]), pk(v[4], v[5]), pk(v[6], v[7]));
  }
}

DI void swa_attn(const Params& p, int item, char* smem) {
  const int hq = item & 15, n = (item >> 4) & 127, b = item >> 11, hkv = hq >> 3;
  const int tok0 = b * SEQ + n * 128;
  bf16_t* Ks = (bf16_t*)smem;
  bf16_t* vT = Ks + 256 * 72;
  const bf16_t* QKV = (const bf16_t*)(p.ws + OFF_BIG);
  bf16_t* OUT = (bf16_t*)(p.ws + OFF_ACT_B);
  const int tid = threadIdx.x, lane = tid & 63, w = tid >> 6, r = lane & 31, h = lane >> 5;
  __syncthreads();
#pragma unroll
  for (int i = 0; i < 8; ++i) {
    const int cidx = tid + 256 * i, kk = cidx >> 3, kc = cidx & 7;
    const int pos = n * 128 - 128 + kk;
    uint4 kw = make_uint4(0, 0, 0, 0), vw = make_uint4(0, 0, 0, 0);
    if (pos >= 0) {
      const bf16_t* base = QKV + (size_t)(b * SEQ + pos) * 1280;
      kw = *(const uint4*)(base + 1024 + hkv * 64 + kc * 8);
      vw = *(const uint4*)(base + 1152 + hkv * 64 + kc * 8);
    }
    *(uint4*)(Ks + kk * 72 + kc * 8) = kw;
    bf16_t* vd = vT + (kc * 8) * 264 + kk;
    vd[0 * 264] = (bf16_t)(vw.x & 0xffff); vd[1 * 264] = (bf16_t)(vw.x >> 16);
    vd[2 * 264] = (bf16_t)(vw.y & 0xffff); vd[3 * 264] = (bf16_t)(vw.y >> 16);
    vd[4 * 264] = (bf16_t)(vw.z & 0xffff); vd[5 * 264] = (bf16_t)(vw.z >> 16);
    vd[6 * 264] = (bf16_t)(vw.w & 0xffff); vd[7 * 264] = (bf16_t)(vw.w >> 16);
  }
  __syncthreads();
  const int iq = 32 * w + r;
  const bf16_t* qrow = QKV + (size_t)(tok0 + iq) * 1280 + hq * 64 + h * 8;
  bf16x8 qf[4];
#pragma unroll
  for (int s = 0; s < 4; ++s) qf[s] = *(const bf16x8*)(qrow + s * 16);
  f32x16 X[5];
#pragma unroll
  for (int kt = 0; kt < 5; ++kt) {
    X[kt] = zero16();
#pragma unroll
    for (int s = 0; s < 4; ++s) {
      const bf16x8 A = *(const bf16x8*)(Ks + ((w + kt) * 32 + r) * 72 + s * 16 + h * 8);
      X[kt] = mfma32(A, qf[s], X[kt]);
    }
  }
  const float sink = p.swa_sinks[hq];
  float m = sink;
#pragma unroll
  for (int kt = 0; kt < 5; ++kt)
#pragma unroll
    for (int i = 0; i < 16; ++i) {
      const int kk = (w + kt) * 32 + crow(i, h);
      const bool valid = (kk > iq) && (kk <= iq + 128) && (n > 0 || kk >= 128);
      const float xv = valid ? X[kt][i] : -INFINITY;
      X[kt][i] = xv;
      m = fmaxf(m, xv);
    }
  m = fmaxf(m, __shfl_xor(m, 32));
  float l = 0.f;
#pragma unroll
  for (int kt = 0; kt < 5; ++kt)
#pragma unroll
    for (int i = 0; i < 16; ++i) {
      const float pv = __expf(X[kt][i] - m);
      X[kt][i] = pv;
      l += pv;
    }
  l += __shfl_xor(l, 32);
  l += __expf(sink - m);
  f32x16 O[2];
  O[0] = zero16(); O[1] = zero16();
#pragma unroll
  for (int kt = 0; kt < 5; ++kt)
#pragma unroll
    for (int s2 = 0; s2 < 2; ++s2) {
      const uint4 pw = make_uint4(pk(X[kt][8 * s2 + 0], X[kt][8 * s2 + 1]), pk(X[kt][8 * s2 + 2], X[kt][8 * s2 + 3]),
                                  pk(X[kt][8 * s2 + 4], X[kt][8 * s2 + 5]), pk(X[kt][8 * s2 + 6], X[kt][8 * s2 + 7]));
      const bf16x8 P = __builtin_bit_cast(bf16x8, pw);
#pragma unroll
      for (int mt = 0; mt < 2; ++mt) {
        const bf16_t* vp = vT + (mt * 32 + r) * 264 + (w + kt) * 32 + 16 * s2 + 4 * h;
        const uint2 lo = *(const uint2*)vp, hi = *(const uint2*)(vp + 8);
        const bf16x8 A = __builtin_bit_cast(bf16x8, make_uint4(lo.x, lo.y, hi.x, hi.y));
        O[mt] = mfma32(A, P, O[mt]);
      }
    }
  const float inv = 1.f / l;
  bf16_t* orow = OUT + (size_t)(tok0 + iq) * 1024 + hq * 64 + 4 * h;
#pragma unroll
  for (int mt = 0; mt < 2; ++mt)
#pragma unroll
    for (int g = 0; g < 4; ++g)
      *(uint2*)(orow + mt * 32 + 8 * g) = make_uint2(pk(O[mt][4 * g] * inv, O[mt][4 * g + 1] * inv), pk(O[mt][4 * g + 2] * inv, O[mt][4 * g + 3] * inv));
}

DI unsigned fkey_u(unsigned u) { return u ^ ((unsigned)((int)u >> 31) | 0x80000000u); }
DI float unfkey(unsigned k) { return __uint_as_float(k ^ ((~(unsigned)((int)k >> 31)) | 0x80000000u)); }
DI void cswap(unsigned& a, unsigned& b) { const unsigned hi = a > b ? a : b, lo = a > b ? b : a; a = hi; b = lo; }
DI void sort16(unsigned (&t)[16]) {
#pragma unroll
  for (int k = 2; k <= 16; k <<= 1)
#pragma unroll
    for (int j = k >> 1; j > 0; j >>= 1)
#pragma unroll
      for (int i = 0; i < 16; ++i) {
        const int l = i ^ j;
        if (l > i) { if ((i & k) == 0) cswap(t[i], t[l]); else cswap(t[l], t[i]); }
      }
}
DI void merge16(unsigned (&a)[16], const unsigned (&b)[16]) {
#pragma unroll
  for (int j = 0; j < 16; ++j) a[j] = a[j] > b[15 - j] ? a[j] : b[15 - j];
#pragma unroll
  for (int j = 8; j > 0; j >>= 1)
#pragma unroll
    for (int i = 0; i < 16; ++i) { const int l = i ^ j; if (l > i) cswap(a[i], a[l]); }
}
DI void cswap2(unsigned& ak, int& ap, unsigned& bk, int& bp) {
  const bool sw = bk > ak;
  const unsigned hk = sw ? bk : ak, lk = sw ? ak : bk;
  const int hp = sw ? bp : ap, lp = sw ? ap : bp;
  ak = hk; ap = hp; bk = lk; bp = lp;
}
DI void sort16p(unsigned (&t)[16], int (&q)[16]) {
#pragma unroll
  for (int k = 2; k <= 16; k <<= 1)
#pragma unroll
    for (int j = k >> 1; j > 0; j >>= 1)
#pragma unroll
      for (int i = 0; i < 16; ++i) {
        const int l = i ^ j;
        if (l > i) { if ((i & k) == 0) cswap2(t[i], q[i], t[l], q[l]); else cswap2(t[l], q[l], t[i], q[i]); }
      }
}
__device__ constexpr int CIA[25] = {0,0,0,0,0,0,0,0,0,0,0,0,0,0,0,0, 2,2,2,2,2, 3,3,3,3};
__device__ constexpr int CJA[25] = {0,1,2,3,4,5,6,7,8,9,10,11,12,13,14,15, 0,1,2,3,4, 0,1,2,3};
__device__ constexpr int CIB[25] = {1,1,1,1,1,1,1,1, 4,4,4, 5,5,6,6,7,7, 8,9,10,11,12,13,14,15};
__device__ constexpr int CJB[25] = {0,1,2,3,4,5,6,7, 0,1,2, 0,1,0,1,0,1, 0,0,0,0,0,0,0,0};

DI void peer_topk_wave(const Params& p, int layer, int item) {
  const int head = item >> 10, tok0 = (item & 1023) * 32;
  const bf16_t* Q = (const bf16_t*)(p.ws + OFF_BIG);
  const bf16_t* KEYS = (const bf16_t*)(p.ws + OFF_KEYS) + (size_t)(layer * 8 + head) * 256 * 64;
  int* E = (int*)(p.ws + OFF_E);
  float* G = (float*)(p.ws + OFF_G);
  const int lane = threadIdx.x & 63, r = lane & 31, h = lane >> 5;
  const unsigned h4 = 4u * (1u - (unsigned)h);
  unsigned tl[2][16];
  bf16x8 qf[2][4], kf[4][4];
#pragma unroll
  for (int set = 0; set < 2; ++set) {
    const bf16_t* qrow = Q + (size_t)(tok0 + r) * 1024 + head * 128 + set * 64 + h * 8;
#pragma unroll
    for (int s = 0; s < 4; ++s) qf[set][s] = *(const bf16x8*)(qrow + s * 16);
  }
#pragma unroll
  for (int kt = 0; kt < 4; ++kt)
#pragma unroll
    for (int s = 0; s < 4; ++s) kf[kt][s] = *(const bf16x8*)(KEYS + (size_t)(kt * 32 + r) * 64 + h * 8 + s * 16);
#pragma unroll
  for (int set = 0; set < 2; ++set) {
    f32x16 X[4];
#pragma unroll
    for (int kt = 0; kt < 4; ++kt) {
      X[kt] = zero16();
#pragma unroll
      for (int s = 0; s < 4; ++s) X[kt] = mfma32(kf[kt][s], qf[set][s], X[kt]);
    }
#pragma unroll
    for (int kt = 0; kt < 4; ++kt) {
      if (set == 0 && kt == 2) {
#pragma unroll
        for (int k2 = 0; k2 < 4; ++k2)
#pragma unroll
          for (int s = 0; s < 4; ++s) kf[k2][s] = *(const bf16x8*)(KEYS + (size_t)(128 + k2 * 32 + r) * 64 + h * 8 + s * 16);
      }
      unsigned kk[16];
#pragma unroll
      for (int i = 0; i < 16; ++i)
        kk[i] = (fkey_u(__float_as_uint(X[kt][i])) & ~127u) + ((unsigned)(127 - kt * 32 - (i & 3) - 8 * (i >> 2) - 4) + h4);
      sort16(kk);
      if (kt == 0) {
#pragma unroll
        for (int i = 0; i < 16; ++i) tl[set][i] = kk[i];
      } else merge16(tl[set], kk);
    }
  }
  unsigned mine[16], oth[16];
#pragma unroll
  for (int j = 0; j < 16; ++j) {
    const unsigned send = h ? tl[0][j] : tl[1][j];
    oth[j] = (unsigned)__shfl_xor((int)send, 32);
    mine[j] = h ? tl[1][j] : tl[0][j];
  }
  merge16(mine, oth);
  float v1[16], v2[16]; int i1[16], i2[16];
#pragma unroll
  for (int j = 0; j < 16; ++j) {
    const unsigned o = (unsigned)__shfl_xor((int)mine[j], 32);
    const unsigned A = h ? o : mine[j], B = h ? mine[j] : o;
    v1[j] = unfkey(A & ~127u); i1[j] = 127 - (int)(A & 127u);
    v2[j] = unfkey(B & ~127u); i2[j] = 127 - (int)(B & 127u);
  }
  unsigned ck[16], dk[16]; int cp[16], dp[16];
#pragma unroll
  for (int n = 0; n < 32; ++n) {
    unsigned key = 0u; int e = 0;
    if (n < 25) {
      const float sA = v1[CIA[n]] + v2[CJA[n]], sB = v1[CIB[n]] + v2[CJB[n]];
      const int eA = i1[CIA[n]] * 128 + i2[CJA[n]], eB = i1[CIB[n]] * 128 + i2[CJB[n]];
      key = fkey_u(__float_as_uint(h ? sB : sA)); e = h ? eB : eA;
    }
    if (n < 16) { ck[n] = key; cp[n] = e; } else { dk[n - 16] = key; dp[n - 16] = e; }
  }
  sort16p(ck, cp);
  sort16p(dk, dp);
#pragma unroll
  for (int j = 0; j < 16; ++j) { const bool sw = dk[15 - j] > ck[j]; ck[j] = sw ? dk[15 - j] : ck[j]; cp[j] = sw ? dp[15 - j] : cp[j]; }
#pragma unroll
  for (int j = 8; j > 0; j >>= 1)
#pragma unroll
    for (int i = 0; i < 16; ++i) { const int l = i ^ j; if (l > i) cswap2(ck[i], cp[i], ck[l], cp[l]); }
  unsigned fk[16]; int fe[16];
#pragma unroll
  for (int j = 0; j < 16; ++j) { dk[j] = (unsigned)__shfl_xor((int)ck[j], 32); dp[j] = __shfl_xor(cp[j], 32); }
#pragma unroll
  for (int j = 0; j < 16; ++j) {
    const bool sw = (dk[15 - j] > ck[j]) || (dk[15 - j] == ck[j] && dp[15 - j] > cp[j]);
    fk[j] = sw ? dk[15 - j] : ck[j]; fe[j] = sw ? dp[15 - j] : cp[j];
  }
  float sv[16], mx = -INFINITY;
#pragma unroll
  for (int j = 0; j < 16; ++j) { sv[j] = unfkey(fk[j]); mx = fmaxf(mx, sv[j]); }
  float sm = 0.f;
#pragma unroll
  for (int j = 0; j < 16; ++j) { sv[j] = __expf(sv[j] - mx); sm += sv[j]; }
  const float inv = 1.f / sm;
  const size_t o = ((size_t)(tok0 + r) * 8 + head) * 16 + h * 8;
  *(int4*)(E + o) = make_int4(fe[0], fe[1], fe[2], fe[3]);
  *(int4*)(E + o + 4) = make_int4(fe[4], fe[5], fe[6], fe[7]);
  *(float4*)(G + o) = make_float4(sv[0] * inv, sv[1] * inv, sv[2] * inv, sv[3] * inv);
  *(float4*)(G + o + 4) = make_float4(sv[4] * inv, sv[5] * inv, sv[6] * inv, sv[7] * inv);
}

DI v32f fp6x32(const uint2* p) {
  const uint2 a = p[0], b = p[1], c = p[2];
  v6u x; x[0] = a.x; x[1] = a.y; x[2] = b.x; x[3] = b.y; x[4] = c.x; x[5] = c.y;
  return __builtin_amdgcn_cvt_scalef32_pk32_f32_fp6(x, 1.0f);
}

typedef unsigned u2v __attribute__((ext_vector_type(2)));
typedef unsigned v16u __attribute__((ext_vector_type(16)));
typedef __bf16 v32bf __attribute__((ext_vector_type(32)));
DI v6u mk6(u2v a, u2v b, u2v c) { v6u x; x[0] = a[0]; x[1] = a[1]; x[2] = b[0]; x[3] = b[1]; x[4] = c[0]; x[5] = c[1]; return x; }

DI v6u ld6(const unsigned char* p) { const u2v* q = (const u2v*)p; return mk6(q[0], q[1], q[2]); }
#define U_LOAD4(RAW, M4) _Pragma("unroll") for (int mi = 0; mi < 4; ++mi) { \
    const unsigned char* up_ = U + (size_t)e_s[4 * ((M4) + mi) + grp] * 768 + i16 * 24; \
    RAW[2 * mi] = ld6(up_); RAW[2 * mi + 1] = ld6(up_ + 384); }
#define U_COMP4(RAW, M4) _Pragma("unroll") for (int mi = 0; mi < 4; ++mi) { \
    const int pidx = 4 * ((M4) + mi) + grp; \
    const v16u u0 = __builtin_bit_cast(v16u, __builtin_amdgcn_cvt_scalef32_pk32_bf16_fp6(RAW[2 * mi], 1.0f)); \
    const v16u u1 = __builtin_bit_cast(v16u, __builtin_amdgcn_cvt_scalef32_pk32_bf16_fp6(RAW[2 * mi + 1], 1.0f)); \
    float acc0 = 0.f, acc1 = 0.f, acc2 = 0.f, acc3 = 0.f; \
    _Pragma("unroll") for (int i = 0; i < 16; i += 2) { \
      acc0 = dot2(u0[i], xp[0][i], acc0); acc1 = dot2(u0[i + 1], xp[0][i + 1], acc1); \
      acc2 = dot2(u1[i], xp[1][i], acc2); acc3 = dot2(u1[i + 1], xp[1][i + 1], acc3); } \
    float acc = (acc0 + acc1) + (acc2 + acc3); \
    acc += __shfl_xor(acc, 1); acc += __shfl_xor(acc, 2); acc += __shfl_xor(acc, 4); acc += __shfl_xor(acc, 8); \
    acc *= su_s[pidx]; \
    const float a = 0.5f * acc * (1.f + erff(acc * 0.7071067811865476f)) * gv_s[pidx]; \
    if (i16 == 0) a_s[pidx] = a; \
    __builtin_amdgcn_sched_barrier(0); }

DI void peer_gather_u(const Params& p, int layer, char* smem) {
  const int tid = threadIdx.x, lane = tid & 63, w = tid >> 6, grp = lane >> 4, i16 = lane & 15;
  float* a_s = (float*)smem + w * 512;
  float* su_s = a_s + 128;
  float* gv_s = a_s + 256;
  int* e_s = (int*)(a_s + 384);
  const bf16_t* HN = (const bf16_t*)(p.ws + OFF_ACT_A);
  const unsigned char* U = (const unsigned char*)(p.ws + OFF_TBL_U) + (size_t)layer * 16 * MiB;
  const float* IU = (const float*)(p.ws + OFF_INV) + (layer * 2 + 0) * 16384;
  const float* IV = (const float*)(p.ws + OFF_INV) + (layer * 2 + 1) * 16384;
  const int* E = (const int*)(p.ws + OFF_E);
  const float* G = (const float*)(p.ws + OFF_G);
  float* A = (float*)(p.ws + OFF_A);
  for (int tok = blockIdx.x * 4 + w; tok < T_TOK; tok += gridDim.x * 4) {
    unsigned xp[2][16];
#pragma unroll
    for (int c = 0; c < 2; ++c) {
      const uint4* xq = (const uint4*)(HN + (size_t)tok * 1024 + c * 512 + i16 * 32);
#pragma unroll
      for (int q = 0; q < 4; ++q) { const uint4 x0 = xq[q]; xp[c][4 * q] = x0.x; xp[c][4 * q + 1] = x0.y; xp[c][4 * q + 2] = x0.z; xp[c][4 * q + 3] = x0.w; }
    }
    {
      const int e0 = E[(size_t)tok * 128 + lane], e1 = E[(size_t)tok * 128 + 64 + lane];
      e_s[lane] = e0; e_s[64 + lane] = e1;
      su_s[lane] = IU[e0]; su_s[64 + lane] = IU[e1];
      gv_s[lane] = G[(size_t)tok * 128 + lane] * IV[e0]; gv_s[64 + lane] = G[(size_t)tok * 128 + 64 + lane] * IV[e1];
    }
    wave_sync();
    v6u rA[8], rB[8];
    U_LOAD4(rA, 0)
#pragma unroll 1
    for (int m4 = 0; m4 < 32; m4 += 8) {
      U_LOAD4(rB, m4 + 4)
      U_COMP4(rA, m4)
      if (m4 + 8 < 32) { U_LOAD4(rA, m4 + 8) }
      U_COMP4(rB, m4 + 4)
    }
    wave_sync();
    A[(size_t)tok * 128 + lane] = a_s[lane];
    A[(size_t)tok * 128 + 64 + lane] = a_s[64 + lane];
    wave_sync();
  }
}

#define V_LOAD8(RAW, M8) _Pragma("unroll") for (int mi = 0; mi < 4; ++mi) RAW[mi] = ld6(V + (size_t)e_s[2 * ((M8) + mi) + h] * 768 + r * 24);
#define V_COMP8(RAW, M8) _Pragma("unroll") for (int mi = 0; mi < 4; ++mi) { \
    const float a = a_s[2 * ((M8) + mi) + h]; \
    const v32f vv = __builtin_amdgcn_cvt_scalef32_pk32_f32_fp6(RAW[mi], 1.0f); \
    _Pragma("unroll") for (int i = 0; i < 32; ++i) o[i] = fmaf(a, vv[i], o[i]); \
    __builtin_amdgcn_sched_barrier(0); }

DI void peer_gather_v(const Params& p, int layer, char* smem, const float* __restrict__ next_gain) {
  const int tid = threadIdx.x, lane = tid & 63, w = tid >> 6, r = lane & 31, h = lane >> 5;
  float* a_s = (float*)smem + w * 256;
  int* e_s = (int*)(a_s + 128);
  const unsigned char* V = (const unsigned char*)(p.ws + OFF_TBL_V) + (size_t)layer * 16 * MiB;
  const int* E = (const int*)(p.ws + OFF_E);
  const float* A = (const float*)(p.ws + OFF_A);
  for (int tok = blockIdx.x * 4 + w; tok < T_TOK; tok += gridDim.x * 4) {
    e_s[lane] = E[(size_t)tok * 128 + lane]; e_s[64 + lane] = E[(size_t)tok * 128 + 64 + lane];
    a_s[lane] = A[(size_t)tok * 128 + lane]; a_s[64 + lane] = A[(size_t)tok * 128 + 64 + lane];
    wave_sync();
    float o[32];
#pragma unroll
    for (int i = 0; i < 32; ++i) o[i] = 0.f;
    v6u rA[4], rB[4];
    V_LOAD8(rA, 0)
#pragma unroll 1
    for (int m8 = 0; m8 < 64; m8 += 8) {
      V_LOAD8(rB, m8 + 4)
      V_COMP8(rA, m8)
      if (m8 + 8 < 64) { V_LOAD8(rA, m8 + 8) }
      V_COMP8(rB, m8 + 4)
    }
#pragma unroll
    for (int i = 0; i < 32; ++i) o[i] += __shfl_xor(o[i], 32);
    float4* hp = (float4*)(p.out + (size_t)tok * 1024 + r * 32 + h * 16);
    float4 hv[4];
    float ss = 0.f;
#pragma unroll
    for (int q = 0; q < 4; ++q) {
      float4 t = hp[q];
      t.x += h ? o[16 + 4 * q] : o[4 * q]; t.y += h ? o[17 + 4 * q] : o[4 * q + 1];
      t.z += h ? o[18 + 4 * q] : o[4 * q + 2]; t.w += h ? o[19 + 4 * q] : o[4 * q + 3];
      hp[q] = t; hv[q] = t;
      ss += t.x * t.x + t.y * t.y + t.z * t.z + t.w * t.w;
    }
    if (next_gain) {
#pragma unroll
      for (int o2 = 32; o2 >= 1; o2 >>= 1) ss += __shfl_xor(ss, o2);
      const float rs = rsqrtf(ss * (1.f / 1024.f) + 1e-6f);
      const float4* gp = (const float4*)(next_gain + r * 32 + h * 16);
      unsigned pw[8];
#pragma unroll
      for (int q = 0; q < 4; ++q) {
        const float4 g = gp[q];
        pw[2 * q] = pk(hv[q].x * rs * g.x, hv[q].y * rs * g.y); pw[2 * q + 1] = pk(hv[q].z * rs * g.z, hv[q].w * rs * g.w);
      }
      uint4* dp = (uint4*)((bf16_t*)(p.ws + OFF_ACT_A) + (size_t)tok * 1024 + r * 32 + h * 16);
      dp[0] = make_uint4(pw[0], pw[1], pw[2], pw[3]); dp[1] = make_uint4(pw[4], pw[5], pw[6], pw[7]);
    }
    wave_sync();
  }
}

DI void run_phase(const Params& p, int ph, char* smem) {
  bf16_t* actA = (bf16_t*)(p.ws + OFF_ACT_A);
  bf16_t* big = (bf16_t*)(p.ws + OFF_BIG);
  switch (ph) {
    case 0: phase_convert(p, smem); phase_cvt_tables(p, 0); phase_cvt_tables(p, 1); break;
    case 1: phase_rmsnorm(p.x, p.ln_mix, actA); break;
    case 2: phase_gemm<EPI_GLA_IN>(p, actA, (const bf16_t*)(p.ws + OFF_WT_GLA_IN), 25, big, 3072, nullptr, smem); break;
    case 3: for (int it = blockIdx.x; it < 2048; it += gridDim.x) gla_phase1(p, it, smem); break;
    case 4: gla_scan(p); break;
    case 5: for (int it = blockIdx.x; it < 2048; it += gridDim.x) gla_phase3(p, it, smem); break;
    case 6: phase_gemm<EPI_RESID_X>(p, actA, (const bf16_t*)(p.ws + OFF_WT_GLA_OUT), 8, nullptr, 0, nullptr, smem); break;
    case 7: phase_rmsnorm(p.out, p.ln_ffn, actA); break;
    case 8: phase_gemm<EPI_BF16>(p, actA, (const bf16_t*)(p.ws + OFF_WT_PQ), 8, big, 1024, nullptr, smem); break;
    case 9: for (int it = blockIdx.x * 4 + (threadIdx.x >> 6); it < 8192; it += gridDim.x * 4) peer_topk_wave(p, 0, it); break;
    case 10: peer_gather_u(p, 0, smem); break;
    case 11: peer_gather_v(p, 0, smem, p.ln_mix + 1024); break;
    case 12: break;
    case 13: phase_gemm<EPI_BF16>(p, actA, (const bf16_t*)(p.ws + OFF_WT_SWA_IN), 10, big, 1280, p.swa_b_in, smem); break;
    case 14: swa_qknorm(p); break;
    case 15: for (int it = blockIdx.x; it < 4096; it += gridDim.x) swa_attn(p, it, smem); break;
    case 16: phase_gemm<EPI_RESID_INPLACE>(p, (const bf16_t*)(p.ws + OFF_ACT_B), (const bf16_t*)(p.ws + OFF_WT_SWA_OUT), 8, nullptr, 0, p.swa_b_out, smem); break;
    case 17: phase_rmsnorm(p.out, p.ln_ffn + 1024, actA); break;
    case 18: phase_gemm<EPI_BF16>(p, actA, (const bf16_t*)(p.ws + OFF_WT_PQ) + (size_t)1024 * 1024, 8, big, 1024, nullptr, smem); break;
    case 19: for (int it = blockIdx.x * 4 + (threadIdx.x >> 6); it < 8192; it += gridDim.x * 4) peer_topk_wave(p, 1, it); break;
    case 20: peer_gather_u(p, 1, smem); break;
    case 21: peer_gather_v(p, 1, smem, nullptr); break;
    default: break;
  }
}

template <int PH>
__global__ void __launch_bounds__(256, 2) phase_kernel(Params p) {
  __shared__ __attribute__((aligned(16))) char smem[SMEM_BYTES];
  run_phase(p, PH, smem);
}

template <int PH>
static void launch_phases(const Params& p, int grid, hipStream_t stream) {
  hipLaunchKernelGGL(phase_kernel<PH>, dim3(grid), dim3(256), 0, stream, p);
  if constexpr (PH + 1 < NPHASE) launch_phases<PH + 1>(p, grid, stream);
}


#define XB_TMO      128
#define XB_XCNT(j)  (256  + 64 * (j))
#define XB_XSUB(j)  (1280 + 64 * (j))
#define XB_XGEN(j)  (2304 + 64 * (j))
#define XB_TOP      3328
#define XB_TOPGEN   3392
#define XCD_BAR_WORDS 3456
#define XB_SPIN_CAP (1u << 23)
#define LAS __attribute__((address_space(3)))
DI unsigned xb_ld(unsigned* p) { return __hip_atomic_load(p, __ATOMIC_RELAXED, __HIP_MEMORY_SCOPE_AGENT); }
DI unsigned xb_add(unsigned* p, unsigned v) { return __hip_atomic_fetch_add(p, v, __ATOMIC_RELAXED, __HIP_MEMORY_SCOPE_AGENT); }
DI unsigned xb_xcc_id() { return (unsigned)__builtin_amdgcn_s_getreg((3 << 11) | 20) & 0xFu; }
#define XB_SPIN(cond, bar) do { unsigned _sp = 0; while (cond) { __builtin_amdgcn_s_sleep(1); \
    if ((++_sp & 255u) == 0u) { if (xb_ld(&(bar)[XB_TMO])) break; if (_sp > XB_SPIN_CAP) { atomicAdd(&(bar)[XB_TMO], 1u); break; } } } } while (0)
struct XcdBarrier { unsigned* bar; unsigned x; volatile LAS unsigned* st; };
DI XcdBarrier xcd_barrier_post(unsigned* bar, volatile LAS unsigned* st) {
  XcdBarrier b; b.bar = bar; b.x = xb_xcc_id(); b.st = st;
  if (threadIdx.x == 0) (void)xb_add(&bar[XB_XCNT(b.x)], 1u);
  return b;
}
DI void xcd_barrier_complete(unsigned* bar, unsigned x, unsigned& nloc, unsigned& nx) {
  const unsigned G = gridDim.x * gridDim.y * gridDim.z;
  unsigned sum, cnt, mine, sp = 0u;
  for (;;) {
    sum = 0u; cnt = 0u; mine = 0u;
#pragma unroll
    for (unsigned j = 0; j < 16; ++j) { const unsigned c = xb_ld(&bar[XB_XCNT(j)]); sum += c; cnt += (c > 0u) ? 1u : 0u; mine = (j == x) ? c : mine; }
    if (sum == G) break;
    __builtin_amdgcn_s_sleep(1);
    if ((++sp & 255u) == 0u) { if (xb_ld(&bar[XB_TMO])) break; if (sp > XB_SPIN_CAP) { atomicAdd(&bar[XB_TMO], 1u); break; } }
  }
  nloc = mine > 0u ? mine : 1u; nx = cnt > 0u ? cnt : 1u;
}
DI void xcd_barrier(const XcdBarrier& b) {
  asm volatile("s_waitcnt vmcnt(0)" ::: "memory");
  __syncthreads();
  if (threadIdx.x == 0) {
    unsigned* bar = b.bar;
    __builtin_amdgcn_s_waitcnt(0);
    unsigned nloc = b.st[0], nx = b.st[1];
    if (nloc == 0u) { xcd_barrier_complete(bar, b.x, nloc, nx); b.st[0] = nloc; b.st[1] = nx; }
    const unsigned old = xb_add(&bar[XB_XSUB(b.x)], 1u);
    const unsigned gen = old / nloc;
    if (old + 1u == (gen + 1u) * nloc) {
      __builtin_amdgcn_fence(__ATOMIC_RELEASE, "agent");
      asm volatile("s_waitcnt vmcnt(0)" ::: "memory");
      const unsigned og = xb_add(&bar[XB_TOP], 1u);
      const unsigned tg = og / nx;
      if (og + 1u == (tg + 1u) * nx) xb_add(&bar[XB_TOPGEN], 1u);
      else XB_SPIN(xb_ld(&bar[XB_TOPGEN]) == tg, bar);
      __builtin_amdgcn_fence(__ATOMIC_ACQUIRE, "agent");
      xb_add(&bar[XB_XGEN(b.x)], 1u);
      asm volatile("s_waitcnt vmcnt(0)" ::: "memory");
    } else {
      XB_SPIN(xb_ld(&bar[XB_XGEN(b.x)]) == gen, bar);
      __builtin_amdgcn_fence(__ATOMIC_ACQUIRE, "agent");
      asm volatile("s_waitcnt vmcnt(0)" ::: "memory");
    }
  }
  __syncthreads();
}

#if !MULTI_LAUNCH
template <int PH>
DI void run_all(const Params& p, char* smem, const XcdBarrier& xb) {
  if constexpr (PH != 12) {
    run_phase(p, PH, smem);
    if constexpr (PH + 1 < NPHASE) {
      if constexpr (PH == 0) cg::this_grid().sync();
      else xcd_barrier(xb);
    }
  }
  if constexpr (PH + 1 < NPHASE) run_all<PH + 1>(p, smem, xb);
}
__global__ void __launch_bounds__(256, 2) trunk_kernel(Params p) {
  __shared__ __attribute__((aligned(16))) char smem[SMEM_BYTES];
  __shared__ uint4 xb_words;
  if (threadIdx.x == 0) xb_words = make_uint4(0u, 0u, 0u, 0u);
  __syncthreads();
  const XcdBarrier xb = xcd_barrier_post((unsigned*)(p.ws + OFF_BAR), (volatile LAS unsigned*)&xb_words);
  run_all<0>(p, smem, xb);
}
#endif

extern "C" void kernel_launch(void* const* d_in, const int* in_sizes, int n_in, void* d_out, int out_size, void* d_ws, size_t ws_size,
                              hipStream_t stream) {
  Params p{};
  p.x = (const float*)d_in[0]; p.pos = (const int*)d_in[1]; p.ln_mix = (const float*)d_in[2]; p.ln_ffn = (const float*)d_in[3];
  p.gla_w_in = (const float*)d_in[4]; p.gla_w_alpha = (const float*)d_in[5]; p.gla_b_alpha = (const float*)d_in[6];
  p.gla_norm = (const float*)d_in[7]; p.gla_w_out = (const float*)d_in[8];
  p.swa_w_in = (const float*)d_in[9]; p.swa_b_in = (const float*)d_in[10]; p.swa_qn = (const float*)d_in[11]; p.swa_kn = (const float*)d_in[12];
  p.swa_sinks = (const float*)d_in[13]; p.swa_w_out = (const float*)d_in[14]; p.swa_b_out = (const float*)d_in[15];
  p.peer_wq = (const float*)d_in[16]; p.peer_keys = (const float*)d_in[17]; p.peer_u = (const float*)d_in[18]; p.peer_v = (const float*)d_in[19];
  p.out = (float*)d_out; p.ws = (char*)d_ws;
  static int grid_blocks = 0;
  if (!grid_blocks) {
    int dev = 0, cus = 0, per_cu = 0;
    (void)hipGetDevice(&dev);
    (void)hipDeviceGetAttribute(&cus, hipDeviceAttributeMultiprocessorCount, dev);
    #if MULTI_LAUNCH
    per_cu = 2;
#else
    (void)hipOccupancyMaxActiveBlocksPerMultiprocessor(&per_cu, trunk_kernel, 256, 0);
#endif
    if (per_cu < 1) per_cu = 1;
    if (per_cu > 2) per_cu = 2;
    grid_blocks = cus * per_cu;
  }
#if MULTI_LAUNCH
  p.phase_lo = 0; p.phase_hi = 0;
  launch_phases<0>(p, grid_blocks, stream);
#else
  p.phase_lo = 0; p.phase_hi = NPHASE - 1;
  void* args[] = {&p};
  (void)hipMemsetAsync((char*)d_ws + OFF_BAR, 0, XCD_BAR_WORDS * 4, stream);
  hipError_t e = hipLaunchCooperativeKernel((void*)trunk_kernel, dim3(grid_blocks), dim3(256), args, 0, stream);
  if (e != hipSuccess) fprintf(stderr, "cooperative launch failed: %s (grid %d)\n", hipGetErrorString(e), grid_blocks);
#endif
}
```

```cpp
#include <hip/hip_runtime.h>
#include <hip/hip_cooperative_groups.h>
#include <stdint.h>
#include <stdio.h>
namespace cg = cooperative_groups;

#ifndef MULTI_LAUNCH
#define MULTI_LAUNCH 0
#endif

#define DI __device__ __forceinline__
typedef unsigned short bf16_t;
typedef __attribute__((ext_vector_type(8))) short bf16x8;
typedef __attribute__((ext_vector_type(16))) float f32x16;
typedef __bf16 bf16x2_t __attribute__((ext_vector_type(2)));
typedef float f32x2_t __attribute__((ext_vector_type(2)));
typedef float f2 __attribute__((ext_vector_type(2)));

constexpr int T_TOK = 32768;
constexpr int SEQ = 16384;
constexpr int DM = 1024;
constexpr int NPHASE = 22;

constexpr size_t MiB = 1048576;
constexpr size_t OFF_WT_GLA_IN = 0;
constexpr size_t OFF_WT_GLA_OUT = 7 * MiB;
constexpr size_t OFF_WT_SWA_IN = 9 * MiB;
constexpr size_t OFF_WT_SWA_OUT = 12 * MiB;
constexpr size_t OFF_WT_PQ = 14 * MiB;
constexpr size_t OFF_KEYS = 18 * MiB;
constexpr size_t OFF_INV = 20 * MiB;
constexpr size_t OFF_TBL_U = 24 * MiB;
constexpr size_t OFF_TBL_V = 56 * MiB;
constexpr size_t OFF_ACT_A = 88 * MiB;
constexpr size_t OFF_BIG = 152 * MiB;
constexpr size_t OFF_E = OFF_BIG + 64 * MiB;
constexpr size_t OFF_G = OFF_BIG + 80 * MiB;
constexpr size_t OFF_A = OFF_BIG + 96 * MiB;
constexpr size_t OFF_KVT = 344 * MiB;
constexpr size_t OFF_ACT_B = OFF_KVT;
constexpr size_t OFF_LR = 472 * MiB;
constexpr size_t OFF_DECAY = 474 * MiB;
constexpr size_t OFF_BAR = 476 * MiB;

constexpr int SMEM_BYTES = 73728;
constexpr int LDK = 72;

struct Params {
  const float* x; const int* pos; const float* ln_mix; const float* ln_ffn;
  const float* gla_w_in; const float* gla_w_alpha; const float* gla_b_alpha; const float* gla_norm; const float* gla_w_out;
  const float* swa_w_in; const float* swa_b_in; const float* swa_qn; const float* swa_kn; const float* swa_sinks;
  const float* swa_w_out; const float* swa_b_out;
  const float* peer_wq; const float* peer_keys; const float* peer_u; const float* peer_v;
  float* out; char* ws;
  int phase_lo, phase_hi;
};

DI unsigned pk(float lo, float hi) { f32x2_t v = {lo, hi}; bf16x2_t b = __builtin_convertvector(v, bf16x2_t); return __builtin_bit_cast(unsigned, b); }
DI bf16_t f2bf(float x) { return (bf16_t)(pk(x, 0.f) & 0xffffu); }
DI float bflo(unsigned w) { return __uint_as_float(w << 16); }
DI float bfhi(unsigned w) { return __uint_as_float(w & 0xffff0000u); }
DI float bf2f(bf16_t b) { return __uint_as_float(((unsigned)b) << 16); }
DI float dot2(unsigned a, unsigned b, float c) { return __builtin_amdgcn_fdot2_f32_bf16(__builtin_bit_cast(bf16x2_t, a), __builtin_bit_cast(bf16x2_t, b), c, false); }
DI int crow(int i, int h) { return (i & 3) + 8 * (i >> 2) + 4 * h; }
DI f32x16 mfma32(bf16x8 a, bf16x8 b, f32x16 c) { return __builtin_amdgcn_mfma_f32_32x32x16_bf16(a, b, c, 0, 0, 0); }
DI f32x16 zero16() { f32x16 z; for (int i = 0; i < 16; ++i) z[i] = 0.f; return z; }
DI void wave_sync() { __builtin_amdgcn_fence(__ATOMIC_RELEASE, "wavefront"); __builtin_amdgcn_wave_barrier(); __builtin_amdgcn_fence(__ATOMIC_ACQUIRE, "wavefront"); }
DI int mbcnt64(unsigned long long m) { return __builtin_amdgcn_mbcnt_hi((unsigned)(m >> 32), __builtin_amdgcn_mbcnt_lo((unsigned)m, 0)); }
DI float logsig(float z) { return fminf(z, 0.f) - __logf(1.f + __expf(-fabsf(z))); }

DI void transpose_tile(const float* __restrict__ src, int N, bf16_t* __restrict__ dst, int kt, int nt, float* sT) {
  const int tid = threadIdx.x;
  const int r = tid >> 4, c4 = (tid & 15) * 4;
#pragma unroll
  for (int i = 0; i < 4; ++i) {
    const int k = kt * 64 + r + 16 * i, n = nt * 64 + c4;
    float4 v = make_float4(0.f, 0.f, 0.f, 0.f);
    if (n + 3 < N) v = *(const float4*)(src + (size_t)k * N + n);
    float* d = sT + (r + 16 * i) * 65 + c4;
    d[0] = v.x; d[1] = v.y; d[2] = v.z; d[3] = v.w;
  }
  __syncthreads();
  const int n = tid >> 2, seg = tid & 3;
  unsigned w[8];
#pragma unroll
  for (int j = 0; j < 8; ++j) w[j] = pk(sT[(seg * 16 + 2 * j) * 65 + n], sT[(seg * 16 + 2 * j + 1) * 65 + n]);
  uint4* d = (uint4*)(dst + (size_t)(nt * 64 + n) * 1024 + kt * 64 + seg * 16);
  d[0] = make_uint4(w[0], w[1], w[2], w[3]);
  d[1] = make_uint4(w[4], w[5], w[6], w[7]);
  __syncthreads();
}

DI void cvt_elems(const float* __restrict__ src, bf16_t* __restrict__ dst, size_t n8) {
  for (size_t i = (size_t)blockIdx.x * 256 + threadIdx.x; i < n8; i += (size_t)gridDim.x * 256) {
    const float4 a = ((const float4*)src)[2 * i], b = ((const float4*)src)[2 * i + 1];
    ((uint4*)dst)[i] = make_uint4(pk(a.x, a.y), pk(a.z, a.w), pk(b.x, b.y), pk(b.z, b.w));
  }
}

DI void phase_convert(const Params& p, char* smem) {
  float* sT = (float*)smem;
  for (int t = blockIdx.x; t < 2144; t += gridDim.x) {
    const float* src; int N, ntn; bf16_t* dst; int local;
    if (t < 800) { src = p.gla_w_in; N = 3088; ntn = 50; dst = (bf16_t*)(p.ws + OFF_WT_GLA_IN); local = t; }
    else if (t < 1056) { src = p.gla_w_out; N = 1024; ntn = 16; dst = (bf16_t*)(p.ws + OFF_WT_GLA_OUT); local = t - 800; }
    else if (t < 1376) { src = p.swa_w_in; N = 1280; ntn = 20; dst = (bf16_t*)(p.ws + OFF_WT_SWA_IN); local = t - 1056; }
    else if (t < 1632) { src = p.swa_w_out; N = 1024; ntn = 16; dst = (bf16_t*)(p.ws + OFF_WT_SWA_OUT); local = t - 1376; }
    else if (t < 1888) { src = p.peer_wq; N = 1024; ntn = 16; dst = (bf16_t*)(p.ws + OFF_WT_PQ); local = t - 1632; }
    else { src = p.peer_wq + (size_t)1024 * 1024; N = 1024; ntn = 16; dst = (bf16_t*)(p.ws + OFF_WT_PQ) + (size_t)1024 * 1024; local = t - 1888; }
    transpose_tile(src, N, dst, local / ntn, local % ntn, sT);
  }
  cvt_elems(p.peer_keys, (bf16_t*)(p.ws + OFF_KEYS), (size_t)2 * 8 * 2 * 128 * 64 / 8);
}

typedef unsigned v6u __attribute__((ext_vector_type(6)));
typedef float v32f __attribute__((ext_vector_type(32)));
DI unsigned fp6_code(float y) {
  const float a = fminf(fabsf(y), 7.5f);
  float c = rintf(a * 8.f);
  c = a >= 2.f ? rintf(a * 4.f) + 8.f : c;
  c = a >= 4.f ? rintf(a * 2.f) + 16.f : c;
  unsigned u = (unsigned)c;
  u = u > 31u ? 31u : u;
  return u | ((__float_as_uint(y) >> 26) & 32u);
}
DI void cvt_table_fp6(const float* __restrict__ src, unsigned char* __restrict__ dst, float* __restrict__ inv, int bid, int nb) {
  const int lane = threadIdx.x & 63, w = threadIdx.x >> 6, r = lane & 31, h = lane >> 5;
  for (int rp = bid * 4 + w; rp < 8192; rp += nb * 4) {
    const int row = rp * 2 + h;
    const float4* sp = (const float4*)(src + (size_t)row * 1024 + r * 32);
    float v[32];
    float mx = 0.f;
#pragma unroll
    for (int i = 0; i < 8; ++i) {
      const float4 t = sp[i];
      v[4 * i] = t.x; v[4 * i + 1] = t.y; v[4 * i + 2] = t.z; v[4 * i + 3] = t.w;
      mx = fmaxf(fmaxf(mx, fmaxf(fabsf(t.x), fabsf(t.y))), fmaxf(fabsf(t.z), fabsf(t.w)));
    }
#pragma unroll
    for (int o = 16; o >= 1; o >>= 1) mx = fmaxf(mx, __shfl_xor(mx, o));
    const float sc = mx > 0.f ? 7.5f / mx : 1.f;
    unsigned c[32];
#pragma unroll
    for (int i = 0; i < 32; ++i) c[i] = fp6_code(v[i] * sc);
    unsigned d[6];
#pragma unroll
    for (int g = 0; g < 2; ++g) {
      const unsigned* q = c + 16 * g;
      d[3 * g + 0] = q[0] | (q[1] << 6) | (q[2] << 12) | (q[3] << 18) | (q[4] << 24) | (q[5] << 30);
      d[3 * g + 1] = (q[5] >> 2) | (q[6] << 4) | (q[7] << 10) | (q[8] << 16) | (q[9] << 22) | (q[10] << 28);
      d[3 * g + 2] = (q[10] >> 4) | (q[11] << 2) | (q[12] << 8) | (q[13] << 14) | (q[14] << 20) | (q[15] << 26);
    }
    uint2* dp = (uint2*)(dst + (size_t)row * 768 + r * 24);
    dp[0] = make_uint2(d[0], d[1]); dp[1] = make_uint2(d[2], d[3]); dp[2] = make_uint2(d[4], d[5]);
    if (r == 0) inv[row] = mx > 0.f ? mx * (1.f / 7.5f) : 1.f;
  }
}
DI void phase_cvt_tables(const Params& p, int layer) {
  const int nb = gridDim.x / 2, bid = blockIdx.x % nb;
  const int rows_lo = (blockIdx.x < nb) ? 0 : 1;
  cvt_table_fp6(p.peer_u + (size_t)layer * 16384 * 1024, (unsigned char*)(p.ws + OFF_TBL_U) + (size_t)layer * 16 * MiB, (float*)(p.ws + OFF_INV) + (layer * 2 + 0) * 16384, bid * 2 + rows_lo, nb * 2);
  cvt_table_fp6(p.peer_v + (size_t)layer * 16384 * 1024, (unsigned char*)(p.ws + OFF_TBL_V) + (size_t)layer * 16 * MiB, (float*)(p.ws + OFF_INV) + (layer * 2 + 1) * 16384, bid * 2 + rows_lo, nb * 2);
}

DI void phase_rmsnorm(const float* __restrict__ src, const float* __restrict__ gain, bf16_t* __restrict__ dst) {
  const int lane = threadIdx.x & 63, w = threadIdx.x >> 6;
  for (int row = blockIdx.x * 4 + w; row < T_TOK; row += gridDim.x * 4) {
    const float4* sp = (const float4*)(src + (size_t)row * DM);
    float4 v[4];
    float ss = 0.f;
#pragma unroll
    for (int i = 0; i < 4; ++i) { v[i] = sp[lane + 64 * i]; ss += v[i].x * v[i].x + v[i].y * v[i].y + v[i].z * v[i].z + v[i].w * v[i].w; }
#pragma unroll
    for (int o = 32; o >= 1; o >>= 1) ss += __shfl_xor(ss, o);
    const float rs = rsqrtf(ss * (1.f / 1024.f) + 1e-6f);
#pragma unroll
    for (int i = 0; i < 4; ++i) {
      const float4 g = ((const float4*)gain)[lane + 64 * i];
      uint2 o2 = make_uint2(pk(v[i].x * rs * g.x, v[i].y * rs * g.y), pk(v[i].z * rs * g.z, v[i].w * rs * g.w));
      *(uint2*)(dst + (size_t)row * DM + (lane + 64 * i) * 4) = o2;
    }
  }
}

DI void mma_64x64(const bf16_t* sA, const bf16_t* sB, int arow0, int brow0, f32x16 (&acc)[2][2], int lane) {
  const int r = lane & 31, h = lane >> 5;
#pragma unroll
  for (int s = 0; s < 4; ++s) {
    bf16x8 a[2], b[2];
#pragma unroll
    for (int mi = 0; mi < 2; ++mi) a[mi] = *(const bf16x8*)(sA + (arow0 + mi * 32 + r) * LDK + s * 16 + h * 8);
#pragma unroll
    for (int ni = 0; ni < 2; ++ni) b[ni] = *(const bf16x8*)(sB + (brow0 + ni * 32 + r) * LDK + s * 16 + h * 8);
#pragma unroll
    for (int mi = 0; mi < 2; ++mi)
#pragma unroll
      for (int ni = 0; ni < 2; ++ni) acc[mi][ni] = mfma32(a[mi], b[ni], acc[mi][ni]);
  }
}

enum { EPI_GLA_IN = 0, EPI_RESID_X = 1, EPI_BF16 = 2, EPI_RESID_INPLACE = 3 };

template <int MODE>
DI void phase_gemm(const Params& p, const bf16_t* __restrict__ A, const bf16_t* __restrict__ Bt, int NT, bf16_t* dstb, int ldc,
                   const float* __restrict__ bias, char* smem) {
  const int ntiles = (T_TOK / 128) * NT;
  int t = (gridDim.x & 7) ? (int)blockIdx.x : (int)((blockIdx.x & 7) * (gridDim.x >> 3) + (blockIdx.x >> 3));
  if (t >= ntiles) return;
  bf16_t* sA = (bf16_t*)smem;
  bf16_t* sB = sA + 128 * LDK;
  bf16_t* ct = (bf16_t*)smem;
  const int tid = threadIdx.x, lane = tid & 63, w = tid >> 6, wm = w >> 1, wn = w & 1;
  const int r = lane & 31, h = lane >> 5;
  const int lrow = tid >> 3, kc = tid & 7;
  bf16_t* wa = sA + lrow * LDK + kc * 8;
  bf16_t* wb = sB + lrow * LDK + kc * 8;
  bf16x8 ra0[4], rb0[4], ra1[4], rb1[4];
  int m0 = (t / NT) * 128, n0 = (t % NT) * 128;
  const bf16_t* ap = A + (size_t)(m0 + lrow) * 1024 + kc * 8;
  const bf16_t* bp = Bt + (size_t)(n0 + lrow) * 1024 + kc * 8;
#define GLOAD(RA, RB, KT) _Pragma("unroll") for (int i = 0; i < 4; ++i) { RA[i] = *(const bf16x8*)(ap + (size_t)i * 32 * 1024 + (KT) * 64); RB[i] = *(const bf16x8*)(bp + (size_t)i * 32 * 1024 + (KT) * 64); }
#define SSTORE(RA, RB) _Pragma("unroll") for (int i = 0; i < 4; ++i) { *(bf16x8*)(wa + 32 * i * LDK) = RA[i]; *(bf16x8*)(wb + 32 * i * LDK) = RB[i]; }
  GLOAD(ra0, rb0, 0)
  GLOAD(ra1, rb1, 1)
  for (; t < ntiles; t += gridDim.x) {
    f32x16 acc[2][2];
#pragma unroll
    for (int i = 0; i < 2; ++i)
#pragma unroll
      for (int j = 0; j < 2; ++j) acc[i][j] = zero16();
    __syncthreads();
    SSTORE(ra0, rb0)
    __syncthreads();
    for (int kt = 0; kt < 16; kt += 2) {
      if (kt + 2 < 16) { GLOAD(ra0, rb0, kt + 2) }
      mma_64x64(sA, sB, wm * 64, wn * 64, acc, lane);
      __syncthreads();
      SSTORE(ra1, rb1)
      __syncthreads();
      if (kt + 3 < 16) { GLOAD(ra1, rb1, kt + 3) }
      mma_64x64(sA, sB, wm * 64, wn * 64, acc, lane);
      __syncthreads();
      if (kt + 2 < 16) {
        SSTORE(ra0, rb0)
        __syncthreads();
      }
    }
    const int cm0 = m0, cn0 = n0;
    {
      const int tn = t + gridDim.x;
      if (tn < ntiles) {
        m0 = (tn / NT) * 128; n0 = (tn % NT) * 128;
        ap = A + (size_t)(m0 + lrow) * 1024 + kc * 8;
        bp = Bt + (size_t)(n0 + lrow) * 1024 + kc * 8;
        GLOAD(ra0, rb0, 0)
        GLOAD(ra1, rb1, 1)
      }
    }
    const bool staged = (MODE == EPI_BF16) || (MODE == EPI_GLA_IN && cn0 < 3072);
    if (staged) {
#pragma unroll
      for (int ni = 0; ni < 2; ++ni) {
        const int col = wn * 64 + ni * 32 + r;
        const float bv = (MODE == EPI_BF16 && bias) ? bias[cn0 + col] : 0.f;
#pragma unroll
        for (int mi = 0; mi < 2; ++mi)
#pragma unroll
          for (int i = 0; i < 16; ++i) ct[(wm * 64 + mi * 32 + crow(i, h)) * 136 + col] = f2bf(acc[mi][ni][i] + bv);
      }
      __syncthreads();
      const int ldo = (MODE == EPI_GLA_IN) ? 3072 : ldc;
#pragma unroll
      for (int j = 0; j < 8; ++j) {
        const int c = tid + 256 * j, row = c >> 4, cc = c & 15;
        *(uint4*)(dstb + (size_t)(cm0 + row) * ldo + cn0 + cc * 8) = *(const uint4*)(ct + row * 136 + cc * 8);
      }
    } else {
      const unsigned row0 = (unsigned)(cm0 + wm * 64 + 4 * h), col0 = (unsigned)(cn0 + wn * 64 + r);
      float* __restrict__ lrp = (float*)(p.ws + OFF_LR);
#pragma unroll
      for (int ni = 0; ni < 2; ++ni) {
        const unsigned col = col0 + ni * 32;
        float bv = 0.f;
        if (MODE == EPI_RESID_INPLACE) bv = bias[col];
        const unsigned i0 = row0 * 1024u + col;
        const unsigned l0 = row0 * 16u + (col - 3072u);
#pragma unroll
        for (int mi = 0; mi < 2; ++mi)
#pragma unroll
          for (int i = 0; i < 16; ++i) {
            const unsigned ro = (unsigned)(mi * 32 + (i & 3) + 8 * (i >> 2));
            const float v = acc[mi][ni][i];
            if (MODE == EPI_GLA_IN) { if (col < 3088u) lrp[l0 + ro * 16u] = v; }
            else if (MODE == EPI_RESID_X) p.out[i0 + ro * 1024u] = p.x[i0 + ro * 1024u] + v;
            else if (MODE == EPI_RESID_INPLACE) p.out[i0 + ro * 1024u] += v + bv;
          }
      }
    }
  }
#undef GLOAD
#undef SSTORE
}

DI float gate_la(const float* lr_s, int t, const float (&wa)[16], float ba) {
  float z = ba;
#pragma unroll
  for (int j = 0; j < 16; ++j) z += lr_s[t * 16 + j] * wa[j];
  return logsig(z) * (1.f / 16.f);
}
DI void gla_gates(const Params& p, int t0, int hh, float (&wa)[16], float& ba, float& offset, float& blast, float* lr_s, float* tot_s) {
  const int tid = threadIdx.x, d = tid & 127, half = tid >> 7;
  const float* LR = (const float*)(p.ws + OFF_LR);
  ((float4*)lr_s)[tid] = ((const float4*)(LR + (size_t)t0 * 16))[tid];
#pragma unroll
  for (int j = 0; j < 16; ++j) wa[j] = p.gla_w_alpha[j * 512 + hh * 128 + d];
  ba = p.gla_b_alpha[hh * 128 + d];
  __syncthreads();
  float sum = 0.f;
#pragma unroll 4
  for (int tt = 0; tt < 32; ++tt) sum += gate_la(lr_s, half * 32 + tt, wa, ba);
  tot_s[half * 128 + d] = sum;
  __syncthreads();
  offset = half ? tot_s[d] : 0.f;
  blast = tot_s[d] + tot_s[128 + d];
}

DI void fill_vT(const bf16_t* __restrict__ QKVR, int t0, int hh, int vh, bf16_t* vT) {
  const int tid = threadIdx.x, v = tid & 127, half = tid >> 7;
#pragma unroll 8
  for (int tt = 0; tt < 32; ++tt) {
    const int t = half * 32 + tt;
    vT[v * LDK + t] = QKVR[(size_t)(t0 + t) * 3072 + 1024 + hh * 256 + vh * 128 + v];
  }
}

DI void gla_phase1(const Params& p, int item, char* smem) {
  const int hh = item & 3, c = (item >> 2) & 255, b = item >> 10;
  const int t0 = b * SEQ + c * 64;
  float* lr_s = (float*)smem;
  float* tot_s = (float*)(smem + 4096);
  bf16_t* kfT = (bf16_t*)(smem + 5120);
  bf16_t* vT = kfT + 128 * LDK;
  const bf16_t* QKVR = (const bf16_t*)(p.ws + OFF_BIG);
  bf16_t* KVT = (bf16_t*)(p.ws + OFF_KVT);
  float* DECAY = (float*)(p.ws + OFF_DECAY);
  const int tid = threadIdx.x, lane = tid & 63, w = tid >> 6, wm = w >> 1, wn = w & 1;
  const int d = tid & 127, half = tid >> 7;
  float wa[16], ba, offset, blast;
  gla_gates(p, t0, hh, wa, ba, offset, blast, lr_s, tot_s);
  float run = offset;
#pragma unroll 4
  for (int tt = 0; tt < 32; ++tt) {
    const int t = half * 32 + tt;
    run += gate_la(lr_s, t, wa, ba);
    ((float*)(p.ws + OFF_ACT_A))[(size_t)(t0 + t) * 512 + hh * 128 + d] = run;
    const float kv = bf2f(QKVR[(size_t)(t0 + t) * 3072 + 512 + hh * 128 + d]);
    kfT[d * LDK + t] = f2bf(kv * __expf(blast - run));
  }
  if (half == 0) DECAY[(size_t)item * 128 + d] = __expf(blast);
  const int r = lane & 31, h = lane >> 5;
  for (int vh = 0; vh < 2; ++vh) {
    __syncthreads();
    fill_vT(QKVR, t0, hh, vh, vT);
    __syncthreads();
    f32x16 acc[2][2];
#pragma unroll
    for (int i = 0; i < 2; ++i)
#pragma unroll
      for (int j = 0; j < 2; ++j) acc[i][j] = zero16();
    mma_64x64(vT, kfT, wm * 64, wn * 64, acc, lane);
    bf16_t* kbase = KVT + (size_t)item * 32768 + (vh * 128 + wm * 64 + 4 * h) * 128 + wn * 64 + r;
#pragma unroll
    for (int mi = 0; mi < 2; ++mi)
#pragma unroll
      for (int ni = 0; ni < 2; ++ni)
#pragma unroll
        for (int i = 0; i < 16; ++i) kbase[(mi * 32 + (i & 3) + 8 * (i >> 2)) * 128 + ni * 32] = f2bf(acc[mi][ni][i]);
  }
  __syncthreads();
}

DI void gla_scan(const Params& p) {
  bf16_t* KVT = (bf16_t*)(p.ws + OFF_KVT);
  const float* DECAY = (const float*)(p.ws + OFF_DECAY);
  for (int idx = blockIdx.x * 256 + threadIdx.x; idx < 8 * 16384; idx += gridDim.x * 256) {
    const int bh = idx >> 14, e2 = idx & 16383, b = bh >> 2, hh = bh & 3, d0 = (2 * e2) & 127;
    float s0 = 0.f, s1 = 0.f;
    for (int c0 = 0; c0 < 256; c0 += 8) {
      unsigned kv[8]; float2 dc[8];
#pragma unroll
      for (int u = 0; u < 8; ++u) {
        const size_t item = (size_t)(b * 256 + c0 + u) * 4 + hh;
        kv[u] = *(const unsigned*)(KVT + item * 32768 + 2 * e2);
        dc[u] = *(const float2*)(DECAY + item * 128 + d0);
      }
#pragma unroll
      for (int u = 0; u < 8; ++u) {
        const size_t item = (size_t)(b * 256 + c0 + u) * 4 + hh;
        *(unsigned*)(KVT + item * 32768 + 2 * e2) = pk(s0, s1);
        s0 = dc[u].x * s0 + bflo(kv[u]);
        s1 = dc[u].y * s1 + bfhi(kv[u]);
      }
    }
  }
}

DI void gla_phase3(const Params& p, int item, char* smem) {
  const int hh = item & 3, c = (item >> 2) & 255, b = item >> 10;
  const int t0 = b * SEQ + c * 64;
  float* lr_s = (float*)smem;
  float* tot_s = (float*)(smem + 4096);
  bf16_t* qd = (bf16_t*)(smem + 5120);
  bf16_t* ki = qd + 64 * 136;
  bf16_t* at = ki + 64 * 136;
  bf16_t* vT = at + 64 * 72;
  bf16_t* ot = qd;
  const bf16_t* QKVR = (const bf16_t*)(p.ws + OFF_BIG);
  const bf16_t* ST = (const bf16_t*)(p.ws + OFF_KVT);
  bf16_t* OG = (bf16_t*)(p.ws + OFF_ACT_A);
  const int tid = threadIdx.x, lane = tid & 63, w = tid >> 6;
  const int d = tid & 127, half = tid >> 7;
  const int r = lane & 31, h = lane >> 5;
  {
    const float* Bc = (const float*)(p.ws + OFF_ACT_A);
#pragma unroll 8
    for (int tt = 0; tt < 32; ++tt) {
      const int t = half * 32 + tt;
      const float run = Bc[(size_t)(t0 + t) * 512 + hh * 128 + d];
      const float q = bf2f(QKVR[(size_t)(t0 + t) * 3072 + hh * 128 + d]);
      const float k = bf2f(QKVR[(size_t)(t0 + t) * 3072 + 512 + hh * 128 + d]);
      qd[t * 136 + d] = f2bf(q * 0.08838834764831845f * __expf(run));
      ki[t * 136 + d] = f2bf(k * __expf(-run));
    }
  }
  __syncthreads();
  {
    const int mi = w >> 1, nj = w & 1;
    f32x16 a = zero16();
#pragma unroll
    for (int s = 0; s < 8; ++s) {
      const bf16x8 A = *(const bf16x8*)(qd + (mi * 32 + r) * 136 + s * 16 + h * 8);
      const bf16x8 B = *(const bf16x8*)(ki + (nj * 32 + r) * 136 + s * 16 + h * 8);
      a = mfma32(A, B, a);
    }
#pragma unroll
    for (int i = 0; i < 16; ++i) {
      const int it = mi * 32 + crow(i, h), jt = nj * 32 + r;
      at[it * 72 + jt] = f2bf(jt <= it ? a[i] : 0.f);
    }
  }
  f32x16 o[2][2];
#pragma unroll
  for (int i = 0; i < 2; ++i)
#pragma unroll
    for (int j = 0; j < 2; ++j) o[i][j] = zero16();
#pragma unroll
  for (int vh = 0; vh < 2; ++vh) {
    __syncthreads();
    fill_vT(QKVR, t0, hh, vh, vT);
    __syncthreads();
#pragma unroll
    for (int s = 0; s < 4; ++s) {
      const bf16x8 B = *(const bf16x8*)(vT + (w * 32 + r) * LDK + s * 16 + h * 8);
#pragma unroll
      for (int mt = 0; mt < 2; ++mt) {
        const bf16x8 A = *(const bf16x8*)(at + (mt * 32 + r) * 72 + s * 16 + h * 8);
        o[vh][mt] = mfma32(A, B, o[vh][mt]);
      }
    }
    const bf16_t* Sg = ST + (size_t)item * 32768 + (size_t)(vh * 128 + w * 32 + r) * 128 + h * 8;
#pragma unroll
    for (int s = 0; s < 8; ++s) {
      const bf16x8 B = *(const bf16x8*)(Sg + s * 16);
#pragma unroll
      for (int mt = 0; mt < 2; ++mt) {
        const bf16x8 A = *(const bf16x8*)(qd + (mt * 32 + r) * 136 + s * 16 + h * 8);
        o[vh][mt] = mfma32(A, B, o[vh][mt]);
      }
    }
  }
  __syncthreads();
#pragma unroll
  for (int vh = 0; vh < 2; ++vh)
#pragma unroll
    for (int mt = 0; mt < 2; ++mt)
#pragma unroll
      for (int i = 0; i < 16; ++i) ot[(mt * 32 + crow(i, h)) * 264 + vh * 128 + w * 32 + r] = f2bf(o[vh][mt][i]);
  __syncthreads();
  {
    const int row = tid >> 2, seg = tid & 3;
    const bf16_t* orow = ot + row * 264 + seg * 64;
    float ss = 0.f;
#pragma unroll
    for (int c8 = 0; c8 < 8; ++c8) {
      const uint4 ov = *(const uint4*)(orow + c8 * 8);
      const float f0 = bflo(ov.x), f1 = bfhi(ov.x), f2 = bflo(ov.y), f3 = bfhi(ov.y), f4 = bflo(ov.z), f5 = bfhi(ov.z), f6 = bflo(ov.w), f7 = bfhi(ov.w);
      ss += f0 * f0 + f1 * f1 + f2 * f2 + f3 * f3 + f4 * f4 + f5 * f5 + f6 * f6 + f7 * f7;
    }
    ss += __shfl_xor(ss, 1);
    ss += __shfl_xor(ss, 2);
    const float rs = rsqrtf(ss * (1.f / 256.f) + 1e-6f);
    const bf16_t* rrow = QKVR + (size_t)(t0 + row) * 3072 + 2048 + hh * 256 + seg * 64;
    const float* grow = p.gla_norm + hh * 256 + seg * 64;
    bf16_t* dst = OG + (size_t)(t0 + row) * 1024 + hh * 256 + seg * 64;
#pragma unroll
    for (int c8 = 0; c8 < 8; ++c8) {
      const uint4 ov = *(const uint4*)(orow + c8 * 8);
      const uint4 rv = *(const uint4*)(rrow + c8 * 8);
      const float4 g0 = *(const float4*)(grow + c8 * 8), g1 = *(const float4*)(grow + c8 * 8 + 4);
      float of[8] = {bflo(ov.x), bfhi(ov.x), bflo(ov.y), bfhi(ov.y), bflo(ov.z), bfhi(ov.z), bflo(ov.w), bfhi(ov.w)};
      float rf[8] = {bflo(rv.x), bfhi(rv.x), bflo(rv.y), bfhi(rv.y), bflo(rv.z), bfhi(rv.z), bflo(rv.w), bfhi(rv.w)};
      float gf[8] = {g0.x, g0.y, g0.z, g0.w, g1.x, g1.y, g1.z, g1.w};
      float res[8];
#pragma unroll
      for (int e = 0; e < 8; ++e) res[e] = of[e] * rs * gf[e] * (rf[e] / (1.f + __expf(-rf[e])));
      *(uint4*)(dst + c8 * 8) = make_uint4(pk(res[0], res[1]), pk(res[2], res[3]), pk(res[4], res[5]), pk(res[6], res[7]));
    }
  }
  __syncthreads();
}

DI void swa_qknorm(const Params& p) {
  bf16_t* QKV = (bf16_t*)(p.ws + OFF_BIG);
  const int tid = threadIdx.x, sub = tid & 7;
  const int ngroups = T_TOK * 18;
  for (int g = blockIdx.x * 32 + (tid >> 3); g < ngroups; g += gridDim.x * 32) {
    const int tok = g / 18, slot = g - tok * 18;
    bf16_t* ptr = QKV + (size_t)tok * 1280 + slot * 64 + sub * 8;
    const uint4 wv = *(const uint4*)ptr;
    float v[8] = {bflo(wv.x), bfhi(wv.x), bflo(wv.y), bfhi(wv.y), bflo(wv.z), bfhi(wv.z), bflo(wv.w), bfhi(wv.w)};
    float ss = 0.f;
#pragma unroll
    for (int e = 0; e < 8; ++e) ss += v[e] * v[e];
    ss += __shfl_xor(ss, 1);
    ss += __shfl_xor(ss, 2);
    ss += __shfl_xor(ss, 4);
    const float rs = rsqrtf(ss * (1.f / 64.f) + 1e-6f);
    const float* gain = (slot < 16 ? p.swa_qn : p.swa_kn) + sub * 8;
#pragma unroll
    for (int e = 0; e < 8; ++e) v[e] = v[e] * rs * gain[e];
    const float posf = (float)p.pos[tok];
    const float invf[8] = {1.0f, 0.1939227432012558f, 0.03760603070259094f, 0.007292664609849453f,
                           0.0014142135623842478f, 0.00027424818836152554f, 5.318296098266728e-05f, 1.0313386155758053e-05f};
#pragma unroll
    for (int e = 0; e < 8; ++e) {
      const float other = __shfl_xor(v[e], 1);
      if (sub < 2) {
        const float ang = posf * invf[e];
        const double rev = (double)ang * 0.15915494309189535;
        const float fr = (float)(rev - rint(rev));
        const float sn = __builtin_amdgcn_sinf(fr), cs = __builtin_amdgcn_cosf(fr);
        v[e] = (sub == 0) ? (v[e] * cs - other * sn) : (v[e] * cs + other * sn);
      }
    }
    if (slot < 16) {
#pragma unroll
      for (int e = 0; e < 8; ++e) v[e] *= 0.125f;
    }
    *(uint4*)ptr = make_uint4(pk(v[0], v[1]), pk(v[2], v[3]), pk(v[4], v[5]), pk(v[6], v[7]));
  }
}

DI void swa_attn(const Params& p, int item, char* smem) {
  const int hq = item & 15, n = (item >> 4) & 127, b = item >> 11, hkv = hq >> 3;
  const int tok0 = b * SEQ + n * 128;
  bf16_t* Ks = (bf16_t*)smem;
  bf16_t* vT = Ks + 256 * 72;
  const bf16_t* QKV = (const bf16_t*)(p.ws + OFF_BIG);
  bf16_t* OUT = (bf16_t*)(p.ws + OFF_ACT_B);
  const int tid = threadIdx.x, lane = tid & 63, w = tid >> 6, r = lane & 31, h = lane >> 5;
  __syncthreads();
#pragma unroll
  for (int i = 0; i < 8; ++i) {
    const int cidx = tid + 256 * i, kk = cidx >> 3, kc = cidx & 7;
    const int pos = n * 128 - 128 + kk;
    uint4 kw = make_uint4(0, 0, 0, 0), vw = make_uint4(0, 0, 0, 0);
    if (pos >= 0) {
      const bf16_t* base = QKV + (size_t)(b * SEQ + pos) * 1280;
      kw = *(const uint4*)(base + 1024 + hkv * 64 + kc * 8);
      vw = *(const uint4*)(base + 1152 + hkv * 64 + kc * 8);
    }
    *(uint4*)(Ks + kk * 72 + kc * 8) = kw;
    bf16_t* vd = vT + (kc * 8) * 264 + kk;
    vd[0 * 264] = (bf16_t)(vw.x & 0xffff); vd[1 * 264] = (bf16_t)(vw.x >> 16);
    vd[2 * 264] = (bf16_t)(vw.y & 0xffff); vd[3 * 264] = (bf16_t)(vw.y >> 16);
    vd[4 * 264] = (bf16_t)(vw.z & 0xffff); vd[5 * 264] = (bf16_t)(vw.z >> 16);
    vd[6 * 264] = (bf16_t)(vw.w & 0xffff); vd[7 * 264] = (bf16_t)(vw.w >> 16);
  }
  __syncthreads();
  const int iq = 32 * w + r;
  const bf16_t* qrow = QKV + (size_t)(tok0 + iq) * 1280 + hq * 64 + h * 8;
  bf16x8 qf[4];
#pragma unroll
  for (int s = 0; s < 4; ++s) qf[s] = *(const bf16x8*)(qrow + s * 16);
  f32x16 X[5];
#pragma unroll
  for (int kt = 0; kt < 5; ++kt) {
    X[kt] = zero16();
#pragma unroll
    for (int s = 0; s < 4; ++s) {
      const bf16x8 A = *(const bf16x8*)(Ks + ((w + kt) * 32 + r) * 72 + s * 16 + h * 8);
      X[kt] = mfma32(A, qf[s], X[kt]);
    }
  }
  const float sink = p.swa_sinks[hq];
  float m = sink;
#pragma unroll
  for (int kt = 0; kt < 5; ++kt)
#pragma unroll
    for (int i = 0; i < 16; ++i) {
      const int kk = (w + kt) * 32 + crow(i, h);
      const bool valid = (kk > iq) && (kk <= iq + 128) && (n > 0 || kk >= 128);
      const float xv = valid ? X[kt][i] : -INFINITY;
      X[kt][i] = xv;
      m = fmaxf(m, xv);
    }
  m = fmaxf(m, __shfl_xor(m, 32));
  float l = 0.f;
#pragma unroll
  for (int kt = 0; kt < 5; ++kt)
#pragma unroll
    for (int i = 0; i < 16; ++i) {
      const float pv = __expf(X[kt][i] - m);
      X[kt][i] = pv;
      l += pv;
    }
  l += __shfl_xor(l, 32);
  l += __expf(sink - m);
  f32x16 O[2];
  O[0] = zero16(); O[1] = zero16();
#pragma unroll
  for (int kt = 0; kt < 5; ++kt)
#pragma unroll
    for (int s2 = 0; s2 < 2; ++s2) {
      const uint4 pw = make_uint4(pk(X[kt][8 * s2 + 0], X[kt][8 * s2 + 1]), pk(X[kt][8 * s2 + 2], X[kt][8 * s2 + 3]),
                                  pk(X[kt][8 * s2 + 4], X[kt][8 * s2 + 5]), pk(X[kt][8 * s2 + 6], X[kt][8 * s2 + 7]));
      const bf16x8 P = __builtin_bit_cast(bf16x8, pw);
#pragma unroll
      for (int mt = 0; mt < 2; ++mt) {
        const bf16_t* vp = vT + (mt * 32 + r) * 264 + (w + kt) * 32 + 16 * s2 + 4 * h;
        const uint2 lo = *(const uint2*)vp, hi = *(const uint2*)(vp + 8);
        const bf16x8 A = __builtin_bit_cast(bf16x8, make_uint4(lo.x, lo.y, hi.x, hi.y));
        O[mt] = mfma32(A, P, O[mt]);
      }
    }
  const float inv = 1.f / l;
  bf16_t* orow = OUT + (size_t)(tok0 + iq) * 1024 + hq * 64 + 4 * h;
#pragma unroll
  for (int mt = 0; mt < 2; ++mt)
#pragma unroll
    for (int g = 0; g < 4; ++g)
      *(uint2*)(orow + mt * 32 + 8 * g) = make_uint2(pk(O[mt][4 * g] * inv, O[mt][4 * g + 1] * inv), pk(O[mt][4 * g + 2] * inv, O[mt][4 * g + 3] * inv));
}

DI unsigned fkey_u(unsigned u) { return u ^ ((unsigned)((int)u >> 31) | 0x80000000u); }
DI float unfkey(unsigned k) { return __uint_as_float(k ^ ((~(unsigned)((int)k >> 31)) | 0x80000000u)); }
DI void cswap(unsigned& a, unsigned& b) { const unsigned hi = a > b ? a : b, lo = a > b ? b : a; a = hi; b = lo; }
DI void sort16(unsigned (&t)[16]) {
#pragma unroll
  for (int k = 2; k <= 16; k <<= 1)
#pragma unroll
    for (int j = k >> 1; j > 0; j >>= 1)
#pragma unroll
      for (int i = 0; i < 16; ++i) {
        const int l = i ^ j;
        if (l > i) { if ((i & k) == 0) cswap(t[i], t[l]); else cswap(t[l], t[i]); }
      }
}
DI void merge16(unsigned (&a)[16], const unsigned (&b)[16]) {
#pragma unroll
  for (int j = 0; j < 16; ++j) a[j] = a[j] > b[15 - j] ? a[j] : b[15 - j];
#pragma unroll
  for (int j = 8; j > 0; j >>= 1)
#pragma unroll
    for (int i = 0; i < 16; ++i) { const int l = i ^ j; if (l > i) cswap(a[i], a[l]); }
}
DI void cswap2(unsigned& ak, int& ap, unsigned& bk, int& bp) {
  const bool sw = bk > ak;
  const unsigned hk = sw ? bk : ak, lk = sw ? ak : bk;
  const int hp = sw ? bp : ap, lp = sw ? ap : bp;
  ak = hk; ap = hp; bk = lk; bp = lp;
}
DI void sort16p(unsigned (&t)[16], int (&q)[16]) {
#pragma unroll
  for (int k = 2; k <= 16; k <<= 1)
#pragma unroll
    for (int j = k >> 1; j > 0; j >>= 1)
#pragma unroll
      for (int i = 0; i < 16; ++i) {
        const int l = i ^ j;
        if (l > i) { if ((i & k) == 0) cswap2(t[i], q[i], t[l], q[l]); else cswap2(t[l], q[l], t[i], q[i]); }
      }
}
__device__ constexpr int CIA[25] = {0,0,0,0,0,0,0,0,0,0,0,0,0,0,0,0, 2,2,2,2,2, 3,3,3,3};
__device__ constexpr int CJA[25] = {0,1,2,3,4,5,6,7,8,9,10,11,12,13,14,15, 0,1,2,3,4, 0,1,2,3};
__device__ constexpr int CIB[25] = {1,1,1,1,1,1,1,1, 4,4,4, 5,5,6,6,7,7, 8,9,10,11,12,13,14,15};
__device__ constexpr int CJB[25] = {0,1,2,3,4,5,6,7, 0,1,2, 0,1,0,1,0,1, 0,0,0,0,0,0,0,0};

DI void peer_topk_wave(const Params& p, int layer, int item) {
  const int head = item >> 10, tok0 = (item & 1023) * 32;
  const bf16_t* Q = (const bf16_t*)(p.ws + OFF_BIG);
  const bf16_t* KEYS = (const bf16_t*)(p.ws + OFF_KEYS) + (size_t)(layer * 8 + head) * 256 * 64;
  int* E = (int*)(p.ws + OFF_E);
  float* G = (float*)(p.ws + OFF_G);
  const int lane = threadIdx.x & 63, r = lane & 31, h = lane >> 5;
  const unsigned h4 = 4u * (1u - (unsigned)h);
  unsigned tl[2][16];
  bf16x8 qf[2][4], kf[4][4];
#pragma unroll
  for (int set = 0; set < 2; ++set) {
    const bf16_t* qrow = Q + (size_t)(tok0 + r) * 1024 + head * 128 + set * 64 + h * 8;
#pragma unroll
    for (int s = 0; s < 4; ++s) qf[set][s] = *(const bf16x8*)(qrow + s * 16);
  }
#pragma unroll
  for (int kt = 0; kt < 4; ++kt)
#pragma unroll
    for (int s = 0; s < 4; ++s) kf[kt][s] = *(const bf16x8*)(KEYS + (size_t)(kt * 32 + r) * 64 + h * 8 + s * 16);
#pragma unroll
  for (int set = 0; set < 2; ++set) {
    f32x16 X[4];
#pragma unroll
    for (int kt = 0; kt < 4; ++kt) {
      X[kt] = zero16();
#pragma unroll
      for (int s = 0; s < 4; ++s) X[kt] = mfma32(kf[kt][s], qf[set][s], X[kt]);
    }
#pragma unroll
    for (int kt = 0; kt < 4; ++kt) {
      if (set == 0 && kt == 2) {
#pragma unroll
        for (int k2 = 0; k2 < 4; ++k2)
#pragma unroll
          for (int s = 0; s < 4; ++s) kf[k2][s] = *(const bf16x8*)(KEYS + (size_t)(128 + k2 * 32 + r) * 64 + h * 8 + s * 16);
      }
      unsigned kk[16];
#pragma unroll
      for (int i = 0; i < 16; ++i)
        kk[i] = (fkey_u(__float_as_uint(X[kt][i])) & ~127u) + ((unsigned)(127 - kt * 32 - (i & 3) - 8 * (i >> 2) - 4) + h4);
      sort16(kk);
      if (kt == 0) {
#pragma unroll
        for (int i = 0; i < 16; ++i) tl[set][i] = kk[i];
      } else merge16(tl[set], kk);
    }
  }
  unsigned mine[16], oth[16];
#pragma unroll
  for (int j = 0; j < 16; ++j) {
    const unsigned send = h ? tl[0][j] : tl[1][j];
    oth[j] = (unsigned)__shfl_xor((int)send, 32);
    mine[j] = h ? tl[1][j] : tl[0][j];
  }
  merge16(mine, oth);
  float v1[16], v2[16]; int i1[16], i2[16];
#pragma unroll
  for (int j = 0; j < 16; ++j) {
    const unsigned o = (unsigned)__shfl_xor((int)mine[j], 32);
    const unsigned A = h ? o : mine[j], B = h ? mine[j] : o;
    v1[j] = unfkey(A & ~127u); i1[j] = 127 - (int)(A & 127u);
    v2[j] = unfkey(B & ~127u); i2[j] = 127 - (int)(B & 127u);
  }
  unsigned ck[16], dk[16]; int cp[16], dp[16];
#pragma unroll
  for (int n = 0; n < 32; ++n) {
    unsigned key = 0u; int e = 0;
    if (n < 25) {
      const float sA = v1[CIA[n]] + v2[CJA[n]], sB = v1[CIB[n]] + v2[CJB[n]];
      const int eA = i1[CIA[n]] * 128 + i2[CJA[n]], eB = i1[CIB[n]] * 128 + i2[CJB[n]];
      key = fkey_u(__float_as_uint(h ? sB : sA)); e = h ? eB : eA;
    }
    if (n < 16) { ck[n] = key; cp[n] = e; } else { dk[n - 16] = key; dp[n - 16] = e; }
  }
  sort16p(ck, cp);
  sort16p(dk, dp);
#pragma unroll
  for (int j = 0; j < 16; ++j) { const bool sw = dk[15 - j] > ck[j]; ck[j] = sw ? dk[15 - j] : ck[j]; cp[j] = sw ? dp[15 - j] : cp[j]; }
#pragma unroll
  for (int j = 8; j > 0; j >>= 1)
#pragma unroll
    for (int i = 0; i < 16; ++i) { const int l = i ^ j; if (l > i) cswap2(ck[i], cp[i], ck[l], cp[l]); }
  unsigned fk[16]; int fe[16];
#pragma unroll
  for (int j = 0; j < 16; ++j) { dk[j] = (unsigned)__shfl_xor((int)ck[j], 32); dp[j] = __shfl_xor(cp[j], 32); }
#pragma unroll
  for (int j = 0; j < 16; ++j) {
    const bool sw = (dk[15 - j] > ck[j]) || (dk[15 - j] == ck[j] && dp[15 - j] > cp[j]);
    fk[j] = sw ? dk[15 - j] : ck[j]; fe[j] = sw ? dp[15 - j] : cp[j];
  }
  float sv[16], mx = -INFINITY;
#pragma unroll
  for (int j = 0; j < 16; ++j) { sv[j] = unfkey(fk[j]); mx = fmaxf(mx, sv[j]); }
  float sm = 0.f;
#pragma unroll
  for (int j = 0; j < 16; ++j) { sv[j] = __expf(sv[j] - mx); sm += sv[j]; }
  const float inv = 1.f / sm;
  const size_t o = ((size_t)(tok0 + r) * 8 + head) * 16 + h * 8;
  *(int4*)(E + o) = make_int4(fe[0], fe[1], fe[2], fe[3]);
  *(int4*)(E + o + 4) = make_int4(fe[4], fe[5], fe[6], fe[7]);
  *(float4*)(G + o) = make_float4(sv[0] * inv, sv[1] * inv, sv[2] * inv, sv[3] * inv);
  *(float4*)(G + o + 4) = make_float4(sv[4] * inv, sv[5] * inv, sv[6] * inv, sv[7] * inv);
}

DI v32f fp6x32(const uint2* p) {
  const uint2 a = p[0], b = p[1], c = p[2];
  v6u x; x[0] = a.x; x[1] = a.y; x[2] = b.x; x[3] = b.y; x[4] = c.x; x[5] = c.y;
  return __builtin_amdgcn_cvt_scalef32_pk32_f32_fp6(x, 1.0f);
}

typedef unsigned u2v __attribute__((ext_vector_type(2)));
typedef unsigned v16u __attribute__((ext_vector_type(16)));
typedef __bf16 v32bf __attribute__((ext_vector_type(32)));
DI v6u mk6(u2v a, u2v b, u2v c) { v6u x; x[0] = a[0]; x[1] = a[1]; x[2] = b[0]; x[3] = b[1]; x[4] = c[0]; x[5] = c[1]; return x; }

DI v6u ld6(const unsigned char* p) { const u2v* q = (const u2v*)p; return mk6(q[0], q[1], q[2]); }
#define U_LOAD2(RAW, M2) _Pragma("unroll") for (int mi = 0; mi < 2; ++mi) { \
    const unsigned char* up_ = U + (size_t)e_s[8 * ((M2) + mi) + grp8] * 768 + i8 * 24; \
    _Pragma("unroll") for (int k = 0; k < 4; ++k) RAW[4 * mi + k] = ld6(up_ + 192 * k); }
#define U_COMP2(RAW, M2) _Pragma("unroll") for (int mi = 0; mi < 2; ++mi) { \
    const int pidx = 8 * ((M2) + mi) + grp8; \
    float acc0 = 0.f, acc1 = 0.f, acc2 = 0.f, acc3 = 0.f; \
    _Pragma("unroll") for (int k = 0; k < 4; ++k) { \
      const v16u ub = __builtin_bit_cast(v16u, __builtin_amdgcn_cvt_scalef32_pk32_bf16_fp6(RAW[4 * mi + k], 1.0f)); \
      _Pragma("unroll") for (int i = 0; i < 16; i += 4) { \
        acc0 = dot2(ub[i], xp[k][i], acc0); acc1 = dot2(ub[i + 1], xp[k][i + 1], acc1); \
        acc2 = dot2(ub[i + 2], xp[k][i + 2], acc2); acc3 = dot2(ub[i + 3], xp[k][i + 3], acc3); } } \
    float acc = (acc0 + acc1) + (acc2 + acc3); \
    acc += __shfl_xor(acc, 1); acc += __shfl_xor(acc, 2); acc += __shfl_xor(acc, 4); \
    acc *= su_s[pidx]; \
    const float a = 0.5f * acc * (1.f + erff(acc * 0.7071067811865476f)) * gv_s[pidx]; \
    if (i8 == 0) a_s[pidx] = a; \
    __builtin_amdgcn_sched_barrier(0); }

DI void peer_gather_u(const Params& p, int layer, char* smem) {
  const int tid = threadIdx.x, lane = tid & 63, w = tid >> 6, grp8 = lane >> 3, i8 = lane & 7;
  float* a_s = (float*)smem + w * 512;
  float* su_s = a_s + 128;
  float* gv_s = a_s + 256;
  int* e_s = (int*)(a_s + 384);
  const bf16_t* HN = (const bf16_t*)(p.ws + OFF_ACT_A);
  const unsigned char* U = (const unsigned char*)(p.ws + OFF_TBL_U) + (size_t)layer * 16 * MiB;
  const float* IU = (const float*)(p.ws + OFF_INV) + (layer * 2 + 0) * 16384;
  const float* IV = (const float*)(p.ws + OFF_INV) + (layer * 2 + 1) * 16384;
  const int* E = (const int*)(p.ws + OFF_E);
  const float* G = (const float*)(p.ws + OFF_G);
  float* A = (float*)(p.ws + OFF_A);
  for (int tok = blockIdx.x * 4 + w; tok < T_TOK; tok += gridDim.x * 4) {
    unsigned xp[4][16];
#pragma unroll
    for (int k = 0; k < 4; ++k) {
      const uint4* xq = (const uint4*)(HN + (size_t)tok * 1024 + (i8 + 8 * k) * 32);
#pragma unroll
      for (int q = 0; q < 4; ++q) { const uint4 x0 = xq[q]; xp[k][4 * q] = x0.x; xp[k][4 * q + 1] = x0.y; xp[k][4 * q + 2] = x0.z; xp[k][4 * q + 3] = x0.w; }
    }
    {
      const int e0 = E[(size_t)tok * 128 + lane], e1 = E[(size_t)tok * 128 + 64 + lane];
      e_s[lane] = e0; e_s[64 + lane] = e1;
      su_s[lane] = IU[e0]; su_s[64 + lane] = IU[e1];
      gv_s[lane] = G[(size_t)tok * 128 + lane] * IV[e0]; gv_s[64 + lane] = G[(size_t)tok * 128 + 64 + lane] * IV[e1];
    }
    wave_sync();
    v6u rA[8], rB[8];
    U_LOAD2(rA, 0)
#pragma unroll 1
    for (int m2 = 0; m2 < 16; m2 += 4) {
      U_LOAD2(rB, m2 + 2)
      U_COMP2(rA, m2)
      if (m2 + 4 < 16) { U_LOAD2(rA, m2 + 4) }
      U_COMP2(rB, m2 + 2)
    }
    wave_sync();
    A[(size_t)tok * 128 + lane] = a_s[lane];
    A[(size_t)tok * 128 + 64 + lane] = a_s[64 + lane];
    wave_sync();
  }
}

#define V_LOAD8(RAW, M8) _Pragma("unroll") for (int mi = 0; mi < 4; ++mi) RAW[mi] = ld6(V + (size_t)e_s[2 * ((M8) + mi) + h] * 768 + r * 24);
#define V_COMP8(RAW, M8) _Pragma("unroll") for (int mi = 0; mi < 4; ++mi) { \
    const float a = a_s[2 * ((M8) + mi) + h]; \
    const v32f vv = __builtin_amdgcn_cvt_scalef32_pk32_f32_fp6(RAW[mi], 1.0f); \
    _Pragma("unroll") for (int i = 0; i < 32; ++i) o[i] = fmaf(a, vv[i], o[i]); \
    __builtin_amdgcn_sched_barrier(0); }

DI void peer_gather_v(const Params& p, int layer, char* smem, const float* __restrict__ next_gain) {
  const int tid = threadIdx.x, lane = tid & 63, w = tid >> 6, r = lane & 31, h = lane >> 5;
  float* a_s = (float*)smem + w * 256;
  int* e_s = (int*)(a_s + 128);
  const unsigned char* V = (const unsigned char*)(p.ws + OFF_TBL_V) + (size_t)layer * 16 * MiB;
  const int* E = (const int*)(p.ws + OFF_E);
  const float* A = (const float*)(p.ws + OFF_A);
  for (int tok = blockIdx.x * 4 + w; tok < T_TOK; tok += gridDim.x * 4) {
    e_s[lane] = E[(size_t)tok * 128 + lane]; e_s[64 + lane] = E[(size_t)tok * 128 + 64 + lane];
    a_s[lane] = A[(size_t)tok * 128 + lane]; a_s[64 + lane] = A[(size_t)tok * 128 + 64 + lane];
    wave_sync();
    float o[32];
#pragma unroll
    for (int i = 0; i < 32; ++i) o[i] = 0.f;
    v6u rA[4], rB[4];
    V_LOAD8(rA, 0)
#pragma unroll 1
    for (int m8 = 0; m8 < 64; m8 += 8) {
      V_LOAD8(rB, m8 + 4)
      V_COMP8(rA, m8)
      if (m8 + 8 < 64) { V_LOAD8(rA, m8 + 8) }
      V_COMP8(rB, m8 + 4)
    }
#pragma unroll
    for (int i = 0; i < 32; ++i) o[i] += __shfl_xor(o[i], 32);
    float4* hp = (float4*)(p.out + (size_t)tok * 1024 + r * 32 + h * 16);
    float4 hv[4];
    float ss = 0.f;
#pragma unroll
    for (int q = 0; q < 4; ++q) {
      float4 t = hp[q];
      t.x += h ? o[16 + 4 * q] : o[4 * q]; t.y += h ? o[17 + 4 * q] : o[4 * q + 1];
      t.z += h ? o[18 + 4 * q] : o[4 * q + 2]; t.w += h ? o[19 + 4 * q] : o[4 * q + 3];
      hp[q] = t; hv[q] = t;
      ss += t.x * t.x + t.y * t.y + t.z * t.z + t.w * t.w;
    }
    if (next_gain) {
#pragma unroll
      for (int o2 = 32; o2 >= 1; o2 >>= 1) ss += __shfl_xor(ss, o2);
      const float rs = rsqrtf(ss * (1.f / 1024.f) + 1e-6f);
      const float4* gp = (const float4*)(next_gain + r * 32 + h * 16);
      unsigned pw[8];
#pragma unroll
      for (int q = 0; q < 4; ++q) {
        const float4 g = gp[q];
        pw[2 * q] = pk(hv[q].x * rs * g.x, hv[q].y * rs * g.y); pw[2 * q + 1] = pk(hv[q].z * rs * g.z, hv[q].w * rs * g.w);
      }
      uint4* dp = (uint4*)((bf16_t*)(p.ws + OFF_ACT_A) + (size_t)tok * 1024 + r * 32 + h * 16);
      dp[0] = make_uint4(pw[0], pw[1], pw[2], pw[3]); dp[1] = make_uint4(pw[4], pw[5], pw[6], pw[7]);
    }
    wave_sync();
  }
}

DI void run_phase(const Params& p, int ph, char* smem) {
  bf16_t* actA = (bf16_t*)(p.ws + OFF_ACT_A);
  bf16_t* big = (bf16_t*)(p.ws + OFF_BIG);
  switch (ph) {
    case 0: phase_convert(p, smem); phase_cvt_tables(p, 0); phase_cvt_tables(p, 1); break;
    case 1: phase_rmsnorm(p.x, p.ln_mix, actA); break;
    case 2: phase_gemm<EPI_GLA_IN>(p, actA, (const bf16_t*)(p.ws + OFF_WT_GLA_IN), 25, big, 3072, nullptr, smem); break;
    case 3: for (int it = blockIdx.x; it < 2048; it += gridDim.x) gla_phase1(p, it, smem); break;
    case 4: gla_scan(p); break;
    case 5: for (int it = blockIdx.x; it < 2048; it += gridDim.x) gla_phase3(p, it, smem); break;
    case 6: phase_gemm<EPI_RESID_X>(p, actA, (const bf16_t*)(p.ws + OFF_WT_GLA_OUT), 8, nullptr, 0, nullptr, smem); break;
    case 7: phase_rmsnorm(p.out, p.ln_ffn, actA); break;
    case 8: phase_gemm<EPI_BF16>(p, actA, (const bf16_t*)(p.ws + OFF_WT_PQ), 8, big, 1024, nullptr, smem); break;
    case 9: for (int it = blockIdx.x * 4 + (threadIdx.x >> 6); it < 8192; it += gridDim.x * 4) peer_topk_wave(p, 0, it); break;
    case 10: peer_gather_u(p, 0, smem); break;
    case 11: peer_gather_v(p, 0, smem, p.ln_mix + 1024); break;
    case 12: break;
    case 13: phase_gemm<EPI_BF16>(p, actA, (const bf16_t*)(p.ws + OFF_WT_SWA_IN), 10, big, 1280, p.swa_b_in, smem); break;
    case 14: swa_qknorm(p); break;
    case 15: for (int it = blockIdx.x; it < 4096; it += gridDim.x) swa_attn(p, it, smem); break;
    case 16: phase_gemm<EPI_RESID_INPLACE>(p, (const bf16_t*)(p.ws + OFF_ACT_B), (const bf16_t*)(p.ws + OFF_WT_SWA_OUT), 8, nullptr, 0, p.swa_b_out, smem); break;
    case 17: phase_rmsnorm(p.out, p.ln_ffn + 1024, actA); break;
    case 18: phase_gemm<EPI_BF16>(p, actA, (const bf16_t*)(p.ws + OFF_WT_PQ) + (size_t)1024 * 1024, 8, big, 1024, nullptr, smem); break;
    case 19: for (int it = blockIdx.x * 4 + (threadIdx.x >> 6); it < 8192; it += gridDim.x * 4) peer_topk_wave(p, 1, it); break;
    case 20: peer_gather_u(p, 1, smem); break;
    case 21: peer_gather_v(p, 1, smem, nullptr); break;
    default: break;
  }
}

template <int PH>
__global__ void __launch_bounds__(256, 2) phase_kernel(Params p) {
  __shared__ __attribute__((aligned(16))) char smem[SMEM_BYTES];
  run_phase(p, PH, smem);
}

template <int PH>
static void launch_phases(const Params& p, int grid, hipStream_t stream) {
  hipLaunchKernelGGL(phase_kernel<PH>, dim3(grid), dim3(256), 0, stream, p);
  if constexpr (PH + 1 < NPHASE) launch_phases<PH + 1>(p, grid, stream);
}


#define XB_TMO      128
#define XB_XCNT(j)  (256  + 64 * (j))
#define XB_XSUB(j)  (1280 + 64 * (j))
#define XB_XGEN(j)  (2304 + 64 * (j))
#define XB_TOP      3328
#define XB_TOPGEN   3392
#define XCD_BAR_WORDS 3456
#define XB_SPIN_CAP (1u << 23)
#define LAS __attribute__((address_space(3)))
DI unsigned xb_ld(unsigned* p) { return __hip_atomic_load(p, __ATOMIC_RELAXED, __HIP_MEMORY_SCOPE_AGENT); }
DI unsigned xb_add(unsigned* p, unsigned v) { return __hip_atomic_fetch_add(p, v, __ATOMIC_RELAXED, __HIP_MEMORY_SCOPE_AGENT); }
DI unsigned xb_xcc_id() { return (unsigned)__builtin_amdgcn_s_getreg((3 << 11) | 20) & 0xFu; }
#define XB_SPIN(cond, bar) do { unsigned _sp = 0; while (cond) { __builtin_amdgcn_s_sleep(1); \
    if ((++_sp & 255u) == 0u) { if (xb_ld(&(bar)[XB_TMO])) break; if (_sp > XB_SPIN_CAP) { atomicAdd(&(bar)[XB_TMO], 1u); break; } } } } while (0)
struct XcdBarrier { unsigned* bar; unsigned x; volatile LAS unsigned* st; };
DI XcdBarrier xcd_barrier_post(unsigned* bar, volatile LAS unsigned* st) {
  XcdBarrier b; b.bar = bar; b.x = xb_xcc_id(); b.st = st;
  if (threadIdx.x == 0) (void)xb_add(&bar[XB_XCNT(b.x)], 1u);
  return b;
}
DI void xcd_barrier_complete(unsigned* bar, unsigned x, unsigned& nloc, unsigned& nx) {
  const unsigned G = gridDim.x * gridDim.y * gridDim.z;
  unsigned sum, cnt, mine, sp = 0u;
  for (;;) {
    sum = 0u; cnt = 0u; mine = 0u;
#pragma unroll
    for (unsigned j = 0; j < 16; ++j) { const unsigned c = xb_ld(&bar[XB_XCNT(j)]); sum += c; cnt += (c > 0u) ? 1u : 0u; mine = (j == x) ? c : mine; }
    if (sum == G) break;
    __builtin_amdgcn_s_sleep(1);
    if ((++sp & 255u) == 0u) { if (xb_ld(&bar[XB_TMO])) break; if (sp > XB_SPIN_CAP) { atomicAdd(&bar[XB_TMO], 1u); break; } }
  }
  nloc = mine > 0u ? mine : 1u; nx = cnt > 0u ? cnt : 1u;
}
DI void xcd_barrier(const XcdBarrier& b) {
  asm volatile("s_waitcnt vmcnt(0)" ::: "memory");
  __syncthreads();
  if (threadIdx.x == 0) {
    unsigned* bar = b.bar;
    __builtin_amdgcn_s_waitcnt(0);
    unsigned nloc = b.st[0], nx = b.st[1];
    if (nloc == 0u) { xcd_barrier_complete(bar, b.x, nloc, nx); b.st[0] = nloc; b.st[1] = nx; }
    const unsigned old = xb_add(&bar[XB_XSUB(b.x)], 1u);
    const unsigned gen = old / nloc;
    if (old + 1u == (gen + 1u) * nloc) {
      __builtin_amdgcn_fence(__ATOMIC_RELEASE, "agent");
      asm volatile("s_waitcnt vmcnt(0)" ::: "memory");
      const unsigned og = xb_add(&bar[XB_TOP], 1u);
      const unsigned tg = og / nx;
      if (og + 1u == (tg + 1u) * nx) xb_add(&bar[XB_TOPGEN], 1u);
      else XB_SPIN(xb_ld(&bar[XB_TOPGEN]) == tg, bar);
      __builtin_amdgcn_fence(__ATOMIC_ACQUIRE, "agent");
      xb_add(&bar[XB_XGEN(b.x)], 1u);
      asm volatile("s_waitcnt vmcnt(0)" ::: "memory");
    } else {
      XB_SPIN(xb_ld(&bar[XB_XGEN(b.x)]) == gen, bar);
      __builtin_amdgcn_fence(__ATOMIC_ACQUIRE, "agent");
      asm volatile("s_waitcnt vmcnt(0)" ::: "memory");
    }
  }
  __syncthreads();
}

#if !MULTI_LAUNCH
template <int PH>
DI void run_all(const Params& p, char* smem, const XcdBarrier& xb) {
  if constexpr (PH != 12) {
    run_phase(p, PH, smem);
    if constexpr (PH + 1 < NPHASE) {
      if constexpr (PH == 0) cg::this_grid().sync();
      else xcd_barrier(xb);
    }
  }
  if constexpr (PH + 1 < NPHASE) run_all<PH + 1>(p, smem, xb);
}
__global__ void __launch_bounds__(256, 2) trunk_kernel(Params p) {
  __shared__ __attribute__((aligned(16))) char smem[SMEM_BYTES];
  __shared__ uint4 xb_words;
  if (threadIdx.x == 0) xb_words = make_uint4(0u, 0u, 0u, 0u);
  __syncthreads();
  const XcdBarrier xb = xcd_barrier_post((unsigned*)(p.ws + OFF_BAR), (volatile LAS unsigned*)&xb_words);
  run_all<0>(p, smem, xb);
}
#endif

extern "C" void kernel_launch(void* const* d_in, const int* in_sizes, int n_in, void* d_out, int out_size, void* d_ws, size_t ws_size,
                              hipStream_t stream) {
  Params p{};
  p.x = (const float*)d_in[0]; p.pos = (const int*)d_in[1]; p.ln_mix = (const float*)d_in[2]; p.ln_ffn = (const float*)d_in[3];
  p.gla_w_in = (const float*)d_in[4]; p.gla_w_alpha = (const float*)d_in[5]; p.gla_b_alpha = (const float*)d_in[6];
  p.gla_norm = (const float*)d_in[7]; p.gla_w_out = (const float*)d_in[8];
  p.swa_w_in = (const float*)d_in[9]; p.swa_b_in = (const float*)d_in[10]; p.swa_qn = (const float*)d_in[11]; p.swa_kn = (const float*)d_in[12];
  p.swa_sinks = (const float*)d_in[13]; p.swa_w_out = (const float*)d_in[14]; p.swa_b_out = (const float*)d_in[15];
  p.peer_wq = (const float*)d_in[16]; p.peer_keys = (const float*)d_in[17]; p.peer_u = (const float*)d_in[18]; p.peer_v = (const float*)d_in[19];
  p.out = (float*)d_out; p.ws = (char*)d_ws;
  static int grid_blocks = 0;
  if (!grid_blocks) {
    int dev = 0, cus = 0, per_cu = 0;
    (void)hipGetDevice(&dev);
    (void)hipDeviceGetAttribute(&cus, hipDeviceAttributeMultiprocessorCount, dev);
    #if MULTI_LAUNCH
    per_cu = 2;
#else
    (void)hipOccupancyMaxActiveBlocksPerMultiprocessor(&per_cu, trunk_kernel, 256, 0);
#endif
    if (per_cu < 1) per_cu = 1;
    if (per_cu > 2) per_cu = 2;
    grid_blocks = cus * per_cu;
  }
#if MULTI_LAUNCH
  p.phase_lo = 0; p.phase_hi = 0;
  launch_phases<0>(p, grid_blocks, stream);
#else
  p.phase_lo = 0; p.phase_hi = NPHASE - 1;
  void* args[] = {&p};
  (void)hipMemsetAsync((char*)d_ws + OFF_BAR, 0, XCD_BAR_WORDS * 4, stream);
  hipError_t e = hipLaunchCooperativeKernel((void*)trunk_kernel, dim3(grid_blocks), dim3(256), args, 0, stream);
  if (e != hipSuccess) fprintf(stderr, "cooperative launch failed: %s (grid %d)\n", hipGetErrorString(e), grid_blocks);
#endif
}
```

```cpp
#include <hip/hip_runtime.h>
#include <hip/hip_cooperative_groups.h>
#include <stdint.h>
#include <stdio.h>
namespace cg = cooperative_groups;

#ifndef MULTI_LAUNCH
#define MULTI_LAUNCH 0
#endif

#define DI __device__ __forceinline__
typedef unsigned short bf16_t;
typedef __attribute__((ext_vector_type(8))) short bf16x8;
typedef __attribute__((ext_vector_type(16))) float f32x16;
typedef __bf16 bf16x2_t __attribute__((ext_vector_type(2)));
typedef float f32x2_t __attribute__((ext_vector_type(2)));
typedef float f2 __attribute__((ext_vector_type(2)));

constexpr int T_TOK = 32768;
constexpr int SEQ = 16384;
constexpr int DM = 1024;
constexpr int NPHASE = 22;

constexpr size_t MiB = 1048576;
constexpr size_t OFF_WT_GLA_IN = 0;
constexpr size_t OFF_WT_GLA_OUT = 7 * MiB;
constexpr size_t OFF_WT_SWA_IN = 9 * MiB;
constexpr size_t OFF_WT_SWA_OUT = 12 * MiB;
constexpr size_t OFF_WT_PQ = 14 * MiB;
constexpr size_t OFF_KEYS = 18 * MiB;
constexpr size_t OFF_INV = 20 * MiB;
constexpr size_t OFF_TBL_U = 24 * MiB;
constexpr size_t OFF_TBL_V = 56 * MiB;
constexpr size_t OFF_ACT_A = 88 * MiB;
constexpr size_t OFF_BIG = 152 * MiB;
constexpr size_t OFF_E = OFF_BIG + 64 * MiB;
constexpr size_t OFF_G = OFF_BIG + 80 * MiB;
constexpr size_t OFF_A = OFF_BIG + 96 * MiB;
constexpr size_t OFF_KVT = 344 * MiB;
constexpr size_t OFF_ACT_B = OFF_KVT;
constexpr size_t OFF_LR = 472 * MiB;
constexpr size_t OFF_DECAY = 474 * MiB;
constexpr size_t OFF_BAR = 476 * MiB;

constexpr int SMEM_BYTES = 73728;
constexpr int LDK = 72;

struct Params {
  const float* x; const int* pos; const float* ln_mix; const float* ln_ffn;
  const float* gla_w_in; const float* gla_w_alpha; const float* gla_b_alpha; const float* gla_norm; const float* gla_w_out;
  const float* swa_w_in; const float* swa_b_in; const float* swa_qn; const float* swa_kn; const float* swa_sinks;
  const float* swa_w_out; const float* swa_b_out;
  const float* peer_wq; const float* peer_keys; const float* peer_u; const float* peer_v;
  float* out; char* ws;
  int phase_lo, phase_hi;
};

DI unsigned pk(float lo, float hi) { f32x2_t v = {lo, hi}; bf16x2_t b = __builtin_convertvector(v, bf16x2_t); return __builtin_bit_cast(unsigned, b); }
DI bf16_t f2bf(float x) { return (bf16_t)(pk(x, 0.f) & 0xffffu); }
DI float bflo(unsigned w) { return __uint_as_float(w << 16); }
DI float bfhi(unsigned w) { return __uint_as_float(w & 0xffff0000u); }
DI float bf2f(bf16_t b) { return __uint_as_float(((unsigned)b) << 16); }
DI float dot2(unsigned a, unsigned b, float c) { return __builtin_amdgcn_fdot2_f32_bf16(__builtin_bit_cast(bf16x2_t, a), __builtin_bit_cast(bf16x2_t, b), c, false); }
DI int crow(int i, int h) { return (i & 3) + 8 * (i >> 2) + 4 * h; }
DI f32x16 mfma32(bf16x8 a, bf16x8 b, f32x16 c) { return __builtin_amdgcn_mfma_f32_32x32x16_bf16(a, b, c, 0, 0, 0); }
DI f32x16 zero16() { f32x16 z; for (int i = 0; i < 16; ++i) z[i] = 0.f; return z; }
DI void wave_sync() { __builtin_amdgcn_fence(__ATOMIC_RELEASE, "wavefront"); __builtin_amdgcn_wave_barrier(); __builtin_amdgcn_fence(__ATOMIC_ACQUIRE, "wavefront"); }
DI int mbcnt64(unsigned long long m) { return __builtin_amdgcn_mbcnt_hi((unsigned)(m >> 32), __builtin_amdgcn_mbcnt_lo((unsigned)m, 0)); }
DI float logsig(float z) { return fminf(z, 0.f) - __logf(1.f + __expf(-fabsf(z))); }

DI void transpose_tile(const float* __restrict__ src, int N, bf16_t* __restrict__ dst, int kt, int nt, float* sT) {
  const int tid = threadIdx.x;
  const int r = tid >> 4, c4 = (tid & 15) * 4;
#pragma unroll
  for (int i = 0; i < 4; ++i) {
    const int k = kt * 64 + r + 16 * i, n = nt * 64 + c4;
    float4 v = make_float4(0.f, 0.f, 0.f, 0.f);
    if (n + 3 < N) v = *(const float4*)(src + (size_t)k * N + n);
    float* d = sT + (r + 16 * i) * 65 + c4;
    d[0] = v.x; d[1] = v.y; d[2] = v.z; d[3] = v.w;
  }
  __syncthreads();
  const int n = tid >> 2, seg = tid & 3;
  unsigned w[8];
#pragma unroll
  for (int j = 0; j < 8; ++j) w[j] = pk(sT[(seg * 16 + 2 * j) * 65 + n], sT[(seg * 16 + 2 * j + 1) * 65 + n]);
  uint4* d = (uint4*)(dst + (size_t)(nt * 64 + n) * 1024 + kt * 64 + seg * 16);
  d[0] = make_uint4(w[0], w[1], w[2], w[3]);
  d[1] = make_uint4(w[4], w[5], w[6], w[7]);
  __syncthreads();
}

DI void cvt_elems(const float* __restrict__ src, bf16_t* __restrict__ dst, size_t n8) {
  for (size_t i = (size_t)blockIdx.x * 256 + threadIdx.x; i < n8; i += (size_t)gridDim.x * 256) {
    const float4 a = ((const float4*)src)[2 * i], b = ((const float4*)src)[2 * i + 1];
    ((uint4*)dst)[i] = make_uint4(pk(a.x, a.y), pk(a.z, a.w), pk(b.x, b.y), pk(b.z, b.w));
  }
}

DI void phase_convert(const Params& p, char* smem) {
  float* sT = (float*)smem;
  for (int t = blockIdx.x; t < 2144; t += gridDim.x) {
    const float* src; int N, ntn; bf16_t* dst; int local;
    if (t < 800) { src = p.gla_w_in; N = 3088; ntn = 50; dst = (bf16_t*)(p.ws + OFF_WT_GLA_IN); local = t; }
    else if (t < 1056) { src = p.gla_w_out; N = 1024; ntn = 16; dst = (bf16_t*)(p.ws + OFF_WT_GLA_OUT); local = t - 800; }
    else if (t < 1376) { src = p.swa_w_in; N = 1280; ntn = 20; dst = (bf16_t*)(p.ws + OFF_WT_SWA_IN); local = t - 1056; }
    else if (t < 1632) { src = p.swa_w_out; N = 1024; ntn = 16; dst = (bf16_t*)(p.ws + OFF_WT_SWA_OUT); local = t - 1376; }
    else if (t < 1888) { src = p.peer_wq; N = 1024; ntn = 16; dst = (bf16_t*)(p.ws + OFF_WT_PQ); local = t - 1632; }
    else { src = p.peer_wq + (size_t)1024 * 1024; N = 1024; ntn = 16; dst = (bf16_t*)(p.ws + OFF_WT_PQ) + (size_t)1024 * 1024; local = t - 1888; }
    transpose_tile(src, N, dst, local / ntn, local % ntn, sT);
  }
  cvt_elems(p.peer_keys, (bf16_t*)(p.ws + OFF_KEYS), (size_t)2 * 8 * 2 * 128 * 64 / 8);
}

typedef unsigned v6u __attribute__((ext_vector_type(6)));
typedef float v32f __attribute__((ext_vector_type(32)));
DI unsigned fp6_code(float y) {
  const float a = fminf(fabsf(y), 7.5f);
  float c = rintf(a * 8.f);
  c = a >= 2.f ? rintf(a * 4.f) + 8.f : c;
  c = a >= 4.f ? rintf(a * 2.f) + 16.f : c;
  unsigned u = (unsigned)c;
  u = u > 31u ? 31u : u;
  return u | ((__float_as_uint(y) >> 26) & 32u);
}
DI void cvt_table_fp6(const float* __restrict__ src, unsigned char* __restrict__ dst, float* __restrict__ inv, int bid, int nb) {
  const int lane = threadIdx.x & 63, w = threadIdx.x >> 6, r = lane & 31, h = lane >> 5;
  for (int rp = bid * 4 + w; rp < 8192; rp += nb * 4) {
    const int row = rp * 2 + h;
    const float4* sp = (const float4*)(src + (size_t)row * 1024 + r * 32);
    float v[32];
    float mx = 0.f;
#pragma unroll
    for (int i = 0; i < 8; ++i) {
      const float4 t = sp[i];
      v[4 * i] = t.x; v[4 * i + 1] = t.y; v[4 * i + 2] = t.z; v[4 * i + 3] = t.w;
      mx = fmaxf(fmaxf(mx, fmaxf(fabsf(t.x), fabsf(t.y))), fmaxf(fabsf(t.z), fabsf(t.w)));
    }
#pragma unroll
    for (int o = 16; o >= 1; o >>= 1) mx = fmaxf(mx, __shfl_xor(mx, o));
    const float sc = mx > 0.f ? 7.5f / mx : 1.f;
    unsigned c[32];
#pragma unroll
    for (int i = 0; i < 32; ++i) c[i] = fp6_code(v[i] * sc);
    unsigned d[6];
#pragma unroll
    for (int g = 0; g < 2; ++g) {
      const unsigned* q = c + 16 * g;
      d[3 * g + 0] = q[0] | (q[1] << 6) | (q[2] << 12) | (q[3] << 18) | (q[4] << 24) | (q[5] << 30);
      d[3 * g + 1] = (q[5] >> 2) | (q[6] << 4) | (q[7] << 10) | (q[8] << 16) | (q[9] << 22) | (q[10] << 28);
      d[3 * g + 2] = (q[10] >> 4) | (q[11] << 2) | (q[12] << 8) | (q[13] << 14) | (q[14] << 20) | (q[15] << 26);
    }
    uint2* dp = (uint2*)(dst + (size_t)row * 768 + r * 24);
    dp[0] = make_uint2(d[0], d[1]); dp[1] = make_uint2(d[2], d[3]); dp[2] = make_uint2(d[4], d[5]);
    if (r == 0) inv[row] = mx > 0.f ? mx * (1.f / 7.5f) : 1.f;
  }
}
DI void phase_cvt_tables(const Params& p, int layer) {
  const int nb = gridDim.x / 2, bid = blockIdx.x % nb;
  const int rows_lo = (blockIdx.x < nb) ? 0 : 1;
  cvt_table_fp6(p.peer_u + (size_t)layer * 16384 * 1024, (unsigned char*)(p.ws + OFF_TBL_U) + (size_t)layer * 16 * MiB, (float*)(p.ws + OFF_INV) + (layer * 2 + 0) * 16384, bid * 2 + rows_lo, nb * 2);
  cvt_table_fp6(p.peer_v + (size_t)layer * 16384 * 1024, (unsigned char*)(p.ws + OFF_TBL_V) + (size_t)layer * 16 * MiB, (float*)(p.ws + OFF_INV) + (layer * 2 + 1) * 16384, bid * 2 + rows_lo, nb * 2);
}

DI void phase_rmsnorm(const float* __restrict__ src, const float* __restrict__ gain, bf16_t* __restrict__ dst) {
  const int lane = threadIdx.x & 63, w = threadIdx.x >> 6;
  for (int row = blockIdx.x * 4 + w; row < T_TOK; row += gridDim.x * 4) {
    const float4* sp = (const float4*)(src + (size_t)row * DM);
    float4 v[4];
    float ss = 0.f;
#pragma unroll
    for (int i = 0; i < 4; ++i) { v[i] = sp[lane + 64 * i]; ss += v[i].x * v[i].x + v[i].y * v[i].y + v[i].z * v[i].z + v[i].w * v[i].w; }
#pragma unroll
    for (int o = 32; o >= 1; o >>= 1) ss += __shfl_xor(ss, o);
    const float rs = rsqrtf(ss * (1.f / 1024.f) + 1e-6f);
#pragma unroll
    for (int i = 0; i < 4; ++i) {
      const float4 g = ((const float4*)gain)[lane + 64 * i];
      uint2 o2 = make_uint2(pk(v[i].x * rs * g.x, v[i].y * rs * g.y), pk(v[i].z * rs * g.z, v[i].w * rs * g.w));
      *(uint2*)(dst + (size_t)row * DM + (lane + 64 * i) * 4) = o2;
    }
  }
}

DI void mma_64x64(const bf16_t* sA, const bf16_t* sB, int arow0, int brow0, f32x16 (&acc)[2][2], int lane) {
  const int r = lane & 31, h = lane >> 5;
#pragma unroll
  for (int s = 0; s < 4; ++s) {
    bf16x8 a[2], b[2];
#pragma unroll
    for (int mi = 0; mi < 2; ++mi) a[mi] = *(const bf16x8*)(sA + (arow0 + mi * 32 + r) * LDK + s * 16 + h * 8);
#pragma unroll
    for (int ni = 0; ni < 2; ++ni) b[ni] = *(const bf16x8*)(sB + (brow0 + ni * 32 + r) * LDK + s * 16 + h * 8);
#pragma unroll
    for (int mi = 0; mi < 2; ++mi)
#pragma unroll
      for (int ni = 0; ni < 2; ++ni) acc[mi][ni] = mfma32(a[mi], b[ni], acc[mi][ni]);
  }
}

enum { EPI_GLA_IN = 0, EPI_RESID_X = 1, EPI_BF16 = 2, EPI_RESID_INPLACE = 3 };

template <int MODE>
DI void phase_gemm(const Params& p, const bf16_t* __restrict__ A, const bf16_t* __restrict__ Bt, int NT, bf16_t* dstb, int ldc,
                   const float* __restrict__ bias, char* smem) {
  const int ntiles = (T_TOK / 128) * NT;
  int t = (gridDim.x & 7) ? (int)blockIdx.x : (int)((blockIdx.x & 7) * (gridDim.x >> 3) + (blockIdx.x >> 3));
  if (t >= ntiles) return;
  bf16_t* sA = (bf16_t*)smem;
  bf16_t* sB = sA + 128 * LDK;
  bf16_t* ct = (bf16_t*)smem;
  const int tid = threadIdx.x, lane = tid & 63, w = tid >> 6, wm = w >> 1, wn = w & 1;
  const int r = lane & 31, h = lane >> 5;
  const int lrow = tid >> 3, kc = tid & 7;
  bf16_t* wa = sA + lrow * LDK + kc * 8;
  bf16_t* wb = sB + lrow * LDK + kc * 8;
  bf16x8 ra0[4], rb0[4], ra1[4], rb1[4];
  int m0 = (t / NT) * 128, n0 = (t % NT) * 128;
  const bf16_t* ap = A + (size_t)(m0 + lrow) * 1024 + kc * 8;
  const bf16_t* bp = Bt + (size_t)(n0 + lrow) * 1024 + kc * 8;
#define GLOAD(RA, RB, KT) _Pragma("unroll") for (int i = 0; i < 4; ++i) { RA[i] = *(const bf16x8*)(ap + (size_t)i * 32 * 1024 + (KT) * 64); RB[i] = *(const bf16x8*)(bp + (size_t)i * 32 * 1024 + (KT) * 64); }
#define SSTORE(RA, RB) _Pragma("unroll") for (int i = 0; i < 4; ++i) { *(bf16x8*)(wa + 32 * i * LDK) = RA[i]; *(bf16x8*)(wb + 32 * i * LDK) = RB[i]; }
  GLOAD(ra0, rb0, 0)
  GLOAD(ra1, rb1, 1)
  for (; t < ntiles; t += gridDim.x) {
    f32x16 acc[2][2];
#pragma unroll
    for (int i = 0; i < 2; ++i)
#pragma unroll
      for (int j = 0; j < 2; ++j) acc[i][j] = zero16();
    __syncthreads();
    SSTORE(ra0, rb0)
    __syncthreads();
    for (int kt = 0; kt < 16; kt += 2) {
      if (kt + 2 < 16) { GLOAD(ra0, rb0, kt + 2) }
      mma_64x64(sA, sB, wm * 64, wn * 64, acc, lane);
      __syncthreads();
      SSTORE(ra1, rb1)
      __syncthreads();
      if (kt + 3 < 16) { GLOAD(ra1, rb1, kt + 3) }
      mma_64x64(sA, sB, wm * 64, wn * 64, acc, lane);
      __syncthreads();
      if (kt + 2 < 16) {
        SSTORE(ra0, rb0)
        __syncthreads();
      }
    }
    const int cm0 = m0, cn0 = n0;
    {
      const int tn = t + gridDim.x;
      if (tn < ntiles) {
        m0 = (tn / NT) * 128; n0 = (tn % NT) * 128;
        ap = A + (size_t)(m0 + lrow) * 1024 + kc * 8;
        bp = Bt + (size_t)(n0 + lrow) * 1024 + kc * 8;
        GLOAD(ra0, rb0, 0)
        GLOAD(ra1, rb1, 1)
      }
    }
    const bool staged = (MODE == EPI_BF16) || (MODE == EPI_GLA_IN && cn0 < 3072);
    if (staged) {
#pragma unroll
      for (int ni = 0; ni < 2; ++ni) {
        const int col = wn * 64 + ni * 32 + r;
        const float bv = (MODE == EPI_BF16 && bias) ? bias[cn0 + col] : 0.f;
#pragma unroll
        for (int mi = 0; mi < 2; ++mi)
#pragma unroll
          for (int i = 0; i < 16; ++i) ct[(wm * 64 + mi * 32 + crow(i, h)) * 136 + col] = f2bf(acc[mi][ni][i] + bv);
      }
      __syncthreads();
      const int ldo = (MODE == EPI_GLA_IN) ? 3072 : ldc;
#pragma unroll
      for (int j = 0; j < 8; ++j) {
        const int c = tid + 256 * j, row = c >> 4, cc = c & 15;
        *(uint4*)(dstb + (size_t)(cm0 + row) * ldo + cn0 + cc * 8) = *(const uint4*)(ct + row * 136 + cc * 8);
      }
    } else {
      const unsigned row0 = (unsigned)(cm0 + wm * 64 + 4 * h), col0 = (unsigned)(cn0 + wn * 64 + r);
      float* __restrict__ lrp = (float*)(p.ws + OFF_LR);
#pragma unroll
      for (int ni = 0; ni < 2; ++ni) {
        const unsigned col = col0 + ni * 32;
        float bv = 0.f;
        if (MODE == EPI_RESID_INPLACE) bv = bias[col];
        const unsigned i0 = row0 * 1024u + col;
        const unsigned l0 = row0 * 16u + (col - 3072u);
#pragma unroll
        for (int mi = 0; mi < 2; ++mi)
#pragma unroll
          for (int i = 0; i < 16; ++i) {
            const unsigned ro = (unsigned)(mi * 32 + (i & 3) + 8 * (i >> 2));
            const float v = acc[mi][ni][i];
            if (MODE == EPI_GLA_IN) { if (col < 3088u) lrp[l0 + ro * 16u] = v; }
            else if (MODE == EPI_RESID_X) p.out[i0 + ro * 1024u] = p.x[i0 + ro * 1024u] + v;
            else if (MODE == EPI_RESID_INPLACE) p.out[i0 + ro * 1024u] += v + bv;
          }
      }
    }
  }
#undef GLOAD
#undef SSTORE
}

DI float gate_la(const float* lr_s, int t, const float (&wa)[16], float ba) {
  float z = ba;
#pragma unroll
  for (int j = 0; j < 16; ++j) z += lr_s[t * 16 + j] * wa[j];
  return logsig(z) * (1.f / 16.f);
}
DI void gla_gates(const Params& p, int t0, int hh, float (&wa)[16], float& ba, float& offset, float& blast, float* lr_s, float* tot_s) {
  const int tid = threadIdx.x, d = tid & 127, half = tid >> 7;
  const float* LR = (const float*)(p.ws + OFF_LR);
  ((float4*)lr_s)[tid] = ((const float4*)(LR + (size_t)t0 * 16))[tid];
#pragma unroll
  for (int j = 0; j < 16; ++j) wa[j] = p.gla_w_alpha[j * 512 + hh * 128 + d];
  ba = p.gla_b_alpha[hh * 128 + d];
  __syncthreads();
  float sum = 0.f;
#pragma unroll 4
  for (int tt = 0; tt < 32; ++tt) sum += gate_la(lr_s, half * 32 + tt, wa, ba);
  tot_s[half * 128 + d] = sum;
  __syncthreads();
  offset = half ? tot_s[d] : 0.f;
  blast = tot_s[d] + tot_s[128 + d];
}

DI void fill_vT(const bf16_t* __restrict__ QKVR, int t0, int hh, int vh, bf16_t* vT) {
  const int tid = threadIdx.x, v = tid & 127, half = tid >> 7;
#pragma unroll 8
  for (int tt = 0; tt < 32; ++tt) {
    const int t = half * 32 + tt;
    vT[v * LDK + t] = QKVR[(size_t)(t0 + t) * 3072 + 1024 + hh * 256 + vh * 128 + v];
  }
}

DI void gla_phase1(const Params& p, int item, char* smem) {
  const int hh = item & 3, c = (item >> 2) & 255, b = item >> 10;
  const int t0 = b * SEQ + c * 64;
  float* lr_s = (float*)smem;
  float* tot_s = (float*)(smem + 4096);
  bf16_t* kfT = (bf16_t*)(smem + 5120);
  bf16_t* vT = kfT + 128 * LDK;
  const bf16_t* QKVR = (const bf16_t*)(p.ws + OFF_BIG);
  bf16_t* KVT = (bf16_t*)(p.ws + OFF_KVT);
  float* DECAY = (float*)(p.ws + OFF_DECAY);
  const int tid = threadIdx.x, lane = tid & 63, w = tid >> 6, wm = w >> 1, wn = w & 1;
  const int d = tid & 127, half = tid >> 7;
  float wa[16], ba, offset, blast;
  gla_gates(p, t0, hh, wa, ba, offset, blast, lr_s, tot_s);
  float run = offset;
#pragma unroll 4
  for (int tt = 0; tt < 32; ++tt) {
    const int t = half * 32 + tt;
    run += gate_la(lr_s, t, wa, ba);
    ((float*)(p.ws + OFF_ACT_A))[(size_t)(t0 + t) * 512 + hh * 128 + d] = run;
    const float kv = bf2f(QKVR[(size_t)(t0 + t) * 3072 + 512 + hh * 128 + d]);
    kfT[d * LDK + t] = f2bf(kv * __expf(blast - run));
  }
  if (half == 0) DECAY[(size_t)item * 128 + d] = __expf(blast);
  const int r = lane & 31, h = lane >> 5;
  for (int vh = 0; vh < 2; ++vh) {
    __syncthreads();
    fill_vT(QKVR, t0, hh, vh, vT);
    __syncthreads();
    f32x16 acc[2][2];
#pragma unroll
    for (int i = 0; i < 2; ++i)
#pragma unroll
      for (int j = 0; j < 2; ++j) acc[i][j] = zero16();
    mma_64x64(vT, kfT, wm * 64, wn * 64, acc, lane);
    bf16_t* kbase = KVT + (size_t)item * 32768 + (vh * 128 + wm * 64 + 4 * h) * 128 + wn * 64 + r;
#pragma unroll
    for (int mi = 0; mi < 2; ++mi)
#pragma unroll
      for (int ni = 0; ni < 2; ++ni)
#pragma unroll
        for (int i = 0; i < 16; ++i) kbase[(mi * 32 + (i & 3) + 8 * (i >> 2)) * 128 + ni * 32] = f2bf(acc[mi][ni][i]);
  }
  __syncthreads();
}

DI void gla_scan(const Params& p) {
  bf16_t* KVT = (bf16_t*)(p.ws + OFF_KVT);
  const float* DECAY = (const float*)(p.ws + OFF_DECAY);
  for (int idx = blockIdx.x * 256 + threadIdx.x; idx < 8 * 16384; idx += gridDim.x * 256) {
    const int bh = idx >> 14, e2 = idx & 16383, b = bh >> 2, hh = bh & 3, d0 = (2 * e2) & 127;
    float s0 = 0.f, s1 = 0.f;
    for (int c0 = 0; c0 < 256; c0 += 8) {
      unsigned kv[8]; float2 dc[8];
#pragma unroll
      for (int u = 0; u < 8; ++u) {
        const size_t item = (size_t)(b * 256 + c0 + u) * 4 + hh;
        kv[u] = *(const unsigned*)(KVT + item * 32768 + 2 * e2);
        dc[u] = *(const float2*)(DECAY + item * 128 + d0);
      }
#pragma unroll
      for (int u = 0; u < 8; ++u) {
        const size_t item = (size_t)(b * 256 + c0 + u) * 4 + hh;
        *(unsigned*)(KVT + item * 32768 + 2 * e2) = pk(s0, s1);
        s0 = dc[u].x * s0 + bflo(kv[u]);
        s1 = dc[u].y * s1 + bfhi(kv[u]);
      }
    }
  }
}

DI void gla_phase3(const Params& p, int item, char* smem) {
  const int hh = item & 3, c = (item >> 2) & 255, b = item >> 10;
  const int t0 = b * SEQ + c * 64;
  float* lr_s = (float*)smem;
  float* tot_s = (float*)(smem + 4096);
  bf16_t* qd = (bf16_t*)(smem + 5120);
  bf16_t* ki = qd + 64 * 136;
  bf16_t* at = ki + 64 * 136;
  bf16_t* vT = at + 64 * 72;
  bf16_t* ot = qd;
  const bf16_t* QKVR = (const bf16_t*)(p.ws + OFF_BIG);
  const bf16_t* ST = (const bf16_t*)(p.ws + OFF_KVT);
  bf16_t* OG = (bf16_t*)(p.ws + OFF_ACT_A);
  const int tid = threadIdx.x, lane = tid & 63, w = tid >> 6;
  const int d = tid & 127, half = tid >> 7;
  const int r = lane & 31, h = lane >> 5;
  {
    const float* Bc = (const float*)(p.ws + OFF_ACT_A);
#pragma unroll 8
    for (int tt = 0; tt < 32; ++tt) {
      const int t = half * 32 + tt;
      const float run = Bc[(size_t)(t0 + t) * 512 + hh * 128 + d];
      const float q = bf2f(QKVR[(size_t)(t0 + t) * 3072 + hh * 128 + d]);
      const float k = bf2f(QKVR[(size_t)(t0 + t) * 3072 + 512 + hh * 128 + d]);
      qd[t * 136 + d] = f2bf(q * 0.08838834764831845f * __expf(run));
      ki[t * 136 + d] = f2bf(k * __expf(-run));
    }
  }
  __syncthreads();
  {
    const int mi = w >> 1, nj = w & 1;
    f32x16 a = zero16();
#pragma unroll
    for (int s = 0; s < 8; ++s) {
      const bf16x8 A = *(const bf16x8*)(qd + (mi * 32 + r) * 136 + s * 16 + h * 8);
      const bf16x8 B = *(const bf16x8*)(ki + (nj * 32 + r) * 136 + s * 16 + h * 8);
      a = mfma32(A, B, a);
    }
#pragma unroll
    for (int i = 0; i < 16; ++i) {
      const int it = mi * 32 + crow(i, h), jt = nj * 32 + r;
      at[it * 72 + jt] = f2bf(jt <= it ? a[i] : 0.f);
    }
  }
  f32x16 o[2][2];
#pragma unroll
  for (int i = 0; i < 2; ++i)
#pragma unroll
    for (int j = 0; j < 2; ++j) o[i][j] = zero16();
#pragma unroll
  for (int vh = 0; vh < 2; ++vh) {
    __syncthreads();
    fill_vT(QKVR, t0, hh, vh, vT);
    __syncthreads();
#pragma unroll
    for (int s = 0; s < 4; ++s) {
      const bf16x8 B = *(const bf16x8*)(vT + (w * 32 + r) * LDK + s * 16 + h * 8);
#pragma unroll
      for (int mt = 0; mt < 2; ++mt) {
        const bf16x8 A = *(const bf16x8*)(at + (mt * 32 + r) * 72 + s * 16 + h * 8);
        o[vh][mt] = mfma32(A, B, o[vh][mt]);
      }
    }
    const bf16_t* Sg = ST + (size_t)item * 32768 + (size_t)(vh * 128 + w * 32 + r) * 128 + h * 8;
#pragma unroll
    for (int s = 0; s < 8; ++s) {
      const bf16x8 B = *(const bf16x8*)(Sg + s * 16);
#pragma unroll
      for (int mt = 0; mt < 2; ++mt) {
        const bf16x8 A = *(const bf16x8*)(qd + (mt * 32 + r) * 136 + s * 16 + h * 8);
        o[vh][mt] = mfma32(A, B, o[vh][mt]);
      }
    }
  }
  __syncthreads();
#pragma unroll
  for (int vh = 0; vh < 2; ++vh)
#pragma unroll
    for (int mt = 0; mt < 2; ++mt)
#pragma unroll
      for (int i = 0; i < 16; ++i) ot[(mt * 32 + crow(i, h)) * 264 + vh * 128 + w * 32 + r] = f2bf(o[vh][mt][i]);
  __syncthreads();
  {
    const int row = tid >> 2, seg = tid & 3;
    const bf16_t* orow = ot + row * 264 + seg * 64;
    float ss = 0.f;
#pragma unroll
    for (int c8 = 0; c8 < 8; ++c8) {
      const uint4 ov = *(const uint4*)(orow + c8 * 8);
      const float f0 = bflo(ov.x), f1 = bfhi(ov.x), f2 = bflo(ov.y), f3 = bfhi(ov.y), f4 = bflo(ov.z), f5 = bfhi(ov.z), f6 = bflo(ov.w), f7 = bfhi(ov.w);
      ss += f0 * f0 + f1 * f1 + f2 * f2 + f3 * f3 + f4 * f4 + f5 * f5 + f6 * f6 + f7 * f7;
    }
    ss += __shfl_xor(ss, 1);
    ss += __shfl_xor(ss, 2);
    const float rs = rsqrtf(ss * (1.f / 256.f) + 1e-6f);
    const bf16_t* rrow = QKVR + (size_t)(t0 + row) * 3072 + 2048 + hh * 256 + seg * 64;
    const float* grow = p.gla_norm + hh * 256 + seg * 64;
    bf16_t* dst = OG + (size_t)(t0 + row) * 1024 + hh * 256 + seg * 64;
#pragma unroll
    for (int c8 = 0; c8 < 8; ++c8) {
      const uint4 ov = *(const uint4*)(orow + c8 * 8);
      const uint4 rv = *(const uint4*)(rrow + c8 * 8);
      const float4 g0 = *(const float4*)(grow + c8 * 8), g1 = *(const float4*)(grow + c8 * 8 + 4);
      float of[8] = {bflo(ov.x), bfhi(ov.x), bflo(ov.y), bfhi(ov.y), bflo(ov.z), bfhi(ov.z), bflo(ov.w), bfhi(ov.w)};
      float rf[8] = {bflo(rv.x), bfhi(rv.x), bflo(rv.y), bfhi(rv.y), bflo(rv.z), bfhi(rv.z), bflo(rv.w), bfhi(rv.w)};
      float gf[8] = {g0.x, g0.y, g0.z, g0.w, g1.x, g1.y, g1.z, g1.w};
      float res[8];
#pragma unroll
      for (int e = 0; e < 8; ++e) res[e] = of[e] * rs * gf[e] * (rf[e] / (1.f + __expf(-rf[e])));
      *(uint4*)(dst + c8 * 8) = make_uint4(pk(res[0], res[1]), pk(res[2], res[3]), pk(res[4], res[5]), pk(res[6], res[7]));
    }
  }
  __syncthreads();
}

DI void swa_qknorm(const Params& p) {
  bf16_t* QKV = (bf16_t*)(p.ws + OFF_BIG);
  const int tid = threadIdx.x, sub = tid & 7;
  const int ngroups = T_TOK * 18;
  for (int g = blockIdx.x * 32 + (tid >> 3); g < ngroups; g += gridDim.x * 32) {
    const int tok = g / 18, slot = g - tok * 18;
    bf16_t* ptr = QKV + (size_t)tok * 1280 + slot * 64 + sub * 8;
    const uint4 wv = *(const uint4*)ptr;
    float v[8] = {bflo(wv.x), bfhi(wv.x), bflo(wv.y), bfhi(wv.y), bflo(wv.z), bfhi(wv.z), bflo(wv.w), bfhi(wv.w)};
    float ss = 0.f;
#pragma unroll
    for (int e = 0; e < 8; ++e) ss += v[e] * v[e];
    ss += __shfl_xor(ss, 1);
    ss += __shfl_xor(ss, 2);
    ss += __shfl_xor(ss, 4);
    const float rs = rsqrtf(ss * (1.f / 64.f) + 1e-6f);
    const float* gain = (slot < 16 ? p.swa_qn : p.swa_kn) + sub * 8;
#pragma unroll
    for (int e = 0; e < 8; ++e) v[e] = v[e] * rs * gain[e];
    const float posf = (float)p.pos[tok];
    const float invf[8] = {1.0f, 0.1939227432012558f, 0.03760603070259094f, 0.007292664609849453f,
                           0.0014142135623842478f, 0.00027424818836152554f, 5.318296098266728e-05f, 1.0313386155758053e-05f};
#pragma unroll
    for (int e = 0; e < 8; ++e) {
      const float other = __shfl_xor(v[e], 1);
      if (sub < 2) {
        const float ang = posf * invf[e];
        const double rev = (double)ang * 0.15915494309189535;
        const float fr = (float)(rev - rint(rev));
        const float sn = __builtin_amdgcn_sinf(fr), cs = __builtin_amdgcn_cosf(fr);
        v[e] = (sub == 0) ? (v[e] * cs - other * sn) : (v[e] * cs + other * sn);
      }
    }
    if (slot < 16) {
#pragma unroll
      for (int e = 0; e < 8; ++e) v[e] *= 0.125f;
    }
    *(uint4*)ptr = make_uint4(pk(v[0], v[1]), pk(v[2], v[3]), pk(v[4], v[5]), pk(v[6], v[7]));
  }
}

DI void swa_attn(const Params& p, int item, char* smem) {
  const int hq = item & 15, n = (item >> 4) & 127, b = item >> 11, hkv = hq >> 3;
  const int tok0 = b * SEQ + n * 128;
  bf16_t* Ks = (bf16_t*)smem;
  bf16_t* vT = Ks + 256 * 72;
  const bf16_t* QKV = (const bf16_t*)(p.ws + OFF_BIG);
  bf16_t* OUT = (bf16_t*)(p.ws + OFF_ACT_B);
  const int tid = threadIdx.x, lane = tid & 63, w = tid >> 6, r = lane & 31, h = lane >> 5;
  __syncthreads();
#pragma unroll
  for (int i = 0; i < 8; ++i) {
    const int cidx = tid + 256 * i, kk = cidx >> 3, kc = cidx & 7;
    const int pos = n * 128 - 128 + kk;
    uint4 kw = make_uint4(0, 0, 0, 0), vw = make_uint4(0, 0, 0, 0);
    if (pos >= 0) {
      const bf16_t* base = QKV + (size_t)(b * SEQ + pos) * 1280;
      kw = *(const uint4*)(base + 1024 + hkv * 64 + kc * 8);
      vw = *(const uint4*)(base + 1152 + hkv * 64 + kc * 8);
    }
    *(uint4*)(Ks + kk * 72 + kc * 8) = kw;
    bf16_t* vd = vT + (kc * 8) * 264 + kk;
    vd[0 * 264] = (bf16_t)(vw.x & 0xffff); vd[1 * 264] = (bf16_t)(vw.x >> 16);
    vd[2 * 264] = (bf16_t)(vw.y & 0xffff); vd[3 * 264] = (bf16_t)(vw.y >> 16);
    vd[4 * 264] = (bf16_t)(vw.z & 0xffff); vd[5 * 264] = (bf16_t)(vw.z >> 16);
    vd[6 * 264] = (bf16_t)(vw.w & 0xffff); vd[7 * 264] = (bf16_t)(vw.w >> 16);
  }
  __syncthreads();
  const int iq = 32 * w + r;
  const bf16_t* qrow = QKV + (size_t)(tok0 + iq) * 1280 + hq * 64 + h * 8;
  bf16x8 qf[4];
#pragma unroll
  for (int s = 0; s < 4; ++s) qf[s] = *(const bf16x8*)(qrow + s * 16);
  f32x16 X[5];
#pragma unroll
  for (int kt = 0; kt < 5; ++kt) {
    X[kt] = zero16();
#pragma unroll
    for (int s = 0; s < 4; ++s) {
      const bf16x8 A = *(const bf16x8*)(Ks + ((w + kt) * 32 + r) * 72 + s * 16 + h * 8);
      X[kt] = mfma32(A, qf[s], X[kt]);
    }
  }
  const float sink = p.swa_sinks[hq];
  float m = sink;
#pragma unroll
  for (int kt = 0; kt < 5; ++kt)
#pragma unroll
    for (int i = 0; i < 16; ++i) {
      const int kk = (w + kt) * 32 + crow(i, h);
      const bool valid = (kk > iq) && (kk <= iq + 128) && (n > 0 || kk >= 128);
      const float xv = valid ? X[kt][i] : -INFINITY;
      X[kt][i] = xv;
      m = fmaxf(m, xv);
    }
  m = fmaxf(m, __shfl_xor(m, 32));
  float l = 0.f;
#pragma unroll
  for (int kt = 0; kt < 5; ++kt)
#pragma unroll
    for (int i = 0; i < 16; ++i) {
      const float pv = __expf(X[kt][i] - m);
      X[kt][i] = pv;
      l += pv;
    }
  l += __shfl_xor(l, 32);
  l += __expf(sink - m);
  f32x16 O[2];
  O[0] = zero16(); O[1] = zero16();
#pragma unroll
  for (int kt = 0; kt < 5; ++kt)
#pragma unroll
    for (int s2 = 0; s2 < 2; ++s2) {
      const uint4 pw = make_uint4(pk(X[kt][8 * s2 + 0], X[kt][8 * s2 + 1]), pk(X[kt][8 * s2 + 2], X[kt][8 * s2 + 3]),
                                  pk(X[kt][8 * s2 + 4], X[kt][8 * s2 + 5]), pk(X[kt][8 * s2 + 6], X[kt][8 * s2 + 7]));
      const bf16x8 P = __builtin_bit_cast(bf16x8, pw);
#pragma unroll
      for (int mt = 0; mt < 2; ++mt) {
        const bf16_t* vp = vT + (mt * 32 + r) * 264 + (w + kt) * 32 + 16 * s2 + 4 * h;
        const uint2 lo = *(const uint2*)vp, hi = *(const uint2*)(vp + 8);
        const bf16x8 A = __builtin_bit_cast(bf16x8, make_uint4(lo.x, lo.y, hi.x, hi.y));
        O[mt] = mfma32(A, P, O[mt]);
      }
    }
  const float inv = 1.f / l;
  bf16_t* orow = OUT + (size_t)(tok0 + iq) * 1024 + hq * 64 + 4 * h;
#pragma unroll
  for (int mt = 0; mt < 2; ++mt)
#pragma unroll
    for (int g = 0; g < 4; ++g)
      *(uint2*)(orow + mt * 32 + 8 * g) = make_uint2(pk(O[mt][4 * g] * inv, O[mt][4 * g + 1] * inv), pk(O[mt][4 * g + 2] * inv, O[mt][4 * g + 3] * inv));
}

DI unsigned fkey_u(unsigned u) { return u ^ ((unsigned)((int)u >> 31) | 0x80000000u); }
DI float unfkey(unsigned k) { return __uint_as_float(k ^ ((~(unsigned)((int)k >> 31)) | 0x80000000u)); }
DI void cswap(unsigned& a, unsigned& b) { const unsigned hi = a > b ? a : b, lo = a > b ? b : a; a = hi; b = lo; }
DI void sort16(unsigned (&t)[16]) {
#pragma unroll
  for (int k = 2; k <= 16; k <<= 1)
#pragma unroll
    for (int j = k >> 1; j > 0; j >>= 1)
#pragma unroll
      for (int i = 0; i < 16; ++i) {
        const int l = i ^ j;
        if (l > i) { if ((i & k) == 0) cswap(t[i], t[l]); else cswap(t[l], t[i]); }
      }
}
DI void merge16(unsigned (&a)[16], const unsigned (&b)[16]) {
#pragma unroll
  for (int j = 0; j < 16; ++j) a[j] = a[j] > b[15 - j] ? a[j] : b[15 - j];
#pragma unroll
  for (int j = 8; j > 0; j >>= 1)
#pragma unroll
    for (int i = 0; i < 16; ++i) { const int l = i ^ j; if (l > i) cswap(a[i], a[l]); }
}
DI void cswap2(unsigned& ak, int& ap, unsigned& bk, int& bp) {
  const bool sw = bk > ak;
  const unsigned hk = sw ? bk : ak, lk = sw ? ak : bk;
  const int hp = sw ? bp : ap, lp = sw ? ap : bp;
  ak = hk; ap = hp; bk = lk; bp = lp;
}
DI void sort16p(unsigned (&t)[16], int (&q)[16]) {
#pragma unroll
  for (int k = 2; k <= 16; k <<= 1)
#pragma unroll
    for (int j = k >> 1; j > 0; j >>= 1)
#pragma unroll
      for (int i = 0; i < 16; ++i) {
        const int l = i ^ j;
        if (l > i) { if ((i & k) == 0) cswap2(t[i], q[i], t[l], q[l]); else cswap2(t[l], q[l], t[i], q[i]); }
      }
}
__device__ constexpr int CIA[25] = {0,0,0,0,0,0,0,0,0,0,0,0,0,0,0,0, 2,2,2,2,2, 3,3,3,3};
__device__ constexpr int CJA[25] = {0,1,2,3,4,5,6,7,8,9,10,11,12,13,14,15, 0,1,2,3,4, 0,1,2,3};
__device__ constexpr int CIB[25] = {1,1,1,1,1,1,1,1, 4,4,4, 5,5,6,6,7,7, 8,9,10,11,12,13,14,15};
__device__ constexpr int CJB[25] = {0,1,2,3,4,5,6,7, 0,1,2, 0,1,0,1,0,1, 0,0,0,0,0,0,0,0};

DI void peer_topk_wave(const Params& p, int layer, int item) {
  const int head = item >> 10, tok0 = (item & 1023) * 32;
  const bf16_t* Q = (const bf16_t*)(p.ws + OFF_BIG);
  const bf16_t* KEYS = (const bf16_t*)(p.ws + OFF_KEYS) + (size_t)(layer * 8 + head) * 256 * 64;
  int* E = (int*)(p.ws + OFF_E);
  float* G = (float*)(p.ws + OFF_G);
  const int lane = threadIdx.x & 63, r = lane & 31, h = lane >> 5;
  const unsigned h4 = 4u * (1u - (unsigned)h);
  unsigned tl[2][16];
  bf16x8 qf[2][4], kf[4][4];
#pragma unroll
  for (int set = 0; set < 2; ++set) {
    const bf16_t* qrow = Q + (size_t)(tok0 + r) * 1024 + head * 128 + set * 64 + h * 8;
#pragma unroll
    for (int s = 0; s < 4; ++s) qf[set][s] = *(const bf16x8*)(qrow + s * 16);
  }
#pragma unroll
  for (int kt = 0; kt < 4; ++kt)
#pragma unroll
    for (int s = 0; s < 4; ++s) kf[kt][s] = *(const bf16x8*)(KEYS + (size_t)(kt * 32 + r) * 64 + h * 8 + s * 16);
#pragma unroll
  for (int set = 0; set < 2; ++set) {
    f32x16 X[4];
#pragma unroll
    for (int kt = 0; kt < 4; ++kt) {
      X[kt] = zero16();
#pragma unroll
      for (int s = 0; s < 4; ++s) X[kt] = mfma32(kf[kt][s], qf[set][s], X[kt]);
    }
#pragma unroll
    for (int kt = 0; kt < 4; ++kt) {
      if (set == 0 && kt == 2) {
#pragma unroll
        for (int k2 = 0; k2 < 4; ++k2)
#pragma unroll
          for (int s = 0; s < 4; ++s) kf[k2][s] = *(const bf16x8*)(KEYS + (size_t)(128 + k2 * 32 + r) * 64 + h * 8 + s * 16);
      }
      unsigned kk[16];
#pragma unroll
      for (int i = 0; i < 16; ++i)
        kk[i] = (fkey_u(__float_as_uint(X[kt][i])) & ~127u) + ((unsigned)(127 - kt * 32 - (i & 3) - 8 * (i >> 2) - 4) + h4);
      sort16(kk);
      if (kt == 0) {
#pragma unroll
        for (int i = 0; i < 16; ++i) tl[set][i] = kk[i];
      } else merge16(tl[set], kk);
    }
  }
  unsigned mine[16], oth[16];
#pragma unroll
  for (int j = 0; j < 16; ++j) {
    const unsigned send = h ? tl[0][j] : tl[1][j];
    oth[j] = (unsigned)__shfl_xor((int)send, 32);
    mine[j] = h ? tl[1][j] : tl[0][j];
  }
  merge16(mine, oth);
  float v1[16], v2[16]; int i1[16], i2[16];
#pragma unroll
  for (int j = 0; j < 16; ++j) {
    const unsigned o = (unsigned)__shfl_xor((int)mine[j], 32);
    const unsigned A = h ? o : mine[j], B = h ? mine[j] : o;
    v1[j] = unfkey(A & ~127u); i1[j] = 127 - (int)(A & 127u);
    v2[j] = unfkey(B & ~127u); i2[j] = 127 - (int)(B & 127u);
  }
  unsigned ck[16], dk[16]; int cp[16], dp[16];
#pragma unroll
  for (int n = 0; n < 32; ++n) {
    unsigned key = 0u; int e = 0;
    if (n < 25) {
      const float sA = v1[CIA[n]] + v2[CJA[n]], sB = v1[CIB[n]] + v2[CJB[n]];
      const int eA = i1[CIA[n]] * 128 + i2[CJA[n]], eB = i1[CIB[n]] * 128 + i2[CJB[n]];
      key = fkey_u(__float_as_uint(h ? sB : sA)); e = h ? eB : eA;
    }
    if (n < 16) { ck[n] = key; cp[n] = e; } else { dk[n - 16] = key; dp[n - 16] = e; }
  }
  sort16p(ck, cp);
  sort16p(dk, dp);
#pragma unroll
  for (int j = 0; j < 16; ++j) { const bool sw = dk[15 - j] > ck[j]; ck[j] = sw ? dk[15 - j] : ck[j]; cp[j] = sw ? dp[15 - j] : cp[j]; }
#pragma unroll
  for (int j = 8; j > 0; j >>= 1)
#pragma unroll
    for (int i = 0; i < 16; ++i) { const int l = i ^ j; if (l > i) cswap2(ck[i], cp[i], ck[l], cp[l]); }
  unsigned fk[16]; int fe[16];
#pragma unroll
  for (int j = 0; j < 16; ++j) { dk[j] = (unsigned)__shfl_xor((int)ck[j], 32); dp[j] = __shfl_xor(cp[j], 32); }
#pragma unroll
  for (int j = 0; j < 16; ++j) {
    const bool sw = (dk[15 - j] > ck[j]) || (dk[15 - j] == ck[j] && dp[15 - j] > cp[j]);
    fk[j] = sw ? dk[15 - j] : ck[j]; fe[j] = sw ? dp[15 - j] : cp[j];
  }
  float sv[16], mx = -INFINITY;
#pragma unroll
  for (int j = 0; j < 16; ++j) { sv[j] = unfkey(fk[j]); mx = fmaxf(mx, sv[j]); }
  float sm = 0.f;
#pragma unroll
  for (int j = 0; j < 16; ++j) { sv[j] = __expf(sv[j] - mx); sm += sv[j]; }
  const float inv = 1.f / sm;
  const size_t o = ((size_t)(tok0 + r) * 8 + head) * 16 + h * 8;
  *(int4*)(E + o) = make_int4(fe[0], fe[1], fe[2], fe[3]);
  *(int4*)(E + o + 4) = make_int4(fe[4], fe[5], fe[6], fe[7]);
  *(float4*)(G + o) = make_float4(sv[0] * inv, sv[1] * inv, sv[2] * inv, sv[3] * inv);
  *(float4*)(G + o + 4) = make_float4(sv[4] * inv, sv[5] * inv, sv[6] * inv, sv[7] * inv);
}

DI v32f fp6x32(const uint2* p) {
  const uint2 a = p[0], b = p[1], c = p[2];
  v6u x; x[0] = a.x; x[1] = a.y; x[2] = b.x; x[3] = b.y; x[4] = c.x; x[5] = c.y;
  return __builtin_amdgcn_cvt_scalef32_pk32_f32_fp6(x, 1.0f);
}

typedef unsigned u2v __attribute__((ext_vector_type(2)));
typedef unsigned v16u __attribute__((ext_vector_type(16)));
typedef __bf16 v32bf __attribute__((ext_vector_type(32)));
DI v6u mk6(u2v a, u2v b, u2v c) { v6u x; x[0] = a[0]; x[1] = a[1]; x[2] = b[0]; x[3] = b[1]; x[4] = c[0]; x[5] = c[1]; return x; }

DI v6u ld6(const unsigned char* p) { const u2v* q = (const u2v*)p; return mk6(q[0], q[1], q[2]); }
#define U_LOAD2(RAW, M2) _Pragma("unroll") for (int mi = 0; mi < 2; ++mi) { \
    const unsigned char* up_ = U + (size_t)e_s[8 * ((M2) + mi) + grp8] * 768 + i8 * 24; \
    _Pragma("unroll") for (int k = 0; k < 4; ++k) RAW[4 * mi + k] = ld6(up_ + 192 * k); }
#define U_COMP2(RAW, M2) _Pragma("unroll") for (int mi = 0; mi < 2; ++mi) { \
    const int pidx = 8 * ((M2) + mi) + grp8; \
    float acc0 = 0.f, acc1 = 0.f, acc2 = 0.f, acc3 = 0.f; \
    _Pragma("unroll") for (int k = 0; k < 4; ++k) { \
      const v16u ub = __builtin_bit_cast(v16u, __builtin_amdgcn_cvt_scalef32_pk32_bf16_fp6(RAW[4 * mi + k], 1.0f)); \
      _Pragma("unroll") for (int i = 0; i < 16; i += 4) { \
        acc0 = dot2(ub[i], xp[k][i], acc0); acc1 = dot2(ub[i + 1], xp[k][i + 1], acc1); \
        acc2 = dot2(ub[i + 2], xp[k][i + 2], acc2); acc3 = dot2(ub[i + 3], xp[k][i + 3], acc3); } } \
    float acc = (acc0 + acc1) + (acc2 + acc3); \
    acc += __shfl_xor(acc, 1); acc += __shfl_xor(acc, 2); acc += __shfl_xor(acc, 4); \
    if (i8 == 0) a_s[pidx] = acc;              \
    __builtin_amdgcn_sched_barrier(0); }

DI void peer_gather_u(const Params& p, int layer, char* smem) {
  const int tid = threadIdx.x, lane = tid & 63, w = tid >> 6, grp8 = lane >> 3, i8 = lane & 7;
  float* a_s = (float*)smem + w * 512;
  float* su_s = a_s + 128;
  float* gv_s = a_s + 256;
  int* e_s = (int*)(a_s + 384);
  const bf16_t* HN = (const bf16_t*)(p.ws + OFF_ACT_A);
  const unsigned char* U = (const unsigned char*)(p.ws + OFF_TBL_U) + (size_t)layer * 16 * MiB;
  const float* IU = (const float*)(p.ws + OFF_INV) + (layer * 2 + 0) * 16384;
  const float* IV = (const float*)(p.ws + OFF_INV) + (layer * 2 + 1) * 16384;
  const int* E = (const int*)(p.ws + OFF_E);
  const float* G = (const float*)(p.ws + OFF_G);
  float* A = (float*)(p.ws + OFF_A);
  for (int tok = blockIdx.x * 4 + w; tok < T_TOK; tok += gridDim.x * 4) {
    unsigned xp[4][16];
#pragma unroll
    for (int k = 0; k < 4; ++k) {
      const uint4* xq = (const uint4*)(HN + (size_t)tok * 1024 + (i8 + 8 * k) * 32);
#pragma unroll
      for (int q = 0; q < 4; ++q) { const uint4 x0 = xq[q]; xp[k][4 * q] = x0.x; xp[k][4 * q + 1] = x0.y; xp[k][4 * q + 2] = x0.z; xp[k][4 * q + 3] = x0.w; }
    }
    const int e0 = E[(size_t)tok * 128 + lane], e1 = E[(size_t)tok * 128 + 64 + lane];
    e_s[lane] = e0; e_s[64 + lane] = e1;
    const float su0 = IU[e0], su1 = IU[e1];
    const float gv0 = G[(size_t)tok * 128 + lane] * IV[e0], gv1 = G[(size_t)tok * 128 + 64 + lane] * IV[e1];
    wave_sync();
    v6u rA[8], rB[8];
    U_LOAD2(rA, 0)
#pragma unroll 1
    for (int m2 = 0; m2 < 16; m2 += 4) {
      U_LOAD2(rB, m2 + 2)
      U_COMP2(rA, m2)
      if (m2 + 4 < 16) { U_LOAD2(rA, m2 + 4) }
      U_COMP2(rB, m2 + 2)
    }
    wave_sync();
    {
      const float s0 = a_s[lane] * su0, s1 = a_s[64 + lane] * su1;
      A[(size_t)tok * 128 + lane] = 0.5f * s0 * (1.f + erff(s0 * 0.7071067811865476f)) * gv0;
      A[(size_t)tok * 128 + 64 + lane] = 0.5f * s1 * (1.f + erff(s1 * 0.7071067811865476f)) * gv1;
    }
    wave_sync();
  }
}

#define V_LOAD8(RAW, M8) _Pragma("unroll") for (int mi = 0; mi < 4; ++mi) RAW[mi] = ld6(V + (size_t)e_s[2 * ((M8) + mi) + h] * 768 + r * 24);
#define V_COMP8(RAW, M8) _Pragma("unroll") for (int mi = 0; mi < 4; ++mi) { \
    const float a = a_s[2 * ((M8) + mi) + h]; \
    const v32f vv = __builtin_amdgcn_cvt_scalef32_pk32_f32_fp6(RAW[mi], 1.0f); \
    _Pragma("unroll") for (int i = 0; i < 32; ++i) o[i] = fmaf(a, vv[i], o[i]); \
    __builtin_amdgcn_sched_barrier(0); }

DI void peer_gather_v(const Params& p, int layer, char* smem, const float* __restrict__ next_gain) {
  const int tid = threadIdx.x, lane = tid & 63, w = tid >> 6, r = lane & 31, h = lane >> 5;
  float* a_s = (float*)smem + w * 256;
  int* e_s = (int*)(a_s + 128);
  const unsigned char* V = (const unsigned char*)(p.ws + OFF_TBL_V) + (size_t)layer * 16 * MiB;
  const int* E = (const int*)(p.ws + OFF_E);
  const float* A = (const float*)(p.ws + OFF_A);
  for (int tok = blockIdx.x * 4 + w; tok < T_TOK; tok += gridDim.x * 4) {
    e_s[lane] = E[(size_t)tok * 128 + lane]; e_s[64 + lane] = E[(size_t)tok * 128 + 64 + lane];
    a_s[lane] = A[(size_t)tok * 128 + lane]; a_s[64 + lane] = A[(size_t)tok * 128 + 64 + lane];
    wave_sync();
    float o[32];
#pragma unroll
    for (int i = 0; i < 32; ++i) o[i] = 0.f;
    v6u rA[4], rB[4];
    V_LOAD8(rA, 0)
#pragma unroll 1
    for (int m8 = 0; m8 < 64; m8 += 8) {
      V_LOAD8(rB, m8 + 4)
      V_COMP8(rA, m8)
      if (m8 + 8 < 64) { V_LOAD8(rA, m8 + 8) }
      V_COMP8(rB, m8 + 4)
    }
#pragma unroll
    for (int i = 0; i < 32; ++i) o[i] += __shfl_xor(o[i], 32);
    float4* hp = (float4*)(p.out + (size_t)tok * 1024 + r * 32 + h * 16);
    float4 hv[4];
    float ss = 0.f;
#pragma unroll
    for (int q = 0; q < 4; ++q) {
      float4 t = hp[q];
      t.x += h ? o[16 + 4 * q] : o[4 * q]; t.y += h ? o[17 + 4 * q] : o[4 * q + 1];
      t.z += h ? o[18 + 4 * q] : o[4 * q + 2]; t.w += h ? o[19 + 4 * q] : o[4 * q + 3];
      hp[q] = t; hv[q] = t;
      ss += t.x * t.x + t.y * t.y + t.z * t.z + t.w * t.w;
    }
    if (next_gain) {
#pragma unroll
      for (int o2 = 32; o2 >= 1; o2 >>= 1) ss += __shfl_xor(ss, o2);
      const float rs = rsqrtf(ss * (1.f / 1024.f) + 1e-6f);
      const float4* gp = (const float4*)(next_gain + r * 32 + h * 16);
      unsigned pw[8];
#pragma unroll
      for (int q = 0; q < 4; ++q) {
        const float4 g = gp[q];
        pw[2 * q] = pk(hv[q].x * rs * g.x, hv[q].y * rs * g.y); pw[2 * q + 1] = pk(hv[q].z * rs * g.z, hv[q].w * rs * g.w);
      }
      uint4* dp = (uint4*)((bf16_t*)(p.ws + OFF_ACT_A) + (size_t)tok * 1024 + r * 32 + h * 16);
      dp[0] = make_uint4(pw[0], pw[1], pw[2], pw[3]); dp[1] = make_uint4(pw[4], pw[5], pw[6], pw[7]);
    }
    wave_sync();
  }
}

DI void run_phase(const Params& p, int ph, char* smem) {
  bf16_t* actA = (bf16_t*)(p.ws + OFF_ACT_A);
  bf16_t* big = (bf16_t*)(p.ws + OFF_BIG);
  switch (ph) {
    case 0: phase_convert(p, smem); phase_cvt_tables(p, 0); phase_cvt_tables(p, 1); break;
    case 1: phase_rmsnorm(p.x, p.ln_mix, actA); break;
    case 2: phase_gemm<EPI_GLA_IN>(p, actA, (const bf16_t*)(p.ws + OFF_WT_GLA_IN), 25, big, 3072, nullptr, smem); break;
    case 3: for (int it = blockIdx.x; it < 2048; it += gridDim.x) gla_phase1(p, it, smem); break;
    case 4: gla_scan(p); break;
    case 5: for (int it = blockIdx.x; it < 2048; it += gridDim.x) gla_phase3(p, it, smem); break;
    case 6: phase_gemm<EPI_RESID_X>(p, actA, (const bf16_t*)(p.ws + OFF_WT_GLA_OUT), 8, nullptr, 0, nullptr, smem); break;
    case 7: phase_rmsnorm(p.out, p.ln_ffn, actA); break;
    case 8: phase_gemm<EPI_BF16>(p, actA, (const bf16_t*)(p.ws + OFF_WT_PQ), 8, big, 1024, nullptr, smem); break;
    case 9: for (int it = blockIdx.x * 4 + (threadIdx.x >> 6); it < 8192; it += gridDim.x * 4) peer_topk_wave(p, 0, it); break;
    case 10: peer_gather_u(p, 0, smem); break;
    case 11: peer_gather_v(p, 0, smem, p.ln_mix + 1024); break;
    case 12: break;
    case 13: phase_gemm<EPI_BF16>(p, actA, (const bf16_t*)(p.ws + OFF_WT_SWA_IN), 10, big, 1280, p.swa_b_in, smem); break;
    case 14: swa_qknorm(p); break;
    case 15: for (int it = blockIdx.x; it < 4096; it += gridDim.x) swa_attn(p, it, smem); break;
    case 16: phase_gemm<EPI_RESID_INPLACE>(p, (const bf16_t*)(p.ws + OFF_ACT_B), (const bf16_t*)(p.ws + OFF_WT_SWA_OUT), 8, nullptr, 0, p.swa_b_out, smem); break;
    case 17: phase_rmsnorm(p.out, p.ln_ffn + 1024, actA); break;
    case 18: phase_gemm<EPI_BF16>(p, actA, (const bf16_t*)(p.ws + OFF_WT_PQ) + (size_t)1024 * 1024, 8, big, 1024, nullptr, smem); break;
    case 19: for (int it = blockIdx.x * 4 + (threadIdx.x >> 6); it < 8192; it += gridDim.x * 4) peer_topk_wave(p, 1, it); break;
    case 20: peer_gather_u(p, 1, smem); break;
    case 21: peer_gather_v(p, 1, smem, nullptr); break;
    default: break;
  }
}

template <int PH>
__global__ void __launch_bounds__(256, 2) phase_kernel(Params p) {
  __shared__ __attribute__((aligned(16))) char smem[SMEM_BYTES];
  run_phase(p, PH, smem);
}

template <int PH>
static void launch_phases(const Params& p, int grid, hipStream_t stream) {
  hipLaunchKernelGGL(phase_kernel<PH>, dim3(grid), dim3(256), 0, stream, p);
  if constexpr (PH + 1 < NPHASE) launch_phases<PH + 1>(p, grid, stream);
}


#define XB_TMO      128
#define XB_XCNT(j)  (256  + 64 * (j))
#define XB_XSUB(j)  (1280 + 64 * (j))
#define XB_XGEN(j)  (2304 + 64 * (j))
#define XB_TOP      3328
#define XB_TOPGEN   3392
#define XCD_BAR_WORDS 3456
#define XB_SPIN_CAP (1u << 23)
#define LAS __attribute__((address_space(3)))
DI unsigned xb_ld(unsigned* p) { return __hip_atomic_load(p, __ATOMIC_RELAXED, __HIP_MEMORY_SCOPE_AGENT); }
DI unsigned xb_add(unsigned* p, unsigned v) { return __hip_atomic_fetch_add(p, v, __ATOMIC_RELAXED, __HIP_MEMORY_SCOPE_AGENT); }
DI unsigned xb_xcc_id() { return (unsigned)__builtin_amdgcn_s_getreg((3 << 11) | 20) & 0xFu; }
#define XB_SPIN(cond, bar) do { unsigned _sp = 0; while (cond) { __builtin_amdgcn_s_sleep(1); \
    if ((++_sp & 255u) == 0u) { if (xb_ld(&(bar)[XB_TMO])) break; if (_sp > XB_SPIN_CAP) { atomicAdd(&(bar)[XB_TMO], 1u); break; } } } } while (0)
struct XcdBarrier { unsigned* bar; unsigned x; volatile LAS unsigned* st; };
DI XcdBarrier xcd_barrier_post(unsigned* bar, volatile LAS unsigned* st) {
  XcdBarrier b; b.bar = bar; b.x = xb_xcc_id(); b.st = st;
  if (threadIdx.x == 0) (void)xb_add(&bar[XB_XCNT(b.x)], 1u);
  return b;
}
DI void xcd_barrier_complete(unsigned* bar, unsigned x, unsigned& nloc, unsigned& nx) {
  const unsigned G = gridDim.x * gridDim.y * gridDim.z;
  unsigned sum, cnt, mine, sp = 0u;
  for (;;) {
    sum = 0u; cnt = 0u; mine = 0u;
#pragma unroll
    for (unsigned j = 0; j < 16; ++j) { const unsigned c = xb_ld(&bar[XB_XCNT(j)]); sum += c; cnt += (c > 0u) ? 1u : 0u; mine = (j == x) ? c : mine; }
    if (sum == G) break;
    __builtin_amdgcn_s_sleep(1);
    if ((++sp & 255u) == 0u) { if (xb_ld(&bar[XB_TMO])) break; if (sp > XB_SPIN_CAP) { atomicAdd(&bar[XB_TMO], 1u); break; } }
  }
  nloc = mine > 0u ? mine : 1u; nx = cnt > 0u ? cnt : 1u;
}
DI void xcd_barrier(const XcdBarrier& b) {
  asm volatile("s_waitcnt vmcnt(0)" ::: "memory");
  __syncthreads();
  if (threadIdx.x == 0) {
    unsigned* bar = b.bar;
    __builtin_amdgcn_s_waitcnt(0);
    unsigned nloc = b.st[0], nx = b.st[1];
    if (nloc == 0u) { xcd_barrier_complete(bar, b.x, nloc, nx); b.st[0] = nloc; b.st[1] = nx; }
    const unsigned old = xb_add(&bar[XB_XSUB(b.x)], 1u);
    const unsigned gen = old / nloc;
    if (old + 1u == (gen + 1u) * nloc) {
      __builtin_amdgcn_fence(__ATOMIC_RELEASE, "agent");
      asm volatile("s_waitcnt vmcnt(0)" ::: "memory");
      const unsigned og = xb_add(&bar[XB_TOP], 1u);
      const unsigned tg = og / nx;
      if (og + 1u == (tg + 1u) * nx) xb_add(&bar[XB_TOPGEN], 1u);
      else XB_SPIN(xb_ld(&bar[XB_TOPGEN]) == tg, bar);
      __builtin_amdgcn_fence(__ATOMIC_ACQUIRE, "agent");
      xb_add(&bar[XB_XGEN(b.x)], 1u);
      asm volatile("s_waitcnt vmcnt(0)" ::: "memory");
    } else {
      XB_SPIN(xb_ld(&bar[XB_XGEN(b.x)]) == gen, bar);
      __builtin_amdgcn_fence(__ATOMIC_ACQUIRE, "agent");
      asm volatile("s_waitcnt vmcnt(0)" ::: "memory");
    }
  }
  __syncthreads();
}

#if !MULTI_LAUNCH
template <int PH>
DI void run_all(const Params& p, char* smem, const XcdBarrier& xb) {
  if constexpr (PH != 12) {
    run_phase(p, PH, smem);
    if constexpr (PH + 1 < NPHASE) {
      if constexpr (PH == 0) cg::this_grid().sync();
      else xcd_barrier(xb);
    }
  }
  if constexpr (PH + 1 < NPHASE) run_all<PH + 1>(p, smem, xb);
}
__global__ void __launch_bounds__(256, 2) trunk_kernel(Params p) {
  __shared__ __attribute__((aligned(16))) char smem[SMEM_BYTES];
  __shared__ uint4 xb_words;
  if (threadIdx.x == 0) xb_words = make_uint4(0u, 0u, 0u, 0u);
  __syncthreads();
  const XcdBarrier xb = xcd_barrier_post((unsigned*)(p.ws + OFF_BAR), (volatile LAS unsigned*)&xb_words);
  run_all<0>(p, smem, xb);
}
#endif

extern "C" void kernel_launch(void* const* d_in, const int* in_sizes, int n_in, void* d_out, int out_size, void* d_ws, size_t ws_size,
                              hipStream_t stream) {
  Params p{};
  p.x = (const float*)d_in[0]; p.pos = (const int*)d_in[1]; p.ln_mix = (const float*)d_in[2]; p.ln_ffn = (const float*)d_in[3];
  p.gla_w_in = (const float*)d_in[4]; p.gla_w_alpha = (const float*)d_in[5]; p.gla_b_alpha = (const float*)d_in[6];
  p.gla_norm = (const float*)d_in[7]; p.gla_w_out = (const float*)d_in[8];
  p.swa_w_in = (const float*)d_in[9]; p.swa_b_in = (const float*)d_in[10]; p.swa_qn = (const float*)d_in[11]; p.swa_kn = (const float*)d_in[12];
  p.swa_sinks = (const float*)d_in[13]; p.swa_w_out = (const float*)d_in[14]; p.swa_b_out = (const float*)d_in[15];
  p.peer_wq = (const float*)d_in[16]; p.peer_keys = (const float*)d_in[17]; p.peer_u = (const float*)d_in[18]; p.peer_v = (const float*)d_in[19];
  p.out = (float*)d_out; p.ws = (char*)d_ws;
  static int grid_blocks = 0;
  if (!grid_blocks) {
    int dev = 0, cus = 0, per_cu = 0;
    (void)hipGetDevice(&dev);
    (void)hipDeviceGetAttribute(&cus, hipDeviceAttributeMultiprocessorCount, dev);
    #if MULTI_LAUNCH
    per_cu = 2;
#else
    (void)hipOccupancyMaxActiveBlocksPerMultiprocessor(&per_cu, trunk_kernel, 256, 0);
#endif
    if (per_cu < 1) per_cu = 1;
    if (per_cu > 2) per_cu = 2;
    grid_blocks = cus * per_cu;
  }
#if MULTI_LAUNCH
  p.phase_lo = 0; p.phase_hi = 0;
  launch_phases<0>(p, grid_blocks, stream);
#else
  p.phase_lo = 0; p.phase_hi = NPHASE - 1;
  void* args[] = {&p};
  (void)hipMemsetAsync((char*)d_ws + OFF_BAR, 0, XCD_BAR_WORDS * 4, stream);
  hipError_t e = hipLaunchCooperativeKernel((void*)trunk_kernel, dim3(grid_blocks), dim3(256), args, 0, stream);
  if (e != hipSuccess) fprintf(stderr, "cooperative launch failed: %s (grid %d)\n", hipGetErrorString(e), grid_blocks);
#endif
}
```

```cpp
#include <hip/hip_runtime.h>
#include <hip/hip_cooperative_groups.h>
#include <stdint.h>
#include <stdio.h>
namespace cg = cooperative_groups;

#ifndef MULTI_LAUNCH
#define MULTI_LAUNCH 0
#endif

#define DI __device__ __forceinline__
typedef unsigned short bf16_t;
typedef __attribute__((ext_vector_type(8))) short bf16x8;
typedef __attribute__((ext_vector_type(16))) float f32x16;
typedef __bf16 bf16x2_t __attribute__((ext_vector_type(2)));
typedef float f32x2_t __attribute__((ext_vector_type(2)));
typedef float f2 __attribute__((ext_vector_type(2)));

constexpr int T_TOK = 32768;
constexpr int SEQ = 16384;
constexpr int DM = 1024;
constexpr int NPHASE = 22;

constexpr size_t MiB = 1048576;
constexpr size_t OFF_WT_GLA_IN = 0;
constexpr size_t OFF_WT_GLA_OUT = 7 * MiB;
constexpr size_t OFF_WT_SWA_IN = 9 * MiB;
constexpr size_t OFF_WT_SWA_OUT = 12 * MiB;
constexpr size_t OFF_WT_PQ = 14 * MiB;
constexpr size_t OFF_KEYS = 18 * MiB;
constexpr size_t OFF_INV = 20 * MiB;
constexpr size_t OFF_TBL_U = 24 * MiB;
constexpr size_t OFF_TBL_V = 56 * MiB;
constexpr size_t OFF_ACT_A = 88 * MiB;
constexpr size_t OFF_BIG = 152 * MiB;
constexpr size_t OFF_E = OFF_BIG + 64 * MiB;
constexpr size_t OFF_G = OFF_BIG + 80 * MiB;
constexpr size_t OFF_A = OFF_BIG + 96 * MiB;
constexpr size_t OFF_KVT = 344 * MiB;
constexpr size_t OFF_ACT_B = OFF_KVT;
constexpr size_t OFF_LR = 472 * MiB;
constexpr size_t OFF_DECAY = 474 * MiB;
constexpr size_t OFF_BAR = 476 * MiB;

constexpr int SMEM_BYTES = 73728;
constexpr int LDK = 72;

struct Params {
  const float* x; const int* pos; const float* ln_mix; const float* ln_ffn;
  const float* gla_w_in; const float* gla_w_alpha; const float* gla_b_alpha; const float* gla_norm; const float* gla_w_out;
  const float* swa_w_in; const float* swa_b_in; const float* swa_qn; const float* swa_kn; const float* swa_sinks;
  const float* swa_w_out; const float* swa_b_out;
  const float* peer_wq; const float* peer_keys; const float* peer_u; const float* peer_v;
  float* out; char* ws;
  int phase_lo, phase_hi;
};

DI unsigned pk(float lo, float hi) { f32x2_t v = {lo, hi}; bf16x2_t b = __builtin_convertvector(v, bf16x2_t); return __builtin_bit_cast(unsigned, b); }
DI bf16_t f2bf(float x) { return (bf16_t)(pk(x, 0.f) & 0xffffu); }
DI float bflo(unsigned w) { return __uint_as_float(w << 16); }
DI float bfhi(unsigned w) { return __uint_as_float(w & 0xffff0000u); }
DI float bf2f(bf16_t b) { return __uint_as_float(((unsigned)b) << 16); }
DI float dot2(unsigned a, unsigned b, float c) { return __builtin_amdgcn_fdot2_f32_bf16(__builtin_bit_cast(bf16x2_t, a), __builtin_bit_cast(bf16x2_t, b), c, false); }
DI int crow(int i, int h) { return (i & 3) + 8 * (i >> 2) + 4 * h; }
DI f32x16 mfma32(bf16x8 a, bf16x8 b, f32x16 c) { return __builtin_amdgcn_mfma_f32_32x32x16_bf16(a, b, c, 0, 0, 0); }
DI f32x16 zero16() { f32x16 z; for (int i = 0; i < 16; ++i) z[i] = 0.f; return z; }
DI void wave_sync() { __builtin_amdgcn_fence(__ATOMIC_RELEASE, "wavefront"); __builtin_amdgcn_wave_barrier(); __builtin_amdgcn_fence(__ATOMIC_ACQUIRE, "wavefront"); }
DI int mbcnt64(unsigned long long m) { return __builtin_amdgcn_mbcnt_hi((unsigned)(m >> 32), __builtin_amdgcn_mbcnt_lo((unsigned)m, 0)); }
DI float logsig(float z) { return fminf(z, 0.f) - __logf(1.f + __expf(-fabsf(z))); }

DI void transpose_tile(const float* __restrict__ src, int N, bf16_t* __restrict__ dst, int kt, int nt, float* sT) {
  const int tid = threadIdx.x;
  const int r = tid >> 4, c4 = (tid & 15) * 4;
#pragma unroll
  for (int i = 0; i < 4; ++i) {
    const int k = kt * 64 + r + 16 * i, n = nt * 64 + c4;
    float4 v = make_float4(0.f, 0.f, 0.f, 0.f);
    if (n + 3 < N) v = *(const float4*)(src + (size_t)k * N + n);
    float* d = sT + (r + 16 * i) * 65 + c4;
    d[0] = v.x; d[1] = v.y; d[2] = v.z; d[3] = v.w;
  }
  __syncthreads();
  const int n = tid >> 2, seg = tid & 3;
  unsigned w[8];
#pragma unroll
  for (int j = 0; j < 8; ++j) w[j] = pk(sT[(seg * 16 + 2 * j) * 65 + n], sT[(seg * 16 + 2 * j + 1) * 65 + n]);
  uint4* d = (uint4*)(dst + (size_t)(nt * 64 + n) * 1024 + kt * 64 + seg * 16);
  d[0] = make_uint4(w[0], w[1], w[2], w[3]);
  d[1] = make_uint4(w[4], w[5], w[6], w[7]);
  __syncthreads();
}

DI void cvt_elems(const float* __restrict__ src, bf16_t* __restrict__ dst, size_t n8) {
  for (size_t i = (size_t)blockIdx.x * 256 + threadIdx.x; i < n8; i += (size_t)gridDim.x * 256) {
    const float4 a = ((const float4*)src)[2 * i], b = ((const float4*)src)[2 * i + 1];
    ((uint4*)dst)[i] = make_uint4(pk(a.x, a.y), pk(a.z, a.w), pk(b.x, b.y), pk(b.z, b.w));
  }
}

DI void phase_convert(const Params& p, char* smem) {
  float* sT = (float*)smem;
  for (int t = blockIdx.x; t < 2144; t += gridDim.x) {
    const float* src; int N, ntn; bf16_t* dst; int local;
    if (t < 800) { src = p.gla_w_in; N = 3088; ntn = 50; dst = (bf16_t*)(p.ws + OFF_WT_GLA_IN); local = t; }
    else if (t < 1056) { src = p.gla_w_out; N = 1024; ntn = 16; dst = (bf16_t*)(p.ws + OFF_WT_GLA_OUT); local = t - 800; }
    else if (t < 1376) { src = p.swa_w_in; N = 1280; ntn = 20; dst = (bf16_t*)(p.ws + OFF_WT_SWA_IN); local = t - 1056; }
    else if (t < 1632) { src = p.swa_w_out; N = 1024; ntn = 16; dst = (bf16_t*)(p.ws + OFF_WT_SWA_OUT); local = t - 1376; }
    else if (t < 1888) { src = p.peer_wq; N = 1024; ntn = 16; dst = (bf16_t*)(p.ws + OFF_WT_PQ); local = t - 1632; }
    else { src = p.peer_wq + (size_t)1024 * 1024; N = 1024; ntn = 16; dst = (bf16_t*)(p.ws + OFF_WT_PQ) + (size_t)1024 * 1024; local = t - 1888; }
    transpose_tile(src, N, dst, local / ntn, local % ntn, sT);
  }
  cvt_elems(p.peer_keys, (bf16_t*)(p.ws + OFF_KEYS), (size_t)2 * 8 * 2 * 128 * 64 / 8);
}

typedef unsigned v6u __attribute__((ext_vector_type(6)));
typedef float v32f __attribute__((ext_vector_type(32)));
DI unsigned fp6_code(float y) {
  const float a = fminf(fabsf(y), 7.5f);
  float c = rintf(a * 8.f);
  c = a >= 2.f ? rintf(a * 4.f) + 8.f : c;
  c = a >= 4.f ? rintf(a * 2.f) + 16.f : c;
  unsigned u = (unsigned)c;
  u = u > 31u ? 31u : u;
  return u | ((__float_as_uint(y) >> 26) & 32u);
}
DI void cvt_table_fp6(const float* __restrict__ src, unsigned char* __restrict__ dst, float* __restrict__ inv, int bid, int nb) {
  const int lane = threadIdx.x & 63, w = threadIdx.x >> 6, r = lane & 31, h = lane >> 5;
  for (int rp = bid * 4 + w; rp < 8192; rp += nb * 4) {
    const int row = rp * 2 + h;
    const float4* sp = (const float4*)(src + (size_t)row * 1024 + r * 32);
    float v[32];
    float mx = 0.f;
#pragma unroll
    for (int i = 0; i < 8; ++i) {
      const float4 t = sp[i];
      v[4 * i] = t.x; v[4 * i + 1] = t.y; v[4 * i + 2] = t.z; v[4 * i + 3] = t.w;
      mx = fmaxf(fmaxf(mx, fmaxf(fabsf(t.x), fabsf(t.y))), fmaxf(fabsf(t.z), fabsf(t.w)));
    }
#pragma unroll
    for (int o = 16; o >= 1; o >>= 1) mx = fmaxf(mx, __shfl_xor(mx, o));
    const float sc = mx > 0.f ? 7.5f / mx : 1.f;
    unsigned c[32];
#pragma unroll
    for (int i = 0; i < 32; ++i) c[i] = fp6_code(v[i] * sc);
    unsigned d[6];
#pragma unroll
    for (int g = 0; g < 2; ++g) {
      const unsigned* q = c + 16 * g;
      d[3 * g + 0] = q[0] | (q[1] << 6) | (q[2] << 12) | (q[3] << 18) | (q[4] << 24) | (q[5] << 30);
      d[3 * g + 1] = (q[5] >> 2) | (q[6] << 4) | (q[7] << 10) | (q[8] << 16) | (q[9] << 22) | (q[10] << 28);
      d[3 * g + 2] = (q[10] >> 4) | (q[11] << 2) | (q[12] << 8) | (q[13] << 14) | (q[14] << 20) | (q[15] << 26);
    }
    uint2* dp = (uint2*)(dst + (size_t)row * 768 + r * 24);
    dp[0] = make_uint2(d[0], d[1]); dp[1] = make_uint2(d[2], d[3]); dp[2] = make_uint2(d[4], d[5]);
    if (r == 0) inv[row] = mx > 0.f ? mx * (1.f / 7.5f) : 1.f;
  }
}
DI void phase_cvt_tables(const Params& p, int layer) {
  const int nb = gridDim.x / 2, bid = blockIdx.x % nb;
  const int rows_lo = (blockIdx.x < nb) ? 0 : 1;
  cvt_table_fp6(p.peer_u + (size_t)layer * 16384 * 1024, (unsigned char*)(p.ws + OFF_TBL_U) + (size_t)layer * 16 * MiB, (float*)(p.ws + OFF_INV) + (layer * 2 + 0) * 16384, bid * 2 + rows_lo, nb * 2);
  cvt_table_fp6(p.peer_v + (size_t)layer * 16384 * 1024, (unsigned char*)(p.ws + OFF_TBL_V) + (size_t)layer * 16 * MiB, (float*)(p.ws + OFF_INV) + (layer * 2 + 1) * 16384, bid * 2 + rows_lo, nb * 2);
}

DI void phase_rmsnorm(const float* __restrict__ src, const float* __restrict__ gain, bf16_t* __restrict__ dst) {
  const int lane = threadIdx.x & 63, w = threadIdx.x >> 6;
  for (int row = blockIdx.x * 4 + w; row < T_TOK; row += gridDim.x * 4) {
    const float4* sp = (const float4*)(src + (size_t)row * DM);
    float4 v[4];
    float ss = 0.f;
#pragma unroll
    for (int i = 0; i < 4; ++i) { v[i] = sp[lane + 64 * i]; ss += v[i].x * v[i].x + v[i].y * v[i].y + v[i].z * v[i].z + v[i].w * v[i].w; }
#pragma unroll
    for (int o = 32; o >= 1; o >>= 1) ss += __shfl_xor(ss, o);
    const float rs = rsqrtf(ss * (1.f / 1024.f) + 1e-6f);
#pragma unroll
    for (int i = 0; i < 4; ++i) {
      const float4 g = ((const float4*)gain)[lane + 64 * i];
      uint2 o2 = make_uint2(pk(v[i].x * rs * g.x, v[i].y * rs * g.y), pk(v[i].z * rs * g.z, v[i].w * rs * g.w));
      *(uint2*)(dst + (size_t)row * DM + (lane + 64 * i) * 4) = o2;
    }
  }
}

DI void mma_64x64(const bf16_t* sA, const bf16_t* sB, int arow0, int brow0, f32x16 (&acc)[2][2], int lane) {
  const int r = lane & 31, h = lane >> 5;
#pragma unroll
  for (int s = 0; s < 4; ++s) {
    bf16x8 a[2], b[2];
#pragma unroll
    for (int mi = 0; mi < 2; ++mi) a[mi] = *(const bf16x8*)(sA + (arow0 + mi * 32 + r) * LDK + s * 16 + h * 8);
#pragma unroll
    for (int ni = 0; ni < 2; ++ni) b[ni] = *(const bf16x8*)(sB + (brow0 + ni * 32 + r) * LDK + s * 16 + h * 8);
#pragma unroll
    for (int mi = 0; mi < 2; ++mi)
#pragma unroll
      for (int ni = 0; ni < 2; ++ni) acc[mi][ni] = mfma32(a[mi], b[ni], acc[mi][ni]);
  }
}

enum { EPI_GLA_IN = 0, EPI_RESID_X = 1, EPI_BF16 = 2, EPI_RESID_INPLACE = 3, EPI_SWA_IN = 4 };

template <int MODE>
DI void phase_gemm(const Params& p, const bf16_t* __restrict__ A, const bf16_t* __restrict__ Bt, int NT, bf16_t* dstb, int ldc,
                   const float* __restrict__ bias, char* smem) {
  const int ntiles = (T_TOK / 128) * NT;
  int t = (gridDim.x & 7) ? (int)blockIdx.x : (int)((blockIdx.x & 7) * (gridDim.x >> 3) + (blockIdx.x >> 3));
  if (t >= ntiles) return;
  bf16_t* sA = (bf16_t*)smem;
  bf16_t* sB = sA + 128 * LDK;
  bf16_t* ct = (bf16_t*)smem;
  const int tid = threadIdx.x, lane = tid & 63, w = tid >> 6, wm = w >> 1, wn = w & 1;
  const int r = lane & 31, h = lane >> 5;
  const int lrow = tid >> 3, kc = tid & 7;
  bf16_t* wa = sA + lrow * LDK + kc * 8;
  bf16_t* wb = sB + lrow * LDK + kc * 8;
  bf16x8 ra0[4], rb0[4], ra1[4], rb1[4];
  int m0 = (t / NT) * 128, n0 = (t % NT) * 128;
  const bf16_t* ap = A + (size_t)(m0 + lrow) * 1024 + kc * 8;
  const bf16_t* bp = Bt + (size_t)(n0 + lrow) * 1024 + kc * 8;
#define GLOAD(RA, RB, KT) _Pragma("unroll") for (int i = 0; i < 4; ++i) { RA[i] = *(const bf16x8*)(ap + (size_t)i * 32 * 1024 + (KT) * 64); RB[i] = *(const bf16x8*)(bp + (size_t)i * 32 * 1024 + (KT) * 64); }
#define SSTORE(RA, RB) _Pragma("unroll") for (int i = 0; i < 4; ++i) { *(bf16x8*)(wa + 32 * i * LDK) = RA[i]; *(bf16x8*)(wb + 32 * i * LDK) = RB[i]; }
  GLOAD(ra0, rb0, 0)
  GLOAD(ra1, rb1, 1)
  for (; t < ntiles; t += gridDim.x) {
    f32x16 acc[2][2];
#pragma unroll
    for (int i = 0; i < 2; ++i)
#pragma unroll
      for (int j = 0; j < 2; ++j) acc[i][j] = zero16();
    __syncthreads();
    SSTORE(ra0, rb0)
    __syncthreads();
    for (int kt = 0; kt < 16; kt += 2) {
      if (kt + 2 < 16) { GLOAD(ra0, rb0, kt + 2) }
      mma_64x64(sA, sB, wm * 64, wn * 64, acc, lane);
      __syncthreads();
      SSTORE(ra1, rb1)
      __syncthreads();
      if (kt + 3 < 16) { GLOAD(ra1, rb1, kt + 3) }
      mma_64x64(sA, sB, wm * 64, wn * 64, acc, lane);
      __syncthreads();
      if (kt + 2 < 16) {
        SSTORE(ra0, rb0)
        __syncthreads();
      }
    }
    const int cm0 = m0, cn0 = n0;
    {
      const int tn = t + gridDim.x;
      if (tn < ntiles) {
        m0 = (tn / NT) * 128; n0 = (tn % NT) * 128;
        ap = A + (size_t)(m0 + lrow) * 1024 + kc * 8;
        bp = Bt + (size_t)(n0 + lrow) * 1024 + kc * 8;
        GLOAD(ra0, rb0, 0)
        GLOAD(ra1, rb1, 1)
      }
    }
    const bool staged = (MODE == EPI_BF16) || (MODE == EPI_SWA_IN) || (MODE == EPI_GLA_IN && cn0 < 3072);
    if (staged) {
#pragma unroll
      for (int ni = 0; ni < 2; ++ni) {
        const int col = wn * 64 + ni * 32 + r;
        const float bv = ((MODE == EPI_BF16 || MODE == EPI_SWA_IN) && bias) ? bias[cn0 + col] : 0.f;
#pragma unroll
        for (int mi = 0; mi < 2; ++mi)
#pragma unroll
          for (int i = 0; i < 16; ++i) ct[(wm * 64 + mi * 32 + crow(i, h)) * 136 + col] = f2bf(acc[mi][ni][i] + bv);
      }
      __syncthreads();
      if (MODE == EPI_SWA_IN && cn0 < 1152) {
        const int row = tid >> 1, hd = tid & 1;
        bf16_t* hp = ct + row * 136 + hd * 64;
        float ss = 0.f;
#pragma unroll
        for (int c8 = 0; c8 < 8; ++c8) {
          const uint4 wv = *(const uint4*)(hp + c8 * 8);
          const float f0 = bflo(wv.x), f1 = bfhi(wv.x), f2 = bflo(wv.y), f3 = bfhi(wv.y), f4 = bflo(wv.z), f5 = bfhi(wv.z), f6 = bflo(wv.w), f7 = bfhi(wv.w);
          ss += f0 * f0 + f1 * f1 + f2 * f2 + f3 * f3 + f4 * f4 + f5 * f5 + f6 * f6 + f7 * f7;
        }
        const float rs = rsqrtf(ss * (1.f / 64.f) + 1e-6f);
        const float* gain = (cn0 < 1024) ? p.swa_qn : p.swa_kn;
        const float qs = (cn0 < 1024) ? 0.125f : 1.f;
        {
          const uint4 w0 = *(const uint4*)hp, w1 = *(const uint4*)(hp + 8);
          float x1[8] = {bflo(w0.x), bfhi(w0.x), bflo(w0.y), bfhi(w0.y), bflo(w0.z), bfhi(w0.z), bflo(w0.w), bfhi(w0.w)};
          float x2[8] = {bflo(w1.x), bfhi(w1.x), bflo(w1.y), bfhi(w1.y), bflo(w1.z), bfhi(w1.z), bflo(w1.w), bfhi(w1.w)};
          const float posf = (float)p.pos[cm0 + row];
          const float invf[8] = {1.0f, 0.1939227432012558f, 0.03760603070259094f, 0.007292664609849453f,
                                 0.0014142135623842478f, 0.00027424818836152554f, 5.318296098266728e-05f, 1.0313386155758053e-05f};
#pragma unroll
          for (int e = 0; e < 8; ++e) {
            const float a1 = x1[e] * rs * gain[e], a2 = x2[e] * rs * gain[8 + e];
            const float ang = posf * invf[e];
            const double rev = (double)ang * 0.15915494309189535;
            const float fr = (float)(rev - rint(rev));
            const float sn = __builtin_amdgcn_sinf(fr), cs = __builtin_amdgcn_cosf(fr);
            x1[e] = (a1 * cs - a2 * sn) * qs;
            x2[e] = (a2 * cs + a1 * sn) * qs;
          }
          *(uint4*)hp = make_uint4(pk(x1[0], x1[1]), pk(x1[2], x1[3]), pk(x1[4], x1[5]), pk(x1[6], x1[7]));
          *(uint4*)(hp + 8) = make_uint4(pk(x2[0], x2[1]), pk(x2[2], x2[3]), pk(x2[4], x2[5]), pk(x2[6], x2[7]));
        }
#pragma unroll
        for (int c8 = 2; c8 < 8; ++c8) {
          const uint4 wv = *(const uint4*)(hp + c8 * 8);
          const float* g = gain + c8 * 8;
          const float sc = rs * qs;
          *(uint4*)(hp + c8 * 8) = make_uint4(pk(bflo(wv.x) * sc * g[0], bfhi(wv.x) * sc * g[1]), pk(bflo(wv.y) * sc * g[2], bfhi(wv.y) * sc * g[3]),
                                              pk(bflo(wv.z) * sc * g[4], bfhi(wv.z) * sc * g[5]), pk(bflo(wv.w) * sc * g[6], bfhi(wv.w) * sc * g[7]));
        }
        __syncthreads();
      }
      const int ldo = (MODE == EPI_GLA_IN) ? 3072 : ldc;
#pragma unroll
      for (int j = 0; j < 8; ++j) {
        const int c = tid + 256 * j, row = c >> 4, cc = c & 15;
        *(uint4*)(dstb + (size_t)(cm0 + row) * ldo + cn0 + cc * 8) = *(const uint4*)(ct + row * 136 + cc * 8);
      }
    } else {
      const unsigned row0 = (unsigned)(cm0 + wm * 64 + 4 * h), col0 = (unsigned)(cn0 + wn * 64 + r);
      float* __restrict__ lrp = (float*)(p.ws + OFF_LR);
#pragma unroll
      for (int ni = 0; ni < 2; ++ni) {
        const unsigned col = col0 + ni * 32;
        float bv = 0.f;
        if (MODE == EPI_RESID_INPLACE) bv = bias[col];
        const unsigned i0 = row0 * 1024u + col;
        const unsigned l0 = row0 * 16u + (col - 3072u);
#pragma unroll
        for (int mi = 0; mi < 2; ++mi)
#pragma unroll
          for (int i = 0; i < 16; ++i) {
            const unsigned ro = (unsigned)(mi * 32 + (i & 3) + 8 * (i >> 2));
            const float v = acc[mi][ni][i];
            if (MODE == EPI_GLA_IN) { if (col < 3088u) lrp[l0 + ro * 16u] = v; }
            else if (MODE == EPI_RESID_X) p.out[i0 + ro * 1024u] = p.x[i0 + ro * 1024u] + v;
            else if (MODE == EPI_RESID_INPLACE) p.out[i0 + ro * 1024u] += v + bv;
          }
      }
    }
  }
#undef GLOAD
#undef SSTORE
}

DI float gate_la(const float* lr_s, int t, const float (&wa)[16], float ba) {
  float z = ba;
#pragma unroll
  for (int j = 0; j < 16; ++j) z += lr_s[t * 16 + j] * wa[j];
  return logsig(z) * (1.f / 16.f);
}
DI void gla_gates(const Params& p, int t0, int hh, float (&wa)[16], float& ba, float& offset, float& blast, float* lr_s, float* tot_s) {
  const int tid = threadIdx.x, d = tid & 127, half = tid >> 7;
  const float* LR = (const float*)(p.ws + OFF_LR);
  ((float4*)lr_s)[tid] = ((const float4*)(LR + (size_t)t0 * 16))[tid];
#pragma unroll
  for (int j = 0; j < 16; ++j) wa[j] = p.gla_w_alpha[j * 512 + hh * 128 + d];
  ba = p.gla_b_alpha[hh * 128 + d];
  __syncthreads();
  float sum = 0.f;
#pragma unroll 4
  for (int tt = 0; tt < 32; ++tt) sum += gate_la(lr_s, half * 32 + tt, wa, ba);
  tot_s[half * 128 + d] = sum;
  __syncthreads();
  offset = half ? tot_s[d] : 0.f;
  blast = tot_s[d] + tot_s[128 + d];
}

DI void fill_vT(const bf16_t* __restrict__ QKVR, int t0, int hh, int vh, bf16_t* vT) {
  const int tid = threadIdx.x, v = tid & 127, half = tid >> 7;
#pragma unroll 8
  for (int tt = 0; tt < 32; ++tt) {
    const int t = half * 32 + tt;
    vT[v * LDK + t] = QKVR[(size_t)(t0 + t) * 3072 + 1024 + hh * 256 + vh * 128 + v];
  }
}

DI void gla_phase1(const Params& p, int item, char* smem) {
  const int hh = item & 3, c = (item >> 2) & 255, b = item >> 10;
  const int t0 = b * SEQ + c * 64;
  float* lr_s = (float*)smem;
  float* tot_s = (float*)(smem + 4096);
  bf16_t* kfT = (bf16_t*)(smem + 5120);
  bf16_t* vT = kfT + 128 * LDK;
  const bf16_t* QKVR = (const bf16_t*)(p.ws + OFF_BIG);
  bf16_t* KVT = (bf16_t*)(p.ws + OFF_KVT);
  float* DECAY = (float*)(p.ws + OFF_DECAY);
  const int tid = threadIdx.x, lane = tid & 63, w = tid >> 6, wm = w >> 1, wn = w & 1;
  const int d = tid & 127, half = tid >> 7;
  float wa[16], ba, offset, blast;
  gla_gates(p, t0, hh, wa, ba, offset, blast, lr_s, tot_s);
  float run = offset;
#pragma unroll 4
  for (int tt = 0; tt < 32; ++tt) {
    const int t = half * 32 + tt;
    run += gate_la(lr_s, t, wa, ba);
    ((float*)(p.ws + OFF_ACT_A))[(size_t)(t0 + t) * 512 + hh * 128 + d] = run;
    const float kv = bf2f(QKVR[(size_t)(t0 + t) * 3072 + 512 + hh * 128 + d]);
    kfT[d * LDK + t] = f2bf(kv * __expf(blast - run));
  }
  if (half == 0) DECAY[(size_t)item * 128 + d] = __expf(blast);
  const int r = lane & 31, h = lane >> 5;
  for (int vh = 0; vh < 2; ++vh) {
    __syncthreads();
    fill_vT(QKVR, t0, hh, vh, vT);
    __syncthreads();
    f32x16 acc[2][2];
#pragma unroll
    for (int i = 0; i < 2; ++i)
#pragma unroll
      for (int j = 0; j < 2; ++j) acc[i][j] = zero16();
    mma_64x64(vT, kfT, wm * 64, wn * 64, acc, lane);
    bf16_t* kbase = KVT + (size_t)item * 32768 + (vh * 128 + wm * 64 + 4 * h) * 128 + wn * 64 + r;
#pragma unroll
    for (int mi = 0; mi < 2; ++mi)
#pragma unroll
      for (int ni = 0; ni < 2; ++ni)
#pragma unroll
        for (int i = 0; i < 16; ++i) kbase[(mi * 32 + (i & 3) + 8 * (i >> 2)) * 128 + ni * 32] = f2bf(acc[mi][ni][i]);
  }
  __syncthreads();
}

DI void gla_scan(const Params& p) {
  bf16_t* KVT = (bf16_t*)(p.ws + OFF_KVT);
  const float* DECAY = (const float*)(p.ws + OFF_DECAY);
  for (int idx = blockIdx.x * 256 + threadIdx.x; idx < 8 * 16384; idx += gridDim.x * 256) {
    const int bh = idx >> 14, e2 = idx & 16383, b = bh >> 2, hh = bh & 3, d0 = (2 * e2) & 127;
    float s0 = 0.f, s1 = 0.f;
    for (int c0 = 0; c0 < 256; c0 += 8) {
      unsigned kv[8]; float2 dc[8];
#pragma unroll
      for (int u = 0; u < 8; ++u) {
        const size_t item = (size_t)(b * 256 + c0 + u) * 4 + hh;
        kv[u] = *(const unsigned*)(KVT + item * 32768 + 2 * e2);
        dc[u] = *(const float2*)(DECAY + item * 128 + d0);
      }
#pragma unroll
      for (int u = 0; u < 8; ++u) {
        const size_t item = (size_t)(b * 256 + c0 + u) * 4 + hh;
        *(unsigned*)(KVT + item * 32768 + 2 * e2) = pk(s0, s1);
        s0 = dc[u].x * s0 + bflo(kv[u]);
        s1 = dc[u].y * s1 + bfhi(kv[u]);
      }
    }
  }
}

DI void gla_phase3(const Params& p, int item, char* smem) {
  const int hh = item & 3, c = (item >> 2) & 255, b = item >> 10;
  const int t0 = b * SEQ + c * 64;
  float* lr_s = (float*)smem;
  float* tot_s = (float*)(smem + 4096);
  bf16_t* qd = (bf16_t*)(smem + 5120);
  bf16_t* ki = qd + 64 * 136;
  bf16_t* at = ki + 64 * 136;
  bf16_t* vT = at + 64 * 72;
  bf16_t* ot = qd;
  const bf16_t* QKVR = (const bf16_t*)(p.ws + OFF_BIG);
  const bf16_t* ST = (const bf16_t*)(p.ws + OFF_KVT);
  bf16_t* OG = (bf16_t*)(p.ws + OFF_ACT_A);
  const int tid = threadIdx.x, lane = tid & 63, w = tid >> 6;
  const int d = tid & 127, half = tid >> 7;
  const int r = lane & 31, h = lane >> 5;
  {
    const float* Bc = (const float*)(p.ws + OFF_ACT_A);
#pragma unroll 8
    for (int tt = 0; tt < 32; ++tt) {
      const int t = half * 32 + tt;
      const float run = Bc[(size_t)(t0 + t) * 512 + hh * 128 + d];
      const float q = bf2f(QKVR[(size_t)(t0 + t) * 3072 + hh * 128 + d]);
      const float k = bf2f(QKVR[(size_t)(t0 + t) * 3072 + 512 + hh * 128 + d]);
      qd[t * 136 + d] = f2bf(q * 0.08838834764831845f * __expf(run));
      ki[t * 136 + d] = f2bf(k * __expf(-run));
    }
  }
  __syncthreads();
  {
    const int mi = w >> 1, nj = w & 1;
    f32x16 a = zero16();
#pragma unroll
    for (int s = 0; s < 8; ++s) {
      const bf16x8 A = *(const bf16x8*)(qd + (mi * 32 + r) * 136 + s * 16 + h * 8);
      const bf16x8 B = *(const bf16x8*)(ki + (nj * 32 + r) * 136 + s * 16 + h * 8);
      a = mfma32(A, B, a);
    }
#pragma unroll
    for (int i = 0; i < 16; ++i) {
      const int it = mi * 32 + crow(i, h), jt = nj * 32 + r;
      at[it * 72 + jt] = f2bf(jt <= it ? a[i] : 0.f);
    }
  }
  f32x16 o[2][2];
#pragma unroll
  for (int i = 0; i < 2; ++i)
#pragma unroll
    for (int j = 0; j < 2; ++j) o[i][j] = zero16();
#pragma unroll
  for (int vh = 0; vh < 2; ++vh) {
    __syncthreads();
    fill_vT(QKVR, t0, hh, vh, vT);
    __syncthreads();
#pragma unroll
    for (int s = 0; s < 4; ++s) {
      const bf16x8 B = *(const bf16x8*)(vT + (w * 32 + r) * LDK + s * 16 + h * 8);
#pragma unroll
      for (int mt = 0; mt < 2; ++mt) {
        const bf16x8 A = *(const bf16x8*)(at + (mt * 32 + r) * 72 + s * 16 + h * 8);
        o[vh][mt] = mfma32(A, B, o[vh][mt]);
      }
    }
    const bf16_t* Sg = ST + (size_t)item * 32768 + (size_t)(vh * 128 + w * 32 + r) * 128 + h * 8;
#pragma unroll
    for (int s = 0; s < 8; ++s) {
      const bf16x8 B = *(const bf16x8*)(Sg + s * 16);
#pragma unroll
      for (int mt = 0; mt < 2; ++mt) {
        const bf16x8 A = *(const bf16x8*)(qd + (mt * 32 + r) * 136 + s * 16 + h * 8);
        o[vh][mt] = mfma32(A, B, o[vh][mt]);
      }
    }
  }
  __syncthreads();
#pragma unroll
  for (int vh = 0; vh < 2; ++vh)
#pragma unroll
    for (int mt = 0; mt < 2; ++mt)
#pragma unroll
      for (int i = 0; i < 16; ++i) ot[(mt * 32 + crow(i, h)) * 264 + vh * 128 + w * 32 + r] = f2bf(o[vh][mt][i]);
  __syncthreads();
  {
    const int row = tid >> 2, seg = tid & 3;
    const bf16_t* orow = ot + row * 264 + seg * 64;
    float ss = 0.f;
#pragma unroll
    for (int c8 = 0; c8 < 8; ++c8) {
      const uint4 ov = *(const uint4*)(orow + c8 * 8);
      const float f0 = bflo(ov.x), f1 = bfhi(ov.x), f2 = bflo(ov.y), f3 = bfhi(ov.y), f4 = bflo(ov.z), f5 = bfhi(ov.z), f6 = bflo(ov.w), f7 = bfhi(ov.w);
      ss += f0 * f0 + f1 * f1 + f2 * f2 + f3 * f3 + f4 * f4 + f5 * f5 + f6 * f6 + f7 * f7;
    }
    ss += __shfl_xor(ss, 1);
    ss += __shfl_xor(ss, 2);
    const float rs = rsqrtf(ss * (1.f / 256.f) + 1e-6f);
    const bf16_t* rrow = QKVR + (size_t)(t0 + row) * 3072 + 2048 + hh * 256 + seg * 64;
    const float* grow = p.gla_norm + hh * 256 + seg * 64;
    bf16_t* dst = OG + (size_t)(t0 + row) * 1024 + hh * 256 + seg * 64;
#pragma unroll
    for (int c8 = 0; c8 < 8; ++c8) {
      const uint4 ov = *(const uint4*)(orow + c8 * 8);
      const uint4 rv = *(const uint4*)(rrow + c8 * 8);
      const float4 g0 = *(const float4*)(grow + c8 * 8), g1 = *(const float4*)(grow + c8 * 8 + 4);
      float of[8] = {bflo(ov.x), bfhi(ov.x), bflo(ov.y), bfhi(ov.y), bflo(ov.z), bfhi(ov.z), bflo(ov.w), bfhi(ov.w)};
      float rf[8] = {bflo(rv.x), bfhi(rv.x), bflo(rv.y), bfhi(rv.y), bflo(rv.z), bfhi(rv.z), bflo(rv.w), bfhi(rv.w)};
      float gf[8] = {g0.x, g0.y, g0.z, g0.w, g1.x, g1.y, g1.z, g1.w};
      float res[8];
#pragma unroll
      for (int e = 0; e < 8; ++e) res[e] = of[e] * rs * gf[e] * (rf[e] / (1.f + __expf(-rf[e])));
      *(uint4*)(dst + c8 * 8) = make_uint4(pk(res[0], res[1]), pk(res[2], res[3]), pk(res[4], res[5]), pk(res[6], res[7]));
    }
  }
  __syncthreads();
}

DI void swa_qknorm(const Params& p) {
  bf16_t* QKV = (bf16_t*)(p.ws + OFF_BIG);
  const int tid = threadIdx.x, sub = tid & 7;
  const int ngroups = T_TOK * 18;
  for (int g = blockIdx.x * 32 + (tid >> 3); g < ngroups; g += gridDim.x * 32) {
    const int tok = g / 18, slot = g - tok * 18;
    bf16_t* ptr = QKV + (size_t)tok * 1280 + slot * 64 + sub * 8;
    const uint4 wv = *(const uint4*)ptr;
    float v[8] = {bflo(wv.x), bfhi(wv.x), bflo(wv.y), bfhi(wv.y), bflo(wv.z), bfhi(wv.z), bflo(wv.w), bfhi(wv.w)};
    float ss = 0.f;
#pragma unroll
    for (int e = 0; e < 8; ++e) ss += v[e] * v[e];
    ss += __shfl_xor(ss, 1);
    ss += __shfl_xor(ss, 2);
    ss += __shfl_xor(ss, 4);
    const float rs = rsqrtf(ss * (1.f / 64.f) + 1e-6f);
    const float* gain = (slot < 16 ? p.swa_qn : p.swa_kn) + sub * 8;
#pragma unroll
    for (int e = 0; e < 8; ++e) v[e] = v[e] * rs * gain[e];
    const float posf = (float)p.pos[tok];
    const float invf[8] = {1.0f, 0.1939227432012558f, 0.03760603070259094f, 0.007292664609849453f,
                           0.0014142135623842478f, 0.00027424818836152554f, 5.318296098266728e-05f, 1.0313386155758053e-05f};
#pragma unroll
    for (int e = 0; e < 8; ++e) {
      const float other = __shfl_xor(v[e], 1);
      if (sub < 2) {
        const float ang = posf * invf[e];
        const double rev = (double)ang * 0.15915494309189535;
        const float fr = (float)(rev - rint(rev));
        const float sn = __builtin_amdgcn_sinf(fr), cs = __builtin_amdgcn_cosf(fr);
        v[e] = (sub == 0) ? (v[e] * cs - other * sn) : (v[e] * cs + other * sn);
      }
    }
    if (slot < 16) {
#pragma unroll
      for (int e = 0; e < 8; ++e) v[e] *= 0.125f;
    }
    *(uint4*)ptr = make_uint4(pk(v[0], v[1]), pk(v[2], v[3]), pk(v[4], v[5]), pk(v[6], v[7]));
  }
}

DI void swa_attn(const Params& p, int item, char* smem) {
  const int hq = item & 15, n = (item >> 4) & 127, b = item >> 11, hkv = hq >> 3;
  const int tok0 = b * SEQ + n * 128;
  bf16_t* Ks = (bf16_t*)smem;
  bf16_t* vT = Ks + 256 * 72;
  const bf16_t* QKV = (const bf16_t*)(p.ws + OFF_BIG);
  bf16_t* OUT = (bf16_t*)(p.ws + OFF_ACT_B);
  const int tid = threadIdx.x, lane = tid & 63, w = tid >> 6, r = lane & 31, h = lane >> 5;
  __syncthreads();
#pragma unroll
  for (int i = 0; i < 8; ++i) {
    const int cidx = tid + 256 * i, kk = cidx >> 3, kc = cidx & 7;
    const int pos = n * 128 - 128 + kk;
    uint4 kw = make_uint4(0, 0, 0, 0), vw = make_uint4(0, 0, 0, 0);
    if (pos >= 0) {
      const bf16_t* base = QKV + (size_t)(b * SEQ + pos) * 1280;
      kw = *(const uint4*)(base + 1024 + hkv * 64 + kc * 8);
      vw = *(const uint4*)(base + 1152 + hkv * 64 + kc * 8);
    }
    *(uint4*)(Ks + kk * 72 + kc * 8) = kw;
    bf16_t* vd = vT + (kc * 8) * 264 + kk;
    vd[0 * 264] = (bf16_t)(vw.x & 0xffff); vd[1 * 264] = (bf16_t)(vw.x >> 16);
    vd[2 * 264] = (bf16_t)(vw.y & 0xffff); vd[3 * 264] = (bf16_t)(vw.y >> 16);
    vd[4 * 264] = (bf16_t)(vw.z & 0xffff); vd[5 * 264] = (bf16_t)(vw.z >> 16);
    vd[6 * 264] = (bf16_t)(vw.w & 0xffff); vd[7 * 264] = (bf16_t)(vw.w >> 16);
  }
  __syncthreads();
  const int iq = 32 * w + r;
  const bf16_t* qrow = QKV + (size_t)(tok0 + iq) * 1280 + hq * 64 + h * 8;
  bf16x8 qf[4];
#pragma unroll
  for (int s = 0; s < 4; ++s) qf[s] = *(const bf16x8*)(qrow + s * 16);
  f32x16 X[5];
#pragma unroll
  for (int kt = 0; kt < 5; ++kt) {
    X[kt] = zero16();
#pragma unroll
    for (int s = 0; s < 4; ++s) {
      const bf16x8 A = *(const bf16x8*)(Ks + ((w + kt) * 32 + r) * 72 + s * 16 + h * 8);
      X[kt] = mfma32(A, qf[s], X[kt]);
    }
  }
  const float sink = p.swa_sinks[hq];
  float m = sink;
#pragma unroll
  for (int kt = 0; kt < 5; ++kt)
#pragma unroll
    for (int i = 0; i < 16; ++i) {
      const int kk = (w + kt) * 32 + crow(i, h);
      const bool valid = (kk > iq) && (kk <= iq + 128) && (n > 0 || kk >= 128);
      const float xv = valid ? X[kt][i] : -INFINITY;
      X[kt][i] = xv;
      m = fmaxf(m, xv);
    }
  m = fmaxf(m, __shfl_xor(m, 32));
  float l = 0.f;
#pragma unroll
  for (int kt = 0; kt < 5; ++kt)
#pragma unroll
    for (int i = 0; i < 16; ++i) {
      const float pv = __expf(X[kt][i] - m);
      X[kt][i] = pv;
      l += pv;
    }
  l += __shfl_xor(l, 32);
  l += __expf(sink - m);
  f32x16 O[2];
  O[0] = zero16(); O[1] = zero16();
#pragma unroll
  for (int kt = 0; kt < 5; ++kt)
#pragma unroll
    for (int s2 = 0; s2 < 2; ++s2) {
      const uint4 pw = make_uint4(pk(X[kt][8 * s2 + 0], X[kt][8 * s2 + 1]), pk(X[kt][8 * s2 + 2], X[kt][8 * s2 + 3]),
                                  pk(X[kt][8 * s2 + 4], X[kt][8 * s2 + 5]), pk(X[kt][8 * s2 + 6], X[kt][8 * s2 + 7]));
      const bf16x8 P = __builtin_bit_cast(bf16x8, pw);
#pragma unroll
      for (int mt = 0; mt < 2; ++mt) {
        const bf16_t* vp = vT + (mt * 32 + r) * 264 + (w + kt) * 32 + 16 * s2 + 4 * h;
        const uint2 lo = *(const uint2*)vp, hi = *(const uint2*)(vp + 8);
        const bf16x8 A = __builtin_bit_cast(bf16x8, make_uint4(lo.x, lo.y, hi.x, hi.y));
        O[mt] = mfma32(A, P, O[mt]);
      }
    }
  const float inv = 1.f / l;
  bf16_t* orow = OUT + (size_t)(tok0 + iq) * 1024 + hq * 64 + 4 * h;
#pragma unroll
  for (int mt = 0; mt < 2; ++mt)
#pragma unroll
    for (int g = 0; g < 4; ++g)
      *(uint2*)(orow + mt * 32 + 8 * g) = make_uint2(pk(O[mt][4 * g] * inv, O[mt][4 * g + 1] * inv), pk(O[mt][4 * g + 2] * inv, O[mt][4 * g + 3] * inv));
}

DI unsigned fkey_u(unsigned u) { return u ^ ((unsigned)((int)u >> 31) | 0x80000000u); }
DI float unfkey(unsigned k) { return __uint_as_float(k ^ ((~(unsigned)((int)k >> 31)) | 0x80000000u)); }
DI void cswap(unsigned& a, unsigned& b) { const unsigned hi = a > b ? a : b, lo = a > b ? b : a; a = hi; b = lo; }
DI void sort16(unsigned (&t)[16]) {
#pragma unroll
  for (int k = 2; k <= 16; k <<= 1)
#pragma unroll
    for (int j = k >> 1; j > 0; j >>= 1)
#pragma unroll
      for (int i = 0; i < 16; ++i) {
        const int l = i ^ j;
        if (l > i) { if ((i & k) == 0) cswap(t[i], t[l]); else cswap(t[l], t[i]); }
      }
}
DI void merge16(unsigned (&a)[16], const unsigned (&b)[16]) {
#pragma unroll
  for (int j = 0; j < 16; ++j) a[j] = a[j] > b[15 - j] ? a[j] : b[15 - j];
#pragma unroll
  for (int j = 8; j > 0; j >>= 1)
#pragma unroll
    for (int i = 0; i < 16; ++i) { const int l = i ^ j; if (l > i) cswap(a[i], a[l]); }
}
DI void cswap2(unsigned& ak, int& ap, unsigned& bk, int& bp) {
  const bool sw = bk > ak;
  const unsigned hk = sw ? bk : ak, lk = sw ? ak : bk;
  const int hp = sw ? bp : ap, lp = sw ? ap : bp;
  ak = hk; ap = hp; bk = lk; bp = lp;
}
DI void sort16p(unsigned (&t)[16], int (&q)[16]) {
#pragma unroll
  for (int k = 2; k <= 16; k <<= 1)
#pragma unroll
    for (int j = k >> 1; j > 0; j >>= 1)
#pragma unroll
      for (int i = 0; i < 16; ++i) {
        const int l = i ^ j;
        if (l > i) { if ((i & k) == 0) cswap2(t[i], q[i], t[l], q[l]); else cswap2(t[l], q[l], t[i], q[i]); }
      }
}
__device__ constexpr int CIA[25] = {0,0,0,0,0,0,0,0,0,0,0,0,0,0,0,0, 2,2,2,2,2, 3,3,3,3};
__device__ constexpr int CJA[25] = {0,1,2,3,4,5,6,7,8,9,10,11,12,13,14,15, 0,1,2,3,4, 0,1,2,3};
__device__ constexpr int CIB[25] = {1,1,1,1,1,1,1,1, 4,4,4, 5,5,6,6,7,7, 8,9,10,11,12,13,14,15};
__device__ constexpr int CJB[25] = {0,1,2,3,4,5,6,7, 0,1,2, 0,1,0,1,0,1, 0,0,0,0,0,0,0,0};

DI void peer_topk_wave(const Params& p, int layer, int item) {
  const int head = item >> 10, tok0 = (item & 1023) * 32;
  const bf16_t* Q = (const bf16_t*)(p.ws + OFF_BIG);
  const bf16_t* KEYS = (const bf16_t*)(p.ws + OFF_KEYS) + (size_t)(layer * 8 + head) * 256 * 64;
  int* E = (int*)(p.ws + OFF_E);
  float* G = (float*)(p.ws + OFF_G);
  const int lane = threadIdx.x & 63, r = lane & 31, h = lane >> 5;
  const unsigned h4 = 4u * (1u - (unsigned)h);
  unsigned tl[2][16];
  bf16x8 qf[2][4], kf[4][4];
#pragma unroll
  for (int set = 0; set < 2; ++set) {
    const bf16_t* qrow = Q + (size_t)(tok0 + r) * 1024 + head * 128 + set * 64 + h * 8;
#pragma unroll
    for (int s = 0; s < 4; ++s) qf[set][s] = *(const bf16x8*)(qrow + s * 16);
  }
#pragma unroll
  for (int kt = 0; kt < 4; ++kt)
#pragma unroll
    for (int s = 0; s < 4; ++s) kf[kt][s] = *(const bf16x8*)(KEYS + (size_t)(kt * 32 + r) * 64 + h * 8 + s * 16);
#pragma unroll
  for (int set = 0; set < 2; ++set) {
    f32x16 X[4];
#pragma unroll
    for (int kt = 0; kt < 4; ++kt) {
      X[kt] = zero16();
#pragma unroll
      for (int s = 0; s < 4; ++s) X[kt] = mfma32(kf[kt][s], qf[set][s], X[kt]);
    }
#pragma unroll
    for (int kt = 0; kt < 4; ++kt) {
      if (set == 0 && kt == 2) {
#pragma unroll
        for (int k2 = 0; k2 < 4; ++k2)
#pragma unroll
          for (int s = 0; s < 4; ++s) kf[k2][s] = *(const bf16x8*)(KEYS + (size_t)(128 + k2 * 32 + r) * 64 + h * 8 + s * 16);
      }
      unsigned kk[16];
#pragma unroll
      for (int i = 0; i < 16; ++i)
        kk[i] = (fkey_u(__float_as_uint(X[kt][i])) & ~127u) + ((unsigned)(127 - kt * 32 - (i & 3) - 8 * (i >> 2) - 4) + h4);
      sort16(kk);
      if (kt == 0) {
#pragma unroll
        for (int i = 0; i < 16; ++i) tl[set][i] = kk[i];
      } else merge16(tl[set], kk);
    }
  }
  unsigned mine[16], oth[16];
#pragma unroll
  for (int j = 0; j < 16; ++j) {
    const unsigned send = h ? tl[0][j] : tl[1][j];
    oth[j] = (unsigned)__shfl_xor((int)send, 32);
    mine[j] = h ? tl[1][j] : tl[0][j];
  }
  merge16(mine, oth);
  float v1[16], v2[16]; int i1[16], i2[16];
#pragma unroll
  for (int j = 0; j < 16; ++j) {
    const unsigned o = (unsigned)__shfl_xor((int)mine[j], 32);
    const unsigned A = h ? o : mine[j], B = h ? mine[j] : o;
    v1[j] = unfkey(A & ~127u); i1[j] = 127 - (int)(A & 127u);
    v2[j] = unfkey(B & ~127u); i2[j] = 127 - (int)(B & 127u);
  }
  unsigned ck[16], dk[16]; int cp[16], dp[16];
#pragma unroll
  for (int n = 0; n < 32; ++n) {
    unsigned key = 0u; int e = 0;
    if (n < 25) {
      const float sA = v1[CIA[n]] + v2[CJA[n]], sB = v1[CIB[n]] + v2[CJB[n]];
      const int eA = i1[CIA[n]] * 128 + i2[CJA[n]], eB = i1[CIB[n]] * 128 + i2[CJB[n]];
      key = fkey_u(__float_as_uint(h ? sB : sA)); e = h ? eB : eA;
    }
    if (n < 16) { ck[n] = key; cp[n] = e; } else { dk[n - 16] = key; dp[n - 16] = e; }
  }
  sort16p(ck, cp);
  sort16p(dk, dp);
#pragma unroll
  for (int j = 0; j < 16; ++j) { const bool sw = dk[15 - j] > ck[j]; ck[j] = sw ? dk[15 - j] : ck[j]; cp[j] = sw ? dp[15 - j] : cp[j]; }
#pragma unroll
  for (int j = 8; j > 0; j >>= 1)
#pragma unroll
    for (int i = 0; i < 16; ++i) { const int l = i ^ j; if (l > i) cswap2(ck[i], cp[i], ck[l], cp[l]); }
  unsigned fk[16]; int fe[16];
#pragma unroll
  for (int j = 0; j < 16; ++j) { dk[j] = (unsigned)__shfl_xor((int)ck[j], 32); dp[j] = __shfl_xor(cp[j], 32); }
#pragma unroll
  for (int j = 0; j < 16; ++j) {
    const bool sw = (dk[15 - j] > ck[j]) || (dk[15 - j] == ck[j] && dp[15 - j] > cp[j]);
    fk[j] = sw ? dk[15 - j] : ck[j]; fe[j] = sw ? dp[15 - j] : cp[j];
  }
  float sv[16], mx = -INFINITY;
#pragma unroll
  for (int j = 0; j < 16; ++j) { sv[j] = unfkey(fk[j]); mx = fmaxf(mx, sv[j]); }
  float sm = 0.f;
#pragma unroll
  for (int j = 0; j < 16; ++j) { sv[j] = __expf(sv[j] - mx); sm += sv[j]; }
  const float inv = 1.f / sm;
  const size_t o = ((size_t)(tok0 + r) * 8 + head) * 16 + h * 8;
  *(int4*)(E + o) = make_int4(fe[0], fe[1], fe[2], fe[3]);
  *(int4*)(E + o + 4) = make_int4(fe[4], fe[5], fe[6], fe[7]);
  *(float4*)(G + o) = make_float4(sv[0] * inv, sv[1] * inv, sv[2] * inv, sv[3] * inv);
  *(float4*)(G + o + 4) = make_float4(sv[4] * inv, sv[5] * inv, sv[6] * inv, sv[7] * inv);
}

DI v32f fp6x32(const uint2* p) {
  const uint2 a = p[0], b = p[1], c = p[2];
  v6u x; x[0] = a.x; x[1] = a.y; x[2] = b.x; x[3] = b.y; x[4] = c.x; x[5] = c.y;
  return __builtin_amdgcn_cvt_scalef32_pk32_f32_fp6(x, 1.0f);
}

typedef unsigned u2v __attribute__((ext_vector_type(2)));
typedef unsigned v16u __attribute__((ext_vector_type(16)));
typedef __bf16 v32bf __attribute__((ext_vector_type(32)));
DI v6u mk6(u2v a, u2v b, u2v c) { v6u x; x[0] = a[0]; x[1] = a[1]; x[2] = b[0]; x[3] = b[1]; x[4] = c[0]; x[5] = c[1]; return x; }

DI v6u ld6(const unsigned char* p) { const u2v* q = (const u2v*)p; return mk6(q[0], q[1], q[2]); }
#define U_LOAD2(RAW, M2) _Pragma("unroll") for (int mi = 0; mi < 2; ++mi) { \
    const unsigned char* up_ = U + (size_t)e_s[8 * ((M2) + mi) + grp8] * 768 + i8 * 24; \
    _Pragma("unroll") for (int k = 0; k < 4; ++k) RAW[4 * mi + k] = ld6(up_ + 192 * k); }
#define U_COMP2(RAW, M2) _Pragma("unroll") for (int mi = 0; mi < 2; ++mi) { \
    const int pidx = 8 * ((M2) + mi) + grp8; \
    float acc0 = 0.f, acc1 = 0.f, acc2 = 0.f, acc3 = 0.f; \
    _Pragma("unroll") for (int k = 0; k < 4; ++k) { \
      const v16u ub = __builtin_bit_cast(v16u, __builtin_amdgcn_cvt_scalef32_pk32_bf16_fp6(RAW[4 * mi + k], 1.0f)); \
      _Pragma("unroll") for (int i = 0; i < 16; i += 4) { \
        acc0 = dot2(ub[i], xp[k][i], acc0); acc1 = dot2(ub[i + 1], xp[k][i + 1], acc1); \
        acc2 = dot2(ub[i + 2], xp[k][i + 2], acc2); acc3 = dot2(ub[i + 3], xp[k][i + 3], acc3); } } \
    float acc = (acc0 + acc1) + (acc2 + acc3); \
    acc += __shfl_xor(acc, 1); acc += __shfl_xor(acc, 2); acc += __shfl_xor(acc, 4); \
    if (i8 == 0) a_s[pidx] = acc;              \
    __builtin_amdgcn_sched_barrier(0); }

DI void peer_gather_u(const Params& p, int layer, char* smem) {
  const int tid = threadIdx.x, lane = tid & 63, w = tid >> 6, grp8 = lane >> 3, i8 = lane & 7;
  float* a_s = (float*)smem + w * 512;
  float* su_s = a_s + 128;
  float* gv_s = a_s + 256;
  int* e_s = (int*)(a_s + 384);
  const bf16_t* HN = (const bf16_t*)(p.ws + OFF_ACT_A);
  const unsigned char* U = (const unsigned char*)(p.ws + OFF_TBL_U) + (size_t)layer * 16 * MiB;
  const float* IU = (const float*)(p.ws + OFF_INV) + (layer * 2 + 0) * 16384;
  const float* IV = (const float*)(p.ws + OFF_INV) + (layer * 2 + 1) * 16384;
  const int* E = (const int*)(p.ws + OFF_E);
  const float* G = (const float*)(p.ws + OFF_G);
  float* A = (float*)(p.ws + OFF_A);
  for (int tok = blockIdx.x * 4 + w; tok < T_TOK; tok += gridDim.x * 4) {
    unsigned xp[4][16];
#pragma unroll
    for (int k = 0; k < 4; ++k) {
      const uint4* xq = (const uint4*)(HN + (size_t)tok * 1024 + (i8 + 8 * k) * 32);
#pragma unroll
      for (int q = 0; q < 4; ++q) { const uint4 x0 = xq[q]; xp[k][4 * q] = x0.x; xp[k][4 * q + 1] = x0.y; xp[k][4 * q + 2] = x0.z; xp[k][4 * q + 3] = x0.w; }
    }
    const int e0 = E[(size_t)tok * 128 + lane], e1 = E[(size_t)tok * 128 + 64 + lane];
    e_s[lane] = e0; e_s[64 + lane] = e1;
    const float su0 = IU[e0], su1 = IU[e1];
    const float gv0 = G[(size_t)tok * 128 + lane] * IV[e0], gv1 = G[(size_t)tok * 128 + 64 + lane] * IV[e1];
    wave_sync();
    v6u rA[8], rB[8];
    U_LOAD2(rA, 0)
#pragma unroll 1
    for (int m2 = 0; m2 < 16; m2 += 4) {
      U_LOAD2(rB, m2 + 2)
      U_COMP2(rA, m2)
      if (m2 + 4 < 16) { U_LOAD2(rA, m2 + 4) }
      U_COMP2(rB, m2 + 2)
    }
    wave_sync();
    {
      const float s0 = a_s[lane] * su0, s1 = a_s[64 + lane] * su1;
      A[(size_t)tok * 128 + lane] = 0.5f * s0 * (1.f + erff(s0 * 0.7071067811865476f)) * gv0;
      A[(size_t)tok * 128 + 64 + lane] = 0.5f * s1 * (1.f + erff(s1 * 0.7071067811865476f)) * gv1;
    }
    wave_sync();
  }
}

#define V_LOAD8(RAW, M8) _Pragma("unroll") for (int mi = 0; mi < 4; ++mi) RAW[mi] = ld6(V + (size_t)e_s[2 * ((M8) + mi) + h] * 768 + r * 24);
#define V_COMP8(RAW, M8) _Pragma("unroll") for (int mi = 0; mi < 4; ++mi) { \
    const float a = a_s[2 * ((M8) + mi) + h]; \
    const v32f vv = __builtin_amdgcn_cvt_scalef32_pk32_f32_fp6(RAW[mi], 1.0f); \
    _Pragma("unroll") for (int i = 0; i < 32; ++i) o[i] = fmaf(a, vv[i], o[i]); \
    __builtin_amdgcn_sched_barrier(0); }

DI void peer_gather_v(const Params& p, int layer, char* smem, const float* __restrict__ next_gain) {
  const int tid = threadIdx.x, lane = tid & 63, w = tid >> 6, r = lane & 31, h = lane >> 5;
  float* a_s = (float*)smem + w * 256;
  int* e_s = (int*)(a_s + 128);
  const unsigned char* V = (const unsigned char*)(p.ws + OFF_TBL_V) + (size_t)layer * 16 * MiB;
  const int* E = (const int*)(p.ws + OFF_E);
  const float* A = (const float*)(p.ws + OFF_A);
  for (int tok = blockIdx.x * 4 + w; tok < T_TOK; tok += gridDim.x * 4) {
    e_s[lane] = E[(size_t)tok * 128 + lane]; e_s[64 + lane] = E[(size_t)tok * 128 + 64 + lane];
    a_s[lane] = A[(size_t)tok * 128 + lane]; a_s[64 + lane] = A[(size_t)tok * 128 + 64 + lane];
    wave_sync();
    float o[32];
#pragma unroll
    for (int i = 0; i < 32; ++i) o[i] = 0.f;
    v6u rA[4], rB[4];
    V_LOAD8(rA, 0)
#pragma unroll 1
    for (int m8 = 0; m8 < 64; m8 += 8) {
      V_LOAD8(rB, m8 + 4)
      V_COMP8(rA, m8)
      if (m8 + 8 < 64) { V_LOAD8(rA, m8 + 8) }
      V_COMP8(rB, m8 + 4)
    }
#pragma unroll
    for (int i = 0; i < 32; ++i) o[i] += __shfl_xor(o[i], 32);
    float4* hp = (float4*)(p.out + (size_t)tok * 1024 + r * 32 + h * 16);
    float4 hv[4];
    float ss = 0.f;
#pragma unroll
    for (int q = 0; q < 4; ++q) {
      float4 t = hp[q];
      t.x += h ? o[16 + 4 * q] : o[4 * q]; t.y += h ? o[17 + 4 * q] : o[4 * q + 1];
      t.z += h ? o[18 + 4 * q] : o[4 * q + 2]; t.w += h ? o[19 + 4 * q] : o[4 * q + 3];
      hp[q] = t; hv[q] = t;
      ss += t.x * t.x + t.y * t.y + t.z * t.z + t.w * t.w;
    }
    if (next_gain) {
#pragma unroll
      for (int o2 = 32; o2 >= 1; o2 >>= 1) ss += __shfl_xor(ss, o2);
      const float rs = rsqrtf(ss * (1.f / 1024.f) + 1e-6f);
      const float4* gp = (const float4*)(next_gain + r * 32 + h * 16);
      unsigned pw[8];
#pragma unroll
      for (int q = 0; q < 4; ++q) {
        const float4 g = gp[q];
        pw[2 * q] = pk(hv[q].x * rs * g.x, hv[q].y * rs * g.y); pw[2 * q + 1] = pk(hv[q].z * rs * g.z, hv[q].w * rs * g.w);
      }
      uint4* dp = (uint4*)((bf16_t*)(p.ws + OFF_ACT_A) + (size_t)tok * 1024 + r * 32 + h * 16);
      dp[0] = make_uint4(pw[0], pw[1], pw[2], pw[3]); dp[1] = make_uint4(pw[4], pw[5], pw[6], pw[7]);
    }
    wave_sync();
  }
}

DI void run_phase(const Params& p, int ph, char* smem) {
  bf16_t* actA = (bf16_t*)(p.ws + OFF_ACT_A);
  bf16_t* big = (bf16_t*)(p.ws + OFF_BIG);
  switch (ph) {
    case 0: phase_convert(p, smem); phase_cvt_tables(p, 0); phase_cvt_tables(p, 1); break;
    case 1: phase_rmsnorm(p.x, p.ln_mix, actA); break;
    case 2: phase_gemm<EPI_GLA_IN>(p, actA, (const bf16_t*)(p.ws + OFF_WT_GLA_IN), 25, big, 3072, nullptr, smem); break;
    case 3: for (int it = blockIdx.x; it < 2048; it += gridDim.x) gla_phase1(p, it, smem); break;
    case 4: gla_scan(p); break;
    case 5: for (int it = blockIdx.x; it < 2048; it += gridDim.x) gla_phase3(p, it, smem); break;
    case 6: phase_gemm<EPI_RESID_X>(p, actA, (const bf16_t*)(p.ws + OFF_WT_GLA_OUT), 8, nullptr, 0, nullptr, smem); break;
    case 7: phase_rmsnorm(p.out, p.ln_ffn, actA); break;
    case 8: phase_gemm<EPI_BF16>(p, actA, (const bf16_t*)(p.ws + OFF_WT_PQ), 8, big, 1024, nullptr, smem); break;
    case 9: for (int it = blockIdx.x * 4 + (threadIdx.x >> 6); it < 8192; it += gridDim.x * 4) peer_topk_wave(p, 0, it); break;
    case 10: peer_gather_u(p, 0, smem); break;
    case 11: peer_gather_v(p, 0, smem, p.ln_mix + 1024); break;
    case 12: break;
    case 13: phase_gemm<EPI_SWA_IN>(p, actA, (const bf16_t*)(p.ws + OFF_WT_SWA_IN), 10, big, 1280, p.swa_b_in, smem); break;
    case 14: break;
    case 15: for (int it = blockIdx.x; it < 4096; it += gridDim.x) swa_attn(p, it, smem); break;
    case 16: phase_gemm<EPI_RESID_INPLACE>(p, (const bf16_t*)(p.ws + OFF_ACT_B), (const bf16_t*)(p.ws + OFF_WT_SWA_OUT), 8, nullptr, 0, p.swa_b_out, smem); break;
    case 17: phase_rmsnorm(p.out, p.ln_ffn + 1024, actA); break;
    case 18: phase_gemm<EPI_BF16>(p, actA, (const bf16_t*)(p.ws + OFF_WT_PQ) + (size_t)1024 * 1024, 8, big, 1024, nullptr, smem); break;
    case 19: for (int it = blockIdx.x * 4 + (threadIdx.x >> 6); it < 8192; it += gridDim.x * 4) peer_topk_wave(p, 1, it); break;
    case 20: peer_gather_u(p, 1, smem); break;
    case 21: peer_gather_v(p, 1, smem, nullptr); break;
    default: break;
  }
}

template <int PH>
__global__ void __launch_bounds__(256, 2) phase_kernel(Params p) {
  __shared__ __attribute__((aligned(16))) char smem[SMEM_BYTES];
  run_phase(p, PH, smem);
}

template <int PH>
static void launch_phases(const Params& p, int grid, hipStream_t stream) {
  hipLaunchKernelGGL(phase_kernel<PH>, dim3(grid), dim3(256), 0, stream, p);
  if constexpr (PH + 1 < NPHASE) launch_phases<PH + 1>(p, grid, stream);
}


#define XB_TMO      128
#define XB_XCNT(j)  (256  + 64 * (j))
#define XB_XSUB(j)  (1280 + 64 * (j))
#define XB_XGEN(j)  (2304 + 64 * (j))
#define XB_TOP      3328
#define XB_TOPGEN   3392
#define XCD_BAR_WORDS 3456
#define XB_SPIN_CAP (1u << 23)
#define LAS __attribute__((address_space(3)))
DI unsigned xb_ld(unsigned* p) { return __hip_atomic_load(p, __ATOMIC_RELAXED, __HIP_MEMORY_SCOPE_AGENT); }
DI unsigned xb_add(unsigned* p, unsigned v) { return __hip_atomic_fetch_add(p, v, __ATOMIC_RELAXED, __HIP_MEMORY_SCOPE_AGENT); }
DI unsigned xb_xcc_id() { return (unsigned)__builtin_amdgcn_s_getreg((3 << 11) | 20) & 0xFu; }
#define XB_SPIN(cond, bar) do { unsigned _sp = 0; while (cond) { __builtin_amdgcn_s_sleep(1); \
    if ((++_sp & 255u) == 0u) { if (xb_ld(&(bar)[XB_TMO])) break; if (_sp > XB_SPIN_CAP) { atomicAdd(&(bar)[XB_TMO], 1u); break; } } } } while (0)
struct XcdBarrier { unsigned* bar; unsigned x; volatile LAS unsigned* st; };
DI XcdBarrier xcd_barrier_post(unsigned* bar, volatile LAS unsigned* st) {
  XcdBarrier b; b.bar = bar; b.x = xb_xcc_id(); b.st = st;
  if (threadIdx.x == 0) (void)xb_add(&bar[XB_XCNT(b.x)], 1u);
  return b;
}
DI void xcd_barrier_complete(unsigned* bar, unsigned x, unsigned& nloc, unsigned& nx) {
  const unsigned G = gridDim.x * gridDim.y * gridDim.z;
  unsigned sum, cnt, mine, sp = 0u;
  for (;;) {
    sum = 0u; cnt = 0u; mine = 0u;
#pragma unroll
    for (unsigned j = 0; j < 16; ++j) { const unsigned c = xb_ld(&bar[XB_XCNT(j)]); sum += c; cnt += (c > 0u) ? 1u : 0u; mine = (j == x) ? c : mine; }
    if (sum == G) break;
    __builtin_amdgcn_s_sleep(1);
    if ((++sp & 255u) == 0u) { if (xb_ld(&bar[XB_TMO])) break; if (sp > XB_SPIN_CAP) { atomicAdd(&bar[XB_TMO], 1u); break; } }
  }
  nloc = mine > 0u ? mine : 1u; nx = cnt > 0u ? cnt : 1u;
}
DI void xcd_barrier(const XcdBarrier& b) {
  asm volatile("s_waitcnt vmcnt(0)" ::: "memory");
  __syncthreads();
  if (threadIdx.x == 0) {
    unsigned* bar = b.bar;
    __builtin_amdgcn_s_waitcnt(0);
    unsigned nloc = b.st[0], nx = b.st[1];
    if (nloc == 0u) { xcd_barrier_complete(bar, b.x, nloc, nx); b.st[0] = nloc; b.st[1] = nx; }
    const unsigned old = xb_add(&bar[XB_XSUB(b.x)], 1u);
    const unsigned gen = old / nloc;
    if (old + 1u == (gen + 1u) * nloc) {
      __builtin_amdgcn_fence(__ATOMIC_RELEASE, "agent");
      asm volatile("s_waitcnt vmcnt(0)" ::: "memory");
      const unsigned og = xb_add(&bar[XB_TOP], 1u);
      const unsigned tg = og / nx;
      if (og + 1u == (tg + 1u) * nx) xb_add(&bar[XB_TOPGEN], 1u);
      else XB_SPIN(xb_ld(&bar[XB_TOPGEN]) == tg, bar);
      __builtin_amdgcn_fence(__ATOMIC_ACQUIRE, "agent");
      xb_add(&bar[XB_XGEN(b.x)], 1u);
      asm volatile("s_waitcnt vmcnt(0)" ::: "memory");
    } else {
      XB_SPIN(xb_ld(&bar[XB_XGEN(b.x)]) == gen, bar);
      __builtin_amdgcn_fence(__ATOMIC_ACQUIRE, "agent");
      asm volatile("s_waitcnt vmcnt(0)" ::: "memory");
    }
  }
  __syncthreads();
}

#if !MULTI_LAUNCH
template <int PH>
DI void run_all(const Params& p, char* smem, const XcdBarrier& xb) {
  if constexpr (PH != 12 && PH != 14) {
    run_phase(p, PH, smem);
    if constexpr (PH + 1 < NPHASE) {
      if constexpr (PH == 0) cg::this_grid().sync();
      else xcd_barrier(xb);
    }
  }
  if constexpr (PH + 1 < NPHASE) run_all<PH + 1>(p, smem, xb);
}
__global__ void __launch_bounds__(256, 2) trunk_kernel(Params p) {
  __shared__ __attribute__((aligned(16))) char smem[SMEM_BYTES];
  __shared__ uint4 xb_words;
  if (threadIdx.x == 0) xb_words = make_uint4(0u, 0u, 0u, 0u);
  __syncthreads();
  const XcdBarrier xb = xcd_barrier_post((unsigned*)(p.ws + OFF_BAR), (volatile LAS unsigned*)&xb_words);
  run_all<0>(p, smem, xb);
}
#endif

extern "C" void kernel_launch(void* const* d_in, const int* in_sizes, int n_in, void* d_out, int out_size, void* d_ws, size_t ws_size,
                              hipStream_t stream) {
  Params p{};
  p.x = (const float*)d_in[0]; p.pos = (const int*)d_in[1]; p.ln_mix = (const float*)d_in[2]; p.ln_ffn = (const float*)d_in[3];
  p.gla_w_in = (const float*)d_in[4]; p.gla_w_alpha = (const float*)d_in[5]; p.gla_b_alpha = (const float*)d_in[6];
  p.gla_norm = (const float*)d_in[7]; p.gla_w_out = (const float*)d_in[8];
  p.swa_w_in = (const float*)d_in[9]; p.swa_b_in = (const float*)d_in[10]; p.swa_qn = (const float*)d_in[11]; p.swa_kn = (const float*)d_in[12];
  p.swa_sinks = (const float*)d_in[13]; p.swa_w_out = (const float*)d_in[14]; p.swa_b_out = (const float*)d_in[15];
  p.peer_wq = (const float*)d_in[16]; p.peer_keys = (const float*)d_in[17]; p.peer_u = (const float*)d_in[18]; p.peer_v = (const float*)d_in[19];
  p.out = (float*)d_out; p.ws = (char*)d_ws;
  static int grid_blocks = 0;
  if (!grid_blocks) {
    int dev = 0, cus = 0, per_cu = 0;
    (void)hipGetDevice(&dev);
    (void)hipDeviceGetAttribute(&cus, hipDeviceAttributeMultiprocessorCount, dev);
    #if MULTI_LAUNCH
    per_cu = 2;
#else
    (void)hipOccupancyMaxActiveBlocksPerMultiprocessor(&per_cu, trunk_kernel, 256, 0);
#endif
    if (per_cu < 1) per_cu = 1;
    if (per_cu > 2) per_cu = 2;
    grid_blocks = cus * per_cu;
  }
#if MULTI_LAUNCH
  p.phase_lo = 0; p.phase_hi = 0;
  launch_phases<0>(p, grid_blocks, stream);
#else
  p.phase_lo = 0; p.phase_hi = NPHASE - 1;
  void* args[] = {&p};
  (void)hipMemsetAsync((char*)d_ws + OFF_BAR, 0, XCD_BAR_WORDS * 4, stream);
  hipError_t e = hipLaunchCooperativeKernel((void*)trunk_kernel, dim3(grid_blocks), dim3(256), args, 0, stream);
  if (e != hipSuccess) fprintf(stderr, "cooperative launch failed: %s (grid %d)\n", hipGetErrorString(e), grid_blocks);
#endif
}
```

```cpp
#include <hip/hip_runtime.h>
#include <hip/hip_cooperative_groups.h>
#include <stdint.h>
#include <stdio.h>
namespace cg = cooperative_groups;

#ifndef MULTI_LAUNCH
#define MULTI_LAUNCH 0
#endif

#define DI __device__ __forceinline__
typedef unsigned short bf16_t;
typedef __attribute__((ext_vector_type(8))) short bf16x8;
typedef __attribute__((ext_vector_type(16))) float f32x16;
typedef __bf16 bf16x2_t __attribute__((ext_vector_type(2)));
typedef float f32x2_t __attribute__((ext_vector_type(2)));
typedef float f2 __attribute__((ext_vector_type(2)));

constexpr int T_TOK = 32768;
constexpr int SEQ = 16384;
constexpr int DM = 1024;
constexpr int NPHASE = 22;

constexpr size_t MiB = 1048576;
constexpr size_t OFF_WT_GLA_IN = 0;
constexpr size_t OFF_WT_GLA_OUT = 7 * MiB;
constexpr size_t OFF_WT_SWA_IN = 9 * MiB;
constexpr size_t OFF_WT_SWA_OUT = 12 * MiB;
constexpr size_t OFF_WT_PQ = 14 * MiB;
constexpr size_t OFF_KEYS = 18 * MiB;
constexpr size_t OFF_INV = 20 * MiB;
constexpr size_t OFF_TBL_U = 24 * MiB;
constexpr size_t OFF_TBL_V = 56 * MiB;
constexpr size_t OFF_ACT_A = 88 * MiB;
constexpr size_t OFF_BIG = 152 * MiB;
constexpr size_t OFF_E = OFF_BIG + 64 * MiB;
constexpr size_t OFF_G = OFF_BIG + 80 * MiB;
constexpr size_t OFF_A = OFF_BIG + 96 * MiB;
constexpr size_t OFF_KVT = 344 * MiB;
constexpr size_t OFF_ACT_B = OFF_KVT;
constexpr size_t OFF_LR = 472 * MiB;
constexpr size_t OFF_DECAY = 474 * MiB;
constexpr size_t OFF_BAR = 476 * MiB;

constexpr int SMEM_BYTES = 73728;
constexpr int LDK = 72;

struct Params {
  const float* x; const int* pos; const float* ln_mix; const float* ln_ffn;
  const float* gla_w_in; const float* gla_w_alpha; const float* gla_b_alpha; const float* gla_norm; const float* gla_w_out;
  const float* swa_w_in; const float* swa_b_in; const float* swa_qn; const float* swa_kn; const float* swa_sinks;
  const float* swa_w_out; const float* swa_b_out;
  const float* peer_wq; const float* peer_keys; const float* peer_u; const float* peer_v;
  float* out; char* ws;
  int phase_lo, phase_hi;
};

DI int tidx() { int t = (int)threadIdx.x; asm volatile("" : "+v"(t)); return t; }
DI unsigned pk(float lo, float hi) { f32x2_t v = {lo, hi}; bf16x2_t b = __builtin_convertvector(v, bf16x2_t); return __builtin_bit_cast(unsigned, b); }
DI bf16_t f2bf(float x) { return (bf16_t)(pk(x, 0.f) & 0xffffu); }
DI float bflo(unsigned w) { return __uint_as_float(w << 16); }
DI float bfhi(unsigned w) { return __uint_as_float(w & 0xffff0000u); }
DI float bf2f(bf16_t b) { return __uint_as_float(((unsigned)b) << 16); }
DI float dot2(unsigned a, unsigned b, float c) { return __builtin_amdgcn_fdot2_f32_bf16(__builtin_bit_cast(bf16x2_t, a), __builtin_bit_cast(bf16x2_t, b), c, false); }
DI int crow(int i, int h) { return (i & 3) + 8 * (i >> 2) + 4 * h; }
DI f32x16 mfma32(bf16x8 a, bf16x8 b, f32x16 c) { return __builtin_amdgcn_mfma_f32_32x32x16_bf16(a, b, c, 0, 0, 0); }
DI f32x16 zero16() { f32x16 z; for (int i = 0; i < 16; ++i) z[i] = 0.f; return z; }
DI void wave_sync() { __builtin_amdgcn_fence(__ATOMIC_RELEASE, "wavefront"); __builtin_amdgcn_wave_barrier(); __builtin_amdgcn_fence(__ATOMIC_ACQUIRE, "wavefront"); }
DI int mbcnt64(unsigned long long m) { return __builtin_amdgcn_mbcnt_hi((unsigned)(m >> 32), __builtin_amdgcn_mbcnt_lo((unsigned)m, 0)); }
DI float logsig(float z) { return fminf(z, 0.f) - __logf(1.f + __expf(-fabsf(z))); }

DI void transpose_tile(const float* __restrict__ src, int N, bf16_t* __restrict__ dst, int kt, int nt, float* sT) {
  const int tid = tidx();
  const int r = tid >> 4, c4 = (tid & 15) * 4;
#pragma unroll
  for (int i = 0; i < 4; ++i) {
    const int k = kt * 64 + r + 16 * i, n = nt * 64 + c4;
    float4 v = make_float4(0.f, 0.f, 0.f, 0.f);
    if (n + 3 < N) v = *(const float4*)(src + (size_t)k * N + n);
    float* d = sT + (r + 16 * i) * 65 + c4;
    d[0] = v.x; d[1] = v.y; d[2] = v.z; d[3] = v.w;
  }
  __syncthreads();
  const int n = tid >> 2, seg = tid & 3;
  unsigned w[8];
#pragma unroll
  for (int j = 0; j < 8; ++j) w[j] = pk(sT[(seg * 16 + 2 * j) * 65 + n], sT[(seg * 16 + 2 * j + 1) * 65 + n]);
  uint4* d = (uint4*)(dst + (size_t)(nt * 64 + n) * 1024 + kt * 64 + seg * 16);
  d[0] = make_uint4(w[0], w[1], w[2], w[3]);
  d[1] = make_uint4(w[4], w[5], w[6], w[7]);
  __syncthreads();
}

DI void cvt_elems(const float* __restrict__ src, bf16_t* __restrict__ dst, size_t n8) {
  for (size_t i = (size_t)blockIdx.x * 256 + tidx(); i < n8; i += (size_t)gridDim.x * 256) {
    const float4 a = ((const float4*)src)[2 * i], b = ((const float4*)src)[2 * i + 1];
    ((uint4*)dst)[i] = make_uint4(pk(a.x, a.y), pk(a.z, a.w), pk(b.x, b.y), pk(b.z, b.w));
  }
}

DI void phase_convert(const Params& p, char* smem) {
  float* sT = (float*)smem;
  for (int t = blockIdx.x; t < 2144; t += gridDim.x) {
    const float* src; int N, ntn; bf16_t* dst; int local;
    if (t < 800) { src = p.gla_w_in; N = 3088; ntn = 50; dst = (bf16_t*)(p.ws + OFF_WT_GLA_IN); local = t; }
    else if (t < 1056) { src = p.gla_w_out; N = 1024; ntn = 16; dst = (bf16_t*)(p.ws + OFF_WT_GLA_OUT); local = t - 800; }
    else if (t < 1376) { src = p.swa_w_in; N = 1280; ntn = 20; dst = (bf16_t*)(p.ws + OFF_WT_SWA_IN); local = t - 1056; }
    else if (t < 1632) { src = p.swa_w_out; N = 1024; ntn = 16; dst = (bf16_t*)(p.ws + OFF_WT_SWA_OUT); local = t - 1376; }
    else if (t < 1888) { src = p.peer_wq; N = 1024; ntn = 16; dst = (bf16_t*)(p.ws + OFF_WT_PQ); local = t - 1632; }
    else { src = p.peer_wq + (size_t)1024 * 1024; N = 1024; ntn = 16; dst = (bf16_t*)(p.ws + OFF_WT_PQ) + (size_t)1024 * 1024; local = t - 1888; }
    transpose_tile(src, N, dst, local / ntn, local % ntn, sT);
  }
  cvt_elems(p.peer_keys, (bf16_t*)(p.ws + OFF_KEYS), (size_t)2 * 8 * 2 * 128 * 64 / 8);
}

typedef unsigned v6u __attribute__((ext_vector_type(6)));
typedef float v32f __attribute__((ext_vector_type(32)));
DI unsigned fp6_code(float y) {
  const float a = fminf(fabsf(y), 7.5f);
  float c = rintf(a * 8.f);
  c = a >= 2.f ? rintf(a * 4.f) + 8.f : c;
  c = a >= 4.f ? rintf(a * 2.f) + 16.f : c;
  unsigned u = (unsigned)c;
  u = u > 31u ? 31u : u;
  return u | ((__float_as_uint(y) >> 26) & 32u);
}
DI void cvt_table_fp6(const float* __restrict__ src, unsigned char* __restrict__ dst, float* __restrict__ inv, int bid, int nb) {
  const int lane = tidx() & 63, w = tidx() >> 6, r = lane & 31, h = lane >> 5;
  for (int rp = bid * 4 + w; rp < 8192; rp += nb * 4) {
    const int row = rp * 2 + h;
    const float4* sp = (const float4*)(src + (size_t)row * 1024 + r * 32);
    float v[32];
    float mx = 0.f;
#pragma unroll
    for (int i = 0; i < 8; ++i) {
      const float4 t = sp[i];
      v[4 * i] = t.x; v[4 * i + 1] = t.y; v[4 * i + 2] = t.z; v[4 * i + 3] = t.w;
      mx = fmaxf(fmaxf(mx, fmaxf(fabsf(t.x), fabsf(t.y))), fmaxf(fabsf(t.z), fabsf(t.w)));
    }
#pragma unroll
    for (int o = 16; o >= 1; o >>= 1) mx = fmaxf(mx, __shfl_xor(mx, o));
    const float sc = mx > 0.f ? 7.5f / mx : 1.f;
    unsigned c[32];
#pragma unroll
    for (int i = 0; i < 32; ++i) c[i] = fp6_code(v[i] * sc);
    unsigned d[6];
#pragma unroll
    for (int g = 0; g < 2; ++g) {
      const unsigned* q = c + 16 * g;
      d[3 * g + 0] = q[0] | (q[1] << 6) | (q[2] << 12) | (q[3] << 18) | (q[4] << 24) | (q[5] << 30);
      d[3 * g + 1] = (q[5] >> 2) | (q[6] << 4) | (q[7] << 10) | (q[8] << 16) | (q[9] << 22) | (q[10] << 28);
      d[3 * g + 2] = (q[10] >> 4) | (q[11] << 2) | (q[12] << 8) | (q[13] << 14) | (q[14] << 20) | (q[15] << 26);
    }
    uint2* dp = (uint2*)(dst + (size_t)row * 768 + r * 24);
    dp[0] = make_uint2(d[0], d[1]); dp[1] = make_uint2(d[2], d[3]); dp[2] = make_uint2(d[4], d[5]);
    if (r == 0) inv[row] = mx > 0.f ? mx * (1.f / 7.5f) : 1.f;
  }
}
DI void phase_cvt_tables(const Params& p, int layer) {
  const int nb = gridDim.x / 2, bid = blockIdx.x % nb;
  const int rows_lo = (blockIdx.x < nb) ? 0 : 1;
  cvt_table_fp6(p.peer_u + (size_t)layer * 16384 * 1024, (unsigned char*)(p.ws + OFF_TBL_U) + (size_t)layer * 16 * MiB, (float*)(p.ws + OFF_INV) + (layer * 2 + 0) * 16384, bid * 2 + rows_lo, nb * 2);
  cvt_table_fp6(p.peer_v + (size_t)layer * 16384 * 1024, (unsigned char*)(p.ws + OFF_TBL_V) + (size_t)layer * 16 * MiB, (float*)(p.ws + OFF_INV) + (layer * 2 + 1) * 16384, bid * 2 + rows_lo, nb * 2);
}

DI void phase_rmsnorm(const float* __restrict__ src, const float* __restrict__ gain, bf16_t* __restrict__ dst) {
  const int lane = tidx() & 63, w = tidx() >> 6;
  for (int row = blockIdx.x * 4 + w; row < T_TOK; row += gridDim.x * 4) {
    const float4* sp = (const float4*)(src + (size_t)row * DM);
    float4 v[4];
    float ss = 0.f;
#pragma unroll
    for (int i = 0; i < 4; ++i) { v[i] = sp[lane + 64 * i]; ss += v[i].x * v[i].x + v[i].y * v[i].y + v[i].z * v[i].z + v[i].w * v[i].w; }
#pragma unroll
    for (int o = 32; o >= 1; o >>= 1) ss += __shfl_xor(ss, o);
    const float rs = rsqrtf(ss * (1.f / 1024.f) + 1e-6f);
#pragma unroll
    for (int i = 0; i < 4; ++i) {
      const float4 g = ((const float4*)gain)[lane + 64 * i];
      uint2 o2 = make_uint2(pk(v[i].x * rs * g.x, v[i].y * rs * g.y), pk(v[i].z * rs * g.z, v[i].w * rs * g.w));
      *(uint2*)(dst + (size_t)row * DM + (lane + 64 * i) * 4) = o2;
    }
  }
}

DI void mma_64x64(const bf16_t* sA, const bf16_t* sB, int arow0, int brow0, f32x16 (&acc)[2][2], int lane) {
  const int r = lane & 31, h = lane >> 5;
#pragma unroll
  for (int s = 0; s < 4; ++s) {
    bf16x8 a[2], b[2];
#pragma unroll
    for (int mi = 0; mi < 2; ++mi) a[mi] = *(const bf16x8*)(sA + (arow0 + mi * 32 + r) * LDK + s * 16 + h * 8);
#pragma unroll
    for (int ni = 0; ni < 2; ++ni) b[ni] = *(const bf16x8*)(sB + (brow0 + ni * 32 + r) * LDK + s * 16 + h * 8);
#pragma unroll
    for (int mi = 0; mi < 2; ++mi)
#pragma unroll
      for (int ni = 0; ni < 2; ++ni) acc[mi][ni] = mfma32(a[mi], b[ni], acc[mi][ni]);
  }
}

enum { EPI_GLA_IN = 0, EPI_RESID_X = 1, EPI_BF16 = 2, EPI_RESID_INPLACE = 3, EPI_SWA_IN = 4, EPI_PEER_Q = 5 };
DI void peer_topk_core(const Params& p, int layer, int head, int tok0, const bf16_t* qbase, int qstride);

template <int MODE>
DI void phase_gemm(const Params& p, const bf16_t* __restrict__ A, const bf16_t* __restrict__ Bt, int NT, bf16_t* dstb, int ldc,
                   const float* __restrict__ bias, char* smem) {
  const int ntiles = (T_TOK / 128) * NT;
  int t = (gridDim.x & 7) ? (int)blockIdx.x : (int)((blockIdx.x & 7) * (gridDim.x >> 3) + (blockIdx.x >> 3));
  if (t >= ntiles) return;
  bf16_t* sA = (bf16_t*)smem;
  bf16_t* sB = sA + 128 * LDK;
  bf16_t* ct = (bf16_t*)smem;
  const int tid = tidx(), lane = tid & 63, w = tid >> 6, wm = w >> 1, wn = w & 1;
  const int r = lane & 31, h = lane >> 5;
  const int lrow = tid >> 3, kc = tid & 7;
  bf16_t* wa = sA + lrow * LDK + kc * 8;
  bf16_t* wb = sB + lrow * LDK + kc * 8;
  bf16x8 ra0[4], rb0[4], ra1[4], rb1[4];
  int m0 = (t / NT) * 128, n0 = (t % NT) * 128;
  const bf16_t* ap = A + (size_t)(m0 + lrow) * 1024 + kc * 8;
  const bf16_t* bp = Bt + (size_t)(n0 + lrow) * 1024 + kc * 8;
#define GLOAD(RA, RB, KT) _Pragma("unroll") for (int i = 0; i < 4; ++i) { RA[i] = *(const bf16x8*)(ap + (size_t)i * 32 * 1024 + (KT) * 64); RB[i] = *(const bf16x8*)(bp + (size_t)i * 32 * 1024 + (KT) * 64); }
#define SSTORE(RA, RB) _Pragma("unroll") for (int i = 0; i < 4; ++i) { *(bf16x8*)(wa + 32 * i * LDK) = RA[i]; *(bf16x8*)(wb + 32 * i * LDK) = RB[i]; }
  GLOAD(ra0, rb0, 0)
  GLOAD(ra1, rb1, 1)
  for (; t < ntiles; t += gridDim.x) {
    f32x16 acc[2][2];
#pragma unroll
    for (int i = 0; i < 2; ++i)
#pragma unroll
      for (int j = 0; j < 2; ++j) acc[i][j] = zero16();
    __syncthreads();
    SSTORE(ra0, rb0)
    __syncthreads();
    for (int kt = 0; kt < 16; kt += 2) {
      if (kt + 2 < 16) { GLOAD(ra0, rb0, kt + 2) }
      mma_64x64(sA, sB, wm * 64, wn * 64, acc, lane);
      __syncthreads();
      SSTORE(ra1, rb1)
      __syncthreads();
      if (kt + 3 < 16) { GLOAD(ra1, rb1, kt + 3) }
      mma_64x64(sA, sB, wm * 64, wn * 64, acc, lane);
      __syncthreads();
      if (kt + 2 < 16) {
        SSTORE(ra0, rb0)
        __syncthreads();
      }
    }
    const int cm0 = m0, cn0 = n0;
    if (MODE != EPI_PEER_Q) {
      const int tn = t + gridDim.x;
      if (tn < ntiles) {
        m0 = (tn / NT) * 128; n0 = (tn % NT) * 128;
        ap = A + (size_t)(m0 + lrow) * 1024 + kc * 8;
        bp = Bt + (size_t)(n0 + lrow) * 1024 + kc * 8;
        GLOAD(ra0, rb0, 0)
        GLOAD(ra1, rb1, 1)
      }
    }
    const bool staged = (MODE == EPI_BF16) || (MODE == EPI_SWA_IN) || (MODE == EPI_PEER_Q) || (MODE == EPI_GLA_IN && cn0 < 3072);
    if (staged) {
#pragma unroll
      for (int ni = 0; ni < 2; ++ni) {
        const int col = wn * 64 + ni * 32 + r;
        const float bv = ((MODE == EPI_BF16 || MODE == EPI_SWA_IN) && bias) ? bias[cn0 + col] : 0.f;
#pragma unroll
        for (int mi = 0; mi < 2; ++mi)
#pragma unroll
          for (int i = 0; i < 16; ++i) ct[(wm * 64 + mi * 32 + crow(i, h)) * 136 + col] = f2bf(acc[mi][ni][i] + bv);
      }
      __syncthreads();
      if (MODE == EPI_SWA_IN && cn0 < 1152) {
        const int row = tid >> 1, hd = tid & 1;
        bf16_t* hp = ct + row * 136 + hd * 64;
        float ss = 0.f;
#pragma unroll
        for (int c8 = 0; c8 < 8; ++c8) {
          const uint4 wv = *(const uint4*)(hp + c8 * 8);
          const float f0 = bflo(wv.x), f1 = bfhi(wv.x), f2 = bflo(wv.y), f3 = bfhi(wv.y), f4 = bflo(wv.z), f5 = bfhi(wv.z), f6 = bflo(wv.w), f7 = bfhi(wv.w);
          ss += f0 * f0 + f1 * f1 + f2 * f2 + f3 * f3 + f4 * f4 + f5 * f5 + f6 * f6 + f7 * f7;
        }
        const float rs = rsqrtf(ss * (1.f / 64.f) + 1e-6f);
        const float* gain = (cn0 < 1024) ? p.swa_qn : p.swa_kn;
        const float qs = (cn0 < 1024) ? 0.125f : 1.f;
        {
          const uint4 w0 = *(const uint4*)hp, w1 = *(const uint4*)(hp + 8);
          float x1[8] = {bflo(w0.x), bfhi(w0.x), bflo(w0.y), bfhi(w0.y), bflo(w0.z), bfhi(w0.z), bflo(w0.w), bfhi(w0.w)};
          float x2[8] = {bflo(w1.x), bfhi(w1.x), bflo(w1.y), bfhi(w1.y), bflo(w1.z), bfhi(w1.z), bflo(w1.w), bfhi(w1.w)};
          const float posf = (float)p.pos[cm0 + row];
          const float invf[8] = {1.0f, 0.1939227432012558f, 0.03760603070259094f, 0.007292664609849453f,
                                 0.0014142135623842478f, 0.00027424818836152554f, 5.318296098266728e-05f, 1.0313386155758053e-05f};
#pragma unroll
          for (int e = 0; e < 8; ++e) {
            const float a1 = x1[e] * rs * gain[e], a2 = x2[e] * rs * gain[8 + e];
            const float ang = posf * invf[e];
            const double rev = (double)ang * 0.15915494309189535;
            const float fr = (float)(rev - rint(rev));
            const float sn = __builtin_amdgcn_sinf(fr), cs = __builtin_amdgcn_cosf(fr);
            x1[e] = (a1 * cs - a2 * sn) * qs;
            x2[e] = (a2 * cs + a1 * sn) * qs;
          }
          *(uint4*)hp = make_uint4(pk(x1[0], x1[1]), pk(x1[2], x1[3]), pk(x1[4], x1[5]), pk(x1[6], x1[7]));
          *(uint4*)(hp + 8) = make_uint4(pk(x2[0], x2[1]), pk(x2[2], x2[3]), pk(x2[4], x2[5]), pk(x2[6], x2[7]));
        }
#pragma unroll
        for (int c8 = 2; c8 < 8; ++c8) {
          const uint4 wv = *(const uint4*)(hp + c8 * 8);
          const float* g = gain + c8 * 8;
          const float sc = rs * qs;
          *(uint4*)(hp + c8 * 8) = make_uint4(pk(bflo(wv.x) * sc * g[0], bfhi(wv.x) * sc * g[1]), pk(bflo(wv.y) * sc * g[2], bfhi(wv.y) * sc * g[3]),
                                              pk(bflo(wv.z) * sc * g[4], bfhi(wv.z) * sc * g[5]), pk(bflo(wv.w) * sc * g[6], bfhi(wv.w) * sc * g[7]));
        }
        __syncthreads();
      }
      if (MODE == EPI_PEER_Q) {
        peer_topk_core(p, ldc, cn0 >> 7, cm0 + w * 32, ct + (w * 32) * 136, 136);
        __builtin_amdgcn_sched_barrier(0);
        const int tn = t + gridDim.x;
        if (tn < ntiles) {
          m0 = (tn / NT) * 128; n0 = (tn % NT) * 128;
          ap = A + (size_t)(m0 + lrow) * 1024 + kc * 8;
          bp = Bt + (size_t)(n0 + lrow) * 1024 + kc * 8;
          GLOAD(ra0, rb0, 0)
          GLOAD(ra1, rb1, 1)
        }
      } else {
        const int ldo = (MODE == EPI_GLA_IN) ? 3072 : ldc;
#pragma unroll
        for (int j = 0; j < 8; ++j) {
          const int c = tid + 256 * j, row = c >> 4, cc = c & 15;
          *(uint4*)(dstb + (size_t)(cm0 + row) * ldo + cn0 + cc * 8) = *(const uint4*)(ct + row * 136 + cc * 8);
        }
      }
    } else {
      const unsigned row0 = (unsigned)(cm0 + wm * 64 + 4 * h), col0 = (unsigned)(cn0 + wn * 64 + r);
      float* __restrict__ lrp = (float*)(p.ws + OFF_LR);
#pragma unroll
      for (int ni = 0; ni < 2; ++ni) {
        const unsigned col = col0 + ni * 32;
        float bv = 0.f;
        if (MODE == EPI_RESID_INPLACE) bv = bias[col];
        const unsigned i0 = row0 * 1024u + col;
        const unsigned l0 = row0 * 16u + (col - 3072u);
#pragma unroll
        for (int mi = 0; mi < 2; ++mi)
#pragma unroll
          for (int i = 0; i < 16; ++i) {
            const unsigned ro = (unsigned)(mi * 32 + (i & 3) + 8 * (i >> 2));
            const float v = acc[mi][ni][i];
            if (MODE == EPI_GLA_IN) { if (col < 3088u) lrp[l0 + ro * 16u] = v; }
            else if (MODE == EPI_RESID_X) p.out[i0 + ro * 1024u] = p.x[i0 + ro * 1024u] + v;
            else if (MODE == EPI_RESID_INPLACE) p.out[i0 + ro * 1024u] += v + bv;
          }
      }
    }
  }
#undef GLOAD
#undef SSTORE
}

DI float gate_la(const float* lr_s, int t, const float (&wa)[16], float ba) {
  float z = ba;
#pragma unroll
  for (int j = 0; j < 16; ++j) z += lr_s[t * 16 + j] * wa[j];
  return logsig(z) * (1.f / 16.f);
}
DI void gla_gates(const Params& p, int t0, int hh, float (&wa)[16], float& ba, float& offset, float& blast, float* lr_s, float* tot_s) {
  const int tid = tidx(), d = tid & 127, half = tid >> 7;
  const float* LR = (const float*)(p.ws + OFF_LR);
  ((float4*)lr_s)[tid] = ((const float4*)(LR + (size_t)t0 * 16))[tid];
#pragma unroll
  for (int j = 0; j < 16; ++j) wa[j] = p.gla_w_alpha[j * 512 + hh * 128 + d];
  ba = p.gla_b_alpha[hh * 128 + d];
  __syncthreads();
  float sum = 0.f;
#pragma unroll 4
  for (int tt = 0; tt < 32; ++tt) sum += gate_la(lr_s, half * 32 + tt, wa, ba);
  tot_s[half * 128 + d] = sum;
  __syncthreads();
  offset = half ? tot_s[d] : 0.f;
  blast = tot_s[d] + tot_s[128 + d];
}

DI void fill_vT(const bf16_t* __restrict__ QKVR, int t0, int hh, int vh, bf16_t* vT) {
  const int tid = tidx(), v = tid & 127, half = tid >> 7;
#pragma unroll 8
  for (int tt = 0; tt < 32; ++tt) {
    const int t = half * 32 + tt;
    vT[v * LDK + t] = QKVR[(size_t)(t0 + t) * 3072 + 1024 + hh * 256 + vh * 128 + v];
  }
}

DI void gla_phase1(const Params& p, int item, char* smem) {
  const int hh = item & 3, c = (item >> 2) & 255, b = item >> 10;
  const int t0 = b * SEQ + c * 64;
  float* lr_s = (float*)smem;
  float* tot_s = (float*)(smem + 4096);
  bf16_t* kfT = (bf16_t*)(smem + 5120);
  bf16_t* vT = kfT + 128 * LDK;
  const bf16_t* QKVR = (const bf16_t*)(p.ws + OFF_BIG);
  bf16_t* KVT = (bf16_t*)(p.ws + OFF_KVT);
  float* DECAY = (float*)(p.ws + OFF_DECAY);
  const int tid = tidx(), lane = tid & 63, w = tid >> 6, wm = w >> 1, wn = w & 1;
  const int d = tid & 127, half = tid >> 7;
  float wa[16], ba, offset, blast;
  gla_gates(p, t0, hh, wa, ba, offset, blast, lr_s, tot_s);
  float run = offset;
#pragma unroll 4
  for (int tt = 0; tt < 32; ++tt) {
    const int t = half * 32 + tt;
    run += gate_la(lr_s, t, wa, ba);
    ((float*)(p.ws + OFF_ACT_A))[(size_t)(t0 + t) * 512 + hh * 128 + d] = run;
    const float kv = bf2f(QKVR[(size_t)(t0 + t) * 3072 + 512 + hh * 128 + d]);
    kfT[d * LDK + t] = f2bf(kv * __expf(blast - run));
  }
  if (half == 0) DECAY[(size_t)item * 128 + d] = __expf(blast);
  const int r = lane & 31, h = lane >> 5;
  for (int vh = 0; vh < 2; ++vh) {
    __syncthreads();
    fill_vT(QKVR, t0, hh, vh, vT);
    __syncthreads();
    f32x16 acc[2][2];
#pragma unroll
    for (int i = 0; i < 2; ++i)
#pragma unroll
      for (int j = 0; j < 2; ++j) acc[i][j] = zero16();
    mma_64x64(vT, kfT, wm * 64, wn * 64, acc, lane);
    bf16_t* kbase = KVT + (size_t)item * 32768 + (vh * 128 + wm * 64 + 4 * h) * 128 + wn * 64 + r;
#pragma unroll
    for (int mi = 0; mi < 2; ++mi)
#pragma unroll
      for (int ni = 0; ni < 2; ++ni)
#pragma unroll
        for (int i = 0; i < 16; ++i) kbase[(mi * 32 + (i & 3) + 8 * (i >> 2)) * 128 + ni * 32] = f2bf(acc[mi][ni][i]);
  }
  __syncthreads();
}

DI void gla_scan(const Params& p) {
  bf16_t* KVT = (bf16_t*)(p.ws + OFF_KVT);
  const float* DECAY = (const float*)(p.ws + OFF_DECAY);
  for (int idx = blockIdx.x * 256 + tidx(); idx < 8 * 16384; idx += gridDim.x * 256) {
    const int bh = idx >> 14, e2 = idx & 16383, b = bh >> 2, hh = bh & 3, d0 = (2 * e2) & 127;
    float s0 = 0.f, s1 = 0.f;
    for (int c0 = 0; c0 < 256; c0 += 8) {
      unsigned kv[8]; float2 dc[8];
#pragma unroll
      for (int u = 0; u < 8; ++u) {
        const size_t item = (size_t)(b * 256 + c0 + u) * 4 + hh;
        kv[u] = *(const unsigned*)(KVT + item * 32768 + 2 * e2);
        dc[u] = *(const float2*)(DECAY + item * 128 + d0);
      }
#pragma unroll
      for (int u = 0; u < 8; ++u) {
        const size_t item = (size_t)(b * 256 + c0 + u) * 4 + hh;
        *(unsigned*)(KVT + item * 32768 + 2 * e2) = pk(s0, s1);
        s0 = dc[u].x * s0 + bflo(kv[u]);
        s1 = dc[u].y * s1 + bfhi(kv[u]);
      }
    }
  }
}

DI void gla_phase3(const Params& p, int item, char* smem) {
  const int hh = item & 3, c = (item >> 2) & 255, b = item >> 10;
  const int t0 = b * SEQ + c * 64;
  float* lr_s = (float*)smem;
  float* tot_s = (float*)(smem + 4096);
  bf16_t* qd = (bf16_t*)(smem + 5120);
  bf16_t* ki = qd + 64 * 136;
  bf16_t* at = ki + 64 * 136;
  bf16_t* vT = at + 64 * 72;
  bf16_t* ot = qd;
  const bf16_t* QKVR = (const bf16_t*)(p.ws + OFF_BIG);
  const bf16_t* ST = (const bf16_t*)(p.ws + OFF_KVT);
  bf16_t* OG = (bf16_t*)(p.ws + OFF_ACT_A);
  const int tid = tidx(), lane = tid & 63, w = tid >> 6;
  const int d = tid & 127, half = tid >> 7;
  const int r = lane & 31, h = lane >> 5;
  {
    const float* Bc = (const float*)(p.ws + OFF_ACT_A);
#pragma unroll 8
    for (int tt = 0; tt < 32; ++tt) {
      const int t = half * 32 + tt;
      const float run = Bc[(size_t)(t0 + t) * 512 + hh * 128 + d];
      const float q = bf2f(QKVR[(size_t)(t0 + t) * 3072 + hh * 128 + d]);
      const float k = bf2f(QKVR[(size_t)(t0 + t) * 3072 + 512 + hh * 128 + d]);
      qd[t * 136 + d] = f2bf(q * 0.08838834764831845f * __expf(run));
      ki[t * 136 + d] = f2bf(k * __expf(-run));
    }
  }
  __syncthreads();
  {
    const int mi = w >> 1, nj = w & 1;
    f32x16 a = zero16();
#pragma unroll
    for (int s = 0; s < 8; ++s) {
      const bf16x8 A = *(const bf16x8*)(qd + (mi * 32 + r) * 136 + s * 16 + h * 8);
      const bf16x8 B = *(const bf16x8*)(ki + (nj * 32 + r) * 136 + s * 16 + h * 8);
      a = mfma32(A, B, a);
    }
#pragma unroll
    for (int i = 0; i < 16; ++i) {
      const int it = mi * 32 + crow(i, h), jt = nj * 32 + r;
      at[it * 72 + jt] = f2bf(jt <= it ? a[i] : 0.f);
    }
  }
  f32x16 o[2][2];
#pragma unroll
  for (int i = 0; i < 2; ++i)
#pragma unroll
    for (int j = 0; j < 2; ++j) o[i][j] = zero16();
#pragma unroll
  for (int vh = 0; vh < 2; ++vh) {
    __syncthreads();
    fill_vT(QKVR, t0, hh, vh, vT);
    __syncthreads();
#pragma unroll
    for (int s = 0; s < 4; ++s) {
      const bf16x8 B = *(const bf16x8*)(vT + (w * 32 + r) * LDK + s * 16 + h * 8);
#pragma unroll
      for (int mt = 0; mt < 2; ++mt) {
        const bf16x8 A = *(const bf16x8*)(at + (mt * 32 + r) * 72 + s * 16 + h * 8);
        o[vh][mt] = mfma32(A, B, o[vh][mt]);
      }
    }
    const bf16_t* Sg = ST + (size_t)item * 32768 + (size_t)(vh * 128 + w * 32 + r) * 128 + h * 8;
#pragma unroll
    for (int s = 0; s < 8; ++s) {
      const bf16x8 B = *(const bf16x8*)(Sg + s * 16);
#pragma unroll
      for (int mt = 0; mt < 2; ++mt) {
        const bf16x8 A = *(const bf16x8*)(qd + (mt * 32 + r) * 136 + s * 16 + h * 8);
        o[vh][mt] = mfma32(A, B, o[vh][mt]);
      }
    }
  }
  __syncthreads();
#pragma unroll
  for (int vh = 0; vh < 2; ++vh)
#pragma unroll
    for (int mt = 0; mt < 2; ++mt)
#pragma unroll
      for (int i = 0; i < 16; ++i) ot[(mt * 32 + crow(i, h)) * 264 + vh * 128 + w * 32 + r] = f2bf(o[vh][mt][i]);
  __syncthreads();
  {
    const int row = tid >> 2, seg = tid & 3;
    const bf16_t* orow = ot + row * 264 + seg * 64;
    float ss = 0.f;
#pragma unroll
    for (int c8 = 0; c8 < 8; ++c8) {
      const uint4 ov = *(const uint4*)(orow + c8 * 8);
      const float f0 = bflo(ov.x), f1 = bfhi(ov.x), f2 = bflo(ov.y), f3 = bfhi(ov.y), f4 = bflo(ov.z), f5 = bfhi(ov.z), f6 = bflo(ov.w), f7 = bfhi(ov.w);
      ss += f0 * f0 + f1 * f1 + f2 * f2 + f3 * f3 + f4 * f4 + f5 * f5 + f6 * f6 + f7 * f7;
    }
    ss += __shfl_xor(ss, 1);
    ss += __shfl_xor(ss, 2);
    const float rs = rsqrtf(ss * (1.f / 256.f) + 1e-6f);
    const bf16_t* rrow = QKVR + (size_t)(t0 + row) * 3072 + 2048 + hh * 256 + seg * 64;
    const float* grow = p.gla_norm + hh * 256 + seg * 64;
    bf16_t* dst = OG + (size_t)(t0 + row) * 1024 + hh * 256 + seg * 64;
#pragma unroll
    for (int c8 = 0; c8 < 8; ++c8) {
      const uint4 ov = *(const uint4*)(orow + c8 * 8);
      const uint4 rv = *(const uint4*)(rrow + c8 * 8);
      const float4 g0 = *(const float4*)(grow + c8 * 8), g1 = *(const float4*)(grow + c8 * 8 + 4);
      float of[8] = {bflo(ov.x), bfhi(ov.x), bflo(ov.y), bfhi(ov.y), bflo(ov.z), bfhi(ov.z), bflo(ov.w), bfhi(ov.w)};
      float rf[8] = {bflo(rv.x), bfhi(rv.x), bflo(rv.y), bfhi(rv.y), bflo(rv.z), bfhi(rv.z), bflo(rv.w), bfhi(rv.w)};
      float gf[8] = {g0.x, g0.y, g0.z, g0.w, g1.x, g1.y, g1.z, g1.w};
      float res[8];
#pragma unroll
      for (int e = 0; e < 8; ++e) res[e] = of[e] * rs * gf[e] * (rf[e] / (1.f + __expf(-rf[e])));
      *(uint4*)(dst + c8 * 8) = make_uint4(pk(res[0], res[1]), pk(res[2], res[3]), pk(res[4], res[5]), pk(res[6], res[7]));
    }
  }
  __syncthreads();
}

DI void swa_qknorm(const Params& p) {
  bf16_t* QKV = (bf16_t*)(p.ws + OFF_BIG);
  const int tid = tidx(), sub = tid & 7;
  const int ngroups = T_TOK * 18;
  for (int g = blockIdx.x * 32 + (tid >> 3); g < ngroups; g += gridDim.x * 32) {
    const int tok = g / 18, slot = g - tok * 18;
    bf16_t* ptr = QKV + (size_t)tok * 1280 + slot * 64 + sub * 8;
    const uint4 wv = *(const uint4*)ptr;
    float v[8] = {bflo(wv.x), bfhi(wv.x), bflo(wv.y), bfhi(wv.y), bflo(wv.z), bfhi(wv.z), bflo(wv.w), bfhi(wv.w)};
    float ss = 0.f;
#pragma unroll
    for (int e = 0; e < 8; ++e) ss += v[e] * v[e];
    ss += __shfl_xor(ss, 1);
    ss += __shfl_xor(ss, 2);
    ss += __shfl_xor(ss, 4);
    const float rs = rsqrtf(ss * (1.f / 64.f) + 1e-6f);
    const float* gain = (slot < 16 ? p.swa_qn : p.swa_kn) + sub * 8;
#pragma unroll
    for (int e = 0; e < 8; ++e) v[e] = v[e] * rs * gain[e];
    const float posf = (float)p.pos[tok];
    const float invf[8] = {1.0f, 0.1939227432012558f, 0.03760603070259094f, 0.007292664609849453f,
                           0.0014142135623842478f, 0.00027424818836152554f, 5.318296098266728e-05f, 1.0313386155758053e-05f};
#pragma unroll
    for (int e = 0; e < 8; ++e) {
      const float other = __shfl_xor(v[e], 1);
      if (sub < 2) {
        const float ang = posf * invf[e];
        const double rev = (double)ang * 0.15915494309189535;
        const float fr = (float)(rev - rint(rev));
        const float sn = __builtin_amdgcn_sinf(fr), cs = __builtin_amdgcn_cosf(fr);
        v[e] = (sub == 0) ? (v[e] * cs - other * sn) : (v[e] * cs + other * sn);
      }
    }
    if (slot < 16) {
#pragma unroll
      for (int e = 0; e < 8; ++e) v[e] *= 0.125f;
    }
    *(uint4*)ptr = make_uint4(pk(v[0], v[1]), pk(v[2], v[3]), pk(v[4], v[5]), pk(v[6], v[7]));
  }
}

DI void swa_attn(const Params& p, int item, char* smem) {
  const int hq = item & 15, n = (item >> 4) & 127, b = item >> 11, hkv = hq >> 3;
  const int tok0 = b * SEQ + n * 128;
  bf16_t* Ks = (bf16_t*)smem;
  bf16_t* vT = Ks + 256 * 72;
  const bf16_t* QKV = (const bf16_t*)(p.ws + OFF_BIG);
  bf16_t* OUT = (bf16_t*)(p.ws + OFF_ACT_B);
  const int tid = tidx(), lane = tid & 63, w = tid >> 6, r = lane & 31, h = lane >> 5;
  __syncthreads();
#pragma unroll
  for (int i = 0; i < 8; ++i) {
    const int cidx = tid + 256 * i, kk = cidx >> 3, kc = cidx & 7;
    const int pos = n * 128 - 128 + kk;
    uint4 kw = make_uint4(0, 0, 0, 0), vw = make_uint4(0, 0, 0, 0);
    if (pos >= 0) {
      const bf16_t* base = QKV + (size_t)(b * SEQ + pos) * 1280;
      kw = *(const uint4*)(base + 1024 + hkv * 64 + kc * 8);
      vw = *(const uint4*)(base + 1152 + hkv * 64 + kc * 8);
    }
    *(uint4*)(Ks + kk * 72 + kc * 8) = kw;
    bf16_t* vd = vT + (kc * 8) * 264 + kk;
    vd[0 * 264] = (bf16_t)(vw.x & 0xffff); vd[1 * 264] = (bf16_t)(vw.x >> 16);
    vd[2 * 264] = (bf16_t)(vw.y & 0xffff); vd[3 * 264] = (bf16_t)(vw.y >> 16);
    vd[4 * 264] = (bf16_t)(vw.z & 0xffff); vd[5 * 264] = (bf16_t)(vw.z >> 16);
    vd[6 * 264] = (bf16_t)(vw.w & 0xffff); vd[7 * 264] = (bf16_t)(vw.w >> 16);
  }
  __syncthreads();
  const int iq = 32 * w + r;
  const bf16_t* qrow = QKV + (size_t)(tok0 + iq) * 1280 + hq * 64 + h * 8;
  bf16x8 qf[4];
#pragma unroll
  for (int s = 0; s < 4; ++s) qf[s] = *(const bf16x8*)(qrow + s * 16);
  f32x16 X[5];
#pragma unroll
  for (int kt = 0; kt < 5; ++kt) {
    X[kt] = zero16();
#pragma unroll
    for (int s = 0; s < 4; ++s) {
      const bf16x8 A = *(const bf16x8*)(Ks + ((w + kt) * 32 + r) * 72 + s * 16 + h * 8);
      X[kt] = mfma32(A, qf[s], X[kt]);
    }
  }
  const float sink = p.swa_sinks[hq];
  float m = sink;
#pragma unroll
  for (int kt = 0; kt < 5; ++kt)
#pragma unroll
    for (int i = 0; i < 16; ++i) {
      const int kk = (w + kt) * 32 + crow(i, h);
      const bool valid = (kk > iq) && (kk <= iq + 128) && (n > 0 || kk >= 128);
      const float xv = valid ? X[kt][i] : -INFINITY;
      X[kt][i] = xv;
      m = fmaxf(m, xv);
    }
  m = fmaxf(m, __shfl_xor(m, 32));
  float l = 0.f;
#pragma unroll
  for (int kt = 0; kt < 5; ++kt)
#pragma unroll
    for (int i = 0; i < 16; ++i) {
      const float pv = __expf(X[kt][i] - m);
      X[kt][i] = pv;
      l += pv;
    }
  l += __shfl_xor(l, 32);
  l += __expf(sink - m);
  f32x16 O[2];
  O[0] = zero16(); O[1] = zero16();
#pragma unroll
  for (int kt = 0; kt < 5; ++kt)
#pragma unroll
    for (int s2 = 0; s2 < 2; ++s2) {
      const uint4 pw = make_uint4(pk(X[kt][8 * s2 + 0], X[kt][8 * s2 + 1]), pk(X[kt][8 * s2 + 2], X[kt][8 * s2 + 3]),
                                  pk(X[kt][8 * s2 + 4], X[kt][8 * s2 + 5]), pk(X[kt][8 * s2 + 6], X[kt][8 * s2 + 7]));
      const bf16x8 P = __builtin_bit_cast(bf16x8, pw);
#pragma unroll
      for (int mt = 0; mt < 2; ++mt) {
        const bf16_t* vp = vT + (mt * 32 + r) * 264 + (w + kt) * 32 + 16 * s2 + 4 * h;
        const uint2 lo = *(const uint2*)vp, hi = *(const uint2*)(vp + 8);
        const bf16x8 A = __builtin_bit_cast(bf16x8, make_uint4(lo.x, lo.y, hi.x, hi.y));
        O[mt] = mfma32(A, P, O[mt]);
      }
    }
  const float inv = 1.f / l;
  bf16_t* orow = OUT + (size_t)(tok0 + iq) * 1024 + hq * 64 + 4 * h;
#pragma unroll
  for (int mt = 0; mt < 2; ++mt)
#pragma unroll
    for (int g = 0; g < 4; ++g)
      *(uint2*)(orow + mt * 32 + 8 * g) = make_uint2(pk(O[mt][4 * g] * inv, O[mt][4 * g + 1] * inv), pk(O[mt][4 * g + 2] * inv, O[mt][4 * g + 3] * inv));
}

DI unsigned fkey_u(unsigned u) { return u ^ ((unsigned)((int)u >> 31) | 0x80000000u); }
DI float unfkey(unsigned k) { return __uint_as_float(k ^ ((~(unsigned)((int)k >> 31)) | 0x80000000u)); }
DI void cswap(unsigned& a, unsigned& b) { const unsigned hi = a > b ? a : b, lo = a > b ? b : a; a = hi; b = lo; }
DI void sort16(unsigned (&t)[16]) {
#pragma unroll
  for (int k = 2; k <= 16; k <<= 1)
#pragma unroll
    for (int j = k >> 1; j > 0; j >>= 1)
#pragma unroll
      for (int i = 0; i < 16; ++i) {
        const int l = i ^ j;
        if (l > i) { if ((i & k) == 0) cswap(t[i], t[l]); else cswap(t[l], t[i]); }
      }
}
DI void merge16(unsigned (&a)[16], const unsigned (&b)[16]) {
#pragma unroll
  for (int j = 0; j < 16; ++j) a[j] = a[j] > b[15 - j] ? a[j] : b[15 - j];
#pragma unroll
  for (int j = 8; j > 0; j >>= 1)
#pragma unroll
    for (int i = 0; i < 16; ++i) { const int l = i ^ j; if (l > i) cswap(a[i], a[l]); }
}
DI void cswap2(unsigned& ak, int& ap, unsigned& bk, int& bp) {
  const bool sw = bk > ak;
  const unsigned hk = sw ? bk : ak, lk = sw ? ak : bk;
  const int hp = sw ? bp : ap, lp = sw ? ap : bp;
  ak = hk; ap = hp; bk = lk; bp = lp;
}
DI void sort16p(unsigned (&t)[16], int (&q)[16]) {
#pragma unroll
  for (int k = 2; k <= 16; k <<= 1)
#pragma unroll
    for (int j = k >> 1; j > 0; j >>= 1)
#pragma unroll
      for (int i = 0; i < 16; ++i) {
        const int l = i ^ j;
        if (l > i) { if ((i & k) == 0) cswap2(t[i], q[i], t[l], q[l]); else cswap2(t[l], q[l], t[i], q[i]); }
      }
}
__device__ constexpr int CIA[25] = {0,0,0,0,0,0,0,0,0,0,0,0,0,0,0,0, 2,2,2,2,2, 3,3,3,3};
__device__ constexpr int CJA[25] = {0,1,2,3,4,5,6,7,8,9,10,11,12,13,14,15, 0,1,2,3,4, 0,1,2,3};
__device__ constexpr int CIB[25] = {1,1,1,1,1,1,1,1, 4,4,4, 5,5,6,6,7,7, 8,9,10,11,12,13,14,15};
__device__ constexpr int CJB[25] = {0,1,2,3,4,5,6,7, 0,1,2, 0,1,0,1,0,1, 0,0,0,0,0,0,0,0};

DI void peer_topk_core(const Params& p, int layer, int head, int tok0, const bf16_t* qbase, int qstride) {
  const bf16_t* KEYS = (const bf16_t*)(p.ws + OFF_KEYS) + (size_t)(layer * 8 + head) * 256 * 64;
  int* E = (int*)(p.ws + OFF_E);
  float* G = (float*)(p.ws + OFF_G);
  const int lane = tidx() & 63, r = lane & 31, h = lane >> 5;
  const unsigned h4 = 4u * (1u - (unsigned)h);
  unsigned tl[2][16];
#pragma unroll
  for (int set = 0; set < 2; ++set) {
    bf16x8 qf[4];
    {
      const bf16_t* qrow = qbase + r * qstride + set * 64 + h * 8;
#pragma unroll
      for (int s = 0; s < 4; ++s) qf[s] = *(const bf16x8*)(qrow + s * 16);
    }
#pragma unroll
    for (int hf = 0; hf < 2; ++hf) {
      bf16x8 kf[2][4];
#pragma unroll
      for (int t2 = 0; t2 < 2; ++t2)
#pragma unroll
        for (int s = 0; s < 4; ++s) kf[t2][s] = *(const bf16x8*)(KEYS + (size_t)(set * 128 + (2 * hf + t2) * 32 + r) * 64 + h * 8 + s * 16);
#pragma unroll
      for (int t2 = 0; t2 < 2; ++t2) {
        const int kt = 2 * hf + t2;
        f32x16 X = zero16();
#pragma unroll
        for (int s = 0; s < 4; ++s) X = mfma32(kf[t2][s], qf[s], X);
        unsigned kk[16];
#pragma unroll
        for (int i = 0; i < 16; ++i)
          kk[i] = (fkey_u(__float_as_uint(X[i])) & ~127u) + ((unsigned)(127 - kt * 32 - (i & 3) - 8 * (i >> 2) - 4) + h4);
        sort16(kk);
        if (kt == 0) {
#pragma unroll
          for (int i = 0; i < 16; ++i) tl[set][i] = kk[i];
        } else merge16(tl[set], kk);
      }
    }
  }
  __builtin_amdgcn_sched_barrier(0);
  unsigned mine[16], oth[16];
#pragma unroll
  for (int j = 0; j < 16; ++j) {
    const unsigned send = h ? tl[0][j] : tl[1][j];
    oth[j] = (unsigned)__shfl_xor((int)send, 32);
    mine[j] = h ? tl[1][j] : tl[0][j];
  }
  merge16(mine, oth);
  float v1[16], v2[16]; int i1[16], i2[16];
#pragma unroll
  for (int j = 0; j < 16; ++j) {
    const unsigned o = (unsigned)__shfl_xor((int)mine[j], 32);
    const unsigned A = h ? o : mine[j], B = h ? mine[j] : o;
    v1[j] = unfkey(A & ~127u); i1[j] = 127 - (int)(A & 127u);
    v2[j] = unfkey(B & ~127u); i2[j] = 127 - (int)(B & 127u);
  }
  __builtin_amdgcn_sched_barrier(0);
  unsigned ck[16], dk[16]; int cp[16], dp[16];
#pragma unroll
  for (int n = 0; n < 32; ++n) {
    unsigned key = 0u; int e = 0;
    if (n < 25) {
      const float sA = v1[CIA[n]] + v2[CJA[n]], sB = v1[CIB[n]] + v2[CJB[n]];
      const int eA = i1[CIA[n]] * 128 + i2[CJA[n]], eB = i1[CIB[n]] * 128 + i2[CJB[n]];
      key = fkey_u(__float_as_uint(h ? sB : sA)); e = h ? eB : eA;
    }
    if (n < 16) { ck[n] = key; cp[n] = e; } else { dk[n - 16] = key; dp[n - 16] = e; }
  }
  __builtin_amdgcn_sched_barrier(0);
  sort16p(ck, cp);
  __builtin_amdgcn_sched_barrier(0);
  sort16p(dk, dp);
  __builtin_amdgcn_sched_barrier(0);
#pragma unroll
  for (int j = 0; j < 16; ++j) { const bool sw = dk[15 - j] > ck[j]; ck[j] = sw ? dk[15 - j] : ck[j]; cp[j] = sw ? dp[15 - j] : cp[j]; }
#pragma unroll
  for (int j = 8; j > 0; j >>= 1)
#pragma unroll
    for (int i = 0; i < 16; ++i) { const int l = i ^ j; if (l > i) cswap2(ck[i], cp[i], ck[l], cp[l]); }
  unsigned fk[16]; int fe[16];
#pragma unroll
  for (int j = 0; j < 16; ++j) { dk[j] = (unsigned)__shfl_xor((int)ck[j], 32); dp[j] = __shfl_xor(cp[j], 32); }
#pragma unroll
  for (int j = 0; j < 16; ++j) {
    const bool sw = (dk[15 - j] > ck[j]) || (dk[15 - j] == ck[j] && dp[15 - j] > cp[j]);
    fk[j] = sw ? dk[15 - j] : ck[j]; fe[j] = sw ? dp[15 - j] : cp[j];
  }
  float sv[16], mx = -INFINITY;
#pragma unroll
  for (int j = 0; j < 16; ++j) { sv[j] = unfkey(fk[j]); mx = fmaxf(mx, sv[j]); }
  float sm = 0.f;
#pragma unroll
  for (int j = 0; j < 16; ++j) { sv[j] = __expf(sv[j] - mx); sm += sv[j]; }
  const float inv = 1.f / sm;
  const size_t o = ((size_t)(tok0 + r) * 8 + head) * 16 + h * 8;
  *(int4*)(E + o) = make_int4(fe[0], fe[1], fe[2], fe[3]);
  *(int4*)(E + o + 4) = make_int4(fe[4], fe[5], fe[6], fe[7]);
  *(float4*)(G + o) = make_float4(sv[0] * inv, sv[1] * inv, sv[2] * inv, sv[3] * inv);
  *(float4*)(G + o + 4) = make_float4(sv[4] * inv, sv[5] * inv, sv[6] * inv, sv[7] * inv);
}

DI v32f fp6x32(const uint2* p) {
  const uint2 a = p[0], b = p[1], c = p[2];
  v6u x; x[0] = a.x; x[1] = a.y; x[2] = b.x; x[3] = b.y; x[4] = c.x; x[5] = c.y;
  return __builtin_amdgcn_cvt_scalef32_pk32_f32_fp6(x, 1.0f);
}

typedef unsigned u2v __attribute__((ext_vector_type(2)));
typedef unsigned v16u __attribute__((ext_vector_type(16)));
typedef __bf16 v32bf __attribute__((ext_vector_type(32)));
DI v6u mk6(u2v a, u2v b, u2v c) { v6u x; x[0] = a[0]; x[1] = a[1]; x[2] = b[0]; x[3] = b[1]; x[4] = c[0]; x[5] = c[1]; return x; }

DI v6u ld6(const unsigned char* p) { const u2v* q = (const u2v*)p; return mk6(q[0], q[1], q[2]); }
#define U_LOAD2(RAW, M2) _Pragma("unroll") for (int mi = 0; mi < 2; ++mi) { \
    const unsigned char* up_ = U + (size_t)e_s[8 * ((M2) + mi) + grp8] * 768 + i8 * 24; \
    _Pragma("unroll") for (int k = 0; k < 4; ++k) RAW[4 * mi + k] = ld6(up_ + 192 * k); }
#define U_COMP2(RAW, M2) _Pragma("unroll") for (int mi = 0; mi < 2; ++mi) { \
    const int pidx = 8 * ((M2) + mi) + grp8; \
    float acc0 = 0.f, acc1 = 0.f, acc2 = 0.f, acc3 = 0.f; \
    _Pragma("unroll") for (int k = 0; k < 4; ++k) { \
      const v16u ub = __builtin_bit_cast(v16u, __builtin_amdgcn_cvt_scalef32_pk32_bf16_fp6(RAW[4 * mi + k], 1.0f)); \
      _Pragma("unroll") for (int i = 0; i < 16; i += 4) { \
        acc0 = dot2(ub[i], xp[k][i], acc0); acc1 = dot2(ub[i + 1], xp[k][i + 1], acc1); \
        acc2 = dot2(ub[i + 2], xp[k][i + 2], acc2); acc3 = dot2(ub[i + 3], xp[k][i + 3], acc3); } } \
    float acc = (acc0 + acc1) + (acc2 + acc3); \
    acc += __shfl_xor(acc, 1); acc += __shfl_xor(acc, 2); acc += __shfl_xor(acc, 4); \
    if (i8 == 0) a_s[pidx] = acc;              \
    __builtin_amdgcn_sched_barrier(0); }

DI void peer_gather_u(const Params& p, int layer, char* smem) {
  const int tid = tidx(), lane = tid & 63, w = tid >> 6, grp8 = lane >> 3, i8 = lane & 7;
  float* a_s = (float*)smem + w * 512;
  float* su_s = a_s + 128;
  float* gv_s = a_s + 256;
  int* e_s = (int*)(a_s + 384);
  const bf16_t* HN = (const bf16_t*)(p.ws + OFF_ACT_A);
  const unsigned char* U = (const unsigned char*)(p.ws + OFF_TBL_U) + (size_t)layer * 16 * MiB;
  const float* IU = (const float*)(p.ws + OFF_INV) + (layer * 2 + 0) * 16384;
  const float* IV = (const float*)(p.ws + OFF_INV) + (layer * 2 + 1) * 16384;
  const int* E = (const int*)(p.ws + OFF_E);
  const float* G = (const float*)(p.ws + OFF_G);
  float* A = (float*)(p.ws + OFF_A);
  for (int tok = blockIdx.x * 4 + w; tok < T_TOK; tok += gridDim.x * 4) {
    unsigned xp[4][16];
#pragma unroll
    for (int k = 0; k < 4; ++k) {
      const uint4* xq = (const uint4*)(HN + (size_t)tok * 1024 + (i8 + 8 * k) * 32);
#pragma unroll
      for (int q = 0; q < 4; ++q) { const uint4 x0 = xq[q]; xp[k][4 * q] = x0.x; xp[k][4 * q + 1] = x0.y; xp[k][4 * q + 2] = x0.z; xp[k][4 * q + 3] = x0.w; }
    }
    const int e0 = E[(size_t)tok * 128 + lane], e1 = E[(size_t)tok * 128 + 64 + lane];
    e_s[lane] = e0; e_s[64 + lane] = e1;
    const float su0 = IU[e0], su1 = IU[e1];
    const float gv0 = G[(size_t)tok * 128 + lane] * IV[e0], gv1 = G[(size_t)tok * 128 + 64 + lane] * IV[e1];
    wave_sync();
    v6u rA[8], rB[8];
    U_LOAD2(rA, 0)
#pragma unroll 1
    for (int m2 = 0; m2 < 16; m2 += 4) {
      U_LOAD2(rB, m2 + 2)
      U_COMP2(rA, m2)
      if (m2 + 4 < 16) { U_LOAD2(rA, m2 + 4) }
      U_COMP2(rB, m2 + 2)
    }
    wave_sync();
    {
      const float s0 = a_s[lane] * su0, s1 = a_s[64 + lane] * su1;
      A[(size_t)tok * 128 + lane] = 0.5f * s0 * (1.f + erff(s0 * 0.7071067811865476f)) * gv0;
      A[(size_t)tok * 128 + 64 + lane] = 0.5f * s1 * (1.f + erff(s1 * 0.7071067811865476f)) * gv1;
    }
    wave_sync();
  }
}

#define V_LOAD8(RAW, M8) _Pragma("unroll") for (int mi = 0; mi < 4; ++mi) RAW[mi] = ld6(V + (size_t)e_s[2 * ((M8) + mi) + h] * 768 + r * 24);
#define V_COMP8(RAW, M8) _Pragma("unroll") for (int mi = 0; mi < 4; ++mi) { \
    const float a = a_s[2 * ((M8) + mi) + h]; \
    const v32f vv = __builtin_amdgcn_cvt_scalef32_pk32_f32_fp6(RAW[mi], 1.0f); \
    _Pragma("unroll") for (int i = 0; i < 32; ++i) o[i] = fmaf(a, vv[i], o[i]); \
    __builtin_amdgcn_sched_barrier(0); }

DI void peer_gather_v(const Params& p, int layer, char* smem, const float* __restrict__ next_gain) {
  const int tid = tidx(), lane = tid & 63, w = tid >> 6, r = lane & 31, h = lane >> 5;
  float* a_s = (float*)smem + w * 256;
  int* e_s = (int*)(a_s + 128);
  const unsigned char* V = (const unsigned char*)(p.ws + OFF_TBL_V) + (size_t)layer * 16 * MiB;
  const int* E = (const int*)(p.ws + OFF_E);
  const float* A = (const float*)(p.ws + OFF_A);
  for (int tok = blockIdx.x * 4 + w; tok < T_TOK; tok += gridDim.x * 4) {
    e_s[lane] = E[(size_t)tok * 128 + lane]; e_s[64 + lane] = E[(size_t)tok * 128 + 64 + lane];
    a_s[lane] = A[(size_t)tok * 128 + lane]; a_s[64 + lane] = A[(size_t)tok * 128 + 64 + lane];
    wave_sync();
    float o[32];
#pragma unroll
    for (int i = 0; i < 32; ++i) o[i] = 0.f;
    v6u rA[4], rB[4];
    V_LOAD8(rA, 0)
#pragma unroll 1
    for (int m8 = 0; m8 < 64; m8 += 8) {
      V_LOAD8(rB, m8 + 4)
      V_COMP8(rA, m8)
      if (m8 + 8 < 64) { V_LOAD8(rA, m8 + 8) }
      V_COMP8(rB, m8 + 4)
    }
#pragma unroll
    for (int i = 0; i < 32; ++i) o[i] += __shfl_xor(o[i], 32);
    float4* hp = (float4*)(p.out + (size_t)tok * 1024 + r * 32 + h * 16);
    float4 hv[4];
    float ss = 0.f;
#pragma unroll
    for (int q = 0; q < 4; ++q) {
      float4 t = hp[q];
      t.x += h ? o[16 + 4 * q] : o[4 * q]; t.y += h ? o[17 + 4 * q] : o[4 * q + 1];
      t.z += h ? o[18 + 4 * q] : o[4 * q + 2]; t.w += h ? o[19 + 4 * q] : o[4 * q + 3];
      hp[q] = t; hv[q] = t;
      ss += t.x * t.x + t.y * t.y + t.z * t.z + t.w * t.w;
    }
    if (next_gain) {
#pragma unroll
      for (int o2 = 32; o2 >= 1; o2 >>= 1) ss += __shfl_xor(ss, o2);
      const float rs = rsqrtf(ss * (1.f / 1024.f) + 1e-6f);
      const float4* gp = (const float4*)(next_gain + r * 32 + h * 16);
      unsigned pw[8];
#pragma unroll
      for (int q = 0; q < 4; ++q) {
        const float4 g = gp[q];
        pw[2 * q] = pk(hv[q].x * rs * g.x, hv[q].y * rs * g.y); pw[2 * q + 1] = pk(hv[q].z * rs * g.z, hv[q].w * rs * g.w);
      }
      uint4* dp = (uint4*)((bf16_t*)(p.ws + OFF_ACT_A) + (size_t)tok * 1024 + r * 32 + h * 16);
      dp[0] = make_uint4(pw[0], pw[1], pw[2], pw[3]); dp[1] = make_uint4(pw[4], pw[5], pw[6], pw[7]);
    }
    wave_sync();
  }
}

DI void run_phase(const Params& p, int ph, char* smem) {
  bf16_t* actA = (bf16_t*)(p.ws + OFF_ACT_A);
  bf16_t* big = (bf16_t*)(p.ws + OFF_BIG);
  switch (ph) {
    case 0: phase_convert(p, smem); phase_cvt_tables(p, 0); phase_cvt_tables(p, 1); break;
    case 1: phase_rmsnorm(p.x, p.ln_mix, actA); break;
    case 2: phase_gemm<EPI_GLA_IN>(p, actA, (const bf16_t*)(p.ws + OFF_WT_GLA_IN), 25, big, 3072, nullptr, smem); break;
    case 3: for (int it = blockIdx.x; it < 2048; it += gridDim.x) gla_phase1(p, it, smem); break;
    case 4: gla_scan(p); break;
    case 5: for (int it = blockIdx.x; it < 2048; it += gridDim.x) gla_phase3(p, it, smem); break;
    case 6: phase_gemm<EPI_RESID_X>(p, actA, (const bf16_t*)(p.ws + OFF_WT_GLA_OUT), 8, nullptr, 0, nullptr, smem); break;
    case 7: phase_rmsnorm(p.out, p.ln_ffn, actA); break;
    case 8: phase_gemm<EPI_PEER_Q>(p, actA, (const bf16_t*)(p.ws + OFF_WT_PQ), 8, nullptr, 0, nullptr, smem); break;
    case 9: break;
    case 10: peer_gather_u(p, 0, smem); break;
    case 11: peer_gather_v(p, 0, smem, p.ln_mix + 1024); break;
    case 12: break;
    case 13: phase_gemm<EPI_SWA_IN>(p, actA, (const bf16_t*)(p.ws + OFF_WT_SWA_IN), 10, big, 1280, p.swa_b_in, smem); break;
    case 14: break;
    case 15: for (int it = blockIdx.x; it < 4096; it += gridDim.x) swa_attn(p, it, smem); break;
    case 16: phase_gemm<EPI_RESID_INPLACE>(p, (const bf16_t*)(p.ws + OFF_ACT_B), (const bf16_t*)(p.ws + OFF_WT_SWA_OUT), 8, nullptr, 0, p.swa_b_out, smem); break;
    case 17: phase_rmsnorm(p.out, p.ln_ffn + 1024, actA); break;
    case 18: phase_gemm<EPI_PEER_Q>(p, actA, (const bf16_t*)(p.ws + OFF_WT_PQ) + (size_t)1024 * 1024, 8, nullptr, 1, nullptr, smem); break;
    case 19: break;
    case 20: peer_gather_u(p, 1, smem); break;
    case 21: peer_gather_v(p, 1, smem, nullptr); break;
    default: break;
  }
}

template <int PH>
__global__ void __launch_bounds__(256, 2) phase_kernel(Params p) {
  __shared__ __attribute__((aligned(16))) char smem[SMEM_BYTES];
  run_phase(p, PH, smem);
}

template <int PH>
static void launch_phases(const Params& p, int grid, hipStream_t stream) {
  hipLaunchKernelGGL(phase_kernel<PH>, dim3(grid), dim3(256), 0, stream, p);
  if constexpr (PH + 1 < NPHASE) launch_phases<PH + 1>(p, grid, stream);
}


#define XB_TMO      128
#define XB_XCNT(j)  (256  + 64 * (j))
#define XB_XSUB(j)  (1280 + 64 * (j))
#define XB_XGEN(j)  (2304 + 64 * (j))
#define XB_TOP      3328
#define XB_TOPGEN   3392
#define XCD_BAR_WORDS 3456
#define XB_SPIN_CAP (1u << 23)
#define LAS __attribute__((address_space(3)))
DI unsigned xb_ld(unsigned* p) { return __hip_atomic_load(p, __ATOMIC_RELAXED, __HIP_MEMORY_SCOPE_AGENT); }
DI unsigned xb_add(unsigned* p, unsigned v) { return __hip_atomic_fetch_add(p, v, __ATOMIC_RELAXED, __HIP_MEMORY_SCOPE_AGENT); }
DI unsigned xb_xcc_id() { return (unsigned)__builtin_amdgcn_s_getreg((3 << 11) | 20) & 0xFu; }
#define XB_SPIN(cond, bar) do { unsigned _sp = 0; while (cond) { __builtin_amdgcn_s_sleep(1); \
    if ((++_sp & 255u) == 0u) { if (xb_ld(&(bar)[XB_TMO])) break; if (_sp > XB_SPIN_CAP) { atomicAdd(&(bar)[XB_TMO], 1u); break; } } } } while (0)
struct XcdBarrier { unsigned* bar; unsigned x; volatile LAS unsigned* st; };
DI XcdBarrier xcd_barrier_post(unsigned* bar, volatile LAS unsigned* st) {
  XcdBarrier b; b.bar = bar; b.x = xb_xcc_id(); b.st = st;
  if (tidx() == 0) (void)xb_add(&bar[XB_XCNT(b.x)], 1u);
  return b;
}
DI void xcd_barrier_complete(unsigned* bar, unsigned x, unsigned& nloc, unsigned& nx) {
  const unsigned G = gridDim.x * gridDim.y * gridDim.z;
  unsigned sum, cnt, mine, sp = 0u;
  for (;;) {
    sum = 0u; cnt = 0u; mine = 0u;
#pragma unroll
    for (unsigned j = 0; j < 16; ++j) { const unsigned c = xb_ld(&bar[XB_XCNT(j)]); sum += c; cnt += (c > 0u) ? 1u : 0u; mine = (j == x) ? c : mine; }
    if (sum == G) break;
    __builtin_amdgcn_s_sleep(1);
    if ((++sp & 255u) == 0u) { if (xb_ld(&bar[XB_TMO])) break; if (sp > XB_SPIN_CAP) { atomicAdd(&bar[XB_TMO], 1u); break; } }
  }
  nloc = mine > 0u ? mine : 1u; nx = cnt > 0u ? cnt : 1u;
}
DI void xcd_barrier(const XcdBarrier& b) {
  asm volatile("s_waitcnt vmcnt(0)" ::: "memory");
  __syncthreads();
  if (tidx() == 0) {
    unsigned* bar = b.bar;
    __builtin_amdgcn_s_waitcnt(0);
    unsigned nloc = b.st[0], nx = b.st[1];
    if (nloc == 0u) { xcd_barrier_complete(bar, b.x, nloc, nx); b.st[0] = nloc; b.st[1] = nx; }
    const unsigned old = xb_add(&bar[XB_XSUB(b.x)], 1u);
    const unsigned gen = old / nloc;
    if (old + 1u == (gen + 1u) * nloc) {
      __builtin_amdgcn_fence(__ATOMIC_RELEASE, "agent");
      asm volatile("s_waitcnt vmcnt(0)" ::: "memory");
      const unsigned og = xb_add(&bar[XB_TOP], 1u);
      const unsigned tg = og / nx;
      if (og + 1u == (tg + 1u) * nx) xb_add(&bar[XB_TOPGEN], 1u);
      else XB_SPIN(xb_ld(&bar[XB_TOPGEN]) == tg, bar);
      __builtin_amdgcn_fence(__ATOMIC_ACQUIRE, "agent");
      xb_add(&bar[XB_XGEN(b.x)], 1u);
      asm volatile("s_waitcnt vmcnt(0)" ::: "memory");
    } else {
      XB_SPIN(xb_ld(&bar[XB_XGEN(b.x)]) == gen, bar);
      __builtin_amdgcn_fence(__ATOMIC_ACQUIRE, "agent");
      asm volatile("s_waitcnt vmcnt(0)" ::: "memory");
    }
  }
  __syncthreads();
}

#if !MULTI_LAUNCH
template <int PH>
DI void run_all(const Params& p, char* smem, const XcdBarrier& xb) {
  if constexpr (PH != 12 && PH != 14 && PH != 9 && PH != 19) {
    run_phase(p, PH, smem);
    if constexpr (PH + 1 < NPHASE) {
      if constexpr (PH == 0) cg::this_grid().sync();
      else xcd_barrier(xb);
    }
  }
  if constexpr (PH + 1 < NPHASE) run_all<PH + 1>(p, smem, xb);
}
__global__ void __launch_bounds__(256, 2) trunk_kernel(Params p) {
  __shared__ __attribute__((aligned(16))) char smem[SMEM_BYTES];
  __shared__ uint4 xb_words;
  if (tidx() == 0) xb_words = make_uint4(0u, 0u, 0u, 0u);
  __syncthreads();
  const XcdBarrier xb = xcd_barrier_post((unsigned*)(p.ws + OFF_BAR), (volatile LAS unsigned*)&xb_words);
  run_all<0>(p, smem, xb);
}
#endif

extern "C" void kernel_launch(void* const* d_in, const int* in_sizes, int n_in, void* d_out, int out_size, void* d_ws, size_t ws_size,
                              hipStream_t stream) {
  Params p{};
  p.x = (const float*)d_in[0]; p.pos = (const int*)d_in[1]; p.ln_mix = (const float*)d_in[2]; p.ln_ffn = (const float*)d_in[3];
  p.gla_w_in = (const float*)d_in[4]; p.gla_w_alpha = (const float*)d_in[5]; p.gla_b_alpha = (const float*)d_in[6];
  p.gla_norm = (const float*)d_in[7]; p.gla_w_out = (const float*)d_in[8];
  p.swa_w_in = (const float*)d_in[9]; p.swa_b_in = (const float*)d_in[10]; p.swa_qn = (const float*)d_in[11]; p.swa_kn = (const float*)d_in[12];
  p.swa_sinks = (const float*)d_in[13]; p.swa_w_out = (const float*)d_in[14]; p.swa_b_out = (const float*)d_in[15];
  p.peer_wq = (const float*)d_in[16]; p.peer_keys = (const float*)d_in[17]; p.peer_u = (const float*)d_in[18]; p.peer_v = (const float*)d_in[19];
  p.out = (float*)d_out; p.ws = (char*)d_ws;
  static int grid_blocks = 0;
  if (!grid_blocks) {
    int dev = 0, cus = 0, per_cu = 0;
    (void)hipGetDevice(&dev);
    (void)hipDeviceGetAttribute(&cus, hipDeviceAttributeMultiprocessorCount, dev);
    #if MULTI_LAUNCH
    per_cu = 2;
#else
    (void)hipOccupancyMaxActiveBlocksPerMultiprocessor(&per_cu, trunk_kernel, 256, 0);
#endif
    if (per_cu < 1) per_cu = 1;
    if (per_cu > 2) per_cu = 2;
    grid_blocks = cus * per_cu;
  }
#if MULTI_LAUNCH
  p.phase_lo = 0; p.phase_hi = 0;
  launch_phases<0>(p, grid_blocks, stream);
#else
  p.phase_lo = 0; p.phase_hi = NPHASE - 1;
  void* args[] = {&p};
  (void)hipMemsetAsync((char*)d_ws + OFF_BAR, 0, XCD_BAR_WORDS * 4, stream);
  hipError_t e = hipLaunchCooperativeKernel((void*)trunk_kernel, dim3(grid_blocks), dim3(256), args, 0, stream);
  if (e != hipSuccess) fprintf(stderr, "cooperative launch failed: %s (grid %d)\n", hipGetErrorString(e), grid_blocks);
#endif
}
```

```cpp
#include <hip/hip_runtime.h>
#include <hip/hip_cooperative_groups.h>
#include <stdint.h>
#include <stdio.h>
namespace cg = cooperative_groups;

#ifndef MULTI_LAUNCH
#define MULTI_LAUNCH 0
#endif

#define DI __device__ __forceinline__
typedef unsigned short bf16_t;
typedef __attribute__((ext_vector_type(8))) short bf16x8;
typedef __attribute__((ext_vector_type(16))) float f32x16;
typedef __bf16 bf16x2_t __attribute__((ext_vector_type(2)));
typedef float f32x2_t __attribute__((ext_vector_type(2)));
typedef float f2 __attribute__((ext_vector_type(2)));

constexpr int T_TOK = 32768;
constexpr int SEQ = 16384;
constexpr int DM = 1024;
constexpr int NPHASE = 22;

constexpr size_t MiB = 1048576;
constexpr size_t OFF_WT_GLA_IN = 0;
constexpr size_t OFF_WT_GLA_OUT = 7 * MiB;
constexpr size_t OFF_WT_SWA_IN = 9 * MiB;
constexpr size_t OFF_WT_SWA_OUT = 12 * MiB;
constexpr size_t OFF_WT_PQ = 14 * MiB;
constexpr size_t OFF_KEYS = 18 * MiB;
constexpr size_t OFF_INV = 20 * MiB;
constexpr size_t OFF_TBL_U = 24 * MiB;
constexpr size_t OFF_TBL_V = 56 * MiB;
constexpr size_t OFF_ACT_A = 88 * MiB;
constexpr size_t OFF_BIG = 152 * MiB;
constexpr size_t OFF_E = OFF_BIG + 64 * MiB;
constexpr size_t OFF_G = OFF_BIG + 80 * MiB;
constexpr size_t OFF_A = OFF_BIG + 96 * MiB;
constexpr size_t OFF_KVT = 344 * MiB;
constexpr size_t OFF_ACT_B = OFF_KVT;
constexpr size_t OFF_LR = 472 * MiB;
constexpr size_t OFF_DECAY = 474 * MiB;
constexpr size_t OFF_BAR = 476 * MiB;

constexpr int SMEM_BYTES = 73728;
constexpr int LDK = 72;

struct Params {
  const float* x; const int* pos; const float* ln_mix; const float* ln_ffn;
  const float* gla_w_in; const float* gla_w_alpha; const float* gla_b_alpha; const float* gla_norm; const float* gla_w_out;
  const float* swa_w_in; const float* swa_b_in; const float* swa_qn; const float* swa_kn; const float* swa_sinks;
  const float* swa_w_out; const float* swa_b_out;
  const float* peer_wq; const float* peer_keys; const float* peer_u; const float* peer_v;
  float* out; char* ws;
  int phase_lo, phase_hi;
};

DI int tidx() { int t = (int)threadIdx.x; asm volatile("" : "+v"(t)); return t; }
DI unsigned pk(float lo, float hi) { f32x2_t v = {lo, hi}; bf16x2_t b = __builtin_convertvector(v, bf16x2_t); return __builtin_bit_cast(unsigned, b); }
DI bf16_t f2bf(float x) { return (bf16_t)(pk(x, 0.f) & 0xffffu); }
DI float bflo(unsigned w) { return __uint_as_float(w << 16); }
DI float bfhi(unsigned w) { return __uint_as_float(w & 0xffff0000u); }
DI float bf2f(bf16_t b) { return __uint_as_float(((unsigned)b) << 16); }
DI float dot2(unsigned a, unsigned b, float c) { return __builtin_amdgcn_fdot2_f32_bf16(__builtin_bit_cast(bf16x2_t, a), __builtin_bit_cast(bf16x2_t, b), c, false); }
DI int crow(int i, int h) { return (i & 3) + 8 * (i >> 2) + 4 * h; }
DI f32x16 mfma32(bf16x8 a, bf16x8 b, f32x16 c) { return __builtin_amdgcn_mfma_f32_32x32x16_bf16(a, b, c, 0, 0, 0); }
DI f32x16 zero16() { f32x16 z; for (int i = 0; i < 16; ++i) z[i] = 0.f; return z; }
DI void wave_sync() { __builtin_amdgcn_fence(__ATOMIC_RELEASE, "wavefront"); __builtin_amdgcn_wave_barrier(); __builtin_amdgcn_fence(__ATOMIC_ACQUIRE, "wavefront"); }
DI int mbcnt64(unsigned long long m) { return __builtin_amdgcn_mbcnt_hi((unsigned)(m >> 32), __builtin_amdgcn_mbcnt_lo((unsigned)m, 0)); }
DI float logsig(float z) { return fminf(z, 0.f) - __logf(1.f + __expf(-fabsf(z))); }

DI void transpose_tile(const float* __restrict__ src, int N, bf16_t* __restrict__ dst, int kt, int nt, float* sT) {
  const int tid = tidx();
  const int r = tid >> 4, c4 = (tid & 15) * 4;
#pragma unroll
  for (int i = 0; i < 4; ++i) {
    const int k = kt * 64 + r + 16 * i, n = nt * 64 + c4;
    float4 v = make_float4(0.f, 0.f, 0.f, 0.f);
    if (n + 3 < N) v = *(const float4*)(src + (size_t)k * N + n);
    float* d = sT + (r + 16 * i) * 65 + c4;
    d[0] = v.x; d[1] = v.y; d[2] = v.z; d[3] = v.w;
  }
  __syncthreads();
  const int n = tid >> 2, seg = tid & 3;
  unsigned w[8];
#pragma unroll
  for (int j = 0; j < 8; ++j) w[j] = pk(sT[(seg * 16 + 2 * j) * 65 + n], sT[(seg * 16 + 2 * j + 1) * 65 + n]);
  uint4* d = (uint4*)(dst + (size_t)(nt * 64 + n) * 1024 + kt * 64 + seg * 16);
  d[0] = make_uint4(w[0], w[1], w[2], w[3]);
  d[1] = make_uint4(w[4], w[5], w[6], w[7]);
  __syncthreads();
}

DI void cvt_elems(const float* __restrict__ src, bf16_t* __restrict__ dst, size_t n8) {
  for (size_t i = (size_t)blockIdx.x * 256 + tidx(); i < n8; i += (size_t)gridDim.x * 256) {
    const float4 a = ((const float4*)src)[2 * i], b = ((const float4*)src)[2 * i + 1];
    ((uint4*)dst)[i] = make_uint4(pk(a.x, a.y), pk(a.z, a.w), pk(b.x, b.y), pk(b.z, b.w));
  }
}

DI void phase_convert(const Params& p, char* smem) {
  float* sT = (float*)smem;
  for (int t = blockIdx.x; t < 2144; t += gridDim.x) {
    const float* src; int N, ntn; bf16_t* dst; int local;
    if (t < 800) { src = p.gla_w_in; N = 3088; ntn = 50; dst = (bf16_t*)(p.ws + OFF_WT_GLA_IN); local = t; }
    else if (t < 1056) { src = p.gla_w_out; N = 1024; ntn = 16; dst = (bf16_t*)(p.ws + OFF_WT_GLA_OUT); local = t - 800; }
    else if (t < 1376) { src = p.swa_w_in; N = 1280; ntn = 20; dst = (bf16_t*)(p.ws + OFF_WT_SWA_IN); local = t - 1056; }
    else if (t < 1632) { src = p.swa_w_out; N = 1024; ntn = 16; dst = (bf16_t*)(p.ws + OFF_WT_SWA_OUT); local = t - 1376; }
    else if (t < 1888) { src = p.peer_wq; N = 1024; ntn = 16; dst = (bf16_t*)(p.ws + OFF_WT_PQ); local = t - 1632; }
    else { src = p.peer_wq + (size_t)1024 * 1024; N = 1024; ntn = 16; dst = (bf16_t*)(p.ws + OFF_WT_PQ) + (size_t)1024 * 1024; local = t - 1888; }
    transpose_tile(src, N, dst, local / ntn, local % ntn, sT);
  }
  cvt_elems(p.peer_keys, (bf16_t*)(p.ws + OFF_KEYS), (size_t)2 * 8 * 2 * 128 * 64 / 8);
}

typedef unsigned v6u __attribute__((ext_vector_type(6)));
typedef float v32f __attribute__((ext_vector_type(32)));
DI unsigned fp6_code(float y) {
  const float a = fminf(fabsf(y), 7.5f);
  float c = rintf(a * 8.f);
  c = a >= 2.f ? rintf(a * 4.f) + 8.f : c;
  c = a >= 4.f ? rintf(a * 2.f) + 16.f : c;
  unsigned u = (unsigned)c;
  u = u > 31u ? 31u : u;
  return u | ((__float_as_uint(y) >> 26) & 32u);
}
DI void cvt_table_fp6(const float* __restrict__ src, unsigned char* __restrict__ dst, float* __restrict__ inv, int bid, int nb) {
  const int lane = tidx() & 63, w = tidx() >> 6, r = lane & 31, h = lane >> 5;
  for (int rp = bid * 4 + w; rp < 8192; rp += nb * 4) {
    const int row = rp * 2 + h;
    const float4* sp = (const float4*)(src + (size_t)row * 1024 + r * 32);
    float v[32];
    float mx = 0.f;
#pragma unroll
    for (int i = 0; i < 8; ++i) {
      const float4 t = sp[i];
      v[4 * i] = t.x; v[4 * i + 1] = t.y; v[4 * i + 2] = t.z; v[4 * i + 3] = t.w;
      mx = fmaxf(fmaxf(mx, fmaxf(fabsf(t.x), fabsf(t.y))), fmaxf(fabsf(t.z), fabsf(t.w)));
    }
#pragma unroll
    for (int o = 16; o >= 1; o >>= 1) mx = fmaxf(mx, __shfl_xor(mx, o));
    const float sc = mx > 0.f ? 7.5f / mx : 1.f;
    unsigned c[32];
#pragma unroll
    for (int i = 0; i < 32; ++i) c[i] = fp6_code(v[i] * sc);
    unsigned d[6];
#pragma unroll
    for (int g = 0; g < 2; ++g) {
      const unsigned* q = c + 16 * g;
      d[3 * g + 0] = q[0] | (q[1] << 6) | (q[2] << 12) | (q[3] << 18) | (q[4] << 24) | (q[5] << 30);
      d[3 * g + 1] = (q[5] >> 2) | (q[6] << 4) | (q[7] << 10) | (q[8] << 16) | (q[9] << 22) | (q[10] << 28);
      d[3 * g + 2] = (q[10] >> 4) | (q[11] << 2) | (q[12] << 8) | (q[13] << 14) | (q[14] << 20) | (q[15] << 26);
    }
    uint2* dp = (uint2*)(dst + (size_t)row * 768 + r * 24);
    dp[0] = make_uint2(d[0], d[1]); dp[1] = make_uint2(d[2], d[3]); dp[2] = make_uint2(d[4], d[5]);
    if (r == 0) inv[row] = mx > 0.f ? mx * (1.f / 7.5f) : 1.f;
  }
}
DI void phase_cvt_tables(const Params& p, int layer) {
  const int nb = gridDim.x / 2, bid = blockIdx.x % nb;
  const int rows_lo = (blockIdx.x < nb) ? 0 : 1;
  cvt_table_fp6(p.peer_u + (size_t)layer * 16384 * 1024, (unsigned char*)(p.ws + OFF_TBL_U) + (size_t)layer * 16 * MiB, (float*)(p.ws + OFF_INV) + (layer * 2 + 0) * 16384, bid * 2 + rows_lo, nb * 2);
  cvt_table_fp6(p.peer_v + (size_t)layer * 16384 * 1024, (unsigned char*)(p.ws + OFF_TBL_V) + (size_t)layer * 16 * MiB, (float*)(p.ws + OFF_INV) + (layer * 2 + 1) * 16384, bid * 2 + rows_lo, nb * 2);
}

DI void phase_rmsnorm(const float* __restrict__ src, const float* __restrict__ gain, bf16_t* __restrict__ dst) {
  const int lane = tidx() & 63, w = tidx() >> 6;
  for (int row = blockIdx.x * 4 + w; row < T_TOK; row += gridDim.x * 4) {
    const float4* sp = (const float4*)(src + (size_t)row * DM);
    float4 v[4];
    float ss = 0.f;
#pragma unroll
    for (int i = 0; i < 4; ++i) { v[i] = sp[lane + 64 * i]; ss += v[i].x * v[i].x + v[i].y * v[i].y + v[i].z * v[i].z + v[i].w * v[i].w; }
#pragma unroll
    for (int o = 32; o >= 1; o >>= 1) ss += __shfl_xor(ss, o);
    const float rs = rsqrtf(ss * (1.f / 1024.f) + 1e-6f);
#pragma unroll
    for (int i = 0; i < 4; ++i) {
      const float4 g = ((const float4*)gain)[lane + 64 * i];
      uint2 o2 = make_uint2(pk(v[i].x * rs * g.x, v[i].y * rs * g.y), pk(v[i].z * rs * g.z, v[i].w * rs * g.w));
      *(uint2*)(dst + (size_t)row * DM + (lane + 64 * i) * 4) = o2;
    }
  }
}

DI void mma_64x64(const bf16_t* sA, const bf16_t* sB, int arow0, int brow0, f32x16 (&acc)[2][2], int lane) {
  const int r = lane & 31, h = lane >> 5;
#pragma unroll
  for (int s = 0; s < 4; ++s) {
    bf16x8 a[2], b[2];
#pragma unroll
    for (int mi = 0; mi < 2; ++mi) a[mi] = *(const bf16x8*)(sA + (arow0 + mi * 32 + r) * LDK + s * 16 + h * 8);
#pragma unroll
    for (int ni = 0; ni < 2; ++ni) b[ni] = *(const bf16x8*)(sB + (brow0 + ni * 32 + r) * LDK + s * 16 + h * 8);
#pragma unroll
    for (int mi = 0; mi < 2; ++mi)
#pragma unroll
      for (int ni = 0; ni < 2; ++ni) acc[mi][ni] = mfma32(a[mi], b[ni], acc[mi][ni]);
  }
}

enum { EPI_GLA_IN = 0, EPI_RESID_X = 1, EPI_BF16 = 2, EPI_RESID_INPLACE = 3, EPI_SWA_IN = 4, EPI_PEER_Q = 5 };
DI void peer_topk_core(const Params& p, int layer, int head, int tok0, const bf16_t* qbase, int qstride);

template <int MODE>
DI void phase_gemm(const Params& p, const bf16_t* __restrict__ A, const bf16_t* __restrict__ Bt, int NT, bf16_t* dstb, int ldc,
                   const float* __restrict__ bias, char* smem) {
  const int ntiles = (T_TOK / 128) * NT;
  int t = (gridDim.x & 7) ? (int)blockIdx.x : (int)((blockIdx.x & 7) * (gridDim.x >> 3) + (blockIdx.x >> 3));
  if (t >= ntiles) return;
  bf16_t* sA = (bf16_t*)smem;
  bf16_t* sB = sA + 128 * LDK;
  bf16_t* ct = (bf16_t*)smem;
  const int tid = tidx(), lane = tid & 63, w = tid >> 6, wm = w >> 1, wn = w & 1;
  const int r = lane & 31, h = lane >> 5;
  const int lrow = tid >> 3, kc = tid & 7;
  bf16_t* wa = sA + lrow * LDK + kc * 8;
  bf16_t* wb = sB + lrow * LDK + kc * 8;
  bf16x8 ra0[4], rb0[4], ra1[4], rb1[4];
  int m0 = (t / NT) * 128, n0 = (t % NT) * 128;
  const bf16_t* ap = A + (size_t)(m0 + lrow) * 1024 + kc * 8;
  const bf16_t* bp = Bt + (size_t)(n0 + lrow) * 1024 + kc * 8;
#define GLOAD(RA, RB, KT) _Pragma("unroll") for (int i = 0; i < 4; ++i) { RA[i] = *(const bf16x8*)(ap + (size_t)i * 32 * 1024 + (KT) * 64); RB[i] = *(const bf16x8*)(bp + (size_t)i * 32 * 1024 + (KT) * 64); }
#define SSTORE(RA, RB) _Pragma("unroll") for (int i = 0; i < 4; ++i) { *(bf16x8*)(wa + 32 * i * LDK) = RA[i]; *(bf16x8*)(wb + 32 * i * LDK) = RB[i]; }
  GLOAD(ra0, rb0, 0)
  GLOAD(ra1, rb1, 1)
  for (; t < ntiles; t += gridDim.x) {
    f32x16 acc[2][2];
#pragma unroll
    for (int i = 0; i < 2; ++i)
#pragma unroll
      for (int j = 0; j < 2; ++j) acc[i][j] = zero16();
    __syncthreads();
    SSTORE(ra0, rb0)
    __syncthreads();
    for (int kt = 0; kt < 16; kt += 2) {
      if (kt + 2 < 16) { GLOAD(ra0, rb0, kt + 2) }
      mma_64x64(sA, sB, wm * 64, wn * 64, acc, lane);
      __syncthreads();
      SSTORE(ra1, rb1)
      __syncthreads();
      if (kt + 3 < 16) { GLOAD(ra1, rb1, kt + 3) }
      mma_64x64(sA, sB, wm * 64, wn * 64, acc, lane);
      __syncthreads();
      if (kt + 2 < 16) {
        SSTORE(ra0, rb0)
        __syncthreads();
      }
    }
    const int cm0 = m0, cn0 = n0;
    if (MODE != EPI_PEER_Q) {
      const int tn = t + gridDim.x;
      if (tn < ntiles) {
        m0 = (tn / NT) * 128; n0 = (tn % NT) * 128;
        ap = A + (size_t)(m0 + lrow) * 1024 + kc * 8;
        bp = Bt + (size_t)(n0 + lrow) * 1024 + kc * 8;
        GLOAD(ra0, rb0, 0)
        GLOAD(ra1, rb1, 1)
      }
    }
    const bool staged = (MODE == EPI_BF16) || (MODE == EPI_SWA_IN) || (MODE == EPI_PEER_Q) || (MODE == EPI_GLA_IN && cn0 < 3072);
    if (staged) {
#pragma unroll
      for (int ni = 0; ni < 2; ++ni) {
        const int col = wn * 64 + ni * 32 + r;
        const float bv = ((MODE == EPI_BF16 || MODE == EPI_SWA_IN) && bias) ? bias[cn0 + col] : 0.f;
#pragma unroll
        for (int mi = 0; mi < 2; ++mi)
#pragma unroll
          for (int i = 0; i < 16; ++i) ct[(wm * 64 + mi * 32 + crow(i, h)) * 136 + col] = f2bf(acc[mi][ni][i] + bv);
      }
      __syncthreads();
      if (MODE == EPI_SWA_IN && cn0 < 1152) {
        const int row = tid >> 1, hd = tid & 1;
        bf16_t* hp = ct + row * 136 + hd * 64;
        float ss = 0.f;
#pragma unroll
        for (int c8 = 0; c8 < 8; ++c8) {
          const uint4 wv = *(const uint4*)(hp + c8 * 8);
          const float f0 = bflo(wv.x), f1 = bfhi(wv.x), f2 = bflo(wv.y), f3 = bfhi(wv.y), f4 = bflo(wv.z), f5 = bfhi(wv.z), f6 = bflo(wv.w), f7 = bfhi(wv.w);
          ss += f0 * f0 + f1 * f1 + f2 * f2 + f3 * f3 + f4 * f4 + f5 * f5 + f6 * f6 + f7 * f7;
        }
        const float rs = rsqrtf(ss * (1.f / 64.f) + 1e-6f);
        const float* gain = (cn0 < 1024) ? p.swa_qn : p.swa_kn;
        const float qs = (cn0 < 1024) ? 0.125f : 1.f;
        {
          const uint4 w0 = *(const uint4*)hp, w1 = *(const uint4*)(hp + 8);
          float x1[8] = {bflo(w0.x), bfhi(w0.x), bflo(w0.y), bfhi(w0.y), bflo(w0.z), bfhi(w0.z), bflo(w0.w), bfhi(w0.w)};
          float x2[8] = {bflo(w1.x), bfhi(w1.x), bflo(w1.y), bfhi(w1.y), bflo(w1.z), bfhi(w1.z), bflo(w1.w), bfhi(w1.w)};
          const float posf = (float)p.pos[cm0 + row];
          const float invf[8] = {1.0f, 0.1939227432012558f, 0.03760603070259094f, 0.007292664609849453f,
                                 0.0014142135623842478f, 0.00027424818836152554f, 5.318296098266728e-05f, 1.0313386155758053e-05f};
#pragma unroll
          for (int e = 0; e < 8; ++e) {
            const float a1 = x1[e] * rs * gain[e], a2 = x2[e] * rs * gain[8 + e];
            const float ang = posf * invf[e];
            const double rev = (double)ang * 0.15915494309189535;
            const float fr = (float)(rev - rint(rev));
            const float sn = __builtin_amdgcn_sinf(fr), cs = __builtin_amdgcn_cosf(fr);
            x1[e] = (a1 * cs - a2 * sn) * qs;
            x2[e] = (a2 * cs + a1 * sn) * qs;
          }
          *(uint4*)hp = make_uint4(pk(x1[0], x1[1]), pk(x1[2], x1[3]), pk(x1[4], x1[5]), pk(x1[6], x1[7]));
          *(uint4*)(hp + 8) = make_uint4(pk(x2[0], x2[1]), pk(x2[2], x2[3]), pk(x2[4], x2[5]), pk(x2[6], x2[7]));
        }
#pragma unroll
        for (int c8 = 2; c8 < 8; ++c8) {
          const uint4 wv = *(const uint4*)(hp + c8 * 8);
          const float* g = gain + c8 * 8;
          const float sc = rs * qs;
          *(uint4*)(hp + c8 * 8) = make_uint4(pk(bflo(wv.x) * sc * g[0], bfhi(wv.x) * sc * g[1]), pk(bflo(wv.y) * sc * g[2], bfhi(wv.y) * sc * g[3]),
                                              pk(bflo(wv.z) * sc * g[4], bfhi(wv.z) * sc * g[5]), pk(bflo(wv.w) * sc * g[6], bfhi(wv.w) * sc * g[7]));
        }
        __syncthreads();
      }
      if (MODE == EPI_PEER_Q) {
        peer_topk_core(p, ldc, cn0 >> 7, cm0 + w * 32, ct + (w * 32) * 136, 136);
        __builtin_amdgcn_sched_barrier(0);
        const int tn = t + gridDim.x;
        if (tn < ntiles) {
          m0 = (tn / NT) * 128; n0 = (tn % NT) * 128;
          ap = A + (size_t)(m0 + lrow) * 1024 + kc * 8;
          bp = Bt + (size_t)(n0 + lrow) * 1024 + kc * 8;
          GLOAD(ra0, rb0, 0)
          GLOAD(ra1, rb1, 1)
        }
      } else {
        const int ldo = (MODE == EPI_GLA_IN) ? 3072 : ldc;
#pragma unroll
        for (int j = 0; j < 8; ++j) {
          const int c = tid + 256 * j, row = c >> 4, cc = c & 15;
          *(uint4*)(dstb + (size_t)(cm0 + row) * ldo + cn0 + cc * 8) = *(const uint4*)(ct + row * 136 + cc * 8);
        }
      }
    } else {
      const unsigned row0 = (unsigned)(cm0 + wm * 64 + 4 * h), col0 = (unsigned)(cn0 + wn * 64 + r);
      float* __restrict__ lrp = (float*)(p.ws + OFF_LR);
#pragma unroll
      for (int ni = 0; ni < 2; ++ni) {
        const unsigned col = col0 + ni * 32;
        float bv = 0.f;
        if (MODE == EPI_RESID_INPLACE) bv = bias[col];
        const unsigned i0 = row0 * 1024u + col;
        const unsigned l0 = row0 * 16u + (col - 3072u);
#pragma unroll
        for (int mi = 0; mi < 2; ++mi)
#pragma unroll
          for (int i = 0; i < 16; ++i) {
            const unsigned ro = (unsigned)(mi * 32 + (i & 3) + 8 * (i >> 2));
            const float v = acc[mi][ni][i];
            if (MODE == EPI_GLA_IN) { if (col < 3088u) lrp[l0 + ro * 16u] = v; }
            else if (MODE == EPI_RESID_X) p.out[i0 + ro * 1024u] = p.x[i0 + ro * 1024u] + v;
            else if (MODE == EPI_RESID_INPLACE) p.out[i0 + ro * 1024u] += v + bv;
          }
      }
    }
  }
#undef GLOAD
#undef SSTORE
}

DI float gate_la(const float* lr_s, int t, const float (&wa)[16], float ba) {
  float z = ba;
#pragma unroll
  for (int j = 0; j < 16; ++j) z += lr_s[t * 16 + j] * wa[j];
  return logsig(z) * (1.f / 16.f);
}
DI void gla_gates(const Params& p, int t0, int hh, float (&la)[32], float& offset, float& blast, float* lr_s, float* tot_s) {
  const int tid = tidx(), d = tid & 127, half = tid >> 7;
  const float* LR = (const float*)(p.ws + OFF_LR);
  ((float4*)lr_s)[tid] = ((const float4*)(LR + (size_t)t0 * 16))[tid];
  float wa[16];
#pragma unroll
  for (int j = 0; j < 16; ++j) wa[j] = p.gla_w_alpha[j * 512 + hh * 128 + d];
  const float ba = p.gla_b_alpha[hh * 128 + d];
  __syncthreads();
  float sum = 0.f;
#pragma unroll
  for (int tt = 0; tt < 32; ++tt) { la[tt] = gate_la(lr_s, half * 32 + tt, wa, ba); sum += la[tt]; }
  tot_s[half * 128 + d] = sum;
  __syncthreads();
  offset = half ? tot_s[d] : 0.f;
  blast = tot_s[d] + tot_s[128 + d];
}

DI void fill_vT(const bf16_t* __restrict__ QKVR, int t0, int hh, int vh, bf16_t* vT) {
  const int tid = tidx(), v = tid & 127, half = tid >> 7;
#pragma unroll 8
  for (int tt = 0; tt < 32; ++tt) {
    const int t = half * 32 + tt;
    vT[v * LDK + t] = QKVR[(size_t)(t0 + t) * 3072 + 1024 + hh * 256 + vh * 128 + v];
  }
}

DI void gla_phase1(const Params& p, int item, char* smem) {
  const int hh = item & 3, c = (item >> 2) & 255, b = item >> 10;
  const int t0 = b * SEQ + c * 64;
  float* lr_s = (float*)smem;
  float* tot_s = (float*)(smem + 4096);
  bf16_t* kfT = (bf16_t*)(smem + 5120);
  bf16_t* vT = kfT + 128 * LDK;
  const bf16_t* QKVR = (const bf16_t*)(p.ws + OFF_BIG);
  bf16_t* KVT = (bf16_t*)(p.ws + OFF_KVT);
  float* DECAY = (float*)(p.ws + OFF_DECAY);
  const int tid = tidx(), lane = tid & 63, w = tid >> 6, wm = w >> 1, wn = w & 1;
  const int d = tid & 127, half = tid >> 7;
  float la[32], offset, blast;
  gla_gates(p, t0, hh, la, offset, blast, lr_s, tot_s);
  float run = offset;
#pragma unroll
  for (int tt = 0; tt < 32; ++tt) {
    const int t = half * 32 + tt;
    run += la[tt];
    ((float*)(p.ws + OFF_ACT_A))[(size_t)(t0 + t) * 512 + hh * 128 + d] = run;
    const float kv = bf2f(QKVR[(size_t)(t0 + t) * 3072 + 512 + hh * 128 + d]);
    kfT[d * LDK + t] = f2bf(kv * __expf(blast - run));
  }
  if (half == 0) DECAY[(size_t)item * 128 + d] = __expf(blast);
  const int r = lane & 31, h = lane >> 5;
  for (int vh = 0; vh < 2; ++vh) {
    __syncthreads();
    fill_vT(QKVR, t0, hh, vh, vT);
    __syncthreads();
    f32x16 acc[2][2];
#pragma unroll
    for (int i = 0; i < 2; ++i)
#pragma unroll
      for (int j = 0; j < 2; ++j) acc[i][j] = zero16();
    mma_64x64(vT, kfT, wm * 64, wn * 64, acc, lane);
    bf16_t* kbase = KVT + (size_t)item * 32768 + (vh * 128 + wm * 64 + 4 * h) * 128 + wn * 64 + r;
#pragma unroll
    for (int mi = 0; mi < 2; ++mi)
#pragma unroll
      for (int ni = 0; ni < 2; ++ni)
#pragma unroll
        for (int i = 0; i < 16; ++i) kbase[(mi * 32 + (i & 3) + 8 * (i >> 2)) * 128 + ni * 32] = f2bf(acc[mi][ni][i]);
  }
  __syncthreads();
}

DI void gla_scan(const Params& p) {
  bf16_t* KVT = (bf16_t*)(p.ws + OFF_KVT);
  const float* DECAY = (const float*)(p.ws + OFF_DECAY);
  for (int idx = blockIdx.x * 256 + tidx(); idx < 8 * 16384; idx += gridDim.x * 256) {
    const int bh = idx >> 14, e2 = idx & 16383, b = bh >> 2, hh = bh & 3, d0 = (2 * e2) & 127;
    float s0 = 0.f, s1 = 0.f;
    for (int c0 = 0; c0 < 256; c0 += 8) {
      unsigned kv[8]; float2 dc[8];
#pragma unroll
      for (int u = 0; u < 8; ++u) {
        const size_t item = (size_t)(b * 256 + c0 + u) * 4 + hh;
        kv[u] = *(const unsigned*)(KVT + item * 32768 + 2 * e2);
        dc[u] = *(const float2*)(DECAY + item * 128 + d0);
      }
#pragma unroll
      for (int u = 0; u < 8; ++u) {
        const size_t item = (size_t)(b * 256 + c0 + u) * 4 + hh;
        *(unsigned*)(KVT + item * 32768 + 2 * e2) = pk(s0, s1);
        s0 = dc[u].x * s0 + bflo(kv[u]);
        s1 = dc[u].y * s1 + bfhi(kv[u]);
      }
    }
  }
}

DI void gla_phase3(const Params& p, int item, char* smem) {
  const int hh = item & 3, c = (item >> 2) & 255, b = item >> 10;
  const int t0 = b * SEQ + c * 64;
  float* lr_s = (float*)smem;
  float* tot_s = (float*)(smem + 4096);
  bf16_t* qd = (bf16_t*)(smem + 5120);
  bf16_t* ki = qd + 64 * 136;
  bf16_t* at = ki + 64 * 136;
  bf16_t* vT = at + 64 * 72;
  bf16_t* ot = qd;
  const bf16_t* QKVR = (const bf16_t*)(p.ws + OFF_BIG);
  const bf16_t* ST = (const bf16_t*)(p.ws + OFF_KVT);
  bf16_t* OG = (bf16_t*)(p.ws + OFF_ACT_A);
  const int tid = tidx(), lane = tid & 63, w = tid >> 6;
  const int d = tid & 127, half = tid >> 7;
  const int r = lane & 31, h = lane >> 5;
  {
    const float* Bc = (const float*)(p.ws + OFF_ACT_A);
#pragma unroll 8
    for (int tt = 0; tt < 32; ++tt) {
      const int t = half * 32 + tt;
      const float run = Bc[(size_t)(t0 + t) * 512 + hh * 128 + d];
      const float q = bf2f(QKVR[(size_t)(t0 + t) * 3072 + hh * 128 + d]);
      const float k = bf2f(QKVR[(size_t)(t0 + t) * 3072 + 512 + hh * 128 + d]);
      qd[t * 136 + d] = f2bf(q * 0.08838834764831845f * __expf(run));
      ki[t * 136 + d] = f2bf(k * __expf(-run));
    }
  }
  __syncthreads();
  {
    const int mi = w >> 1, nj = w & 1;
    f32x16 a = zero16();
#pragma unroll
    for (int s = 0; s < 8; ++s) {
      const bf16x8 A = *(const bf16x8*)(qd + (mi * 32 + r) * 136 + s * 16 + h * 8);
      const bf16x8 B = *(const bf16x8*)(ki + (nj * 32 + r) * 136 + s * 16 + h * 8);
      a = mfma32(A, B, a);
    }
#pragma unroll
    for (int i = 0; i < 16; ++i) {
      const int it = mi * 32 + crow(i, h), jt = nj * 32 + r;
      at[it * 72 + jt] = f2bf(jt <= it ? a[i] : 0.f);
    }
  }
  f32x16 o[2][2];
#pragma unroll
  for (int i = 0; i < 2; ++i)
#pragma unroll
    for (int j = 0; j < 2; ++j) o[i][j] = zero16();
#pragma unroll
  for (int vh = 0; vh < 2; ++vh) {
    __syncthreads();
    fill_vT(QKVR, t0, hh, vh, vT);
    __syncthreads();
#pragma unroll
    for (int s = 0; s < 4; ++s) {
      const bf16x8 B = *(const bf16x8*)(vT + (w * 32 + r) * LDK + s * 16 + h * 8);
#pragma unroll
      for (int mt = 0; mt < 2; ++mt) {
        const bf16x8 A = *(const bf16x8*)(at + (mt * 32 + r) * 72 + s * 16 + h * 8);
        o[vh][mt] = mfma32(A, B, o[vh][mt]);
      }
    }
    const bf16_t* Sg = ST + (size_t)item * 32768 + (size_t)(vh * 128 + w * 32 + r) * 128 + h * 8;
#pragma unroll
    for (int s = 0; s < 8; ++s) {
      const bf16x8 B = *(const bf16x8*)(Sg + s * 16);
#pragma unroll
      for (int mt = 0; mt < 2; ++mt) {
        const bf16x8 A = *(const bf16x8*)(qd + (mt * 32 + r) * 136 + s * 16 + h * 8);
        o[vh][mt] = mfma32(A, B, o[vh][mt]);
      }
    }
  }
  __syncthreads();
#pragma unroll
  for (int vh = 0; vh < 2; ++vh)
#pragma unroll
    for (int mt = 0; mt < 2; ++mt)
#pragma unroll
      for (int i = 0; i < 16; ++i) ot[(mt * 32 + crow(i, h)) * 264 + vh * 128 + w * 32 + r] = f2bf(o[vh][mt][i]);
  __syncthreads();
  {
    const int row = tid >> 2, seg = tid & 3;
    const bf16_t* orow = ot + row * 264 + seg * 64;
    float ss = 0.f;
#pragma unroll
    for (int c8 = 0; c8 < 8; ++c8) {
      const uint4 ov = *(const uint4*)(orow + c8 * 8);
      const float f0 = bflo(ov.x), f1 = bfhi(ov.x), f2 = bflo(ov.y), f3 = bfhi(ov.y), f4 = bflo(ov.z), f5 = bfhi(ov.z), f6 = bflo(ov.w), f7 = bfhi(ov.w);
      ss += f0 * f0 + f1 * f1 + f2 * f2 + f3 * f3 + f4 * f4 + f5 * f5 + f6 * f6 + f7 * f7;
    }
    ss += __shfl_xor(ss, 1);
    ss += __shfl_xor(ss, 2);
    const float rs = rsqrtf(ss * (1.f / 256.f) + 1e-6f);
    const bf16_t* rrow = QKVR + (size_t)(t0 + row) * 3072 + 2048 + hh * 256 + seg * 64;
    const float* grow = p.gla_norm + hh * 256 + seg * 64;
    bf16_t* dst = OG + (size_t)(t0 + row) * 1024 + hh * 256 + seg * 64;
#pragma unroll
    for (int c8 = 0; c8 < 8; ++c8) {
      const uint4 ov = *(const uint4*)(orow + c8 * 8);
      const uint4 rv = *(const uint4*)(rrow + c8 * 8);
      const float4 g0 = *(const float4*)(grow + c8 * 8), g1 = *(const float4*)(grow + c8 * 8 + 4);
      float of[8] = {bflo(ov.x), bfhi(ov.x), bflo(ov.y), bfhi(ov.y), bflo(ov.z), bfhi(ov.z), bflo(ov.w), bfhi(ov.w)};
      float rf[8] = {bflo(rv.x), bfhi(rv.x), bflo(rv.y), bfhi(rv.y), bflo(rv.z), bfhi(rv.z), bflo(rv.w), bfhi(rv.w)};
      float gf[8] = {g0.x, g0.y, g0.z, g0.w, g1.x, g1.y, g1.z, g1.w};
      float res[8];
#pragma unroll
      for (int e = 0; e < 8; ++e) res[e] = of[e] * rs * gf[e] * (rf[e] / (1.f + __expf(-rf[e])));
      *(uint4*)(dst + c8 * 8) = make_uint4(pk(res[0], res[1]), pk(res[2], res[3]), pk(res[4], res[5]), pk(res[6], res[7]));
    }
  }
  __syncthreads();
}

DI void swa_qknorm(const Params& p) {
  bf16_t* QKV = (bf16_t*)(p.ws + OFF_BIG);
  const int tid = tidx(), sub = tid & 7;
  const int ngroups = T_TOK * 18;
  for (int g = blockIdx.x * 32 + (tid >> 3); g < ngroups; g += gridDim.x * 32) {
    const int tok = g / 18, slot = g - tok * 18;
    bf16_t* ptr = QKV + (size_t)tok * 1280 + slot * 64 + sub * 8;
    const uint4 wv = *(const uint4*)ptr;
    float v[8] = {bflo(wv.x), bfhi(wv.x), bflo(wv.y), bfhi(wv.y), bflo(wv.z), bfhi(wv.z), bflo(wv.w), bfhi(wv.w)};
    float ss = 0.f;
#pragma unroll
    for (int e = 0; e < 8; ++e) ss += v[e] * v[e];
    ss += __shfl_xor(ss, 1);
    ss += __shfl_xor(ss, 2);
    ss += __shfl_xor(ss, 4);
    const float rs = rsqrtf(ss * (1.f / 64.f) + 1e-6f);
    const float* gain = (slot < 16 ? p.swa_qn : p.swa_kn) + sub * 8;
#pragma unroll
    for (int e = 0; e < 8; ++e) v[e] = v[e] * rs * gain[e];
    const float posf = (float)p.pos[tok];
    const float invf[8] = {1.0f, 0.1939227432012558f, 0.03760603070259094f, 0.007292664609849453f,
                           0.0014142135623842478f, 0.00027424818836152554f, 5.318296098266728e-05f, 1.0313386155758053e-05f};
#pragma unroll
    for (int e = 0; e < 8; ++e) {
      const float other = __shfl_xor(v[e], 1);
      if (sub < 2) {
        const float ang = posf * invf[e];
        const double rev = (double)ang * 0.15915494309189535;
        const float fr = (float)(rev - rint(rev));
        const float sn = __builtin_amdgcn_sinf(fr), cs = __builtin_amdgcn_cosf(fr);
        v[e] = (sub == 0) ? (v[e] * cs - other * sn) : (v[e] * cs + other * sn);
      }
    }
    if (slot < 16) {
#pragma unroll
      for (int e = 0; e < 8; ++e) v[e] *= 0.125f;
    }
    *(uint4*)ptr = make_uint4(pk(v[0], v[1]), pk(v[2], v[3]), pk(v[4], v[5]), pk(v[6], v[7]));
  }
}

DI void swa_attn(const Params& p, int item, char* smem) {
  const int hq = item & 15, n = (item >> 4) & 127, b = item >> 11, hkv = hq >> 3;
  const int tok0 = b * SEQ + n * 128;
  bf16_t* Ks = (bf16_t*)smem;
  bf16_t* vT = Ks + 256 * 72;
  const bf16_t* QKV = (const bf16_t*)(p.ws + OFF_BIG);
  bf16_t* OUT = (bf16_t*)(p.ws + OFF_ACT_B);
  const int tid = tidx(), lane = tid & 63, w = tid >> 6, r = lane & 31, h = lane >> 5;
  __syncthreads();
#pragma unroll
  for (int i = 0; i < 8; ++i) {
    const int cidx = tid + 256 * i, kk = cidx >> 3, kc = cidx & 7;
    const int pos = n * 128 - 128 + kk;
    uint4 kw = make_uint4(0, 0, 0, 0), vw = make_uint4(0, 0, 0, 0);
    if (pos >= 0) {
      const bf16_t* base = QKV + (size_t)(b * SEQ + pos) * 1280;
      kw = *(const uint4*)(base + 1024 + hkv * 64 + kc * 8);
      vw = *(const uint4*)(base + 1152 + hkv * 64 + kc * 8);
    }
    *(uint4*)(Ks + kk * 72 + kc * 8) = kw;
    bf16_t* vd = vT + (kc * 8) * 264 + kk;
    vd[0 * 264] = (bf16_t)(vw.x & 0xffff); vd[1 * 264] = (bf16_t)(vw.x >> 16);
    vd[2 * 264] = (bf16_t)(vw.y & 0xffff); vd[3 * 264] = (bf16_t)(vw.y >> 16);
    vd[4 * 264] = (bf16_t)(vw.z & 0xffff); vd[5 * 264] = (bf16_t)(vw.z >> 16);
    vd[6 * 264] = (bf16_t)(vw.w & 0xffff); vd[7 * 264] = (bf16_t)(vw.w >> 16);
  }
  __syncthreads();
  const int iq = 32 * w + r;
  const bf16_t* qrow = QKV + (size_t)(tok0 + iq) * 1280 + hq * 64 + h * 8;
  bf16x8 qf[4];
#pragma unroll
  for (int s = 0; s < 4; ++s) qf[s] = *(const bf16x8*)(qrow + s * 16);
  f32x16 X[5];
#pragma unroll
  for (int kt = 0; kt < 5; ++kt) {
    X[kt] = zero16();
#pragma unroll
    for (int s = 0; s < 4; ++s) {
      const bf16x8 A = *(const bf16x8*)(Ks + ((w + kt) * 32 + r) * 72 + s * 16 + h * 8);
      X[kt] = mfma32(A, qf[s], X[kt]);
    }
  }
  const float sink = p.swa_sinks[hq];
  float m = sink;
#pragma unroll
  for (int kt = 0; kt < 5; ++kt)
#pragma unroll
    for (int i = 0; i < 16; ++i) {
      const int kk = (w + kt) * 32 + crow(i, h);
      const bool valid = (kk > iq) && (kk <= iq + 128) && (n > 0 || kk >= 128);
      const float xv = valid ? X[kt][i] : -INFINITY;
      X[kt][i] = xv;
      m = fmaxf(m, xv);
    }
  m = fmaxf(m, __shfl_xor(m, 32));
  float l = 0.f;
#pragma unroll
  for (int kt = 0; kt < 5; ++kt)
#pragma unroll
    for (int i = 0; i < 16; ++i) {
      const float pv = __expf(X[kt][i] - m);
      X[kt][i] = pv;
      l += pv;
    }
  l += __shfl_xor(l, 32);
  l += __expf(sink - m);
  f32x16 O[2];
  O[0] = zero16(); O[1] = zero16();
#pragma unroll
  for (int kt = 0; kt < 5; ++kt)
#pragma unroll
    for (int s2 = 0; s2 < 2; ++s2) {
      const uint4 pw = make_uint4(pk(X[kt][8 * s2 + 0], X[kt][8 * s2 + 1]), pk(X[kt][8 * s2 + 2], X[kt][8 * s2 + 3]),
                                  pk(X[kt][8 * s2 + 4], X[kt][8 * s2 + 5]), pk(X[kt][8 * s2 + 6], X[kt][8 * s2 + 7]));
      const bf16x8 P = __builtin_bit_cast(bf16x8, pw);
#pragma unroll
      for (int mt = 0; mt < 2; ++mt) {
        const bf16_t* vp = vT + (mt * 32 + r) * 264 + (w + kt) * 32 + 16 * s2 + 4 * h;
        const uint2 lo = *(const uint2*)vp, hi = *(const uint2*)(vp + 8);
        const bf16x8 A = __builtin_bit_cast(bf16x8, make_uint4(lo.x, lo.y, hi.x, hi.y));
        O[mt] = mfma32(A, P, O[mt]);
      }
    }
  const float inv = 1.f / l;
  bf16_t* orow = OUT + (size_t)(tok0 + iq) * 1024 + hq * 64 + 4 * h;
#pragma unroll
  for (int mt = 0; mt < 2; ++mt)
#pragma unroll
    for (int g = 0; g < 4; ++g)
      *(uint2*)(orow + mt * 32 + 8 * g) = make_uint2(pk(O[mt][4 * g] * inv, O[mt][4 * g + 1] * inv), pk(O[mt][4 * g + 2] * inv, O[mt][4 * g + 3] * inv));
}

DI unsigned fkey_u(unsigned u) { return u ^ ((unsigned)((int)u >> 31) | 0x80000000u); }
DI float unfkey(unsigned k) { return __uint_as_float(k ^ ((~(unsigned)((int)k >> 31)) | 0x80000000u)); }
DI void cswap(unsigned& a, unsigned& b) { const unsigned hi = a > b ? a : b, lo = a > b ? b : a; a = hi; b = lo; }
DI void sort16(unsigned (&t)[16]) {
#pragma unroll
  for (int k = 2; k <= 16; k <<= 1)
#pragma unroll
    for (int j = k >> 1; j > 0; j >>= 1)
#pragma unroll
      for (int i = 0; i < 16; ++i) {
        const int l = i ^ j;
        if (l > i) { if ((i & k) == 0) cswap(t[i], t[l]); else cswap(t[l], t[i]); }
      }
}
DI void merge16(unsigned (&a)[16], const unsigned (&b)[16]) {
#pragma unroll
  for (int j = 0; j < 16; ++j) a[j] = a[j] > b[15 - j] ? a[j] : b[15 - j];
#pragma unroll
  for (int j = 8; j > 0; j >>= 1)
#pragma unroll
    for (int i = 0; i < 16; ++i) { const int l = i ^ j; if (l > i) cswap(a[i], a[l]); }
}
DI void cswap2(unsigned& ak, int& ap, unsigned& bk, int& bp) {
  const bool sw = bk > ak;
  const unsigned hk = sw ? bk : ak, lk = sw ? ak : bk;
  const int hp = sw ? bp : ap, lp = sw ? ap : bp;
  ak = hk; ap = hp; bk = lk; bp = lp;
}
DI void sort16p(unsigned (&t)[16], int (&q)[16]) {
#pragma unroll
  for (int k = 2; k <= 16; k <<= 1)
#pragma unroll
    for (int j = k >> 1; j > 0; j >>= 1)
#pragma unroll
      for (int i = 0; i < 16; ++i) {
        const int l = i ^ j;
        if (l > i) { if ((i & k) == 0) cswap2(t[i], q[i], t[l], q[l]); else cswap2(t[l], q[l], t[i], q[i]); }
      }
}
__device__ constexpr int CIA[25] = {0,0,0,0,0,0,0,0,0,0,0,0,0,0,0,0, 2,2,2,2,2, 3,3,3,3};
__device__ constexpr int CJA[25] = {0,1,2,3,4,5,6,7,8,9,10,11,12,13,14,15, 0,1,2,3,4, 0,1,2,3};
__device__ constexpr int CIB[25] = {1,1,1,1,1,1,1,1, 4,4,4, 5,5,6,6,7,7, 8,9,10,11,12,13,14,15};
__device__ constexpr int CJB[25] = {0,1,2,3,4,5,6,7, 0,1,2, 0,1,0,1,0,1, 0,0,0,0,0,0,0,0};

DI void peer_topk_core(const Params& p, int layer, int head, int tok0, const bf16_t* qbase, int qstride) {
  const bf16_t* KEYS = (const bf16_t*)(p.ws + OFF_KEYS) + (size_t)(layer * 8 + head) * 256 * 64;
  int* E = (int*)(p.ws + OFF_E);
  float* G = (float*)(p.ws + OFF_G);
  const int lane = tidx() & 63, r = lane & 31, h = lane >> 5;
  const unsigned h4 = 4u * (1u - (unsigned)h);
  unsigned tl[2][16];
#pragma unroll
  for (int set = 0; set < 2; ++set) {
    bf16x8 qf[4];
    {
      const bf16_t* qrow = qbase + r * qstride + set * 64 + h * 8;
#pragma unroll
      for (int s = 0; s < 4; ++s) qf[s] = *(const bf16x8*)(qrow + s * 16);
    }
#pragma unroll
    for (int hf = 0; hf < 2; ++hf) {
      bf16x8 kf[2][4];
#pragma unroll
      for (int t2 = 0; t2 < 2; ++t2)
#pragma unroll
        for (int s = 0; s < 4; ++s) kf[t2][s] = *(const bf16x8*)(KEYS + (size_t)(set * 128 + (2 * hf + t2) * 32 + r) * 64 + h * 8 + s * 16);
#pragma unroll
      for (int t2 = 0; t2 < 2; ++t2) {
        const int kt = 2 * hf + t2;
        f32x16 X = zero16();
#pragma unroll
        for (int s = 0; s < 4; ++s) X = mfma32(kf[t2][s], qf[s], X);
        unsigned kk[16];
#pragma unroll
        for (int i = 0; i < 16; ++i)
          kk[i] = (fkey_u(__float_as_uint(X[i])) & ~127u) + ((unsigned)(127 - kt * 32 - (i & 3) - 8 * (i >> 2) - 4) + h4);
        sort16(kk);
        if (kt == 0) {
#pragma unroll
          for (int i = 0; i < 16; ++i) tl[set][i] = kk[i];
        } else merge16(tl[set], kk);
      }
    }
  }
  __builtin_amdgcn_sched_barrier(0);
  unsigned mine[16], oth[16];
#pragma unroll
  for (int j = 0; j < 16; ++j) {
    const unsigned send = h ? tl[0][j] : tl[1][j];
    oth[j] = (unsigned)__shfl_xor((int)send, 32);
    mine[j] = h ? tl[1][j] : tl[0][j];
  }
  merge16(mine, oth);
  float v1[16], v2[16]; int i1[16], i2[16];
#pragma unroll
  for (int j = 0; j < 16; ++j) {
    const unsigned o = (unsigned)__shfl_xor((int)mine[j], 32);
    const unsigned A = h ? o : mine[j], B = h ? mine[j] : o;
    v1[j] = unfkey(A & ~127u); i1[j] = 127 - (int)(A & 127u);
    v2[j] = unfkey(B & ~127u); i2[j] = 127 - (int)(B & 127u);
  }
  __builtin_amdgcn_sched_barrier(0);
  unsigned ck[16], dk[16]; int cp[16], dp[16];
#pragma unroll
  for (int n = 0; n < 32; ++n) {
    unsigned key = 0u; int e = 0;
    if (n < 25) {
      const float sA = v1[CIA[n]] + v2[CJA[n]], sB = v1[CIB[n]] + v2[CJB[n]];
      const int eA = i1[CIA[n]] * 128 + i2[CJA[n]], eB = i1[CIB[n]] * 128 + i2[CJB[n]];
      key = fkey_u(__float_as_uint(h ? sB : sA)); e = h ? eB : eA;
    }
    if (n < 16) { ck[n] = key; cp[n] = e; } else { dk[n - 16] = key; dp[n - 16] = e; }
  }
  __builtin_amdgcn_sched_barrier(0);
  sort16p(ck, cp);
  __builtin_amdgcn_sched_barrier(0);
  sort16p(dk, dp);
  __builtin_amdgcn_sched_barrier(0);
#pragma unroll
  for (int j = 0; j < 16; ++j) { const bool sw = dk[15 - j] > ck[j]; ck[j] = sw ? dk[15 - j] : ck[j]; cp[j] = sw ? dp[15 - j] : cp[j]; }
#pragma unroll
  for (int j = 8; j > 0; j >>= 1)
#pragma unroll
    for (int i = 0; i < 16; ++i) { const int l = i ^ j; if (l > i) cswap2(ck[i], cp[i], ck[l], cp[l]); }
  unsigned fk[16]; int fe[16];
#pragma unroll
  for (int j = 0; j < 16; ++j) { dk[j] = (unsigned)__shfl_xor((int)ck[j], 32); dp[j] = __shfl_xor(cp[j], 32); }
#pragma unroll
  for (int j = 0; j < 16; ++j) {
    const bool sw = (dk[15 - j] > ck[j]) || (dk[15 - j] == ck[j] && dp[15 - j] > cp[j]);
    fk[j] = sw ? dk[15 - j] : ck[j]; fe[j] = sw ? dp[15 - j] : cp[j];
  }
  float sv[16], mx = -INFINITY;
#pragma unroll
  for (int j = 0; j < 16; ++j) { sv[j] = unfkey(fk[j]); mx = fmaxf(mx, sv[j]); }
  float sm = 0.f;
#pragma unroll
  for (int j = 0; j < 16; ++j) { sv[j] = __expf(sv[j] - mx); sm += sv[j]; }
  const float inv = 1.f / sm;
  const size_t o = ((size_t)(tok0 + r) * 8 + head) * 16 + h * 8;
  *(int4*)(E + o) = make_int4(fe[0], fe[1], fe[2], fe[3]);
  *(int4*)(E + o + 4) = make_int4(fe[4], fe[5], fe[6], fe[7]);
  *(float4*)(G + o) = make_float4(sv[0] * inv, sv[1] * inv, sv[2] * inv, sv[3] * inv);
  *(float4*)(G + o + 4) = make_float4(sv[4] * inv, sv[5] * inv, sv[6] * inv, sv[7] * inv);
}

DI v32f fp6x32(const uint2* p) {
  const uint2 a = p[0], b = p[1], c = p[2];
  v6u x; x[0] = a.x; x[1] = a.y; x[2] = b.x; x[3] = b.y; x[4] = c.x; x[5] = c.y;
  return __builtin_amdgcn_cvt_scalef32_pk32_f32_fp6(x, 1.0f);
}

typedef unsigned u2v __attribute__((ext_vector_type(2)));
typedef unsigned v16u __attribute__((ext_vector_type(16)));
typedef __bf16 v32bf __attribute__((ext_vector_type(32)));
DI v6u mk6(u2v a, u2v b, u2v c) { v6u x; x[0] = a[0]; x[1] = a[1]; x[2] = b[0]; x[3] = b[1]; x[4] = c[0]; x[5] = c[1]; return x; }

DI v6u ld6(const unsigned char* p) { const u2v* q = (const u2v*)p; return mk6(q[0], q[1], q[2]); }
#define U_LOAD2(RAW, M2) _Pragma("unroll") for (int mi = 0; mi < 2; ++mi) { \
    const unsigned char* up_ = U + (size_t)e_s[8 * ((M2) + mi) + grp8] * 768 + i8 * 24; \
    _Pragma("unroll") for (int k = 0; k < 4; ++k) RAW[4 * mi + k] = ld6(up_ + 192 * k); }
#define U_COMP2(RAW, M2) _Pragma("unroll") for (int mi = 0; mi < 2; ++mi) { \
    const int pidx = 8 * ((M2) + mi) + grp8; \
    float acc0 = 0.f, acc1 = 0.f, acc2 = 0.f, acc3 = 0.f; \
    _Pragma("unroll") for (int k = 0; k < 4; ++k) { \
      const v16u ub = __builtin_bit_cast(v16u, __builtin_amdgcn_cvt_scalef32_pk32_bf16_fp6(RAW[4 * mi + k], 1.0f)); \
      _Pragma("unroll") for (int i = 0; i < 16; i += 4) { \
        acc0 = dot2(ub[i], xp[k][i], acc0); acc1 = dot2(ub[i + 1], xp[k][i + 1], acc1); \
        acc2 = dot2(ub[i + 2], xp[k][i + 2], acc2); acc3 = dot2(ub[i + 3], xp[k][i + 3], acc3); } } \
    float acc = (acc0 + acc1) + (acc2 + acc3); \
    acc += __shfl_xor(acc, 1); acc += __shfl_xor(acc, 2); acc += __shfl_xor(acc, 4); \
    if (i8 == 0) a_s[pidx] = acc;              \
    __builtin_amdgcn_sched_barrier(0); }

DI void peer_gather_u(const Params& p, int layer, char* smem) {
  const int tid = tidx(), lane = tid & 63, w = tid >> 6, grp8 = lane >> 3, i8 = lane & 7;
  float* a_s = (float*)smem + w * 512;
  float* su_s = a_s + 128;
  float* gv_s = a_s + 256;
  int* e_s = (int*)(a_s + 384);
  const bf16_t* HN = (const bf16_t*)(p.ws + OFF_ACT_A);
  const unsigned char* U = (const unsigned char*)(p.ws + OFF_TBL_U) + (size_t)layer * 16 * MiB;
  const float* IU = (const float*)(p.ws + OFF_INV) + (layer * 2 + 0) * 16384;
  const float* IV = (const float*)(p.ws + OFF_INV) + (layer * 2 + 1) * 16384;
  const int* E = (const int*)(p.ws + OFF_E);
  const float* G = (const float*)(p.ws + OFF_G);
  float* A = (float*)(p.ws + OFF_A);
  for (int tok = blockIdx.x * 4 + w; tok < T_TOK; tok += gridDim.x * 4) {
    unsigned xp[4][16];
#pragma unroll
    for (int k = 0; k < 4; ++k) {
      const uint4* xq = (const uint4*)(HN + (size_t)tok * 1024 + (i8 + 8 * k) * 32);
#pragma unroll
      for (int q = 0; q < 4; ++q) { const uint4 x0 = xq[q]; xp[k][4 * q] = x0.x; xp[k][4 * q + 1] = x0.y; xp[k][4 * q + 2] = x0.z; xp[k][4 * q + 3] = x0.w; }
    }
    const int e0 = E[(size_t)tok * 128 + lane], e1 = E[(size_t)tok * 128 + 64 + lane];
    e_s[lane] = e0; e_s[64 + lane] = e1;
    const float su0 = IU[e0], su1 = IU[e1];
    const float gv0 = G[(size_t)tok * 128 + lane] * IV[e0], gv1 = G[(size_t)tok * 128 + 64 + lane] * IV[e1];
    wave_sync();
    v6u rA[8], rB[8];
    U_LOAD2(rA, 0)
#pragma unroll 1
    for (int m2 = 0; m2 < 16; m2 += 4) {
      U_LOAD2(rB, m2 + 2)
      U_COMP2(rA, m2)
      if (m2 + 4 < 16) { U_LOAD2(rA, m2 + 4) }
      U_COMP2(rB, m2 + 2)
    }
    wave_sync();
    {
      const float s0 = a_s[lane] * su0, s1 = a_s[64 + lane] * su1;
      A[(size_t)tok * 128 + lane] = 0.5f * s0 * (1.f + erff(s0 * 0.7071067811865476f)) * gv0;
      A[(size_t)tok * 128 + 64 + lane] = 0.5f * s1 * (1.f + erff(s1 * 0.7071067811865476f)) * gv1;
    }
    wave_sync();
  }
}

#define V_LOAD8(RAW, M8) _Pragma("unroll") for (int mi = 0; mi < 4; ++mi) RAW[mi] = ld6(V + (size_t)e_s[2 * ((M8) + mi) + h] * 768 + r * 24);
#define V_COMP8(RAW, M8) _Pragma("unroll") for (int mi = 0; mi < 4; ++mi) { \
    const float a = a_s[2 * ((M8) + mi) + h]; \
    const v32f vv = __builtin_amdgcn_cvt_scalef32_pk32_f32_fp6(RAW[mi], 1.0f); \
    _Pragma("unroll") for (int i = 0; i < 32; ++i) o[i] = fmaf(a, vv[i], o[i]); \
    __builtin_amdgcn_sched_barrier(0); }

DI void peer_gather_v(const Params& p, int layer, char* smem, const float* __restrict__ next_gain) {
  const int tid = tidx(), lane = tid & 63, w = tid >> 6, r = lane & 31, h = lane >> 5;
  float* a_s = (float*)smem + w * 256;
  int* e_s = (int*)(a_s + 128);
  const unsigned char* V = (const unsigned char*)(p.ws + OFF_TBL_V) + (size_t)layer * 16 * MiB;
  const int* E = (const int*)(p.ws + OFF_E);
  const float* A = (const float*)(p.ws + OFF_A);
  for (int tok = blockIdx.x * 4 + w; tok < T_TOK; tok += gridDim.x * 4) {
    e_s[lane] = E[(size_t)tok * 128 + lane]; e_s[64 + lane] = E[(size_t)tok * 128 + 64 + lane];
    a_s[lane] = A[(size_t)tok * 128 + lane]; a_s[64 + lane] = A[(size_t)tok * 128 + 64 + lane];
    wave_sync();
    float o[32];
#pragma unroll
    for (int i = 0; i < 32; ++i) o[i] = 0.f;
    v6u rA[4], rB[4];
    V_LOAD8(rA, 0)
#pragma unroll 1
    for (int m8 = 0; m8 < 64; m8 += 8) {
      V_LOAD8(rB, m8 + 4)
      V_COMP8(rA, m8)
      if (m8 + 8 < 64) { V_LOAD8(rA, m8 + 8) }
      V_COMP8(rB, m8 + 4)
    }
#pragma unroll
    for (int i = 0; i < 32; ++i) o[i] += __shfl_xor(o[i], 32);
    float4* hp = (float4*)(p.out + (size_t)tok * 1024 + r * 32 + h * 16);
    float4 hv[4];
    float ss = 0.f;
#pragma unroll
    for (int q = 0; q < 4; ++q) {
      float4 t = hp[q];
      t.x += h ? o[16 + 4 * q] : o[4 * q]; t.y += h ? o[17 + 4 * q] : o[4 * q + 1];
      t.z += h ? o[18 + 4 * q] : o[4 * q + 2]; t.w += h ? o[19 + 4 * q] : o[4 * q + 3];
      hp[q] = t; hv[q] = t;
      ss += t.x * t.x + t.y * t.y + t.z * t.z + t.w * t.w;
    }
    if (next_gain) {
#pragma unroll
      for (int o2 = 32; o2 >= 1; o2 >>= 1) ss += __shfl_xor(ss, o2);
      const float rs = rsqrtf(ss * (1.f / 1024.f) + 1e-6f);
      const float4* gp = (const float4*)(next_gain + r * 32 + h * 16);
      unsigned pw[8];
#pragma unroll
      for (int q = 0; q < 4; ++q) {
        const float4 g = gp[q];
        pw[2 * q] = pk(hv[q].x * rs * g.x, hv[q].y * rs * g.y); pw[2 * q + 1] = pk(hv[q].z * rs * g.z, hv[q].w * rs * g.w);
      }
      uint4* dp = (uint4*)((bf16_t*)(p.ws + OFF_ACT_A) + (size_t)tok * 1024 + r * 32 + h * 16);
      dp[0] = make_uint4(pw[0], pw[1], pw[2], pw[3]); dp[1] = make_uint4(pw[4], pw[5], pw[6], pw[7]);
    }
    wave_sync();
  }
}

DI void run_phase(const Params& p, int ph, char* smem) {
  bf16_t* actA = (bf16_t*)(p.ws + OFF_ACT_A);
  bf16_t* big = (bf16_t*)(p.ws + OFF_BIG);
  switch (ph) {
    case 0: phase_convert(p, smem); phase_cvt_tables(p, 0); phase_cvt_tables(p, 1); break;
    case 1: phase_rmsnorm(p.x, p.ln_mix, actA); break;
    case 2: phase_gemm<EPI_GLA_IN>(p, actA, (const bf16_t*)(p.ws + OFF_WT_GLA_IN), 25, big, 3072, nullptr, smem); break;
    case 3: for (int it = blockIdx.x; it < 2048; it += gridDim.x) gla_phase1(p, it, smem); break;
    case 4: gla_scan(p); break;
    case 5: for (int it = blockIdx.x; it < 2048; it += gridDim.x) gla_phase3(p, it, smem); break;
    case 6: phase_gemm<EPI_RESID_X>(p, actA, (const bf16_t*)(p.ws + OFF_WT_GLA_OUT), 8, nullptr, 0, nullptr, smem); break;
    case 7: phase_rmsnorm(p.out, p.ln_ffn, actA); break;
    case 8: phase_gemm<EPI_PEER_Q>(p, actA, (const bf16_t*)(p.ws + OFF_WT_PQ), 8, nullptr, 0, nullptr, smem); break;
    case 9: break;
    case 10: peer_gather_u(p, 0, smem); break;
    case 11: peer_gather_v(p, 0, smem, p.ln_mix + 1024); break;
    case 12: break;
    case 13: phase_gemm<EPI_SWA_IN>(p, actA, (const bf16_t*)(p.ws + OFF_WT_SWA_IN), 10, big, 1280, p.swa_b_in, smem); break;
    case 14: break;
    case 15: for (int it = blockIdx.x; it < 4096; it += gridDim.x) swa_attn(p, it, smem); break;
    case 16: phase_gemm<EPI_RESID_INPLACE>(p, (const bf16_t*)(p.ws + OFF_ACT_B), (const bf16_t*)(p.ws + OFF_WT_SWA_OUT), 8, nullptr, 0, p.swa_b_out, smem); break;
    case 17: phase_rmsnorm(p.out, p.ln_ffn + 1024, actA); break;
    case 18: phase_gemm<EPI_PEER_Q>(p, actA, (const bf16_t*)(p.ws + OFF_WT_PQ) + (size_t)1024 * 1024, 8, nullptr, 1, nullptr, smem); break;
    case 19: break;
    case 20: peer_gather_u(p, 1, smem); break;
    case 21: peer_gather_v(p, 1, smem, nullptr); break;
    default: break;
  }
}

template <int PH>
__global__ void __launch_bounds__(256, 2) phase_kernel(Params p) {
  __shared__ __attribute__((aligned(16))) char smem[SMEM_BYTES];
  run_phase(p, PH, smem);
}

template <int PH>
static void launch_phases(const Params& p, int grid, hipStream_t stream) {
  hipLaunchKernelGGL(phase_kernel<PH>, dim3(grid), dim3(256), 0, stream, p);
  if constexpr (PH + 1 < NPHASE) launch_phases<PH + 1>(p, grid, stream);
}


#define XB_TMO      128
#define XB_XCNT(j)  (256  + 64 * (j))
#define XB_XSUB(j)  (1280 + 64 * (j))
#define XB_XGEN(j)  (2304 + 64 * (j))
#define XB_TOP      3328
#define XB_TOPGEN   3392
#define XCD_BAR_WORDS 3456
#define XB_SPIN_CAP (1u << 23)
#define LAS __attribute__((address_space(3)))
DI unsigned xb_ld(unsigned* p) { return __hip_atomic_load(p, __ATOMIC_RELAXED, __HIP_MEMORY_SCOPE_AGENT); }
DI unsigned xb_add(unsigned* p, unsigned v) { return __hip_atomic_fetch_add(p, v, __ATOMIC_RELAXED, __HIP_MEMORY_SCOPE_AGENT); }
DI unsigned xb_xcc_id() { return (unsigned)__builtin_amdgcn_s_getreg((3 << 11) | 20) & 0xFu; }
#define XB_SPIN(cond, bar) do { unsigned _sp = 0; while (cond) { __builtin_amdgcn_s_sleep(1); \
    if ((++_sp & 255u) == 0u) { if (xb_ld(&(bar)[XB_TMO])) break; if (_sp > XB_SPIN_CAP) { atomicAdd(&(bar)[XB_TMO], 1u); break; } } } } while (0)
struct XcdBarrier { unsigned* bar; unsigned x; volatile LAS unsigned* st; };
DI XcdBarrier xcd_barrier_post(unsigned* bar, volatile LAS unsigned* st) {
  XcdBarrier b; b.bar = bar; b.x = xb_xcc_id(); b.st = st;
  if (tidx() == 0) (void)xb_add(&bar[XB_XCNT(b.x)], 1u);
  return b;
}
DI void xcd_barrier_complete(unsigned* bar, unsigned x, unsigned& nloc, unsigned& nx) {
  const unsigned G = gridDim.x * gridDim.y * gridDim.z;
  unsigned sum, cnt, mine, sp = 0u;
  for (;;) {
    sum = 0u; cnt = 0u; mine = 0u;
#pragma unroll
    for (unsigned j = 0; j < 16; ++j) { const unsigned c = xb_ld(&bar[XB_XCNT(j)]); sum += c; cnt += (c > 0u) ? 1u : 0u; mine = (j == x) ? c : mine; }
    if (sum == G) break;
    __builtin_amdgcn_s_sleep(1);
    if ((++sp & 255u) == 0u) { if (xb_ld(&bar[XB_TMO])) break; if (sp > XB_SPIN_CAP) { atomicAdd(&bar[XB_TMO], 1u); break; } }
  }
  nloc = mine > 0u ? mine : 1u; nx = cnt > 0u ? cnt : 1u;
}
DI void xcd_barrier(const XcdBarrier& b) {
  asm volatile("s_waitcnt vmcnt(0)" ::: "memory");
  __syncthreads();
  if (tidx() == 0) {
    unsigned* bar = b.bar;
    __builtin_amdgcn_s_waitcnt(0);
    unsigned nloc = b.st[0], nx = b.st[1];
    if (nloc == 0u) { xcd_barrier_complete(bar, b.x, nloc, nx); b.st[0] = nloc; b.st[1] = nx; }
    const unsigned old = xb_add(&bar[XB_XSUB(b.x)], 1u);
    const unsigned gen = old / nloc;
    if (old + 1u == (gen + 1u) * nloc) {
      __builtin_amdgcn_fence(__ATOMIC_RELEASE, "agent");
      asm volatile("s_waitcnt vmcnt(0)" ::: "memory");
      const unsigned og = xb_add(&bar[XB_TOP], 1u);
      const unsigned tg = og / nx;
      if (og + 1u == (tg + 1u) * nx) xb_add(&bar[XB_TOPGEN], 1u);
      else XB_SPIN(xb_ld(&bar[XB_TOPGEN]) == tg, bar);
      __builtin_amdgcn_fence(__ATOMIC_ACQUIRE, "agent");
      xb_add(&bar[XB_XGEN(b.x)], 1u);
      asm volatile("s_waitcnt vmcnt(0)" ::: "memory");
    } else {
      XB_SPIN(xb_ld(&bar[XB_XGEN(b.x)]) == gen, bar);
      __builtin_amdgcn_fence(__ATOMIC_ACQUIRE, "agent");
      asm volatile("s_waitcnt vmcnt(0)" ::: "memory");
    }
  }
  __syncthreads();
}

#if !MULTI_LAUNCH
template <int PH>
DI void run_all(const Params& p, char* smem, const XcdBarrier& xb) {
  if constexpr (PH != 12 && PH != 14 && PH != 9 && PH != 19) {
    run_phase(p, PH, smem);
    if constexpr (PH + 1 < NPHASE) {
      if constexpr (PH == 0) cg::this_grid().sync();
      else xcd_barrier(xb);
    }
  }
  if constexpr (PH + 1 < NPHASE) run_all<PH + 1>(p, smem, xb);
}
__global__ void __launch_bounds__(256, 2) trunk_kernel(Params p) {
  __shared__ __attribute__((aligned(16))) char smem[SMEM_BYTES];
  __shared__ uint4 xb_words;
  if (tidx() == 0) xb_words = make_uint4(0u, 0u, 0u, 0u);
  __syncthreads();
  const XcdBarrier xb = xcd_barrier_post((unsigned*)(p.ws + OFF_BAR), (volatile LAS unsigned*)&xb_words);
  run_all<0>(p, smem, xb);
}
#endif

extern "C" void kernel_launch(void* const* d_in, const int* in_sizes, int n_in, void* d_out, int out_size, void* d_ws, size_t ws_size,
                              hipStream_t stream) {
  Params p{};
  p.x = (const float*)d_in[0]; p.pos = (const int*)d_in[1]; p.ln_mix = (const float*)d_in[2]; p.ln_ffn = (const float*)d_in[3];
  p.gla_w_in = (const float*)d_in[4]; p.gla_w_alpha = (const float*)d_in[5]; p.gla_b_alpha = (const float*)d_in[6];
  p.gla_norm = (const float*)d_in[7]; p.gla_w_out = (const float*)d_in[8];
  p.swa_w_in = (const float*)d_in[9]; p.swa_b_in = (const float*)d_in[10]; p.swa_qn = (const float*)d_in[11]; p.swa_kn = (const float*)d_in[12];
  p.swa_sinks = (const float*)d_in[13]; p.swa_w_out = (const float*)d_in[14]; p.swa_b_out = (const float*)d_in[15];
  p.peer_wq = (const float*)d_in[16]; p.peer_keys = (const float*)d_in[17]; p.peer_u = (const float*)d_in[18]; p.peer_v = (const float*)d_in[19];
  p.out = (float*)d_out; p.ws = (char*)d_ws;
  static int grid_blocks = 0;
  if (!grid_blocks) {
    int dev = 0, cus = 0, per_cu = 0;
    (void)hipGetDevice(&dev);
    (void)hipDeviceGetAttribute(&cus, hipDeviceAttributeMultiprocessorCount, dev);
    #if MULTI_LAUNCH
    per_cu = 2;
#else
    (void)hipOccupancyMaxActiveBlocksPerMultiprocessor(&per_cu, trunk_kernel, 256, 0);
#endif
    if (per_cu < 1) per_cu = 1;
    if (per_cu > 2) per_cu = 2;
    grid_blocks = cus * per_cu;
  }
#if MULTI_LAUNCH
  p.phase_lo = 0; p.phase_hi = 0;
  launch_phases<0>(p, grid_blocks, stream);
#else
  p.phase_lo = 0; p.phase_hi = NPHASE - 1;
  void* args[] = {&p};
  (void)hipMemsetAsync((char*)d_ws + OFF_BAR, 0, XCD_BAR_WORDS * 4, stream);
  hipError_t e = hipLaunchCooperativeKernel((void*)trunk_kernel, dim3(grid_blocks), dim3(256), args, 0, stream);
  if (e != hipSuccess) fprintf(stderr, "cooperative launch failed: %s (grid %d)\n", hipGetErrorString(e), grid_blocks);
#endif
}
```

```cpp
#include <hip/hip_runtime.h>
#include <hip/hip_cooperative_groups.h>
#include <stdint.h>
#include <stdio.h>
namespace cg = cooperative_groups;

#ifndef MULTI_LAUNCH
#define MULTI_LAUNCH 0
#endif

#define DI __device__ __forceinline__
typedef unsigned short bf16_t;
typedef __attribute__((ext_vector_type(8))) short bf16x8;
typedef __attribute__((ext_vector_type(16))) float f32x16;
typedef __bf16 bf16x2_t __attribute__((ext_vector_type(2)));
typedef float f32x2_t __attribute__((ext_vector_type(2)));
typedef float f2 __attribute__((ext_vector_type(2)));

constexpr int T_TOK = 32768;
constexpr int SEQ = 16384;
constexpr int DM = 1024;
constexpr int NPHASE = 22;

constexpr size_t MiB = 1048576;
constexpr size_t OFF_WT_GLA_IN = 0;
constexpr size_t OFF_WT_GLA_OUT = 7 * MiB;
constexpr size_t OFF_WT_SWA_IN = 9 * MiB;
constexpr size_t OFF_WT_SWA_OUT = 12 * MiB;
constexpr size_t OFF_WT_PQ = 14 * MiB;
constexpr size_t OFF_KEYS = 18 * MiB;
constexpr size_t OFF_INV = 20 * MiB;
constexpr size_t OFF_TBL_U = 24 * MiB;
constexpr size_t OFF_TBL_V = 56 * MiB;
constexpr size_t OFF_ACT_A = 88 * MiB;
constexpr size_t OFF_BIG = 152 * MiB;
constexpr size_t OFF_E = OFF_BIG + 64 * MiB;
constexpr size_t OFF_G = OFF_BIG + 80 * MiB;
constexpr size_t OFF_A = OFF_BIG + 96 * MiB;
constexpr size_t OFF_KVT = 344 * MiB;
constexpr size_t OFF_ACT_B = OFF_KVT;
constexpr size_t OFF_LR = 472 * MiB;
constexpr size_t OFF_DECAY = 474 * MiB;
constexpr size_t OFF_BAR = 476 * MiB;

constexpr int SMEM_BYTES = 73728;
constexpr int LDK = 72;

struct Params {
  const float* x; const int* pos; const float* ln_mix; const float* ln_ffn;
  const float* gla_w_in; const float* gla_w_alpha; const float* gla_b_alpha; const float* gla_norm; const float* gla_w_out;
  const float* swa_w_in; const float* swa_b_in; const float* swa_qn; const float* swa_kn; const float* swa_sinks;
  const float* swa_w_out; const float* swa_b_out;
  const float* peer_wq; const float* peer_keys; const float* peer_u; const float* peer_v;
  float* out; char* ws;
  int phase_lo, phase_hi;
};

DI int tidx() { int t = (int)threadIdx.x; asm volatile("" : "+v"(t)); return t; }
DI unsigned pk(float lo, float hi) { f32x2_t v = {lo, hi}; bf16x2_t b = __builtin_convertvector(v, bf16x2_t); return __builtin_bit_cast(unsigned, b); }
DI bf16_t f2bf(float x) { return (bf16_t)(pk(x, 0.f) & 0xffffu); }
DI float bflo(unsigned w) { return __uint_as_float(w << 16); }
DI float bfhi(unsigned w) { return __uint_as_float(w & 0xffff0000u); }
DI float bf2f(bf16_t b) { return __uint_as_float(((unsigned)b) << 16); }
DI float dot2(unsigned a, unsigned b, float c) { return __builtin_amdgcn_fdot2_f32_bf16(__builtin_bit_cast(bf16x2_t, a), __builtin_bit_cast(bf16x2_t, b), c, false); }
DI int crow(int i, int h) { return (i & 3) + 8 * (i >> 2) + 4 * h; }
DI f32x16 mfma32(bf16x8 a, bf16x8 b, f32x16 c) { return __builtin_amdgcn_mfma_f32_32x32x16_bf16(a, b, c, 0, 0, 0); }
DI f32x16 zero16() { f32x16 z; for (int i = 0; i < 16; ++i) z[i] = 0.f; return z; }
DI void wave_sync() { __builtin_amdgcn_fence(__ATOMIC_RELEASE, "wavefront"); __builtin_amdgcn_wave_barrier(); __builtin_amdgcn_fence(__ATOMIC_ACQUIRE, "wavefront"); }
DI int mbcnt64(unsigned long long m) { return __builtin_amdgcn_mbcnt_hi((unsigned)(m >> 32), __builtin_amdgcn_mbcnt_lo((unsigned)m, 0)); }
DI float logsig(float z) { return fminf(z, 0.f) - __logf(1.f + __expf(-fabsf(z))); }

DI void transpose_tile(const float* __restrict__ src, int N, bf16_t* __restrict__ dst, int kt, int nt, float* sT) {
  const int tid = tidx();
  const int r = tid >> 4, c4 = (tid & 15) * 4;
#pragma unroll
  for (int i = 0; i < 4; ++i) {
    const int k = kt * 64 + r + 16 * i, n = nt * 64 + c4;
    float4 v = make_float4(0.f, 0.f, 0.f, 0.f);
    if (n + 3 < N) v = *(const float4*)(src + (size_t)k * N + n);
    float* d = sT + (r + 16 * i) * 65 + c4;
    d[0] = v.x; d[1] = v.y; d[2] = v.z; d[3] = v.w;
  }
  __syncthreads();
  const int n = tid >> 2, seg = tid & 3;
  unsigned w[8];
#pragma unroll
  for (int j = 0; j < 8; ++j) w[j] = pk(sT[(seg * 16 + 2 * j) * 65 + n], sT[(seg * 16 + 2 * j + 1) * 65 + n]);
  uint4* d = (uint4*)(dst + (size_t)(nt * 64 + n) * 1024 + kt * 64 + seg * 16);
  d[0] = make_uint4(w[0], w[1], w[2], w[3]);
  d[1] = make_uint4(w[4], w[5], w[6], w[7]);
  __syncthreads();
}

DI void cvt_elems(const float* __restrict__ src, bf16_t* __restrict__ dst, size_t n8) {
  for (size_t i = (size_t)blockIdx.x * 256 + tidx(); i < n8; i += (size_t)gridDim.x * 256) {
    const float4 a = ((const float4*)src)[2 * i], b = ((const float4*)src)[2 * i + 1];
    ((uint4*)dst)[i] = make_uint4(pk(a.x, a.y), pk(a.z, a.w), pk(b.x, b.y), pk(b.z, b.w));
  }
}

DI void phase_convert(const Params& p, char* smem) {
  float* sT = (float*)smem;
  for (int t = blockIdx.x; t < 2144; t += gridDim.x) {
    const float* src; int N, ntn; bf16_t* dst; int local;
    if (t < 800) { src = p.gla_w_in; N = 3088; ntn = 50; dst = (bf16_t*)(p.ws + OFF_WT_GLA_IN); local = t; }
    else if (t < 1056) { src = p.gla_w_out; N = 1024; ntn = 16; dst = (bf16_t*)(p.ws + OFF_WT_GLA_OUT); local = t - 800; }
    else if (t < 1376) { src = p.swa_w_in; N = 1280; ntn = 20; dst = (bf16_t*)(p.ws + OFF_WT_SWA_IN); local = t - 1056; }
    else if (t < 1632) { src = p.swa_w_out; N = 1024; ntn = 16; dst = (bf16_t*)(p.ws + OFF_WT_SWA_OUT); local = t - 1376; }
    else if (t < 1888) { src = p.peer_wq; N = 1024; ntn = 16; dst = (bf16_t*)(p.ws + OFF_WT_PQ); local = t - 1632; }
    else { src = p.peer_wq + (size_t)1024 * 1024; N = 1024; ntn = 16; dst = (bf16_t*)(p.ws + OFF_WT_PQ) + (size_t)1024 * 1024; local = t - 1888; }
    transpose_tile(src, N, dst, local / ntn, local % ntn, sT);
  }
  cvt_elems(p.peer_keys, (bf16_t*)(p.ws + OFF_KEYS), (size_t)2 * 8 * 2 * 128 * 64 / 8);
}

typedef unsigned v6u __attribute__((ext_vector_type(6)));
typedef float v32f __attribute__((ext_vector_type(32)));
DI unsigned fp6_code(float y) {
  const float a = fminf(fabsf(y), 7.5f);
  float c = rintf(a * 8.f);
  c = a >= 2.f ? rintf(a * 4.f) + 8.f : c;
  c = a >= 4.f ? rintf(a * 2.f) + 16.f : c;
  unsigned u = (unsigned)c;
  u = u > 31u ? 31u : u;
  return u | ((__float_as_uint(y) >> 26) & 32u);
}
DI void cvt_table_fp6(const float* __restrict__ src, unsigned char* __restrict__ dst, float* __restrict__ inv, int bid, int nb) {
  const int lane = tidx() & 63, w = tidx() >> 6, r = lane & 31, h = lane >> 5;
  for (int rp = bid * 4 + w; rp < 8192; rp += nb * 4) {
    const int row = rp * 2 + h;
    const float4* sp = (const float4*)(src + (size_t)row * 1024 + r * 32);
    float v[32];
    float mx = 0.f;
#pragma unroll
    for (int i = 0; i < 8; ++i) {
      const float4 t = sp[i];
      v[4 * i] = t.x; v[4 * i + 1] = t.y; v[4 * i + 2] = t.z; v[4 * i + 3] = t.w;
      mx = fmaxf(fmaxf(mx, fmaxf(fabsf(t.x), fabsf(t.y))), fmaxf(fabsf(t.z), fabsf(t.w)));
    }
#pragma unroll
    for (int o = 16; o >= 1; o >>= 1) mx = fmaxf(mx, __shfl_xor(mx, o));
    const float sc = mx > 0.f ? 7.5f / mx : 1.f;
    unsigned c[32];
#pragma unroll
    for (int i = 0; i < 32; ++i) c[i] = fp6_code(v[i] * sc);
    unsigned d[6];
#pragma unroll
    for (int g = 0; g < 2; ++g) {
      const unsigned* q = c + 16 * g;
      d[3 * g + 0] = q[0] | (q[1] << 6) | (q[2] << 12) | (q[3] << 18) | (q[4] << 24) | (q[5] << 30);
      d[3 * g + 1] = (q[5] >> 2) | (q[6] << 4) | (q[7] << 10) | (q[8] << 16) | (q[9] << 22) | (q[10] << 28);
      d[3 * g + 2] = (q[10] >> 4) | (q[11] << 2) | (q[12] << 8) | (q[13] << 14) | (q[14] << 20) | (q[15] << 26);
    }
    uint2* dp = (uint2*)(dst + (size_t)row * 768 + r * 24);
    dp[0] = make_uint2(d[0], d[1]); dp[1] = make_uint2(d[2], d[3]); dp[2] = make_uint2(d[4], d[5]);
    if (r == 0) inv[row] = mx > 0.f ? mx * (1.f / 7.5f) : 1.f;
  }
}
DI void phase_cvt_tables(const Params& p, int layer) {
  const int nb = gridDim.x / 2, bid = blockIdx.x % nb;
  const int rows_lo = (blockIdx.x < nb) ? 0 : 1;
  cvt_table_fp6(p.peer_u + (size_t)layer * 16384 * 1024, (unsigned char*)(p.ws + OFF_TBL_U) + (size_t)layer * 16 * MiB, (float*)(p.ws + OFF_INV) + (layer * 2 + 0) * 16384, bid * 2 + rows_lo, nb * 2);
  cvt_table_fp6(p.peer_v + (size_t)layer * 16384 * 1024, (unsigned char*)(p.ws + OFF_TBL_V) + (size_t)layer * 16 * MiB, (float*)(p.ws + OFF_INV) + (layer * 2 + 1) * 16384, bid * 2 + rows_lo, nb * 2);
}

DI void phase_rmsnorm(const float* __restrict__ src, const float* __restrict__ gain, bf16_t* __restrict__ dst) {
  const int lane = tidx() & 63, w = tidx() >> 6;
  for (int row = blockIdx.x * 4 + w; row < T_TOK; row += gridDim.x * 4) {
    const float4* sp = (const float4*)(src + (size_t)row * DM);
    float4 v[4];
    float ss = 0.f;
#pragma unroll
    for (int i = 0; i < 4; ++i) { v[i] = sp[lane + 64 * i]; ss += v[i].x * v[i].x + v[i].y * v[i].y + v[i].z * v[i].z + v[i].w * v[i].w; }
#pragma unroll
    for (int o = 32; o >= 1; o >>= 1) ss += __shfl_xor(ss, o);
    const float rs = rsqrtf(ss * (1.f / 1024.f) + 1e-6f);
#pragma unroll
    for (int i = 0; i < 4; ++i) {
      const float4 g = ((const float4*)gain)[lane + 64 * i];
      uint2 o2 = make_uint2(pk(v[i].x * rs * g.x, v[i].y * rs * g.y), pk(v[i].z * rs * g.z, v[i].w * rs * g.w));
      *(uint2*)(dst + (size_t)row * DM + (lane + 64 * i) * 4) = o2;
    }
  }
}

DI void mma_64x64(const bf16_t* sA, const bf16_t* sB, int arow0, int brow0, f32x16 (&acc)[2][2], int lane) {
  const int r = lane & 31, h = lane >> 5;
#pragma unroll
  for (int s = 0; s < 4; ++s) {
    bf16x8 a[2], b[2];
#pragma unroll
    for (int mi = 0; mi < 2; ++mi) a[mi] = *(const bf16x8*)(sA + (arow0 + mi * 32 + r) * LDK + s * 16 + h * 8);
#pragma unroll
    for (int ni = 0; ni < 2; ++ni) b[ni] = *(const bf16x8*)(sB + (brow0 + ni * 32 + r) * LDK + s * 16 + h * 8);
#pragma unroll
    for (int mi = 0; mi < 2; ++mi)
#pragma unroll
      for (int ni = 0; ni < 2; ++ni) acc[mi][ni] = mfma32(a[mi], b[ni], acc[mi][ni]);
  }
}

enum { EPI_GLA_IN = 0, EPI_RESID_X = 1, EPI_BF16 = 2, EPI_RESID_INPLACE = 3, EPI_SWA_IN = 4, EPI_PEER_Q = 5 };
DI void peer_topk_core(const Params& p, int layer, int head, int tok0, const bf16_t* qbase, int qstride);

template <int MODE>
DI void phase_gemm(const Params& p, const bf16_t* __restrict__ A, const bf16_t* __restrict__ Bt, int NT, bf16_t* dstb, int ldc,
                   const float* __restrict__ bias, char* smem) {
  const int ntiles = (T_TOK / 128) * NT;
  int t = (gridDim.x & 7) ? (int)blockIdx.x : (int)((blockIdx.x & 7) * (gridDim.x >> 3) + (blockIdx.x >> 3));
  if (t >= ntiles) return;
  bf16_t* sA = (bf16_t*)smem;
  bf16_t* sB = sA + 128 * LDK;
  bf16_t* ct = (bf16_t*)smem;
  const int tid = tidx(), lane = tid & 63, w = tid >> 6, wm = w >> 1, wn = w & 1;
  const int r = lane & 31, h = lane >> 5;
  const int lrow = tid >> 3, kc = tid & 7;
  bf16_t* wa = sA + lrow * LDK + kc * 8;
  bf16_t* wb = sB + lrow * LDK + kc * 8;
  bf16x8 ra0[4], rb0[4], ra1[4], rb1[4];
  int m0 = (t / NT) * 128, n0 = (t % NT) * 128;
  const bf16_t* ap = A + (size_t)(m0 + lrow) * 1024 + kc * 8;
  const bf16_t* bp = Bt + (size_t)(n0 + lrow) * 1024 + kc * 8;
#define GLOAD(RA, RB, KT) _Pragma("unroll") for (int i = 0; i < 4; ++i) { RA[i] = *(const bf16x8*)(ap + (size_t)i * 32 * 1024 + (KT) * 64); RB[i] = *(const bf16x8*)(bp + (size_t)i * 32 * 1024 + (KT) * 64); }
#define SSTORE(RA, RB) _Pragma("unroll") for (int i = 0; i < 4; ++i) { *(bf16x8*)(wa + 32 * i * LDK) = RA[i]; *(bf16x8*)(wb + 32 * i * LDK) = RB[i]; }
  GLOAD(ra0, rb0, 0)
  GLOAD(ra1, rb1, 1)
  for (; t < ntiles; t += gridDim.x) {
    f32x16 acc[2][2];
#pragma unroll
    for (int i = 0; i < 2; ++i)
#pragma unroll
      for (int j = 0; j < 2; ++j) acc[i][j] = zero16();
    __syncthreads();
    SSTORE(ra0, rb0)
    __syncthreads();
    for (int kt = 0; kt < 16; kt += 2) {
      if (kt + 2 < 16) { GLOAD(ra0, rb0, kt + 2) }
      mma_64x64(sA, sB, wm * 64, wn * 64, acc, lane);
      __syncthreads();
      SSTORE(ra1, rb1)
      __syncthreads();
      if (kt + 3 < 16) { GLOAD(ra1, rb1, kt + 3) }
      mma_64x64(sA, sB, wm * 64, wn * 64, acc, lane);
      __syncthreads();
      if (kt + 2 < 16) {
        SSTORE(ra0, rb0)
        __syncthreads();
      }
    }
    const int cm0 = m0, cn0 = n0;
    if (MODE != EPI_PEER_Q) {
      const int tn = t + gridDim.x;
      if (tn < ntiles) {
        m0 = (tn / NT) * 128; n0 = (tn % NT) * 128;
        ap = A + (size_t)(m0 + lrow) * 1024 + kc * 8;
        bp = Bt + (size_t)(n0 + lrow) * 1024 + kc * 8;
        GLOAD(ra0, rb0, 0)
        GLOAD(ra1, rb1, 1)
      }
    }
    const bool staged = (MODE == EPI_BF16) || (MODE == EPI_SWA_IN) || (MODE == EPI_PEER_Q) || (MODE == EPI_GLA_IN && cn0 < 3072);
    if (staged) {
#pragma unroll
      for (int ni = 0; ni < 2; ++ni) {
        const int col = wn * 64 + ni * 32 + r;
        const float bv = ((MODE == EPI_BF16 || MODE == EPI_SWA_IN) && bias) ? bias[cn0 + col] : 0.f;
#pragma unroll
        for (int mi = 0; mi < 2; ++mi)
#pragma unroll
          for (int i = 0; i < 16; ++i) ct[(wm * 64 + mi * 32 + crow(i, h)) * 136 + col] = f2bf(acc[mi][ni][i] + bv);
      }
      __syncthreads();
      if (MODE == EPI_SWA_IN && cn0 < 1152) {
        const int row = tid >> 1, hd = tid & 1;
        bf16_t* hp = ct + row * 136 + hd * 64;
        float ss = 0.f;
#pragma unroll
        for (int c8 = 0; c8 < 8; ++c8) {
          const uint4 wv = *(const uint4*)(hp + c8 * 8);
          const float f0 = bflo(wv.x), f1 = bfhi(wv.x), f2 = bflo(wv.y), f3 = bfhi(wv.y), f4 = bflo(wv.z), f5 = bfhi(wv.z), f6 = bflo(wv.w), f7 = bfhi(wv.w);
          ss += f0 * f0 + f1 * f1 + f2 * f2 + f3 * f3 + f4 * f4 + f5 * f5 + f6 * f6 + f7 * f7;
        }
        const float rs = rsqrtf(ss * (1.f / 64.f) + 1e-6f);
        const float* gain = (cn0 < 1024) ? p.swa_qn : p.swa_kn;
        const float qs = (cn0 < 1024) ? 0.125f : 1.f;
        {
          const uint4 w0 = *(const uint4*)hp, w1 = *(const uint4*)(hp + 8);
          float x1[8] = {bflo(w0.x), bfhi(w0.x), bflo(w0.y), bfhi(w0.y), bflo(w0.z), bfhi(w0.z), bflo(w0.w), bfhi(w0.w)};
          float x2[8] = {bflo(w1.x), bfhi(w1.x), bflo(w1.y), bfhi(w1.y), bflo(w1.z), bfhi(w1.z), bflo(w1.w), bfhi(w1.w)};
          const float posf = (float)p.pos[cm0 + row];
          const float invf[8] = {1.0f, 0.1939227432012558f, 0.03760603070259094f, 0.007292664609849453f,
                                 0.0014142135623842478f, 0.00027424818836152554f, 5.318296098266728e-05f, 1.0313386155758053e-05f};
#pragma unroll
          for (int e = 0; e < 8; ++e) {
            const float a1 = x1[e] * rs * gain[e], a2 = x2[e] * rs * gain[8 + e];
            const float ang = posf * invf[e];
            const double rev = (double)ang * 0.15915494309189535;
            const float fr = (float)(rev - rint(rev));
            const float sn = __builtin_amdgcn_sinf(fr), cs = __builtin_amdgcn_cosf(fr);
            x1[e] = (a1 * cs - a2 * sn) * qs;
            x2[e] = (a2 * cs + a1 * sn) * qs;
          }
          *(uint4*)hp = make_uint4(pk(x1[0], x1[1]), pk(x1[2], x1[3]), pk(x1[4], x1[5]), pk(x1[6], x1[7]));
          *(uint4*)(hp + 8) = make_uint4(pk(x2[0], x2[1]), pk(x2[2], x2[3]), pk(x2[4], x2[5]), pk(x2[6], x2[7]));
        }
#pragma unroll
        for (int c8 = 2; c8 < 8; ++c8) {
          const uint4 wv = *(const uint4*)(hp + c8 * 8);
          const float* g = gain + c8 * 8;
          const float sc = rs * qs;
          *(uint4*)(hp + c8 * 8) = make_uint4(pk(bflo(wv.x) * sc * g[0], bfhi(wv.x) * sc * g[1]), pk(bflo(wv.y) * sc * g[2], bfhi(wv.y) * sc * g[3]),
                                              pk(bflo(wv.z) * sc * g[4], bfhi(wv.z) * sc * g[5]), pk(bflo(wv.w) * sc * g[6], bfhi(wv.w) * sc * g[7]));
        }
        __syncthreads();
      }
      if (MODE == EPI_PEER_Q) {
        peer_topk_core(p, ldc, cn0 >> 7, cm0 + w * 32, ct + (w * 32) * 136, 136);
        __builtin_amdgcn_sched_barrier(0);
        const int tn = t + gridDim.x;
        if (tn < ntiles) {
          m0 = (tn / NT) * 128; n0 = (tn % NT) * 128;
          ap = A + (size_t)(m0 + lrow) * 1024 + kc * 8;
          bp = Bt + (size_t)(n0 + lrow) * 1024 + kc * 8;
          GLOAD(ra0, rb0, 0)
          GLOAD(ra1, rb1, 1)
        }
      } else {
        const int ldo = (MODE == EPI_GLA_IN) ? 3072 : ldc;
#pragma unroll
        for (int j = 0; j < 8; ++j) {
          const int c = tid + 256 * j, row = c >> 4, cc = c & 15;
          *(uint4*)(dstb + (size_t)(cm0 + row) * ldo + cn0 + cc * 8) = *(const uint4*)(ct + row * 136 + cc * 8);
        }
      }
    } else {
      const unsigned row0 = (unsigned)(cm0 + wm * 64 + 4 * h), col0 = (unsigned)(cn0 + wn * 64 + r);
      float* __restrict__ lrp = (float*)(p.ws + OFF_LR);
#pragma unroll
      for (int ni = 0; ni < 2; ++ni) {
        const unsigned col = col0 + ni * 32;
        float bv = 0.f;
        if (MODE == EPI_RESID_INPLACE) bv = bias[col];
        const unsigned i0 = row0 * 1024u + col;
        const unsigned l0 = row0 * 16u + (col - 3072u);
#pragma unroll
        for (int mi = 0; mi < 2; ++mi)
#pragma unroll
          for (int i = 0; i < 16; ++i) {
            const unsigned ro = (unsigned)(mi * 32 + (i & 3) + 8 * (i >> 2));
            const float v = acc[mi][ni][i];
            if (MODE == EPI_GLA_IN) { if (col < 3088u) lrp[l0 + ro * 16u] = v; }
            else if (MODE == EPI_RESID_X) p.out[i0 + ro * 1024u] = p.x[i0 + ro * 1024u] + v;
            else if (MODE == EPI_RESID_INPLACE) p.out[i0 + ro * 1024u] += v + bv;
          }
      }
    }
  }
#undef GLOAD
#undef SSTORE
}

DI float gate_la(const float* lr_s, int t, const float (&wa)[16], float ba) {
  float z = ba;
#pragma unroll
  for (int j = 0; j < 16; ++j) z += lr_s[t * 16 + j] * wa[j];
  return logsig(z) * (1.f / 16.f);
}
DI void gla_gates(const Params& p, int t0, int hh, float (&la)[32], float& offset, float& blast, float* lr_s, float* tot_s) {
  const int tid = tidx(), d = tid & 127, half = tid >> 7;
  const float* LR = (const float*)(p.ws + OFF_LR);
  ((float4*)lr_s)[tid] = ((const float4*)(LR + (size_t)t0 * 16))[tid];
  float wa[16];
#pragma unroll
  for (int j = 0; j < 16; ++j) wa[j] = p.gla_w_alpha[j * 512 + hh * 128 + d];
  const float ba = p.gla_b_alpha[hh * 128 + d];
  __syncthreads();
  float sum = 0.f;
#pragma unroll
  for (int tt = 0; tt < 32; ++tt) { la[tt] = gate_la(lr_s, half * 32 + tt, wa, ba); sum += la[tt]; }
  tot_s[half * 128 + d] = sum;
  __syncthreads();
  offset = half ? tot_s[d] : 0.f;
  blast = tot_s[d] + tot_s[128 + d];
}

DI void fill_vT(const bf16_t* __restrict__ QKVR, int t0, int hh, int vh, bf16_t* vT) {
  const int tid = tidx(), v = tid & 127, half = tid >> 7;
#pragma unroll 8
  for (int tt = 0; tt < 32; ++tt) {
    const int t = half * 32 + tt;
    vT[v * LDK + t] = QKVR[(size_t)(t0 + t) * 3072 + 1024 + hh * 256 + vh * 128 + v];
  }
}

DI void gla_phase1(const Params& p, int item, char* smem) {
  const int hh = item & 3, c = (item >> 2) & 255, b = item >> 10;
  const int t0 = b * SEQ + c * 64;
  float* lr_s = (float*)smem;
  float* tot_s = (float*)(smem + 4096);
  bf16_t* kfT = (bf16_t*)(smem + 5120);
  bf16_t* vT = kfT + 128 * LDK;
  const bf16_t* QKVR = (const bf16_t*)(p.ws + OFF_BIG);
  bf16_t* KVT = (bf16_t*)(p.ws + OFF_KVT);
  float* DECAY = (float*)(p.ws + OFF_DECAY);
  const int tid = tidx(), lane = tid & 63, w = tid >> 6, wm = w >> 1, wn = w & 1;
  const int d = tid & 127, half = tid >> 7;
  float la[32], offset, blast;
  gla_gates(p, t0, hh, la, offset, blast, lr_s, tot_s);
  float run = offset;
#pragma unroll
  for (int tt = 0; tt < 32; ++tt) {
    const int t = half * 32 + tt;
    run += la[tt];
    ((float*)(p.ws + OFF_ACT_A))[(size_t)(t0 + t) * 512 + hh * 128 + d] = run;
    const float kv = bf2f(QKVR[(size_t)(t0 + t) * 3072 + 512 + hh * 128 + d]);
    kfT[d * LDK + t] = f2bf(kv * __expf(blast - run));
  }
  if (half == 0) DECAY[(size_t)item * 128 + d] = __expf(blast);
  const int r = lane & 31, h = lane >> 5;
  for (int vh = 0; vh < 2; ++vh) {
    __syncthreads();
    fill_vT(QKVR, t0, hh, vh, vT);
    __syncthreads();
    f32x16 acc[2][2];
#pragma unroll
    for (int i = 0; i < 2; ++i)
#pragma unroll
      for (int j = 0; j < 2; ++j) acc[i][j] = zero16();
    mma_64x64(vT, kfT, wm * 64, wn * 64, acc, lane);
    bf16_t* kbase = KVT + (size_t)item * 32768 + (vh * 128 + wm * 64 + 4 * h) * 128 + wn * 64 + r;
#pragma unroll
    for (int mi = 0; mi < 2; ++mi)
#pragma unroll
      for (int ni = 0; ni < 2; ++ni)
#pragma unroll
        for (int i = 0; i < 16; ++i) kbase[(mi * 32 + (i & 3) + 8 * (i >> 2)) * 128 + ni * 32] = f2bf(acc[mi][ni][i]);
  }
  __syncthreads();
}

DI void gla_scan(const Params& p) {
  bf16_t* KVT = (bf16_t*)(p.ws + OFF_KVT);
  const float* DECAY = (const float*)(p.ws + OFF_DECAY);
  for (int idx = blockIdx.x * 256 + tidx(); idx < 8 * 16384; idx += gridDim.x * 256) {
    const int bh = idx >> 14, e2 = idx & 16383, b = bh >> 2, hh = bh & 3, d0 = (2 * e2) & 127;
    float s0 = 0.f, s1 = 0.f;
    for (int c0 = 0; c0 < 256; c0 += 8) {
      unsigned kv[8]; float2 dc[8];
#pragma unroll
      for (int u = 0; u < 8; ++u) {
        const size_t item = (size_t)(b * 256 + c0 + u) * 4 + hh;
        kv[u] = *(const unsigned*)(KVT + item * 32768 + 2 * e2);
        dc[u] = *(const float2*)(DECAY + item * 128 + d0);
      }
#pragma unroll
      for (int u = 0; u < 8; ++u) {
        const size_t item = (size_t)(b * 256 + c0 + u) * 4 + hh;
        *(unsigned*)(KVT + item * 32768 + 2 * e2) = pk(s0, s1);
        s0 = dc[u].x * s0 + bflo(kv[u]);
        s1 = dc[u].y * s1 + bfhi(kv[u]);
      }
    }
  }
}

DI void gla_phase3(const Params& p, int item, char* smem) {
  const int hh = item & 3, c = (item >> 2) & 255, b = item >> 10;
  const int t0 = b * SEQ + c * 64;
  float* lr_s = (float*)smem;
  float* tot_s = (float*)(smem + 4096);
  bf16_t* qd = (bf16_t*)(smem + 5120);
  bf16_t* ki = qd + 64 * 136;
  bf16_t* at = ki + 64 * 136;
  bf16_t* vT = at + 64 * 72;
  bf16_t* ot = qd;
  const bf16_t* QKVR = (const bf16_t*)(p.ws + OFF_BIG);
  const bf16_t* ST = (const bf16_t*)(p.ws + OFF_KVT);
  bf16_t* OG = (bf16_t*)(p.ws + OFF_ACT_A);
  const int tid = tidx(), lane = tid & 63, w = tid >> 6;
  const int d = tid & 127, half = tid >> 7;
  const int r = lane & 31, h = lane >> 5;
  {
    const float* Bc = (const float*)(p.ws + OFF_ACT_A);
#pragma unroll 8
    for (int tt = 0; tt < 32; ++tt) {
      const int t = half * 32 + tt;
      const float run = Bc[(size_t)(t0 + t) * 512 + hh * 128 + d];
      const float q = bf2f(QKVR[(size_t)(t0 + t) * 3072 + hh * 128 + d]);
      const float k = bf2f(QKVR[(size_t)(t0 + t) * 3072 + 512 + hh * 128 + d]);
      qd[t * 136 + d] = f2bf(q * 0.08838834764831845f * __expf(run));
      ki[t * 136 + d] = f2bf(k * __expf(-run));
    }
  }
  __syncthreads();
  {
    const int mi = w >> 1, nj = w & 1;
    f32x16 a = zero16();
#pragma unroll
    for (int s = 0; s < 8; ++s) {
      const bf16x8 A = *(const bf16x8*)(qd + (mi * 32 + r) * 136 + s * 16 + h * 8);
      const bf16x8 B = *(const bf16x8*)(ki + (nj * 32 + r) * 136 + s * 16 + h * 8);
      a = mfma32(A, B, a);
    }
#pragma unroll
    for (int i = 0; i < 16; ++i) {
      const int it = mi * 32 + crow(i, h), jt = nj * 32 + r;
      at[it * 72 + jt] = f2bf(jt <= it ? a[i] : 0.f);
    }
  }
  f32x16 o[2][2];
#pragma unroll
  for (int i = 0; i < 2; ++i)
#pragma unroll
    for (int j = 0; j < 2; ++j) o[i][j] = zero16();
#pragma unroll
  for (int vh = 0; vh < 2; ++vh) {
    __syncthreads();
    fill_vT(QKVR, t0, hh, vh, vT);
    __syncthreads();
#pragma unroll
    for (int s = 0; s < 4; ++s) {
      const bf16x8 B = *(const bf16x8*)(vT + (w * 32 + r) * LDK + s * 16 + h * 8);
#pragma unroll
      for (int mt = 0; mt < 2; ++mt) {
        const bf16x8 A = *(const bf16x8*)(at + (mt * 32 + r) * 72 + s * 16 + h * 8);
        o[vh][mt] = mfma32(A, B, o[vh][mt]);
      }
    }
    const bf16_t* Sg = ST + (size_t)item * 32768 + (size_t)(vh * 128 + w * 32 + r) * 128 + h * 8;
#pragma unroll
    for (int s = 0; s < 8; ++s) {
      const bf16x8 B = *(const bf16x8*)(Sg + s * 16);
#pragma unroll
      for (int mt = 0; mt < 2; ++mt) {
        const bf16x8 A = *(const bf16x8*)(qd + (mt * 32 + r) * 136 + s * 16 + h * 8);
        o[vh][mt] = mfma32(A, B, o[vh][mt]);
      }
    }
  }
  __syncthreads();
#pragma unroll
  for (int vh = 0; vh < 2; ++vh)
#pragma unroll
    for (int mt = 0; mt < 2; ++mt)
#pragma unroll
      for (int i = 0; i < 16; ++i) ot[(mt * 32 + crow(i, h)) * 264 + vh * 128 + w * 32 + r] = f2bf(o[vh][mt][i]);
  __syncthreads();
  {
    const int row = tid >> 2, seg = tid & 3;
    const bf16_t* orow = ot + row * 264 + seg * 64;
    float ss = 0.f;
#pragma unroll
    for (int c8 = 0; c8 < 8; ++c8) {
      const uint4 ov = *(const uint4*)(orow + c8 * 8);
      const float f0 = bflo(ov.x), f1 = bfhi(ov.x), f2 = bflo(ov.y), f3 = bfhi(ov.y), f4 = bflo(ov.z), f5 = bfhi(ov.z), f6 = bflo(ov.w), f7 = bfhi(ov.w);
      ss += f0 * f0 + f1 * f1 + f2 * f2 + f3 * f3 + f4 * f4 + f5 * f5 + f6 * f6 + f7 * f7;
    }
    ss += __shfl_xor(ss, 1);
    ss += __shfl_xor(ss, 2);
    const float rs = rsqrtf(ss * (1.f / 256.f) + 1e-6f);
    const bf16_t* rrow = QKVR + (size_t)(t0 + row) * 3072 + 2048 + hh * 256 + seg * 64;
    const float* grow = p.gla_norm + hh * 256 + seg * 64;
    bf16_t* dst = OG + (size_t)(t0 + row) * 1024 + hh * 256 + seg * 64;
#pragma unroll
    for (int c8 = 0; c8 < 8; ++c8) {
      const uint4 ov = *(const uint4*)(orow + c8 * 8);
      const uint4 rv = *(const uint4*)(rrow + c8 * 8);
      const float4 g0 = *(const float4*)(grow + c8 * 8), g1 = *(const float4*)(grow + c8 * 8 + 4);
      float of[8] = {bflo(ov.x), bfhi(ov.x), bflo(ov.y), bfhi(ov.y), bflo(ov.z), bfhi(ov.z), bflo(ov.w), bfhi(ov.w)};
      float rf[8] = {bflo(rv.x), bfhi(rv.x), bflo(rv.y), bfhi(rv.y), bflo(rv.z), bfhi(rv.z), bflo(rv.w), bfhi(rv.w)};
      float gf[8] = {g0.x, g0.y, g0.z, g0.w, g1.x, g1.y, g1.z, g1.w};
      float res[8];
#pragma unroll
      for (int e = 0; e < 8; ++e) res[e] = of[e] * rs * gf[e] * (rf[e] / (1.f + __expf(-rf[e])));
      *(uint4*)(dst + c8 * 8) = make_uint4(pk(res[0], res[1]), pk(res[2], res[3]), pk(res[4], res[5]), pk(res[6], res[7]));
    }
  }
  __syncthreads();
}

DI void swa_qknorm(const Params& p) {
  bf16_t* QKV = (bf16_t*)(p.ws + OFF_BIG);
  const int tid = tidx(), sub = tid & 7;
  const int ngroups = T_TOK * 18;
  for (int g = blockIdx.x * 32 + (tid >> 3); g < ngroups; g += gridDim.x * 32) {
    const int tok = g / 18, slot = g - tok * 18;
    bf16_t* ptr = QKV + (size_t)tok * 1280 + slot * 64 + sub * 8;
    const uint4 wv = *(const uint4*)ptr;
    float v[8] = {bflo(wv.x), bfhi(wv.x), bflo(wv.y), bfhi(wv.y), bflo(wv.z), bfhi(wv.z), bflo(wv.w), bfhi(wv.w)};
    float ss = 0.f;
#pragma unroll
    for (int e = 0; e < 8; ++e) ss += v[e] * v[e];
    ss += __shfl_xor(ss, 1);
    ss += __shfl_xor(ss, 2);
    ss += __shfl_xor(ss, 4);
    const float rs = rsqrtf(ss * (1.f / 64.f) + 1e-6f);
    const float* gain = (slot < 16 ? p.swa_qn : p.swa_kn) + sub * 8;
#pragma unroll
    for (int e = 0; e < 8; ++e) v[e] = v[e] * rs * gain[e];
    const float posf = (float)p.pos[tok];
    const float invf[8] = {1.0f, 0.1939227432012558f, 0.03760603070259094f, 0.007292664609849453f,
                           0.0014142135623842478f, 0.00027424818836152554f, 5.318296098266728e-05f, 1.0313386155758053e-05f};
#pragma unroll
    for (int e = 0; e < 8; ++e) {
      const float other = __shfl_xor(v[e], 1);
      if (sub < 2) {
        const float ang = posf * invf[e];
        const double rev = (double)ang * 0.15915494309189535;
        const float fr = (float)(rev - rint(rev));
        const float sn = __builtin_amdgcn_sinf(fr), cs = __builtin_amdgcn_cosf(fr);
        v[e] = (sub == 0) ? (v[e] * cs - other * sn) : (v[e] * cs + other * sn);
      }
    }
    if (slot < 16) {
#pragma unroll
      for (int e = 0; e < 8; ++e) v[e] *= 0.125f;
    }
    *(uint4*)ptr = make_uint4(pk(v[0], v[1]), pk(v[2], v[3]), pk(v[4], v[5]), pk(v[6], v[7]));
  }
}

DI void swa_attn(const Params& p, int item, char* smem) {
  const int hq = item & 15, n = (item >> 4) & 127, b = item >> 11, hkv = hq >> 3;
  const int tok0 = b * SEQ + n * 128;
  bf16_t* Ks = (bf16_t*)smem;
  bf16_t* vT = Ks + 256 * 72;
  const bf16_t* QKV = (const bf16_t*)(p.ws + OFF_BIG);
  bf16_t* OUT = (bf16_t*)(p.ws + OFF_ACT_B);
  const int tid = tidx(), lane = tid & 63, w = tid >> 6, r = lane & 31, h = lane >> 5;
  __syncthreads();
#pragma unroll
  for (int i = 0; i < 8; ++i) {
    const int cidx = tid + 256 * i, kk = cidx >> 3, kc = cidx & 7;
    const int pos = n * 128 - 128 + kk;
    uint4 kw = make_uint4(0, 0, 0, 0), vw = make_uint4(0, 0, 0, 0);
    if (pos >= 0) {
      const bf16_t* base = QKV + (size_t)(b * SEQ + pos) * 1280;
      kw = *(const uint4*)(base + 1024 + hkv * 64 + kc * 8);
      vw = *(const uint4*)(base + 1152 + hkv * 64 + kc * 8);
    }
    *(uint4*)(Ks + kk * 72 + kc * 8) = kw;
    bf16_t* vd = vT + (kc * 8) * 264 + kk;
    vd[0 * 264] = (bf16_t)(vw.x & 0xffff); vd[1 * 264] = (bf16_t)(vw.x >> 16);
    vd[2 * 264] = (bf16_t)(vw.y & 0xffff); vd[3 * 264] = (bf16_t)(vw.y >> 16);
    vd[4 * 264] = (bf16_t)(vw.z & 0xffff); vd[5 * 264] = (bf16_t)(vw.z >> 16);
    vd[6 * 264] = (bf16_t)(vw.w & 0xffff); vd[7 * 264] = (bf16_t)(vw.w >> 16);
  }
  __syncthreads();
  const int iq = 32 * w + r;
  const bf16_t* qrow = QKV + (size_t)(tok0 + iq) * 1280 + hq * 64 + h * 8;
  bf16x8 qf[4];
#pragma unroll
  for (int s = 0; s < 4; ++s) qf[s] = *(const bf16x8*)(qrow + s * 16);
  f32x16 X[5];
#pragma unroll
  for (int kt = 0; kt < 5; ++kt) {
    X[kt] = zero16();
#pragma unroll
    for (int s = 0; s < 4; ++s) {
      const bf16x8 A = *(const bf16x8*)(Ks + ((w + kt) * 32 + r) * 72 + s * 16 + h * 8);
      X[kt] = mfma32(A, qf[s], X[kt]);
    }
  }
  const float sink = p.swa_sinks[hq];
  float m = sink;
#pragma unroll
  for (int kt = 0; kt < 5; ++kt)
#pragma unroll
    for (int i = 0; i < 16; ++i) {
      const int kk = (w + kt) * 32 + crow(i, h);
      const bool valid = (kk > iq) && (kk <= iq + 128) && (n > 0 || kk >= 128);
      const float xv = valid ? X[kt][i] : -INFINITY;
      X[kt][i] = xv;
      m = fmaxf(m, xv);
    }
  m = fmaxf(m, __shfl_xor(m, 32));
  float l = 0.f;
#pragma unroll
  for (int kt = 0; kt < 5; ++kt)
#pragma unroll
    for (int i = 0; i < 16; ++i) {
      const float pv = __expf(X[kt][i] - m);
      X[kt][i] = pv;
      l += pv;
    }
  l += __shfl_xor(l, 32);
  l += __expf(sink - m);
  f32x16 O[2];
  O[0] = zero16(); O[1] = zero16();
#pragma unroll
  for (int kt = 0; kt < 5; ++kt)
#pragma unroll
    for (int s2 = 0; s2 < 2; ++s2) {
      const uint4 pw = make_uint4(pk(X[kt][8 * s2 + 0], X[kt][8 * s2 + 1]), pk(X[kt][8 * s2 + 2], X[kt][8 * s2 + 3]),
                                  pk(X[kt][8 * s2 + 4], X[kt][8 * s2 + 5]), pk(X[kt][8 * s2 + 6], X[kt][8 * s2 + 7]));
      const bf16x8 P = __builtin_bit_cast(bf16x8, pw);
#pragma unroll
      for (int mt = 0; mt < 2; ++mt) {
        const bf16_t* vp = vT + (mt * 32 + r) * 264 + (w + kt) * 32 + 16 * s2 + 4 * h;
        const uint2 lo = *(const uint2*)vp, hi = *(const uint2*)(vp + 8);
        const bf16x8 A = __builtin_bit_cast(bf16x8, make_uint4(lo.x, lo.y, hi.x, hi.y));
        O[mt] = mfma32(A, P, O[mt]);
      }
    }
  const float inv = 1.f / l;
  bf16_t* orow = OUT + (size_t)(tok0 + iq) * 1024 + hq * 64 + 4 * h;
#pragma unroll
  for (int mt = 0; mt < 2; ++mt)
#pragma unroll
    for (int g = 0; g < 4; ++g)
      *(uint2*)(orow + mt * 32 + 8 * g) = make_uint2(pk(O[mt][4 * g] * inv, O[mt][4 * g + 1] * inv), pk(O[mt][4 * g + 2] * inv, O[mt][4 * g + 3] * inv));
}

DI unsigned fkey_u(unsigned u) { return u ^ ((unsigned)((int)u >> 31) | 0x80000000u); }
DI float unfkey(unsigned k) { return __uint_as_float(k ^ ((~(unsigned)((int)k >> 31)) | 0x80000000u)); }
DI void cswap(unsigned& a, unsigned& b) { const unsigned hi = a > b ? a : b, lo = a > b ? b : a; a = hi; b = lo; }
DI void sort16(unsigned (&t)[16]) {
#pragma unroll
  for (int k = 2; k <= 16; k <<= 1)
#pragma unroll
    for (int j = k >> 1; j > 0; j >>= 1)
#pragma unroll
      for (int i = 0; i < 16; ++i) {
        const int l = i ^ j;
        if (l > i) { if ((i & k) == 0) cswap(t[i], t[l]); else cswap(t[l], t[i]); }
      }
}
DI void merge16(unsigned (&a)[16], const unsigned (&b)[16]) {
#pragma unroll
  for (int j = 0; j < 16; ++j) a[j] = a[j] > b[15 - j] ? a[j] : b[15 - j];
#pragma unroll
  for (int j = 8; j > 0; j >>= 1)
#pragma unroll
    for (int i = 0; i < 16; ++i) { const int l = i ^ j; if (l > i) cswap(a[i], a[l]); }
}
DI void cswap2(unsigned& ak, int& ap, unsigned& bk, int& bp) {
  const bool sw = bk > ak;
  const unsigned hk = sw ? bk : ak, lk = sw ? ak : bk;
  const int hp = sw ? bp : ap, lp = sw ? ap : bp;
  ak = hk; ap = hp; bk = lk; bp = lp;
}
DI void sort16p(unsigned (&t)[16], int (&q)[16]) {
#pragma unroll
  for (int k = 2; k <= 16; k <<= 1)
#pragma unroll
    for (int j = k >> 1; j > 0; j >>= 1)
#pragma unroll
      for (int i = 0; i < 16; ++i) {
        const int l = i ^ j;
        if (l > i) { if ((i & k) == 0) cswap2(t[i], q[i], t[l], q[l]); else cswap2(t[l], q[l], t[i], q[i]); }
      }
}
__device__ constexpr int CIA[25] = {0,0,0,0,0,0,0,0,0,0,0,0,0,0,0,0, 2,2,2,2,2, 3,3,3,3};
__device__ constexpr int CJA[25] = {0,1,2,3,4,5,6,7,8,9,10,11,12,13,14,15, 0,1,2,3,4, 0,1,2,3};
__device__ constexpr int CIB[25] = {1,1,1,1,1,1,1,1, 4,4,4, 5,5,6,6,7,7, 8,9,10,11,12,13,14,15};
__device__ constexpr int CJB[25] = {0,1,2,3,4,5,6,7, 0,1,2, 0,1,0,1,0,1, 0,0,0,0,0,0,0,0};

DI void peer_topk_core(const Params& p, int layer, int head, int tok0, const bf16_t* qbase, int qstride) {
  const bf16_t* KEYS = (const bf16_t*)(p.ws + OFF_KEYS) + (size_t)(layer * 8 + head) * 256 * 64;
  int* E = (int*)(p.ws + OFF_E);
  float* G = (float*)(p.ws + OFF_G);
  const int lane = tidx() & 63, r = lane & 31, h = lane >> 5;
  const unsigned h4 = 4u * (1u - (unsigned)h);
  unsigned tl[2][16];
#pragma unroll
  for (int set = 0; set < 2; ++set) {
    bf16x8 qf[4];
    {
      const bf16_t* qrow = qbase + r * qstride + set * 64 + h * 8;
#pragma unroll
      for (int s = 0; s < 4; ++s) qf[s] = *(const bf16x8*)(qrow + s * 16);
    }
#pragma unroll
    for (int hf = 0; hf < 2; ++hf) {
      bf16x8 kf[2][4];
#pragma unroll
      for (int t2 = 0; t2 < 2; ++t2)
#pragma unroll
        for (int s = 0; s < 4; ++s) kf[t2][s] = *(const bf16x8*)(KEYS + (size_t)(set * 128 + (2 * hf + t2) * 32 + r) * 64 + h * 8 + s * 16);
#pragma unroll
      for (int t2 = 0; t2 < 2; ++t2) {
        const int kt = 2 * hf + t2;
        f32x16 X = zero16();
#pragma unroll
        for (int s = 0; s < 4; ++s) X = mfma32(kf[t2][s], qf[s], X);
        unsigned kk[16];
#pragma unroll
        for (int i = 0; i < 16; ++i)
          kk[i] = (fkey_u(__float_as_uint(X[i])) & ~127u) + ((unsigned)(127 - kt * 32 - (i & 3) - 8 * (i >> 2) - 4) + h4);
        sort16(kk);
        if (kt == 0) {
#pragma unroll
          for (int i = 0; i < 16; ++i) tl[set][i] = kk[i];
        } else merge16(tl[set], kk);
      }
    }
  }
  __builtin_amdgcn_sched_barrier(0);
  unsigned mine[16], oth[16];
#pragma unroll
  for (int j = 0; j < 16; ++j) {
    const unsigned send = h ? tl[0][j] : tl[1][j];
    oth[j] = (unsigned)__shfl_xor((int)send, 32);
    mine[j] = h ? tl[1][j] : tl[0][j];
  }
  merge16(mine, oth);
  float v1[16], v2[16]; int i1[16], i2[16];
#pragma unroll
  for (int j = 0; j < 16; ++j) {
    const unsigned o = (unsigned)__shfl_xor((int)mine[j], 32);
    const unsigned A = h ? o : mine[j], B = h ? mine[j] : o;
    v1[j] = unfkey(A & ~127u); i1[j] = 127 - (int)(A & 127u);
    v2[j] = unfkey(B & ~127u); i2[j] = 127 - (int)(B & 127u);
  }
  __builtin_amdgcn_sched_barrier(0);
  unsigned ck[16], dk[16]; int cp[16], dp[16];
#pragma unroll
  for (int n = 0; n < 32; ++n) {
    unsigned key = 0u; int e = 0;
    if (n < 25) {
      const float sA = v1[CIA[n]] + v2[CJA[n]], sB = v1[CIB[n]] + v2[CJB[n]];
      const int eA = i1[CIA[n]] * 128 + i2[CJA[n]], eB = i1[CIB[n]] * 128 + i2[CJB[n]];
      key = fkey_u(__float_as_uint(h ? sB : sA)); e = h ? eB : eA;
    }
    if (n < 16) { ck[n] = key; cp[n] = e; } else { dk[n - 16] = key; dp[n - 16] = e; }
  }
  __builtin_amdgcn_sched_barrier(0);
  sort16p(ck, cp);
  __builtin_amdgcn_sched_barrier(0);
  sort16p(dk, dp);
  __builtin_amdgcn_sched_barrier(0);
#pragma unroll
  for (int j = 0; j < 16; ++j) { const bool sw = dk[15 - j] > ck[j]; ck[j] = sw ? dk[15 - j] : ck[j]; cp[j] = sw ? dp[15 - j] : cp[j]; }
#pragma unroll
  for (int j = 8; j > 0; j >>= 1)
#pragma unroll
    for (int i = 0; i < 16; ++i) { const int l = i ^ j; if (l > i) cswap2(ck[i], cp[i], ck[l], cp[l]); }
  unsigned fk[16]; int fe[16];
#pragma unroll
  for (int j = 0; j < 16; ++j) { dk[j] = (unsigned)__shfl_xor((int)ck[j], 32); dp[j] = __shfl_xor(cp[j], 32); }
#pragma unroll
  for (int j = 0; j < 16; ++j) {
    const bool sw = (dk[15 - j] > ck[j]) || (dk[15 - j] == ck[j] && dp[15 - j] > cp[j]);
    fk[j] = sw ? dk[15 - j] : ck[j]; fe[j] = sw ? dp[15 - j] : cp[j];
  }
  float sv[16], mx = -INFINITY;
#pragma unroll
  for (int j = 0; j < 16; ++j) { sv[j] = unfkey(fk[j]); mx = fmaxf(mx, sv[j]); }
  float sm = 0.f;
#pragma unroll
  for (int j = 0; j < 16; ++j) { sv[j] = __expf(sv[j] - mx); sm += sv[j]; }
  const float inv = 1.f / sm;
  const size_t o = ((size_t)(tok0 + r) * 8 + head) * 16 + h * 8;
  *(int4*)(E + o) = make_int4(fe[0], fe[1], fe[2], fe[3]);
  *(int4*)(E + o + 4) = make_int4(fe[4], fe[5], fe[6], fe[7]);
  *(float4*)(G + o) = make_float4(sv[0] * inv, sv[1] * inv, sv[2] * inv, sv[3] * inv);
  *(float4*)(G + o + 4) = make_float4(sv[4] * inv, sv[5] * inv, sv[6] * inv, sv[7] * inv);
}

DI v32f fp6x32(const uint2* p) {
  const uint2 a = p[0], b = p[1], c = p[2];
  v6u x; x[0] = a.x; x[1] = a.y; x[2] = b.x; x[3] = b.y; x[4] = c.x; x[5] = c.y;
  return __builtin_amdgcn_cvt_scalef32_pk32_f32_fp6(x, 1.0f);
}

typedef unsigned u2v __attribute__((ext_vector_type(2)));
typedef unsigned v16u __attribute__((ext_vector_type(16)));
typedef __bf16 v32bf __attribute__((ext_vector_type(32)));
DI v6u mk6(u2v a, u2v b, u2v c) { v6u x; x[0] = a[0]; x[1] = a[1]; x[2] = b[0]; x[3] = b[1]; x[4] = c[0]; x[5] = c[1]; return x; }

DI v6u ld6(const unsigned char* p) { const u2v* q = (const u2v*)p; return mk6(q[0], q[1], q[2]); }
#define U_LOAD2(RAW, M2) _Pragma("unroll") for (int mi = 0; mi < 2; ++mi) { \
    const unsigned char* up_ = U + (size_t)e_s[8 * ((M2) + mi) + grp8] * 768 + i8 * 24; \
    _Pragma("unroll") for (int k = 0; k < 4; ++k) RAW[4 * mi + k] = ld6(up_ + 192 * k); }
#define U_COMP2(RAW, M2) _Pragma("unroll") for (int mi = 0; mi < 2; ++mi) { \
    const int pidx = 8 * ((M2) + mi) + grp8; \
    float acc0 = 0.f, acc1 = 0.f, acc2 = 0.f, acc3 = 0.f; \
    _Pragma("unroll") for (int k = 0; k < 4; ++k) { \
      const v16u ub = __builtin_bit_cast(v16u, __builtin_amdgcn_cvt_scalef32_pk32_bf16_fp6(RAW[4 * mi + k], 1.0f)); \
      _Pragma("unroll") for (int i = 0; i < 16; i += 4) { \
        acc0 = dot2(ub[i], xp[k][i], acc0); acc1 = dot2(ub[i + 1], xp[k][i + 1], acc1); \
        acc2 = dot2(ub[i + 2], xp[k][i + 2], acc2); acc3 = dot2(ub[i + 3], xp[k][i + 3], acc3); } } \
    float acc = (acc0 + acc1) + (acc2 + acc3); \
    acc += __shfl_xor(acc, 1); acc += __shfl_xor(acc, 2); acc += __shfl_xor(acc, 4); \
    if (i8 == 0) a_s[pidx] = acc;              \
    __builtin_amdgcn_sched_barrier(0); }

DI void peer_gather_u(const Params& p, int layer, char* smem) {
  const int tid = tidx(), lane = tid & 63, w = tid >> 6, grp8 = lane >> 3, i8 = lane & 7;
  float* a_s = (float*)smem + w * 512;
  float* su_s = a_s + 128;
  float* gv_s = a_s + 256;
  int* e_s = (int*)(a_s + 384);
  const bf16_t* HN = (const bf16_t*)(p.ws + OFF_ACT_A);
  const unsigned char* U = (const unsigned char*)(p.ws + OFF_TBL_U) + (size_t)layer * 16 * MiB;
  const float* IU = (const float*)(p.ws + OFF_INV) + (layer * 2 + 0) * 16384;
  const float* IV = (const float*)(p.ws + OFF_INV) + (layer * 2 + 1) * 16384;
  const int* E = (const int*)(p.ws + OFF_E);
  const float* G = (const float*)(p.ws + OFF_G);
  float* A = (float*)(p.ws + OFF_A);
  for (int tok = blockIdx.x * 4 + w; tok < T_TOK; tok += gridDim.x * 4) {
    unsigned xp[4][16];
#pragma unroll
    for (int k = 0; k < 4; ++k) {
      const uint4* xq = (const uint4*)(HN + (size_t)tok * 1024 + (i8 + 8 * k) * 32);
#pragma unroll
      for (int q = 0; q < 4; ++q) { const uint4 x0 = xq[q]; xp[k][4 * q] = x0.x; xp[k][4 * q + 1] = x0.y; xp[k][4 * q + 2] = x0.z; xp[k][4 * q + 3] = x0.w; }
    }
    const int e0 = E[(size_t)tok * 128 + lane], e1 = E[(size_t)tok * 128 + 64 + lane];
    e_s[lane] = e0; e_s[64 + lane] = e1;
    const float su0 = IU[e0], su1 = IU[e1];
    const float gv0 = G[(size_t)tok * 128 + lane] * IV[e0], gv1 = G[(size_t)tok * 128 + 64 + lane] * IV[e1];
    wave_sync();
    v6u rA[8], rB[8];
    U_LOAD2(rA, 0)
#pragma unroll 1
    for (int m2 = 0; m2 < 16; m2 += 4) {
      U_LOAD2(rB, m2 + 2)
      U_COMP2(rA, m2)
      if (m2 + 4 < 16) { U_LOAD2(rA, m2 + 4) }
      U_COMP2(rB, m2 + 2)
    }
    wave_sync();
    {
      const float s0 = a_s[lane] * su0, s1 = a_s[64 + lane] * su1;
      A[(size_t)tok * 128 + lane] = 0.5f * s0 * (1.f + erff(s0 * 0.7071067811865476f)) * gv0;
      A[(size_t)tok * 128 + 64 + lane] = 0.5f * s1 * (1.f + erff(s1 * 0.7071067811865476f)) * gv1;
    }
    wave_sync();
  }
}

#define V_LOAD8(RAW, M8) _Pragma("unroll") for (int mi = 0; mi < 4; ++mi) RAW[mi] = ld6(V + (size_t)e_s[2 * ((M8) + mi) + h] * 768 + r * 24);
#define V_COMP8(RAW, M8) _Pragma("unroll") for (int mi = 0; mi < 4; ++mi) { \
    const float a = a_s[2 * ((M8) + mi) + h]; \
    const v32f vv = __builtin_amdgcn_cvt_scalef32_pk32_f32_fp6(RAW[mi], 1.0f); \
    _Pragma("unroll") for (int i = 0; i < 32; ++i) o[i] = fmaf(a, vv[i], o[i]); \
    __builtin_amdgcn_sched_barrier(0); }

DI void peer_gather_v(const Params& p, int layer, char* smem, const float* __restrict__ next_gain) {
  const int tid = tidx(), lane = tid & 63, w = tid >> 6, r = lane & 31, h = lane >> 5;
  float* a_s = (float*)smem + w * 256;
  int* e_s = (int*)(a_s + 128);
  const unsigned char* V = (const unsigned char*)(p.ws + OFF_TBL_V) + (size_t)layer * 16 * MiB;
  const int* E = (const int*)(p.ws + OFF_E);
  const float* A = (const float*)(p.ws + OFF_A);
  for (int tok = blockIdx.x * 4 + w; tok < T_TOK; tok += gridDim.x * 4) {
    e_s[lane] = E[(size_t)tok * 128 + lane]; e_s[64 + lane] = E[(size_t)tok * 128 + 64 + lane];
    a_s[lane] = A[(size_t)tok * 128 + lane]; a_s[64 + lane] = A[(size_t)tok * 128 + 64 + lane];
    wave_sync();
    float o[32];
#pragma unroll
    for (int i = 0; i < 32; ++i) o[i] = 0.f;
    v6u rA[4], rB[4];
    V_LOAD8(rA, 0)
#pragma unroll 1
    for (int m8 = 0; m8 < 64; m8 += 8) {
      V_LOAD8(rB, m8 + 4)
      V_COMP8(rA, m8)
      if (m8 + 8 < 64) { V_LOAD8(rA, m8 + 8) }
      V_COMP8(rB, m8 + 4)
    }
#pragma unroll
    for (int i = 0; i < 32; ++i) {
      const unsigned xb = __float_as_uint(o[i]);
      const auto sw = __builtin_amdgcn_permlane32_swap(xb, xb, false, false);
      o[i] = __uint_as_float(sw[0]) + __uint_as_float(sw[1]);
    }
    float4* hp = (float4*)(p.out + (size_t)tok * 1024 + r * 32 + h * 16);
    float4 hv[4];
    float ss = 0.f;
#pragma unroll
    for (int q = 0; q < 4; ++q) {
      float4 t = hp[q];
      t.x += h ? o[16 + 4 * q] : o[4 * q]; t.y += h ? o[17 + 4 * q] : o[4 * q + 1];
      t.z += h ? o[18 + 4 * q] : o[4 * q + 2]; t.w += h ? o[19 + 4 * q] : o[4 * q + 3];
      hp[q] = t; hv[q] = t;
      ss += t.x * t.x + t.y * t.y + t.z * t.z + t.w * t.w;
    }
    if (next_gain) {
#pragma unroll
      for (int o2 = 32; o2 >= 1; o2 >>= 1) ss += __shfl_xor(ss, o2);
      const float rs = rsqrtf(ss * (1.f / 1024.f) + 1e-6f);
      const float4* gp = (const float4*)(next_gain + r * 32 + h * 16);
      unsigned pw[8];
#pragma unroll
      for (int q = 0; q < 4; ++q) {
        const float4 g = gp[q];
        pw[2 * q] = pk(hv[q].x * rs * g.x, hv[q].y * rs * g.y); pw[2 * q + 1] = pk(hv[q].z * rs * g.z, hv[q].w * rs * g.w);
      }
      uint4* dp = (uint4*)((bf16_t*)(p.ws + OFF_ACT_A) + (size_t)tok * 1024 + r * 32 + h * 16);
      dp[0] = make_uint4(pw[0], pw[1], pw[2], pw[3]); dp[1] = make_uint4(pw[4], pw[5], pw[6], pw[7]);
    }
    wave_sync();
  }
}

DI void run_phase(const Params& p, int ph, char* smem) {
  bf16_t* actA = (bf16_t*)(p.ws + OFF_ACT_A);
  bf16_t* big = (bf16_t*)(p.ws + OFF_BIG);
  switch (ph) {
    case 0: phase_convert(p, smem); phase_cvt_tables(p, 0); phase_cvt_tables(p, 1); break;
    case 1: phase_rmsnorm(p.x, p.ln_mix, actA); break;
    case 2: phase_gemm<EPI_GLA_IN>(p, actA, (const bf16_t*)(p.ws + OFF_WT_GLA_IN), 25, big, 3072, nullptr, smem); break;
    case 3: for (int it = blockIdx.x; it < 2048; it += gridDim.x) gla_phase1(p, it, smem); break;
    case 4: gla_scan(p); break;
    case 5: for (int it = blockIdx.x; it < 2048; it += gridDim.x) gla_phase3(p, it, smem); break;
    case 6: phase_gemm<EPI_RESID_X>(p, actA, (const bf16_t*)(p.ws + OFF_WT_GLA_OUT), 8, nullptr, 0, nullptr, smem); break;
    case 7: phase_rmsnorm(p.out, p.ln_ffn, actA); break;
    case 8: phase_gemm<EPI_PEER_Q>(p, actA, (const bf16_t*)(p.ws + OFF_WT_PQ), 8, nullptr, 0, nullptr, smem); break;
    case 9: break;
    case 10: peer_gather_u(p, 0, smem); break;
    case 11: peer_gather_v(p, 0, smem, p.ln_mix + 1024); break;
    case 12: break;
    case 13: phase_gemm<EPI_SWA_IN>(p, actA, (const bf16_t*)(p.ws + OFF_WT_SWA_IN), 10, big, 1280, p.swa_b_in, smem); break;
    case 14: break;
    case 15: for (int it = blockIdx.x; it < 4096; it += gridDim.x) swa_attn(p, it, smem); break;
    case 16: phase_gemm<EPI_RESID_INPLACE>(p, (const bf16_t*)(p.ws + OFF_ACT_B), (const bf16_t*)(p.ws + OFF_WT_SWA_OUT), 8, nullptr, 0, p.swa_b_out, smem); break;
    case 17: phase_rmsnorm(p.out, p.ln_ffn + 1024, actA); break;
    case 18: phase_gemm<EPI_PEER_Q>(p, actA, (const bf16_t*)(p.ws + OFF_WT_PQ) + (size_t)1024 * 1024, 8, nullptr, 1, nullptr, smem); break;
    case 19: break;
    case 20: peer_gather_u(p, 1, smem); break;
    case 21: peer_gather_v(p, 1, smem, nullptr); break;
    default: break;
  }
}

template <int PH>
__global__ void __launch_bounds__(256, 2) phase_kernel(Params p) {
  __shared__ __attribute__((aligned(16))) char smem[SMEM_BYTES];
  run_phase(p, PH, smem);
}

template <int PH>
static void launch_phases(const Params& p, int grid, hipStream_t stream) {
  hipLaunchKernelGGL(phase_kernel<PH>, dim3(grid), dim3(256), 0, stream, p);
  if constexpr (PH + 1 < NPHASE) launch_phases<PH + 1>(p, grid, stream);
}


#define XB_TMO      128
#define XB_XCNT(j)  (256  + 64 * (j))
#define XB_XSUB(j)  (1280 + 64 * (j))
#define XB_XGEN(j)  (2304 + 64 * (j))
#define XB_TOP      3328
#define XB_TOPGEN   3392
#define XCD_BAR_WORDS 3456
#define XB_SPIN_CAP (1u << 23)
#define LAS __attribute__((address_space(3)))
DI unsigned xb_ld(unsigned* p) { return __hip_atomic_load(p, __ATOMIC_RELAXED, __HIP_MEMORY_SCOPE_AGENT); }
DI unsigned xb_add(unsigned* p, unsigned v) { return __hip_atomic_fetch_add(p, v, __ATOMIC_RELAXED, __HIP_MEMORY_SCOPE_AGENT); }
DI unsigned xb_xcc_id() { return (unsigned)__builtin_amdgcn_s_getreg((3 << 11) | 20) & 0xFu; }
#define XB_SPIN(cond, bar) do { unsigned _sp = 0; while (cond) { __builtin_amdgcn_s_sleep(1); \
    if ((++_sp & 255u) == 0u) { if (xb_ld(&(bar)[XB_TMO])) break; if (_sp > XB_SPIN_CAP) { atomicAdd(&(bar)[XB_TMO], 1u); break; } } } } while (0)
struct XcdBarrier { unsigned* bar; unsigned x; volatile LAS unsigned* st; };
DI XcdBarrier xcd_barrier_post(unsigned* bar, volatile LAS unsigned* st) {
  XcdBarrier b; b.bar = bar; b.x = xb_xcc_id(); b.st = st;
  if (tidx() == 0) (void)xb_add(&bar[XB_XCNT(b.x)], 1u);
  return b;
}
DI void xcd_barrier_complete(unsigned* bar, unsigned x, unsigned& nloc, unsigned& nx) {
  const unsigned G = gridDim.x * gridDim.y * gridDim.z;
  unsigned sum, cnt, mine, sp = 0u;
  for (;;) {
    sum = 0u; cnt = 0u; mine = 0u;
#pragma unroll
    for (unsigned j = 0; j < 16; ++j) { const unsigned c = xb_ld(&bar[XB_XCNT(j)]); sum += c; cnt += (c > 0u) ? 1u : 0u; mine = (j == x) ? c : mine; }
    if (sum == G) break;
    __builtin_amdgcn_s_sleep(1);
    if ((++sp & 255u) == 0u) { if (xb_ld(&bar[XB_TMO])) break; if (sp > XB_SPIN_CAP) { atomicAdd(&bar[XB_TMO], 1u); break; } }
  }
  nloc = mine > 0u ? mine : 1u; nx = cnt > 0u ? cnt : 1u;
}
DI void xcd_barrier(const XcdBarrier& b) {
  asm volatile("s_waitcnt vmcnt(0)" ::: "memory");
  __syncthreads();
  if (tidx() == 0) {
    unsigned* bar = b.bar;
    __builtin_amdgcn_s_waitcnt(0);
    unsigned nloc = b.st[0], nx = b.st[1];
    if (nloc == 0u) { xcd_barrier_complete(bar, b.x, nloc, nx); b.st[0] = nloc; b.st[1] = nx; }
    const unsigned old = xb_add(&bar[XB_XSUB(b.x)], 1u);
    const unsigned gen = old / nloc;
    if (old + 1u == (gen + 1u) * nloc) {
      __builtin_amdgcn_fence(__ATOMIC_RELEASE, "agent");
      asm volatile("s_waitcnt vmcnt(0)" ::: "memory");
      const unsigned og = xb_add(&bar[XB_TOP], 1u);
      const unsigned tg = og / nx;
      if (og + 1u == (tg + 1u) * nx) xb_add(&bar[XB_TOPGEN], 1u);
      else XB_SPIN(xb_ld(&bar[XB_TOPGEN]) == tg, bar);
      __builtin_amdgcn_fence(__ATOMIC_ACQUIRE, "agent");
      xb_add(&bar[XB_XGEN(b.x)], 1u);
      asm volatile("s_waitcnt vmcnt(0)" ::: "memory");
    } else {
      XB_SPIN(xb_ld(&bar[XB_XGEN(b.x)]) == gen, bar);
      __builtin_amdgcn_fence(__ATOMIC_ACQUIRE, "agent");
      asm volatile("s_waitcnt vmcnt(0)" ::: "memory");
    }
  }
  __syncthreads();
}

#if !MULTI_LAUNCH
template <int PH>
DI void run_all(const Params& p, char* smem, const XcdBarrier& xb) {
  if constexpr (PH != 12 && PH != 14 && PH != 9 && PH != 19) {
    run_phase(p, PH, smem);
    if constexpr (PH + 1 < NPHASE) {
      if constexpr (PH == 0) cg::this_grid().sync();
      else xcd_barrier(xb);
    }
  }
  if constexpr (PH + 1 < NPHASE) run_all<PH + 1>(p, smem, xb);
}
__global__ void __launch_bounds__(256, 2) trunk_kernel(Params p) {
  __shared__ __attribute__((aligned(16))) char smem[SMEM_BYTES];
  __shared__ uint4 xb_words;
  if (tidx() == 0) xb_words = make_uint4(0u, 0u, 0u, 0u);
  __syncthreads();
  const XcdBarrier xb = xcd_barrier_post((unsigned*)(p.ws + OFF_BAR), (volatile LAS unsigned*)&xb_words);
  run_all<0>(p, smem, xb);
}
#endif

extern "C" void kernel_launch(void* const* d_in, const int* in_sizes, int n_in, void* d_out, int out_size, void* d_ws, size_t ws_size,
                              hipStream_t stream) {
  Params p{};
  p.x = (const float*)d_in[0]; p.pos = (const int*)d_in[1]; p.ln_mix = (const float*)d_in[2]; p.ln_ffn = (const float*)d_in[3];
  p.gla_w_in = (const float*)d_in[4]; p.gla_w_alpha = (const float*)d_in[5]; p.gla_b_alpha = (const float*)d_in[6];
  p.gla_norm = (const float*)d_in[7]; p.gla_w_out = (const float*)d_in[8];
  p.swa_w_in = (const float*)d_in[9]; p.swa_b_in = (const float*)d_in[10]; p.swa_qn = (const float*)d_in[11]; p.swa_kn = (const float*)d_in[12];
  p.swa_sinks = (const float*)d_in[13]; p.swa_w_out = (const float*)d_in[14]; p.swa_b_out = (const float*)d_in[15];
  p.peer_wq = (const float*)d_in[16]; p.peer_keys = (const float*)d_in[17]; p.peer_u = (const float*)d_in[18]; p.peer_v = (const float*)d_in[19];
  p.out = (float*)d_out; p.ws = (char*)d_ws;
  static int grid_blocks = 0;
  if (!grid_blocks) {
    int dev = 0, cus = 0, per_cu = 0;
    (void)hipGetDevice(&dev);
    (void)hipDeviceGetAttribute(&cus, hipDeviceAttributeMultiprocessorCount, dev);
    #if MULTI_LAUNCH
    per_cu = 2;
#else
    (void)hipOccupancyMaxActiveBlocksPerMultiprocessor(&per_cu, trunk_kernel, 256, 0);
#endif
    if (per_cu < 1) per_cu = 1;
    if (per_cu > 2) per_cu = 2;
    grid_blocks = cus * per_cu;
  }
#if MULTI_LAUNCH
  p.phase_lo = 0; p.phase_hi = 0;
  launch_phases<0>(p, grid_blocks, stream);
#else
  p.phase_lo = 0; p.phase_hi = NPHASE - 1;
  void* args[] = {&p};
  (void)hipMemsetAsync((char*)d_ws + OFF_BAR, 0, XCD_BAR_WORDS * 4, stream);
  hipError_t e = hipLaunchCooperativeKernel((void*)trunk_kernel, dim3(grid_blocks), dim3(256), args, 0, stream);
  if (e != hipSuccess) fprintf(stderr, "cooperative launch failed: %s (grid %d)\n", hipGetErrorString(e), grid_blocks);
#endif
}
```
